# Optimizing an MI355X kernel written in HIP

```python
import math
import jax, jax.numpy as jnp
from jax import lax
import numpy as np

D_MODEL = 1024
BATCH = 16
SEQ = 2048
DEPTH = 4

MEM_LEN = 256

SSD_HEAD_DIM = 64
SSD_INNER = D_MODEL
SSD_HEADS = SSD_INNER // SSD_HEAD_DIM
SSD_GROUPS = 2
SSD_STATE = 64
SSD_CONV = 4
SSD_CHUNK = 128
SSD_CONV_DIM = SSD_INNER + 2 * SSD_GROUPS * SSD_STATE

SB_HEADS = 8
SB_HEAD_DIM = 64
SB_WIDTH = SB_HEADS * SB_HEAD_DIM
SB_BLOCK = 128

XA_HEADS = 4
XA_HEAD_DIM = 128
XA_WIDTH = XA_HEADS * XA_HEAD_DIM

D_FF = 2816
N_EXPERTS = 8
TOP_K = 2
N_DENSE = (DEPTH + 1) // 2
N_MOE = DEPTH // 2

IN_WIDTH = SSD_INNER + SSD_CONV_DIM + SSD_HEADS + 3 * SB_WIDTH + 2 * D_MODEL
EPS = 1e-6

kernel_name = "hybrid_ssd_stickbreaking_moe_trunk"


def rmsnorm(x, g):
    xf = x.astype(jnp.float32)
    y = xf * lax.rsqrt(jnp.mean(xf * xf, axis=-1, keepdims=True) + EPS)
    return (y * g.astype(jnp.float32)).astype(x.dtype)


def causal_dwconv(x, w, b):
    S = x.shape[1]
    K = w.shape[0]
    xp = jnp.pad(x, ((0, 0), (K - 1, 0), (0, 0)))
    y = b
    for k in range(K):
        y = y + xp[:, k:k + S] * w[k]
    return y


def ssd_branch(z, xbc, dt_raw, conv_w, conv_b, dt_bias, a_log, d_skip, norm_g):
    Bsz, S, _ = xbc.shape
    G, hg, P, N, L = SSD_GROUPS, SSD_HEADS // SSD_GROUPS, SSD_HEAD_DIM, SSD_STATE, SSD_CHUNK
    nc = S // L
    xbc = jax.nn.silu(causal_dwconv(xbc, conv_w, conv_b))
    xs, Bm, Cm = jnp.split(xbc, [SSD_INNER, SSD_INNER + G * N], axis=-1)
    x = xs.reshape(Bsz, nc, L, G, hg, P)
    Bm = Bm.reshape(Bsz, nc, L, G, N)
    Cm = Cm.reshape(Bsz, nc, L, G, N)
    dt = jax.nn.softplus((dt_raw + dt_bias).astype(jnp.float32))
    a = (dt * -jnp.exp(a_log.astype(jnp.float32))).reshape(Bsz, nc, L, G, hg)
    xdt = x * dt.reshape(Bsz, nc, L, G, hg)[..., None].astype(x.dtype)
    a_cum = jnp.cumsum(a, axis=2)
    causal = jnp.tril(jnp.ones((L, L), dtype=bool))
    seg = a_cum[:, :, :, None] - a_cum[:, :, None, :]
    decay = jnp.exp(jnp.where(causal[:, :, None, None], seg, -jnp.inf))
    cb = jnp.einsum('bctgn,bcsgn->bctsg', Cm, Bm)
    y_diag = jnp.einsum('bctsgh,bcsghp->bctghp', (cb[..., None] * decay).astype(x.dtype), xdt)
    decay_to_end = jnp.exp(a_cum[:, :, -1:] - a_cum)
    states = jnp.einsum('bclgn,bclghp->bcghpn', Bm, xdt * decay_to_end[..., None].astype(x.dtype))
    chunk_decay = jnp.exp(a_cum[:, :, -1]).astype(states.dtype)

    def step(carry, inp):
        st, dec = inp
        return carry * dec[..., None, None] + st, carry

    _, prev = lax.scan(step, jnp.zeros_like(states[:, 0]),
                       (jnp.moveaxis(states, 1, 0), jnp.moveaxis(chunk_decay, 1, 0)))
    prev = jnp.moveaxis(prev, 0, 1)
    y_off = jnp.einsum('bctgn,bcghpn->bctghp', Cm, prev) * jnp.exp(a_cum)[..., None].astype(x.dtype)
    y = y_diag + y_off + x * d_skip.reshape(G, hg)[:, :, None]
    y = y.reshape(Bsz, S, SSD_INNER) * jax.nn.silu(z)
    y = rmsnorm(y.reshape(Bsz, S, G, SSD_INNER // G), norm_g.reshape(G, SSD_INNER // G))
    return y.reshape(Bsz, S, SSD_INNER)


def stick_breaking_attention(qkv):
    Bsz, S, _ = qkv.shape
    q, k, v = jnp.split(qkv, 3, axis=-1)
    q = q.reshape(Bsz, S, SB_HEADS, SB_HEAD_DIM).transpose(0, 2, 1, 3)
    k = k.reshape(Bsz, S, SB_HEADS, SB_HEAD_DIM).transpose(0, 2, 1, 3)
    v = v.reshape(Bsz, S, SB_HEADS, SB_HEAD_DIM).transpose(0, 2, 1, 3)
    scale = SB_HEAD_DIM ** -0.5
    outs = []
    for blk in range(S // SB_BLOCK):
        t0 = blk * SB_BLOCK
        t1 = t0 + SB_BLOCK
        zb = jnp.einsum('bhtd,bhsd->bhts', q[:, :, t0:t1], k[:, :, :t1]).astype(jnp.float32) * scale
        t_idx = t0 + jnp.arange(SB_BLOCK)
        s_idx = jnp.arange(t1)
        mask = s_idx[None, :] < t_idx[:, None]
        log_keep = jnp.where(mask, jax.nn.log_sigmoid(-zb), 0.0)
        log_between = lax.cumsum(log_keep, axis=3, reverse=True) - log_keep
        att = jnp.where(mask, jnp.exp(jax.nn.log_sigmoid(zb) + log_between), 0.0)
        outs.append(jnp.einsum('bhts,bhsd->bthd', att.astype(v.dtype), v[:, :, :t1]))
    return jnp.concatenate(outs, axis=1).reshape(Bsz, S, SB_WIDTH)


def cross_attention(h, mem_n, wq, wk, wv, wo):
    Bsz, S, _ = h.shape
    M = mem_n.shape[1]
    q = (h @ wq).reshape(Bsz, S, XA_HEADS, XA_HEAD_DIM)
    k = (mem_n @ wk).reshape(Bsz, M, XA_HEADS, XA_HEAD_DIM)
    v = (mem_n @ wv).reshape(Bsz, M, XA_HEADS, XA_HEAD_DIM)
    s = jnp.einsum('bshd,bmhd->bhsm', q, k).astype(jnp.float32) * (XA_HEAD_DIM ** -0.5)
    p = jax.nn.softmax(s, axis=-1).astype(v.dtype)
    o = jnp.einsum('bhsm,bmhd->bshd', p, v).reshape(Bsz, S, XA_WIDTH)
    return o @ wo


def swiglu(u, w_gate, w_up, w_down):
    return (jax.nn.silu(u @ w_gate) * (u @ w_up)) @ w_down


def moe_ffn(u, w_router, w_gate, w_up, w_down):
    logits = (u @ w_router).astype(jnp.float32)
    top_val, top_idx = lax.top_k(logits, TOP_K)
    top_w = jax.nn.softmax(top_val, axis=-1)
    combine = jnp.sum(jax.nn.one_hot(top_idx, N_EXPERTS, dtype=jnp.float32) * top_w[..., None],
                      axis=-2).astype(u.dtype)
    out = jnp.zeros_like(u)
    for e in range(N_EXPERTS):
        out = out + combine[..., e:e + 1] * swiglu(u, w_gate[e], w_up[e], w_down[e])
    return out


def setup_inputs(seed: int = 0) -> dict:
    key = jax.random.key(seed)
    ks = jax.random.split(key, 32)

    def dense(k, shape, fan_in):
        return jax.random.normal(k, shape, jnp.float32) * (fan_in ** -0.5)

    def gain(k, shape):
        return 1.0 + 0.05 * jax.random.normal(k, shape, jnp.float32)

    dt0 = jnp.exp(jax.random.uniform(ks[7], (DEPTH, SSD_HEADS), jnp.float32,
                                     math.log(1e-3), math.log(1e-1)))
    return {
        "x": jax.random.normal(ks[0], (BATCH, SEQ, D_MODEL), jnp.float32),
        "mem": jax.random.normal(ks[1], (BATCH, MEM_LEN, D_MODEL), jnp.float32),
        "norm_mix": gain(ks[2], (DEPTH, D_MODEL)),
        "w_in": dense(ks[3], (DEPTH, D_MODEL, IN_WIDTH), D_MODEL),
        "conv_w": dense(ks[4], (DEPTH, SSD_CONV, SSD_CONV_DIM), SSD_CONV),
        "conv_b": 0.02 * jax.random.normal(ks[5], (DEPTH, SSD_CONV_DIM), jnp.float32),
        "dt_bias": dt0 + jnp.log(-jnp.expm1(-dt0)),
        "a_log": jnp.log(jax.random.uniform(ks[8], (DEPTH, SSD_HEADS), jnp.float32, 1.0, 16.0)),
        "d_skip": gain(ks[9], (DEPTH, SSD_HEADS)),
        "ssd_norm": gain(ks[10], (DEPTH, SSD_INNER)),
        "w_ssd_o": dense(ks[11], (DEPTH, SSD_INNER, D_MODEL), SSD_INNER),
        "w_sb_o": dense(ks[12], (DEPTH, SB_WIDTH, D_MODEL), SB_WIDTH),
        "w_out": dense(ks[13], (DEPTH, D_MODEL, D_MODEL), D_MODEL),
        "norm_xa": gain(ks[14], (DEPTH, D_MODEL)),
        "norm_mem": gain(ks[15], (DEPTH, D_MODEL)),
        "xa_wq": dense(ks[16], (DEPTH, D_MODEL, XA_WIDTH), D_MODEL),
        "xa_wk": dense(ks[17], (DEPTH, D_MODEL, XA_WIDTH), D_MODEL),
        "xa_wv": dense(ks[18], (DEPTH, D_MODEL, XA_WIDTH), D_MODEL),
        "xa_wo": dense(ks[19], (DEPTH, XA_WIDTH, D_MODEL), XA_WIDTH),
        "norm_ffn": gain(ks[20], (DEPTH, D_MODEL)),
        "ffn_w_gate": dense(ks[21], (N_DENSE, D_MODEL, D_FF), D_MODEL),
        "ffn_w_up": dense(ks[22], (N_DENSE, D_MODEL, D_FF), D_MODEL),
        "ffn_w_down": dense(ks[23], (N_DENSE, D_FF, D_MODEL), D_FF),
        "moe_router": dense(ks[24], (N_MOE, D_MODEL, N_EXPERTS), D_MODEL),
        "moe_w_gate": dense(ks[25], (N_MOE, N_EXPERTS, D_MODEL, D_FF), D_MODEL),
        "moe_w_up": dense(ks[26], (N_MOE, N_EXPERTS, D_MODEL, D_FF), D_MODEL),
        "moe_w_down": dense(ks[27], (N_MOE, N_EXPERTS, D_FF, D_MODEL), D_FF),
        "final_norm": gain(ks[28], (D_MODEL,)),
    }


def reference(x, mem, norm_mix, w_in, conv_w, conv_b, dt_bias, a_log, d_skip, ssd_norm,
              w_ssd_o, w_sb_o, w_out, norm_xa, norm_mem, xa_wq, xa_wk, xa_wv, xa_wo,
              norm_ffn, ffn_w_gate, ffn_w_up, ffn_w_down, moe_router, moe_w_gate,
              moe_w_up, moe_w_down, final_norm):
    offsets = [SSD_INNER,
               SSD_INNER + SSD_CONV_DIM,
               SSD_INNER + SSD_CONV_DIM + SSD_HEADS,
               SSD_INNER + SSD_CONV_DIM + SSD_HEADS + 3 * SB_WIDTH,
               SSD_INNER + SSD_CONV_DIM + SSD_HEADS + 3 * SB_WIDTH + D_MODEL]
    h = x
    for i in range(DEPTH):
        u = rmsnorm(h, norm_mix[i])
        proj = u @ w_in[i]
        z, xbc, dt_raw, qkv, g_ssd, g_sb = jnp.split(proj, offsets, axis=-1)
        y_ssd = ssd_branch(z, xbc, dt_raw, conv_w[i], conv_b[i], dt_bias[i], a_log[i],
                           d_skip[i], ssd_norm[i])
        y_sb = stick_breaking_attention(qkv)
        merged = (jax.nn.sigmoid(g_ssd) * (y_ssd @ w_ssd_o[i])
                  + jax.nn.sigmoid(g_sb) * (y_sb @ w_sb_o[i]))
        h = h + merged @ w_out[i]
        h = h + cross_attention(rmsnorm(h, norm_xa[i]), rmsnorm(mem, norm_mem[i]),
                                xa_wq[i], xa_wk[i], xa_wv[i], xa_wo[i])
        u = rmsnorm(h, norm_ffn[i])
        j = i // 2
        if i % 2 == 0:
            h = h + swiglu(u, ffn_w_gate[j], ffn_w_up[j], ffn_w_down[j])
        else:
            h = h + moe_ffn(u, moe_router[j], moe_w_gate[j], moe_w_up[j], moe_w_down[j])
    return rmsnorm(h, final_norm)
```

```cpp
#include <hip/hip_runtime.h>
#include <cstdio>
#include <cstdint>

#define LAS __attribute__((address_space(3)))
#define GAS __attribute__((address_space(1)))
typedef unsigned short bf16_t;
typedef short bf16x8 __attribute__((ext_vector_type(8)));
typedef float f32x4 __attribute__((ext_vector_type(4)));
typedef float f32x2 __attribute__((ext_vector_type(2)));
typedef unsigned u32x4 __attribute__((ext_vector_type(4)));
typedef unsigned u32x2 __attribute__((ext_vector_type(2)));

#ifndef MK_ONE_LAUNCH
#define MK_ONE_LAUNCH 1
#endif

constexpr int T = 32768, D = 1024, SEQ = 2048, NBATCH = 16, DEPTH = 4, MEMLEN = 256, TM = NBATCH * MEMLEN;
constexpr int INW = 5904, NPROJ = 5888, DFF = 2816, NEXP = 8;
constexpr int MOE_ROWS = T + NEXP * 256;
constexpr int MOE_PAN = MOE_ROWS / 256;
constexpr float EPS = 1e-6f;

constexpr size_t MiB = 1u << 20;
constexpr size_t WS_CTL = 0;
constexpr size_t WS_RS = 1 * MiB;
constexpr size_t WS_RSMEM = WS_RS + 256 * 1024;
constexpr size_t WS_DT = 2 * MiB;
constexpr size_t WS_MOE = 4 * MiB;
constexpr size_t WS_KVM = 8 * MiB;
constexpr size_t WS_MEMB = 40 * MiB;
constexpr size_t WS_HB = 48 * MiB;
constexpr size_t WS_W = 112 * MiB;
constexpr size_t W_IN = 0, W_SSDO = W_IN + (size_t)NPROJ * 1024 * 2, W_SBO = W_SSDO + 2 * MiB, W_OUT = W_SBO + 1 * MiB, W_Q = W_OUT + 2 * MiB, W_O = W_Q + 1 * MiB, W_LAYER = W_O + 1 * MiB;
constexpr size_t WS_WKV = WS_W + 4 * W_LAYER;
constexpr size_t WS_WFF = WS_WKV + 8 * MiB;
constexpr size_t W_GU = 0, W_DN = (size_t)2 * DFF * 1024 * 2, W_FF = W_DN + (size_t)1024 * DFF * 2;
constexpr size_t WS_WMOE = WS_WFF + 2 * W_FF;
constexpr size_t WM_GU = 0, WM_DN = (size_t)NEXP * 2 * DFF * 1024 * 2;
constexpr size_t WS_X = WS_WMOE + NEXP * W_FF;
constexpr size_t X_Z = 0, X_XBC = X_Z + 64 * MiB, X_XC = X_XBC + 80 * MiB, X_Q = X_XC + 80 * MiB, X_K = X_Q + 32 * MiB, X_V = X_K + 32 * MiB, X_GS = X_V + 32 * MiB, X_END = X_GS + 128 * MiB;
constexpr size_t X_ACT = 0;
constexpr size_t X_XG = 192 * MiB;
constexpr size_t WS_END = WS_X + X_END;
static_assert(X_XG + (size_t)2 * MOE_ROWS * 1024 * 2 <= X_END, "moe region");
static_assert((size_t)MOE_ROWS * DFF * 2 <= X_XG, "act region");
constexpr size_t MO_TE = 0, MO_TW = MO_TE + 2 * T * 4, MO_TP = MO_TW + 2 * T * 4, MO_ROWL = MO_TP + 2 * T * 4, MO_WROW = MO_ROWL + 2 * MOE_ROWS * 4, MO_RSG = MO_WROW + 2 * MOE_ROWS * 4,
                 MO_PEXP = MO_RSG + 2 * MOE_ROWS * 4, MO_NPAN = MO_PEXP + 2 * 256 * 4, MO_END = MO_NPAN + 256;
static_assert(MO_END <= 4 * MiB, "moe tables");
constexpr int CW_BAR = 4096;
constexpr int CW_CNT = 16384;

constexpr int RING_BYTES = 155648;
constexpr int LDSCTL_OFF = RING_BYTES;
constexpr int LDS_BYTES = 160 * 1024;

__device__ __forceinline__ float bf2f(unsigned b) { return __builtin_bit_cast(float, b << 16); }
__device__ __forceinline__ float bflo(unsigned w) { return __builtin_bit_cast(float, w << 16); }
__device__ __forceinline__ float bfhi(unsigned w) { return __builtin_bit_cast(float, w & 0xffff0000u); }
__device__ __forceinline__ unsigned cvt_pk_bf16(float lo, float hi) { unsigned r; asm volatile("v_cvt_pk_bf16_f32 %0, %1, %2" : "=v"(r) : "v"(lo), "v"(hi)); return r; }
__device__ __forceinline__ unsigned short f2bf(float f) { return (unsigned short)(cvt_pk_bf16(f, 0.f) & 0xffffu); }
__device__ __forceinline__ float wave_sum(float v) {
#pragma unroll
    for (int o = 1; o < 64; o <<= 1) v += __shfl_xor(v, o);
    return v;
}
__device__ __forceinline__ float wave_max(float v) {
#pragma unroll
    for (int o = 1; o < 64; o <<= 1) v = fmaxf(v, __shfl_xor(v, o));
    return v;
}
__device__ __forceinline__ float sigmoidf_(float x) { return __builtin_amdgcn_rcpf(1.f + __builtin_amdgcn_exp2f(-1.4426950408889634f * x)); }
__device__ __forceinline__ unsigned ld_u32_agent(const unsigned* p) { return __hip_atomic_load(p, __ATOMIC_RELAXED, __HIP_MEMORY_SCOPE_AGENT); }
__device__ __forceinline__ float ld_f32_agent(const float* p) { return __builtin_bit_cast(float, __hip_atomic_load((const unsigned*)p, __ATOMIC_RELAXED, __HIP_MEMORY_SCOPE_AGENT)); }
#define LDS_WAIT() asm volatile("s_waitcnt lgkmcnt(0)" ::: "memory")

namespace pg8 {
constexpr int BM = 256, BK = 64, HALF = 128, HTB = HALF * BK * 2, STAGE_BYTES = 8 * HTB, NXCD = 8, WGM = 8;
__host__ __device__ __forceinline__ int lds_byte(int r, int c) { const int st = (r >> 4) * 2 + (c >> 5), rr = r & 15, cc = c & 31, ob = rr * 64 + cc * 2; return st * 1024 + (ob ^ (((ob >> 9) & 1) << 5)); }
__host__ __device__ __forceinline__ void stage_rc(int b, int& R, int& C) { const int st = b / 1024, sb = b % 1024, swz = sb ^ (((sb >> 9) & 1) << 5); R = (st >> 1) * 16 + swz / 64; C = (st & 1) * 32 + (swz % 64) / 2; }
__host__ __device__ __forceinline__ int perm32(int rho) { const int n = rho >> 4, i = rho & 15; return 8 * (i >> 2) + 4 * n + (i & 3); }

struct Unit { int pm, pn, pb; };
struct Gemm { const bf16_t* A; const bf16_t* Bt; int lda, ldb, K; };

struct StaticOrder {
    int nM, nN, nwg, G, c;
    __device__ void init(int M, int N, int G_, int c_) { nM = M / BM; nN = N / BM; nwg = nM * nN; G = G_; c = c_; }
    __device__ bool next(int i, Unit& u) const {
        const long L = (long)i * G + c; if (L >= nwg) return false;
        int wgid = (int)L; { const int q = nwg / NXCD, r = nwg % NXCD, xcd = wgid % NXCD, off = wgid / NXCD; wgid = (xcd < r ? xcd * (q + 1) : r * (q + 1) + (xcd - r) * q) + off; }
        const int nig = WGM * nN, gid = wgid / nig, fm = gid * WGM, gsz = (nM - fm) < WGM ? (nM - fm) : WGM;
        u.pm = fm + ((wgid % nig) % gsz); u.pn = (wgid % nig) / gsz; u.pb = u.pn; return true;
    }
};
struct MoeOrder {
    int nM, nN, nwg, G, c; const unsigned* pexp;
    __device__ void init(int nM_, int nN_, int G_, int c_, const unsigned* pexp_) { nM = nM_; nN = nN_; nwg = nM * nN; G = G_; c = c_; pexp = pexp_; }
    __device__ bool next(int i, Unit& u) const {
        const long L = (long)i * G + c; if (L >= nwg) return false;
        int wgid = (int)L; { const int q = nwg / NXCD, r = nwg % NXCD, xcd = wgid % NXCD, off = wgid / NXCD; wgid = (xcd < r ? xcd * (q + 1) : r * (q + 1) + (xcd - r) * q) + off; }
        const int nig = WGM * nN, gid = wgid / nig, fm = gid * WGM, gsz = (nM - fm) < WGM ? (nM - fm) : WGM;
        u.pm = fm + ((wgid % nig) % gsz); u.pn = (wgid % nig) / gsz;
        const int e = (int)__builtin_amdgcn_readfirstlane(ld_u32_agent(pexp + u.pm)); u.pb = e * nN + u.pn; return true;
    }
};

template <class Epi, class Sched, bool ALIGN_EPI = false, bool SP2 = false>
__device__ __forceinline__ void gemm_phase(LAS unsigned char* lds, const Gemm g, const Sched& S, const Epi& E) {
    int tid_ = threadIdx.x; asm volatile("" : "+v"(tid_));
    const int tid = tid_, wid = __builtin_amdgcn_readfirstlane(tid >> 6), lane = tid & 63, wr = wid >> 2, wc = wid & 3, fr = lane & 15, fq = lane >> 4;
    const int K = g.K, nt = K / BK;
    unsigned voffA[2], voffB[2];
#pragma unroll
    for (int i = 0; i < 2; ++i) { int R, C; stage_rc(tid * 16 + i * 8192, R, C); const int Rb = Epi::PERM ? ((R & ~31) + perm32(R & 31)) : R;
        voffA[i] = (unsigned)(R * g.lda + C) * 2u; voffB[i] = (unsigned)(Rb * g.ldb + C) * 2u; }
    const size_t kstep = (size_t)(BK * 2);
    const size_t hsA = (size_t)HALF * g.lda * 2, hsB = (size_t)HALF * g.ldb * 2;
    const size_t tsA = 2 * hsA, tsB = 2 * hsB;
    const unsigned ldsw = (unsigned)wid * 1024u;
    const int aoff = lds_byte(wr * 64 + fr, fq * 8), boff = lds_byte(wc * 32 + fr, fq * 8);
#define PG8_SA(b, h) (((b) * 2 + (h)) * HTB)
#define PG8_SB(b, h) ((4 + (b) * 2 + (h)) * HTB)
#define PG8_STAGE(bufoff, gbase, voff) do { _Pragma("unroll") for (int _i = 0; _i < 2; ++_i) \
        __builtin_amdgcn_global_load_lds((const unsigned*)((const char*)(gbase) + (voff)[_i]), (LAS unsigned*)(lds + (bufoff) + ldsw + _i * 8192), 16, 0, 0); } while (0)
#define PG8_LDA(dst, b, h) do { _Pragma("unroll") for (int m = 0; m < 4; ++m) _Pragma("unroll") for (int k = 0; k < 2; ++k) dst[m][k] = *(const LAS bf16x8*)(lds + PG8_SA(b, h) + aoff + m * 2048 + k * 1024); } while (0)
#define PG8_LDB(dst, b, h) do { _Pragma("unroll") for (int n = 0; n < 2; ++n) _Pragma("unroll") for (int k = 0; k < 2; ++k) dst[n][k] = *(const LAS bf16x8*)(lds + PG8_SB(b, h) + boff + n * 2048 + k * 1024); } while (0)
#define PG8_MMA(ai, bj, At, Bt) do { __builtin_amdgcn_s_setprio(1); _Pragma("unroll") for (int m = 0; m < 4; ++m) _Pragma("unroll") for (int n = 0; n < 2; ++n) _Pragma("unroll") for (int k = 0; k < 2; ++k) \
        acc[ai][bj][m][n] = __builtin_amdgcn_mfma_f32_16x16x32_bf16(Bt[n][k], At[m][k], acc[ai][bj][m][n], 0, 0, 0); __builtin_amdgcn_s_setprio(0); } while (0)
#define PG8_WAIT_V(n) asm volatile("s_waitcnt vmcnt(" #n ")" ::: "memory")
#define PG8_WAIT_L(n) asm volatile("s_waitcnt lgkmcnt(" #n ")" ::: "memory")
#define PG8_BAR __builtin_amdgcn_s_barrier()
#define PG8_SCHED __builtin_amdgcn_sched_barrier(0)
    Unit cur, nxt; int ui = 0;
    if (!S.next(0, cur)) return;
    f32x4 acc[2][2][4][2];
#pragma unroll
    for (int a = 0; a < 2; ++a)
#pragma unroll
        for (int b = 0; b < 2; ++b)
#pragma unroll
            for (int m = 0; m < 4; ++m)
#pragma unroll
                for (int n = 0; n < 2; ++n) acc[a][b][m][n] = (f32x4){0.f, 0.f, 0.f, 0.f};
    bf16x8 At[4][2], B0[2][2], B1[2][2];
    const char* cA = (const char*)g.A + (size_t)cur.pm * tsA; const char* cB = (const char*)g.Bt + (size_t)cur.pb * tsB;
    if constexpr (SP2) {
        PG8_STAGE(PG8_SB(0, 0), cB, voffB); PG8_STAGE(PG8_SB(0, 1), cB + hsB, voffB); PG8_STAGE(PG8_SA(0, 0), cA, voffA); PG8_STAGE(PG8_SA(0, 1), cA + hsA, voffA);
        if (wr == 1) PG8_BAR;
        PG8_WAIT_V(2); PG8_BAR;
        PG8_STAGE(PG8_SB(1, 0), cB + kstep, voffB); PG8_STAGE(PG8_SA(1, 0), cA + kstep, voffA); PG8_STAGE(PG8_SB(1, 1), cB + hsB + kstep, voffB);
        PG8_WAIT_V(6); PG8_BAR;
    } else {
        PG8_STAGE(PG8_SB(0, 0), cB, voffB); PG8_STAGE(PG8_SA(0, 0), cA, voffA); PG8_STAGE(PG8_SB(0, 1), cB + hsB, voffB); PG8_STAGE(PG8_SA(0, 1), cA + hsA, voffA);
        if (wr == 1) PG8_BAR;
        PG8_WAIT_V(4); PG8_BAR;
        PG8_STAGE(PG8_SB(1, 0), cB + kstep, voffB); PG8_STAGE(PG8_SA(1, 0), cA + kstep, voffA); PG8_STAGE(PG8_SB(1, 1), cB + hsB + kstep, voffB);
        PG8_WAIT_V(6); PG8_BAR;
    }
    for (;;) {
        const bool has_next = S.next(ui + 1, nxt);
        const char* nA = has_next ? (const char*)g.A + (size_t)nxt.pm * tsA : cA; const char* nB = has_next ? (const char*)g.Bt + (size_t)nxt.pb * tsB : cB;
        for (int t = 0; t < nt; t += 2) {
            const bool last = (t == nt - 2);
            const char* a1 = cA + (size_t)(t + 1) * kstep;
            const char* a2 = last ? nA : cA + (size_t)(t + 2) * kstep; const char* b2 = last ? nB : cB + (size_t)(t + 2) * kstep;
            const char* a3 = a2 + kstep; const char* b3 = b2 + kstep;
            if constexpr (SP2) {
            PG8_LDB(B0, 0, 0); PG8_LDB(B1, 0, 1); PG8_SCHED; PG8_LDA(At, 0, 0); PG8_STAGE(PG8_SA(1, 1), a1 + hsA, voffA);
            PG8_WAIT_V(8); PG8_WAIT_L(0); PG8_BAR; PG8_MMA(0, 0, At, B0); PG8_MMA(0, 1, At, B1); PG8_BAR; PG8_SCHED;
            PG8_LDA(At, 0, 1); PG8_STAGE(PG8_SB(0, 0), b2, voffB); PG8_STAGE(PG8_SB(0, 1), b2 + hsB, voffB); PG8_STAGE(PG8_SA(0, 0), a2, voffA);
            PG8_WAIT_V(8); PG8_WAIT_L(0); PG8_BAR; PG8_MMA(1, 0, At, B0); PG8_MMA(1, 1, At, B1); PG8_BAR; PG8_SCHED;
            PG8_LDB(B0, 1, 0); PG8_LDB(B1, 1, 1); PG8_SCHED; PG8_LDA(At, 1, 0); PG8_STAGE(PG8_SA(0, 1), a2 + hsA, voffA);
            PG8_WAIT_V(8); PG8_WAIT_L(0); PG8_BAR; PG8_MMA(0, 0, At, B0); PG8_MMA(0, 1, At, B1); PG8_BAR; PG8_SCHED;
            PG8_LDA(At, 1, 1); PG8_STAGE(PG8_SB(1, 0), b3, voffB); PG8_STAGE(PG8_SB(1, 1), b3 + hsB, voffB); PG8_STAGE(PG8_SA(1, 0), a3, voffA);
            PG8_WAIT_V(8); PG8_WAIT_L(0); PG8_BAR; PG8_MMA(1, 0, At, B0); PG8_MMA(1, 1, At, B1); PG8_BAR; PG8_SCHED;
            } else {
            PG8_LDB(B0, 0, 0); PG8_SCHED; PG8_LDA(At, 0, 0); PG8_STAGE(PG8_SA(1, 1), a1 + hsA, voffA);
            PG8_WAIT_L(8); PG8_BAR; PG8_WAIT_L(0); PG8_MMA(0, 0, At, B0); PG8_BAR; PG8_SCHED;
            PG8_LDB(B1, 0, 1); PG8_STAGE(PG8_SB(0, 0), b2, voffB);
            PG8_BAR; PG8_WAIT_L(0); PG8_MMA(0, 1, At, B1); PG8_BAR;
            PG8_LDA(At, 0, 1); PG8_STAGE(PG8_SA(0, 0), a2, voffA);
            PG8_BAR; PG8_WAIT_L(0); PG8_MMA(1, 0, At, B0); PG8_BAR; PG8_SCHED;
            PG8_STAGE(PG8_SB(0, 1), b2 + hsB, voffB);
            PG8_WAIT_V(6); PG8_BAR; PG8_MMA(1, 1, At, B1); PG8_BAR;
            PG8_LDB(B0, 1, 0); PG8_SCHED; PG8_LDA(At, 1, 0); PG8_STAGE(PG8_SA(0, 1), a2 + hsA, voffA);
            PG8_WAIT_L(8); PG8_BAR; PG8_WAIT_L(0); PG8_MMA(0, 0, At, B0); PG8_BAR; PG8_SCHED;
            PG8_LDB(B1, 1, 1); PG8_STAGE(PG8_SB(1, 0), b3, voffB);
            PG8_BAR; PG8_WAIT_L(0); PG8_MMA(0, 1, At, B1); PG8_BAR;
            PG8_LDA(At, 1, 1); PG8_STAGE(PG8_SA(1, 0), a3, voffA);
            PG8_BAR; PG8_WAIT_L(0); PG8_MMA(1, 0, At, B0); PG8_BAR; PG8_SCHED;
            PG8_STAGE(PG8_SB(1, 1), b3 + hsB, voffB);
            PG8_WAIT_V(6); PG8_BAR; PG8_MMA(1, 1, At, B1); PG8_BAR;
            }
        }
        if constexpr (ALIGN_EPI) { if (wr == 0) PG8_BAR; }
        E(acc, cur, wr, wc, fr, fq);
        if (!has_next) break;
#pragma unroll
        for (int a = 0; a < 2; ++a)
#pragma unroll
            for (int b = 0; b < 2; ++b)
#pragma unroll
                for (int m = 0; m < 4; ++m)
#pragma unroll
                    for (int n = 0; n < 2; ++n) acc[a][b][m][n] = (f32x4){0.f, 0.f, 0.f, 0.f};
        cur = nxt; cA = nA; cB = nB; ++ui;
        if constexpr (ALIGN_EPI) { if (wr == 1) PG8_BAR; }
    }
    PG8_WAIT_V(0);
    if constexpr (!ALIGN_EPI) { if (wr == 0) PG8_BAR; }
    PG8_BAR;
#undef PG8_SA
#undef PG8_SB
#undef PG8_STAGE
#undef PG8_LDA
#undef PG8_LDB
#undef PG8_MMA
#undef PG8_WAIT_V
#undef PG8_WAIT_L
#undef PG8_BAR
#undef PG8_SCHED
}

typedef const f32x4 (&AccT)[2][2][4][2];
#define EPI_FENCE() asm volatile("" ::: "memory")

struct EpiInProj {
    static constexpr bool PERM = true;
    unsigned char* xbase; const float* rs;
    __device__ __forceinline__ void operator()(AccT acc, const Unit& u, int wr, int wc, int fr, int fq) const {
        const int pn = u.pn; size_t boff; int ld, ct; bool sig = false;
        if (pn < 4) { boff = X_Z; ld = 1024; ct = pn; }
        else if (pn < 9) { boff = X_XBC; ld = 1280; ct = pn - 4; }
        else if (pn < 11) { boff = X_Q; ld = 512; ct = pn - 9; }
        else if (pn < 13) { boff = X_K; ld = 512; ct = pn - 11; }
        else if (pn < 15) { boff = X_V; ld = 512; ct = pn - 13; }
        else { boff = X_GS; ld = 2048; ct = pn - 15; sig = true; }
        const unsigned lo = (unsigned)(fr * ld + 8 * fq) * 2u;
        unsigned char* tb = xbase + boff + ((size_t)(u.pm * BM + wr * 64) * ld + ct * BM + wc * 32) * 2;
        const float* rsb = rs + u.pm * BM + wr * 64;
#pragma unroll
        for (int ai = 0; ai < 2; ++ai)
#pragma unroll
            for (int m = 0; m < 4; ++m) { const float r = rsb[ai * HALF + m * 16 + fr]; unsigned char* rowp = tb + (size_t)(ai * HALF + m * 16) * ld * 2;
#pragma unroll
                for (int bj = 0; bj < 2; ++bj) { f32x4 v0 = acc[ai][bj][m][0] * r, v1 = acc[ai][bj][m][1] * r;
                    if (sig) {
#pragma unroll
                        for (int j = 0; j < 4; ++j) { v0[j] = sigmoidf_(v0[j]); v1[j] = sigmoidf_(v1[j]); } }
                    u32x4 w; w.x = cvt_pk_bf16(v0[0], v0[1]); w.y = cvt_pk_bf16(v0[2], v0[3]); w.z = cvt_pk_bf16(v1[0], v1[1]); w.w = cvt_pk_bf16(v1[2], v1[3]);
                    *(u32x4*)(rowp + lo + bj * HALF * 2) = w; }
                EPI_FENCE(); }
    }
};
struct EpiBf16Rs {
    static constexpr bool PERM = true;
    bf16_t* O; int ldc; const float* rs; float sc;
    __device__ __forceinline__ void operator()(AccT acc, const Unit& u, int wr, int wc, int fr, int fq) const {
        const unsigned lo = (unsigned)(fr * ldc + 8 * fq) * 2u;
        unsigned char* tb = (unsigned char*)O + ((size_t)(u.pm * BM + wr * 64) * ldc + u.pn * BM + wc * 32) * 2;
        const float* rsb = rs + u.pm * BM + wr * 64;
#pragma unroll
        for (int ai = 0; ai < 2; ++ai)
#pragma unroll
            for (int m = 0; m < 4; ++m) { const float r = rsb[ai * HALF + m * 16 + fr] * sc; unsigned char* rowp = tb + (size_t)(ai * HALF + m * 16) * ldc * 2;
#pragma unroll
                for (int bj = 0; bj < 2; ++bj) { const f32x4 v0 = acc[ai][bj][m][0] * r, v1 = acc[ai][bj][m][1] * r;
                    u32x4 w; w.x = cvt_pk_bf16(v0[0], v0[1]); w.y = cvt_pk_bf16(v0[2], v0[3]); w.z = cvt_pk_bf16(v1[0], v1[1]); w.w = cvt_pk_bf16(v1[2], v1[3]);
                    *(u32x4*)(rowp + lo + bj * HALF * 2) = w; }
                EPI_FENCE(); }
    }
};
template <bool ADD> struct EpiGate {
    static constexpr bool PERM = true;
    bf16_t* O; const bf16_t* GS; int gcol0;
    __device__ __forceinline__ void operator()(AccT acc, const Unit& u, int wr, int wc, int fr, int fq) const {
        const unsigned lo = (unsigned)(fr * 1024 + 8 * fq) * 2u, lg = (unsigned)(fr * 2048 + 8 * fq) * 2u;
        unsigned char* tb = (unsigned char*)O + ((size_t)(u.pm * BM + wr * 64) * 1024 + u.pn * BM + wc * 32) * 2;
        const unsigned char* gb = (const unsigned char*)GS + ((size_t)(u.pm * BM + wr * 64) * 2048 + gcol0 + u.pn * BM + wc * 32) * 2;
#pragma unroll
        for (int ai = 0; ai < 2; ++ai)
#pragma unroll
            for (int m = 0; m < 4; ++m) { unsigned char* rowp = tb + (size_t)(ai * HALF + m * 16) * 1024 * 2; const unsigned char* gp = gb + (size_t)(ai * HALF + m * 16) * 2048 * 2;
#pragma unroll
                for (int bj = 0; bj < 2; ++bj) { const u32x4 gw = *(const u32x4*)(gp + lg + bj * HALF * 2); f32x4 v0 = acc[ai][bj][m][0], v1 = acc[ai][bj][m][1];
                    v0[0] *= bflo(gw.x); v0[1] *= bfhi(gw.x); v0[2] *= bflo(gw.y); v0[3] *= bfhi(gw.y); v1[0] *= bflo(gw.z); v1[1] *= bfhi(gw.z); v1[2] *= bflo(gw.w); v1[3] *= bfhi(gw.w);
                    if (ADD) { const u32x4 pw = *(const u32x4*)(rowp + lo + bj * HALF * 2);
                        v0[0] += bflo(pw.x); v0[1] += bfhi(pw.x); v0[2] += bflo(pw.y); v0[3] += bfhi(pw.y); v1[0] += bflo(pw.z); v1[1] += bfhi(pw.z); v1[2] += bflo(pw.w); v1[3] += bfhi(pw.w); }
                    u32x4 w; w.x = cvt_pk_bf16(v0[0], v0[1]); w.y = cvt_pk_bf16(v0[2], v0[3]); w.z = cvt_pk_bf16(v1[0], v1[1]); w.w = cvt_pk_bf16(v1[2], v1[3]);
                    *(u32x4*)(rowp + lo + bj * HALF * 2) = w; }
                EPI_FENCE(); }
    }
};
struct EpiResid {
    static constexpr bool PERM = false;
    const float* Hin; float* Hout;
    __device__ __forceinline__ void operator()(AccT acc, const Unit& u, int wr, int wc, int fr, int fq) const {
        const unsigned lo = (unsigned)(fr * 1024 + 4 * fq) * 4u;
        const size_t ub = ((size_t)(u.pm * BM + wr * 64) * 1024 + u.pn * BM + wc * 32) * 4;
#pragma unroll
        for (int ai = 0; ai < 2; ++ai)
#pragma unroll
            for (int m = 0; m < 4; ++m) { const size_t ro = ub + (size_t)(ai * HALF + m * 16) * 1024 * 4; const unsigned char* hi = (const unsigned char*)Hin + ro; unsigned char* ho = (unsigned char*)Hout + ro;
                f32x4 hv[2][2];
#pragma unroll
                for (int bj = 0; bj < 2; ++bj)
#pragma unroll
                    for (int n = 0; n < 2; ++n) hv[bj][n] = *(const f32x4*)(hi + lo + (bj * HALF + n * 16) * 4);
#pragma unroll
                for (int bj = 0; bj < 2; ++bj)
#pragma unroll
                    for (int n = 0; n < 2; ++n) *(f32x4*)(ho + lo + (bj * HALF + n * 16) * 4) = hv[bj][n] + acc[ai][bj][m][n];
                EPI_FENCE(); }
    }
};
struct EpiSwiglu {
    static constexpr bool PERM = true;
    bf16_t* ACT; const float* rs;
    __device__ __forceinline__ void operator()(AccT acc, const Unit& u, int wr, int wc, int fr, int fq) const {
        const unsigned lo = (unsigned)(fr * DFF + 8 * fq) * 2u;
        unsigned char* tb = (unsigned char*)ACT + ((size_t)(u.pm * BM + wr * 64) * DFF + u.pn * HALF + wc * 32) * 2;
        const float* rsb = rs + u.pm * BM + wr * 64;
#pragma unroll
        for (int ai = 0; ai < 2; ++ai)
#pragma unroll
            for (int m = 0; m < 4; ++m) { const float r = rsb[ai * HALF + m * 16 + fr];
                float o[8];
#pragma unroll
                for (int n = 0; n < 2; ++n)
#pragma unroll
                    for (int j = 0; j < 4; ++j) { const float gt = acc[ai][0][m][n][j] * r, up = acc[ai][1][m][n][j] * r; o[n * 4 + j] = gt * sigmoidf_(gt) * up; }
                u32x4 w; w.x = cvt_pk_bf16(o[0], o[1]); w.y = cvt_pk_bf16(o[2], o[3]); w.z = cvt_pk_bf16(o[4], o[5]); w.w = cvt_pk_bf16(o[6], o[7]);
                *(u32x4*)(tb + (size_t)(ai * HALF + m * 16) * DFF * 2 + lo) = w;
                EPI_FENCE(); }
    }
};
struct EpiMoeDown {
    static constexpr bool PERM = false;
    float* H; const int* rowl; const float* wrow;
    __device__ __forceinline__ void operator()(AccT acc, const Unit& u, int wr, int wc, int fr, int fq) const {
        const int rb = u.pm * BM + wr * 64; const unsigned cb = (unsigned)(u.pn * BM + wc * 32 + 4 * fq) * 4u;
#pragma unroll
        for (int ai = 0; ai < 2; ++ai)
#pragma unroll
            for (int m = 0; m < 4; ++m) { const int row = rb + ai * HALF + m * 16 + fr; const int tok = rowl[row]; const float w = wrow[row];
                if (tok >= 0) { unsigned char* hp = (unsigned char*)H + (size_t)tok * 4096 + cb;
                    f32x4 hv[2][2];
#pragma unroll
                    for (int bj = 0; bj < 2; ++bj)
#pragma unroll
                        for (int n = 0; n < 2; ++n) hv[bj][n] = *(const f32x4*)(hp + (bj * HALF + n * 16) * 4);
#pragma unroll
                    for (int bj = 0; bj < 2; ++bj)
#pragma unroll
                        for (int n = 0; n < 2; ++n) *(f32x4*)(hp + (bj * HALF + n * 16) * 4) = hv[bj][n] + acc[ai][bj][m][n] * w; }
                EPI_FENCE(); }
    }
};
}

#define XB_TMO      128
#define XB_XCNT(j)  (256  + 64 * (j))
#define XB_XSUB(j)  (1280 + 64 * (j))
#define XB_XGEN(j)  (2304 + 64 * (j))
#define XB_TOP      3328
#define XB_TOPGEN   3392
#define XCD_BAR_WORDS 3456
#define XB_SPIN_CAP (1u << 22)
__device__ __forceinline__ unsigned xb_ld(unsigned* p)              { return __hip_atomic_load(p, __ATOMIC_RELAXED, __HIP_MEMORY_SCOPE_AGENT); }
__device__ __forceinline__ unsigned xb_add(unsigned* p, unsigned v) { return __hip_atomic_fetch_add(p, v, __ATOMIC_RELAXED, __HIP_MEMORY_SCOPE_AGENT); }
__device__ __forceinline__ unsigned xb_xcc_id() { return (unsigned)__builtin_amdgcn_s_getreg((3 << 11) | 20) & 0xFu; }
#define XB_SPIN(cond, bar) do { unsigned _sp = 0; while (cond) { __builtin_amdgcn_s_sleep(1); \
    if ((++_sp & 255u) == 0u) { if (xb_ld(&(bar)[XB_TMO])) break; if (_sp > XB_SPIN_CAP) { atomicAdd(&(bar)[XB_TMO], 1u); break; } } } } while (0)
struct XcdBarrier { unsigned* bar; unsigned x; volatile LAS unsigned* st; };
__device__ __forceinline__ XcdBarrier xcd_barrier_post(unsigned* bar, volatile LAS unsigned* st) {
    XcdBarrier b; b.bar = bar; b.x = xb_xcc_id(); b.st = st;
    if (threadIdx.x == 0) (void)xb_add(&bar[XB_XCNT(b.x)], 1u);
    return b;
}
__device__ __forceinline__ void xcd_barrier_complete(unsigned* bar, unsigned x, unsigned& nloc, unsigned& nx) {
    const unsigned G = gridDim.x * gridDim.y * gridDim.z;
    unsigned sum, cnt, mine, sp = 0u;
    for (;;) {
        sum = 0u; cnt = 0u; mine = 0u;
#pragma unroll
        for (unsigned j = 0; j < 16; ++j) { const unsigned c = xb_ld(&bar[XB_XCNT(j)]); sum += c; cnt += (c > 0u) ? 1u : 0u; mine = (j == x) ? c : mine; }
        if (sum == G) break;
        __builtin_amdgcn_s_sleep(1);
        if ((++sp & 255u) == 0u) { if (xb_ld(&bar[XB_TMO])) break; if (sp > XB_SPIN_CAP) { atomicAdd(&bar[XB_TMO], 1u); break; } }
    }
    nloc = mine > 0u ? mine : 1u; nx = cnt > 0u ? cnt : 1u;
}
__device__ __forceinline__ void xcd_barrier(const XcdBarrier& b) {
    asm volatile("s_waitcnt vmcnt(0)" ::: "memory");
    __syncthreads();
    if (threadIdx.x == 0) {
        unsigned* bar = b.bar;
        __builtin_amdgcn_s_waitcnt(0);
        unsigned nloc = b.st[0], nx = b.st[1];
        if (nloc == 0u) { xcd_barrier_complete(bar, b.x, nloc, nx); b.st[0] = nloc; b.st[1] = nx; }
        const unsigned old = xb_add(&bar[XB_XSUB(b.x)], 1u);
        const unsigned gen = old / nloc;
        if (old + 1u == (gen + 1u) * nloc) {
            __builtin_amdgcn_fence(__ATOMIC_RELEASE, "agent");
            asm volatile("s_waitcnt vmcnt(0)" ::: "memory");
            const unsigned og = xb_add(&bar[XB_TOP], 1u);
            const unsigned tg = og / nx;
            if (og + 1u == (tg + 1u) * nx) xb_add(&bar[XB_TOPGEN], 1u);
            else XB_SPIN(xb_ld(&bar[XB_TOPGEN]) == tg, bar);
            __builtin_amdgcn_fence(__ATOMIC_ACQUIRE, "agent");
            xb_add(&bar[XB_XGEN(b.x)], 1u);
            asm volatile("s_waitcnt vmcnt(0)" ::: "memory");
        } else {
            XB_SPIN(xb_ld(&bar[XB_XGEN(b.x)]) == gen, bar);
            __builtin_amdgcn_fence(__ATOMIC_ACQUIRE, "agent");
            asm volatile("s_waitcnt vmcnt(0)" ::: "memory");
        }
    }
    __syncthreads();
}

struct Params {
    const float* in[28];
    float* out;
    unsigned char* ws;
    int l_lo, l_hi, ph_lo, ph_hi;
};
enum { I_X = 0, I_MEM, I_NORM_MIX, I_W_IN, I_CONV_W, I_CONV_B, I_DT_BIAS, I_A_LOG, I_D_SKIP, I_SSD_NORM, I_W_SSD_O, I_W_SB_O, I_W_OUT, I_NORM_XA, I_NORM_MEM,
       I_XA_WQ, I_XA_WK, I_XA_WV, I_XA_WO, I_NORM_FFN, I_FFN_G, I_FFN_U, I_FFN_D, I_MOE_R, I_MOE_G, I_MOE_U, I_MOE_D, I_FINAL };

__device__ __forceinline__ void tr_item(const float* W, int ldw, int k0, int n0, const float* gain, bf16_t* WT, int ldt, int drow0, LAS float* scr, int lane) {
#pragma unroll 8
    for (int i = 0; i < 32; ++i) { const int kk = 2 * i + (lane >> 5); const float gk = gain ? gain[k0 + kk] : 1.f; scr[kk * 33 + (lane & 31)] = W[(size_t)(k0 + kk) * ldw + n0 + (lane & 31)] * gk; }
    LDS_WAIT();
    const int c = lane & 7;
#pragma unroll
    for (int j = 0; j < 4; ++j) { const int n = (lane >> 3) + 8 * j; const LAS float* s = scr + (8 * c) * 33 + n;
        u32x4 o; o.x = cvt_pk_bf16(s[0 * 33], s[1 * 33]); o.y = cvt_pk_bf16(s[2 * 33], s[3 * 33]); o.z = cvt_pk_bf16(s[4 * 33], s[5 * 33]); o.w = cvt_pk_bf16(s[6 * 33], s[7 * 33]);
        *(u32x4*)(WT + (size_t)(drow0 + n) * ldt + k0 + 8 * c) = o; }
    LDS_WAIT();
}
struct TrJob { const float* W; int ldw, K, col0, ncols; const float* gain; bf16_t* WT; int dbase, dgroup; };
__device__ __forceinline__ void run_job(const TrJob& j, int& base, int gw, int NGW, LAS float* scr, int lane) {
    const int nblk = j.ncols / 32, nitems = (j.K / 64) * nblk;
    int start = (gw - base) % NGW; if (start < 0) start += NGW;
    for (int it = start; it < nitems; it += NGW) { const int kb = it / nblk, nb = it % nblk, c0 = nb * 32;
        tr_item(j.W, j.ldw, kb * 64, j.col0 + c0, j.gain, j.WT, j.K, j.dbase + (c0 / 128) * j.dgroup + (c0 % 128), scr, lane); }
    base = (base + nitems) % NGW;
}

template <int NE>
__device__ __forceinline__ float rowpass_row(const float* xrow, bf16_t* brow, int lane, const LAS float* wsm, float (&ex)[NE > 0 ? NE : 1]) {
    const f32x4* xr = (const f32x4*)xrow + lane;
    f32x4 v[4]; float s = 0.f;
#pragma unroll
    for (int j = 0; j < 4; ++j) { v[j] = xr[64 * j]; s += (v[j].x * v[j].x + v[j].y * v[j].y) + (v[j].z * v[j].z + v[j].w * v[j].w); }
    const float rstd = 1.f / sqrtf(wave_sum(s) * (1.f / D) + EPS);
    u32x2* o8 = (u32x2*)brow + lane;
#pragma unroll
    for (int j = 0; j < 4; ++j) { u32x2 w; w.x = cvt_pk_bf16(v[j].x, v[j].y); w.y = cvt_pk_bf16(v[j].z, v[j].w); o8[64 * j] = w; }
    if constexpr (NE > 0) {
#pragma unroll
        for (int e = 0; e < NE; ++e) { float p = 0.f;
#pragma unroll
            for (int j = 0; j < 4; ++j) { const f32x4 w4 = *(const LAS f32x4*)(wsm + e * 1024 + 256 * j + 4 * lane); p += (v[j].x * w4.x + v[j].y * w4.y) + (v[j].z * w4.z + v[j].w * w4.w); }
            ex[e] = wave_sum(p) * rstd; }
    }
    return rstd;
}

#define PHASE_ENTER() unsigned char* ws = p.ws; asm volatile("" : "+s"(ws)); int tid_ = threadIdx.x; asm volatile("" : "+v"(tid_)); int bid_ = blockIdx.x; asm volatile("" : "+s"(bid_)); \
    const int tid = tid_, lane = tid & 63, wave = __builtin_amdgcn_readfirstlane(tid >> 6); \
    const int G = gridDim.x, bid = bid_, gw = bid * 8 + wave, NGW = G * 8; (void)lane; (void)gw; (void)NGW; (void)wave; (void)bid; (void)G
#define WSP(type, off) ((type*)(ws + (off)))
__global__ void __launch_bounds__(512, 2) mk_fwd(Params p) {
    extern __shared__ __attribute__((aligned(16))) unsigned char lds_raw[];
    LAS unsigned char* lds = (LAS unsigned char*)lds_raw;
    volatile LAS unsigned* ldsctl = (volatile LAS unsigned*)(lds + LDSCTL_OFF);
    if (threadIdx.x < 64) ldsctl[threadIdx.x] = 0u;
    __syncthreads();
    const int ph_lo = p.ph_lo, ph_hi = p.ph_hi;
    const bool use_bar = (ph_hi - ph_lo) > 1 || (p.l_hi - p.l_lo) > 1;
    XcdBarrier bar; bar.bar = (unsigned*)(p.ws + WS_CTL) + CW_BAR; bar.x = 0; bar.st = nullptr;
    if (use_bar) bar = xcd_barrier_post((unsigned*)(p.ws + WS_CTL) + CW_BAR, ldsctl + 8);
#define PH(k) (ph_lo <= (k) && (k) < ph_hi)
#define GRID_BAR() do { if (use_bar) xcd_barrier(bar); } while (0)

    if (p.l_lo == 0 && PH(0)) {
        PHASE_ENTER();
        LAS float* scr = (LAS float*)(lds + wave * 16384);
        int base = 0;
        for (int jb = 0; jb < 4 * 9 + 2 * 3; ++jb) {
            TrJob j;
            if (jb < 36) { const int l = jb / 9, k = jb % 9; unsigned char* wl = ws + WS_W + (size_t)l * W_LAYER;
                switch (k) {
                case 0: j = TrJob{p.in[I_W_IN] + (size_t)l * D * INW, INW, D, 0, 2304, p.in[I_NORM_MIX] + l * D, (bf16_t*)(wl + W_IN), 0, 128}; break;
                case 1: j = TrJob{p.in[I_W_IN] + (size_t)l * D * INW, INW, D, 2320, 3584, p.in[I_NORM_MIX] + l * D, (bf16_t*)(wl + W_IN), 2304, 128}; break;
                case 2: j = TrJob{p.in[I_W_SSD_O] + (size_t)l * D * D, D, D, 0, D, p.in[I_SSD_NORM] + l * D, (bf16_t*)(wl + W_SSDO), 0, 128}; break;
                case 3: j = TrJob{p.in[I_W_SB_O] + (size_t)l * 512 * D, D, 512, 0, D, nullptr, (bf16_t*)(wl + W_SBO), 0, 128}; break;
                case 4: j = TrJob{p.in[I_W_OUT] + (size_t)l * D * D, D, D, 0, D, nullptr, (bf16_t*)(wl + W_OUT), 0, 128}; break;
                case 5: j = TrJob{p.in[I_XA_WQ] + (size_t)l * D * 512, 512, D, 0, 512, p.in[I_NORM_XA] + l * D, (bf16_t*)(wl + W_Q), 0, 128}; break;
                case 6: j = TrJob{p.in[I_XA_WK] + (size_t)l * D * 512, 512, D, 0, 512, p.in[I_NORM_MEM] + l * D, (bf16_t*)(ws + WS_WKV), l * 1024, 128}; break;
                case 7: j = TrJob{p.in[I_XA_WV] + (size_t)l * D * 512, 512, D, 0, 512, p.in[I_NORM_MEM] + l * D, (bf16_t*)(ws + WS_WKV), l * 1024 + 512, 128}; break;
                default: j = TrJob{p.in[I_XA_WO] + (size_t)l * 512 * D, D, 512, 0, D, nullptr, (bf16_t*)(wl + W_O), 0, 128}; break;
                }
            } else { const int jj = (jb - 36) / 3, k = (jb - 36) % 3; unsigned char* wf = ws + WS_WFF + (size_t)jj * W_FF; const float* gn = p.in[I_NORM_FFN] + (2 * jj) * D;
                if (k == 0) j = TrJob{p.in[I_FFN_G] + (size_t)jj * D * DFF, DFF, D, 0, DFF, gn, (bf16_t*)(wf + W_GU), 0, 256};
                else if (k == 1) j = TrJob{p.in[I_FFN_U] + (size_t)jj * D * DFF, DFF, D, 0, DFF, gn, (bf16_t*)(wf + W_GU), 128, 256};
                else j = TrJob{p.in[I_FFN_D] + (size_t)jj * DFF * D, D, DFF, 0, D, nullptr, (bf16_t*)(wf + W_DN), 0, 128};
            }
            run_job(j, base, gw, NGW, scr, lane);
        }
        float dummy[1]; bf16_t* MEMB = WSP(bf16_t, WS_MEMB); float* RSMEM = WSP(float, WS_RSMEM);
        for (int m = gw; m < TM; m += NGW) { const float r = rowpass_row<0>(p.in[I_MEM] + (size_t)m * D, MEMB + (size_t)m * D, lane, nullptr, dummy); if (lane == 0) RSMEM[m] = r; }
        GRID_BAR();
    }
    if (p.l_lo == 0 && PH(1)) {
        PHASE_ENTER();
        pg8::Gemm g{WSP(bf16_t, WS_MEMB), WSP(bf16_t, WS_WKV), D, D, D}; pg8::StaticOrder S; S.init(TM, 4096, G, bid);
        pg8::EpiBf16Rs E{WSP(bf16_t, WS_KVM), 4096, WSP(float, WS_RSMEM), 1.f};
        pg8::gemm_phase<pg8::EpiBf16Rs, pg8::StaticOrder, true, true>(lds, g, S, E);
        GRID_BAR();
    }

    for (int l = p.l_lo; l < p.l_hi; ++l) {
        const bool moe = (l & 1) != 0; const int jf = l >> 1;

        if (PH(2)) {
            PHASE_ENTER();
            const float* Hin = (l == 0) ? p.in[I_X] : p.out; bf16_t* HB = WSP(bf16_t, WS_HB); float* RS = WSP(float, WS_RS); float* DT = WSP(float, WS_DT);
            LAS float* wsm = (LAS float*)lds;
            for (int i = tid; i < 16 * 1024; i += 512) { const int e = i >> 10, k = i & 1023; wsm[i] = p.in[I_W_IN][(size_t)l * D * INW + (size_t)k * INW + 2304 + e] * p.in[I_NORM_MIX][l * D + k]; }
            __syncthreads();
            for (int m = gw; m < T; m += NGW) { float ex[16];
                const float r = rowpass_row<16>(Hin + (size_t)m * D, HB + (size_t)m * D, lane, wsm, ex);
                if (lane == 0) RS[m] = r;
                float mine = 0.f;
#pragma unroll
                for (int e = 0; e < 16; ++e) mine = (lane == e) ? ex[e] : mine;
                if (lane < 16) { const float xv = mine + p.in[I_DT_BIAS][l * 16 + lane]; DT[(size_t)m * 16 + lane] = fmaxf(xv, 0.f) + log1pf(expf(-fabsf(xv))); }
            }
            __syncthreads();
            if (moe) {
                LAS float* scr = (LAS float*)(lds + 65536 + wave * 8704);
                int base = 0; const float* gn = p.in[I_NORM_FFN] + l * D;
                for (int jb = 0; jb < NEXP * 3; ++jb) { const int e = jb / 3, k = jb % 3; TrJob j; const size_t eo = ((size_t)jf * NEXP + e) * D * DFF;
                    if (k == 0) j = TrJob{p.in[I_MOE_G] + eo, DFF, D, 0, DFF, gn, (bf16_t*)(ws + WS_WMOE + WM_GU) + (size_t)e * 2 * DFF * 1024, 0, 256};
                    else if (k == 1) j = TrJob{p.in[I_MOE_U] + eo, DFF, D, 0, DFF, gn, (bf16_t*)(ws + WS_WMOE + WM_GU) + (size_t)e * 2 * DFF * 1024, 128, 256};
                    else j = TrJob{p.in[I_MOE_D] + eo, D, DFF, 0, D, nullptr, (bf16_t*)(ws + WS_WMOE + WM_DN) + (size_t)e * 1024 * DFF, 0, 128};
                    run_job(j, base, gw, NGW, scr, lane); }
            }
            GRID_BAR();
        }
        if (PH(3)) {
            PHASE_ENTER();
            pg8::Gemm g{WSP(bf16_t, WS_HB), (const bf16_t*)(ws + WS_W + (size_t)l * W_LAYER + W_IN), D, D, D}; pg8::StaticOrder S; S.init(T, NPROJ, G, bid);
            pg8::EpiInProj E{ws + WS_X, WSP(float, WS_RS)};
            pg8::gemm_phase<pg8::EpiInProj, pg8::StaticOrder, true, true>(lds, g, S, E);
            GRID_BAR();
        }
        if (PH(4)) {
            PHASE_ENTER();
            const bf16_t* XBC = WSP(bf16_t, WS_X + X_XBC); bf16_t* XC = WSP(bf16_t, WS_X + X_XC);
            const float* cw = p.in[I_CONV_W] + (size_t)l * 4 * 1280; const float* cb = p.in[I_CONV_B] + (size_t)l * 1280;
            for (int it = bid * 512 + tid; it < T * 160; it += G * 512) { const int tk = it / 160, c8 = (it % 160) * 8, s = tk & (SEQ - 1);
                float a[8];
#pragma unroll
                for (int j = 0; j < 8; ++j) a[j] = cb[c8 + j];
#pragma unroll
                for (int k = 0; k < 4; ++k) { if (s - 3 + k >= 0) { const u32x4 w = *(const u32x4*)(XBC + (size_t)(tk - 3 + k) * 1280 + c8); const float* wk = cw + k * 1280 + c8;
                    a[0] += bflo(w.x) * wk[0]; a[1] += bfhi(w.x) * wk[1]; a[2] += bflo(w.y) * wk[2]; a[3] += bfhi(w.y) * wk[3]; a[4] += bflo(w.z) * wk[4]; a[5] += bfhi(w.z) * wk[5]; a[6] += bflo(w.w) * wk[6]; a[7] += bfhi(w.w) * wk[7]; } }
#pragma unroll
                for (int j = 0; j < 8; ++j) a[j] = a[j] * sigmoidf_(a[j]);
                u32x4 o; o.x = cvt_pk_bf16(a[0], a[1]); o.y = cvt_pk_bf16(a[2], a[3]); o.z = cvt_pk_bf16(a[4], a[5]); o.w = cvt_pk_bf16(a[6], a[7]);
                *(u32x4*)(XC + (size_t)tk * 1280 + c8) = o; }
            GRID_BAR();
        }
        if (PH(5)) {
            PHASE_ENTER();
            if (bid < 32) {
                const bf16_t* XC = WSP(bf16_t, WS_X + X_XC); const bf16_t* Zb = WSP(bf16_t, WS_X + X_Z); bf16_t* YSSD = WSP(bf16_t, WS_X + X_XBC); const float* DT = WSP(float, WS_DT);
                const int b = bid >> 1, gI = bid & 1, hh = wave, pch = lane, head = gI * 8 + hh, ch = gI * 512 + hh * 64 + pch;
                LAS float* BC = (LAS float*)lds;
                LAS float* YB = (LAS float*)(lds + 16384);
                LAS float* RSL = (LAS float*)(lds + 16384 + 65536);
                const float negA = -expf(p.in[I_A_LOG][l * 16 + head]), dsk = p.in[I_D_SKIP][l * 16 + head];
                float S[64];
#pragma unroll
                for (int n = 0; n < 64; ++n) S[n] = 0.f;
                for (int t0 = 0; t0 < SEQ; t0 += 32) {
                    __syncthreads();
                    for (int i = tid; i < 32 * 128; i += 512) { const int tt = i >> 7, c = i & 127; BC[i] = bf2f(XC[(size_t)(b * SEQ + t0 + tt) * 1280 + 1024 + (c >> 6) * 128 + gI * 64 + (c & 63)]); }
                    __syncthreads();
                    for (int tt = 0; tt < 32; ++tt) { const size_t row = (size_t)(b * SEQ + t0 + tt);
                        const float xv = bf2f(XC[row * 1280 + ch]); const float dtv = ld_f32_agent(DT + row * 16 + head); const float ea = expf(dtv * negA); const float xdt = xv * dtv;
                        float y = 0.f;
#pragma unroll
                        for (int n = 0; n < 64; ++n) { S[n] = S[n] * ea + xdt * BC[tt * 128 + n]; y += BC[tt * 128 + 64 + n] * S[n]; }
                        y += xv * dsk; const float zv = bf2f(Zb[row * 1024 + ch]); y *= zv * sigmoidf_(zv);
                        YB[tt * 512 + tid] = y; }
                    __syncthreads();
                    for (int tt = wave; tt < 32; tt += 8) { float s = 0.f;
#pragma unroll
                        for (int j = 0; j < 8; ++j) { const float v = YB[tt * 512 + lane + 64 * j]; s += v * v; }
                        s = wave_sum(s); if (lane == 0) RSL[tt] = 1.f / sqrtf(s * (1.f / 512.f) + EPS); }
                    __syncthreads();
                    for (int tt = 0; tt < 32; ++tt) YSSD[(size_t)(b * SEQ + t0 + tt) * 1024 + ch] = f2bf(YB[tt * 512 + tid] * RSL[tt]);
                }
            } else {
                bf16_t* Qb = WSP(bf16_t, WS_X + X_Q); const bf16_t* Kb = WSP(bf16_t, WS_X + X_K); const bf16_t* Vb = WSP(bf16_t, WS_X + X_V);
                const int wv = (bid - 32) * 8 + wave, nwv = (G - 32) * 8;
                for (int u = wv; u < NBATCH * 8 * SEQ; u += nwv) { const int t = u & (SEQ - 1), bh = u >> 11, h = bh & 7, b = bh >> 3; const size_t rowq = (size_t)(b * SEQ + t);
                    float q[64];
#pragma unroll
                    for (int i = 0; i < 8; ++i) { const u32x4 w = *(const u32x4*)(Qb + rowq * 512 + h * 64 + i * 8);
                        q[8 * i + 0] = bflo(w.x); q[8 * i + 1] = bfhi(w.x); q[8 * i + 2] = bflo(w.y); q[8 * i + 3] = bfhi(w.y); q[8 * i + 4] = bflo(w.z); q[8 * i + 5] = bfhi(w.z); q[8 * i + 6] = bflo(w.w); q[8 * i + 7] = bfhi(w.w); }
                    float o = 0.f, R = 0.f;
                    for (int c0 = t - 1; c0 >= 0; c0 -= 64) { const int s = c0 - lane; const bool valid = s >= 0;
                        float z = 0.f;
                        if (valid) { const bf16_t* kp = Kb + (size_t)(b * SEQ + s) * 512 + h * 64;
#pragma unroll
                            for (int i = 0; i < 8; ++i) { const u32x4 w = *(const u32x4*)(kp + i * 8);
                                z += q[8 * i + 0] * bflo(w.x) + q[8 * i + 1] * bfhi(w.x) + q[8 * i + 2] * bflo(w.y) + q[8 * i + 3] * bfhi(w.y) + q[8 * i + 4] * bflo(w.z) + q[8 * i + 5] * bfhi(w.z) + q[8 * i + 6] * bflo(w.w) + q[8 * i + 7] * bfhi(w.w); } }
                        z *= 0.125f;
                        const float sp = valid ? (fmaxf(z, 0.f) + log1pf(expf(-fabsf(z)))) : 0.f;
                        float inc = sp;
#pragma unroll
                        for (int d = 1; d < 64; d <<= 1) { const float n = __shfl_up(inc, d); if (lane >= d) inc += n; }
                        const float att = valid ? expf(z - sp - R - (inc - sp)) : 0.f;
                        R += __shfl(inc, 63);
                        const int nv = c0 + 1 < 64 ? c0 + 1 : 64;
#pragma unroll 8
                        for (int i = 0; i < 64; ++i) { const float a = __shfl(att, i); if (i < nv) o += a * bf2f(Vb[(size_t)(b * SEQ + c0 - i) * 512 + h * 64 + lane]); }
                    }
                    Qb[rowq * 512 + h * 64 + lane] = f2bf(o); }
            }
            GRID_BAR();
        }
        if (PH(6)) {
            PHASE_ENTER();
            pg8::Gemm g{WSP(bf16_t, WS_X + X_XBC), (const bf16_t*)(ws + WS_W + (size_t)l * W_LAYER + W_SSDO), D, D, D}; pg8::StaticOrder S; S.init(T, D, G, bid);
            pg8::EpiGate<false> E{WSP(bf16_t, WS_X + X_Z), WSP(bf16_t, WS_X + X_GS), 0};
            pg8::gemm_phase<pg8::EpiGate<false>, pg8::StaticOrder, true, true>(lds, g, S, E);
            GRID_BAR();
        }
        if (PH(7)) {
            PHASE_ENTER();
            pg8::Gemm g{WSP(bf16_t, WS_X + X_Q), (const bf16_t*)(ws + WS_W + (size_t)l * W_LAYER + W_SBO), 512, 512, 512}; pg8::StaticOrder S; S.init(T, D, G, bid);
            pg8::EpiGate<true> E{WSP(bf16_t, WS_X + X_Z), WSP(bf16_t, WS_X + X_GS), 1024};
            pg8::gemm_phase<pg8::EpiGate<true>, pg8::StaticOrder, true, true>(lds, g, S, E);
            GRID_BAR();
        }
        if (PH(8)) {
            PHASE_ENTER();
            pg8::Gemm g{WSP(bf16_t, WS_X + X_Z), (const bf16_t*)(ws + WS_W + (size_t)l * W_LAYER + W_OUT), D, D, D}; pg8::StaticOrder S; S.init(T, D, G, bid);
            pg8::EpiResid E{(l == 0) ? p.in[I_X] : p.out, p.out};
            pg8::gemm_phase<pg8::EpiResid, pg8::StaticOrder, true, true>(lds, g, S, E);
            GRID_BAR();
        }
        if (PH(9)) {
            PHASE_ENTER();
            float dummy[1]; bf16_t* HB = WSP(bf16_t, WS_HB); float* RS = WSP(float, WS_RS); const float* H = p.out;
            for (int m = gw; m < T; m += NGW) { const float r = rowpass_row<0>(H + (size_t)m * D, HB + (size_t)m * D, lane, nullptr, dummy); if (lane == 0) RS[m] = r; }
            GRID_BAR();
        }
        if (PH(10)) {
            PHASE_ENTER();
            pg8::Gemm g{WSP(bf16_t, WS_HB), (const bf16_t*)(ws + WS_W + (size_t)l * W_LAYER + W_Q), D, D, D}; pg8::StaticOrder S; S.init(T, 512, G, bid);
            pg8::EpiBf16Rs E{WSP(bf16_t, WS_X + X_K), 512, WSP(float, WS_RS), 0.08838834764831845f};
            pg8::gemm_phase<pg8::EpiBf16Rs, pg8::StaticOrder, true, true>(lds, g, S, E);
            GRID_BAR();
        }
        if (PH(11)) {
            PHASE_ENTER();
            const bf16_t* KVM = WSP(bf16_t, WS_KVM); const bf16_t* XQ = WSP(bf16_t, WS_X + X_K); bf16_t* XO = WSP(bf16_t, WS_X + X_V);
            LAS unsigned char* Ks = lds; LAS unsigned char* Vs = lds + 256 * 272;
            for (int u = bid; u < 256; u += G) { const int b = u >> 4, hd = (u >> 2) & 3, chk = u & 3;
                __syncthreads();
                for (int i = tid; i < 256 * 16; i += 512) { const int m = i >> 4, c = i & 15; const bf16_t* src = KVM + (size_t)(b * 256 + m) * 4096 + l * 1024 + hd * 128 + c * 8;
                    *(LAS u32x4*)(Ks + m * 272 + c * 16) = *(const u32x4*)src; *(LAS u32x4*)(Vs + m * 256 + c * 16) = *(const u32x4*)(src + 512); }
                __syncthreads();
                for (int i = 0; i < 64; ++i) { const size_t row = (size_t)(b * SEQ + chk * 512 + wave * 64 + i);
                    unsigned qp[64];
#pragma unroll
                    for (int c = 0; c < 16; ++c) { const u32x4 w = *(const u32x4*)(XQ + row * 512 + hd * 128 + c * 8); qp[4 * c] = w.x; qp[4 * c + 1] = w.y; qp[4 * c + 2] = w.z; qp[4 * c + 3] = w.w; }
                    float sc[4];
#pragma unroll
                    for (int r = 0; r < 4; ++r) { const int j = lane + 64 * r; float s = 0.f;
#pragma unroll
                        for (int c = 0; c < 16; ++c) { const u32x4 kw = *(const LAS u32x4*)(Ks + j * 272 + c * 16);
                            s += bflo(qp[4 * c]) * bflo(kw.x) + bfhi(qp[4 * c]) * bfhi(kw.x) + bflo(qp[4 * c + 1]) * bflo(kw.y) + bfhi(qp[4 * c + 1]) * bfhi(kw.y)
                               + bflo(qp[4 * c + 2]) * bflo(kw.z) + bfhi(qp[4 * c + 2]) * bfhi(kw.z) + bflo(qp[4 * c + 3]) * bflo(kw.w) + bfhi(qp[4 * c + 3]) * bfhi(kw.w); }
                        sc[r] = s; }
                    const float mx = wave_max(fmaxf(fmaxf(sc[0], sc[1]), fmaxf(sc[2], sc[3])));
                    float sum = 0.f;
#pragma unroll
                    for (int r = 0; r < 4; ++r) { sc[r] = expf(sc[r] - mx); sum += sc[r]; }
                    const float inv = 1.f / wave_sum(sum);
                    float o0 = 0.f, o1 = 0.f;
#pragma unroll
                    for (int r = 0; r < 4; ++r)
#pragma unroll 8
                        for (int ii = 0; ii < 64; ++ii) { const float pj = __shfl(sc[r], ii); const unsigned vw = *(const LAS unsigned*)(Vs + (ii + 64 * r) * 256 + lane * 4); o0 += pj * bflo(vw); o1 += pj * bfhi(vw); }
                    *(unsigned*)(XO + row * 512 + hd * 128 + 2 * lane) = cvt_pk_bf16(o0 * inv, o1 * inv); }
            }
            GRID_BAR();
        }
        if (PH(12)) {
            PHASE_ENTER();
            pg8::Gemm g{WSP(bf16_t, WS_X + X_V), (const bf16_t*)(ws + WS_W + (size_t)l * W_LAYER + W_O), 512, 512, 512}; pg8::StaticOrder S; S.init(T, D, G, bid);
            pg8::EpiResid E{p.out, p.out};
            pg8::gemm_phase<pg8::EpiResid, pg8::StaticOrder, true, true>(lds, g, S, E);
            GRID_BAR();
        }
        if (PH(13)) {
            PHASE_ENTER();
            bf16_t* HB = WSP(bf16_t, WS_HB); float* RS = WSP(float, WS_RS); const float* H = p.out;
            if (!moe) { float dummy[1];
                for (int m = gw; m < T; m += NGW) { const float r = rowpass_row<0>(H + (size_t)m * D, HB + (size_t)m * D, lane, nullptr, dummy); if (lane == 0) RS[m] = r; }
            } else {
                int* TE = WSP(int, WS_MOE + MO_TE); float* TW = WSP(float, WS_MOE + MO_TW); int* TP = WSP(int, WS_MOE + MO_TP); unsigned* CNT = WSP(unsigned, WS_CTL) + CW_CNT + jf * 16;
                LAS float* wsm = (LAS float*)lds;
                for (int i = tid; i < 8 * 1024; i += 512) { const int e = i >> 10, k = i & 1023; wsm[i] = p.in[I_MOE_R][(size_t)jf * D * NEXP + (size_t)k * NEXP + e] * p.in[I_NORM_FFN][l * D + k]; }
                __syncthreads();
                for (int m = gw; m < T; m += NGW) { float lg[8];
                    const float r = rowpass_row<8>(H + (size_t)m * D, HB + (size_t)m * D, lane, wsm, lg);
                    if (lane == 0) { RS[m] = r;
                        int i0 = 0; float v0 = lg[0];
#pragma unroll
                        for (int e = 1; e < 8; ++e) if (lg[e] > v0) { v0 = lg[e]; i0 = e; }
                        int i1 = -1; float v1 = -3.0e38f;
#pragma unroll
                        for (int e = 0; e < 8; ++e) if (e != i0 && lg[e] > v1) { v1 = lg[e]; i1 = e; }
                        const float w0 = 1.f / (1.f + expf(v1 - v0));
                        const unsigned p0 = atomicAdd(CNT + i0, 1u), p1 = atomicAdd(CNT + 8 + i1, 1u);
                        TE[m] = i0; TE[T + m] = i1; TW[m] = w0; TW[T + m] = 1.f - w0; TP[m] = (int)p0; TP[T + m] = (int)p1; }
                }
            }
            GRID_BAR();
        }
        if (!moe) {
            if (PH(14)) {
                PHASE_ENTER();
                pg8::Gemm g{WSP(bf16_t, WS_HB), (const bf16_t*)(ws + WS_WFF + (size_t)jf * W_FF + W_GU), D, D, D}; pg8::StaticOrder S; S.init(T, 2 * DFF, G, bid);
                pg8::EpiSwiglu E{WSP(bf16_t, WS_X + X_ACT), WSP(float, WS_RS)};
                pg8::gemm_phase<pg8::EpiSwiglu, pg8::StaticOrder, true, true>(lds, g, S, E);
                GRID_BAR();
            }
            if (PH(15)) {
                PHASE_ENTER();
                pg8::Gemm g{WSP(bf16_t, WS_X + X_ACT), (const bf16_t*)(ws + WS_WFF + (size_t)jf * W_FF + W_DN), DFF, DFF, DFF}; pg8::StaticOrder S; S.init(T, D, G, bid);
                pg8::EpiResid E{p.out, p.out};
                pg8::gemm_phase<pg8::EpiResid, pg8::StaticOrder, true, true>(lds, g, S, E);
                GRID_BAR();
            }
        } else {
            if (PH(14)) {
                PHASE_ENTER();
                const bf16_t* HB = WSP(bf16_t, WS_HB); const float* RS = WSP(float, WS_RS); bf16_t* XG = WSP(bf16_t, WS_X + X_XG);
                const int* TE = WSP(int, WS_MOE + MO_TE); const float* TW = WSP(float, WS_MOE + MO_TW); const int* TP = WSP(int, WS_MOE + MO_TP); unsigned* CNT = WSP(unsigned, WS_CTL) + CW_CNT + jf * 16;
                int* ROWL = WSP(int, WS_MOE + MO_ROWL); float* WROW = WSP(float, WS_MOE + MO_WROW); float* RSG = WSP(float, WS_MOE + MO_RSG);
                unsigned* PEXP = WSP(unsigned, WS_MOE + MO_PEXP); unsigned* NPAN = WSP(unsigned, WS_MOE + MO_NPAN);
#pragma unroll
                for (int s = 0; s < 2; ++s) {
                    int off[9]; { int a = 0;
#pragma unroll
                        for (int e = 0; e < 8; ++e) { off[e] = a; a += ((int)__builtin_amdgcn_readfirstlane(ld_u32_agent(CNT + s * 8 + e)) + 255) & ~255; }
                        off[8] = a; }
                    if (bid == 0 && tid == 0) { NPAN[s] = (unsigned)(off[8] >> 8);
#pragma unroll
                        for (int e = 0; e < 8; ++e) for (int pnl = off[e] >> 8; pnl < (off[e + 1] >> 8); ++pnl) PEXP[s * 256 + pnl] = (unsigned)e; }
                    for (int m = gw; m < T; m += NGW) { const int e = TE[s * T + m]; int o = 0;
#pragma unroll
                        for (int k = 0; k < 8; ++k) o = (e == k) ? off[k] : o;
                        const int row = o + TP[s * T + m];
                        const u32x4* src = (const u32x4*)(HB + (size_t)m * D); u32x4* dst = (u32x4*)(XG + ((size_t)s * MOE_ROWS + row) * D);
                        dst[lane] = src[lane]; dst[lane + 64] = src[lane + 64];
                        if (lane == 0) { ROWL[s * MOE_ROWS + row] = m; WROW[s * MOE_ROWS + row] = TW[s * T + m]; RSG[s * MOE_ROWS + row] = RS[m]; } }
#pragma unroll
                    for (int e = 0; e < 8; ++e) { const int c = (int)__builtin_amdgcn_readfirstlane(ld_u32_agent(CNT + s * 8 + e)); const int lo = off[e] + c, hi = off[e + 1];
                        for (int row = lo + gw; row < hi; row += NGW) { u32x4* dst = (u32x4*)(XG + ((size_t)s * MOE_ROWS + row) * D); const u32x4 zz = {0u, 0u, 0u, 0u}; dst[lane] = zz; dst[lane + 64] = zz;
                            if (lane == 0) { ROWL[s * MOE_ROWS + row] = -1; WROW[s * MOE_ROWS + row] = 0.f; RSG[s * MOE_ROWS + row] = 0.f; } } }
                }
                GRID_BAR();
            }
#pragma unroll
            for (int s = 0; s < 2; ++s) {
                if (PH(15 + 2 * s)) {
                    PHASE_ENTER();
                    const int npan = (int)__builtin_amdgcn_readfirstlane(ld_u32_agent(WSP(unsigned, WS_MOE + MO_NPAN) + s));
                    pg8::Gemm g{WSP(bf16_t, WS_X + X_XG) + (size_t)s * MOE_ROWS * D, WSP(bf16_t, WS_WMOE + WM_GU), D, D, D}; pg8::MoeOrder S; S.init(npan, 2 * DFF / 256, G, bid, WSP(unsigned, WS_MOE + MO_PEXP) + s * 256);
                    pg8::EpiSwiglu E{WSP(bf16_t, WS_X + X_ACT), WSP(float, WS_MOE + MO_RSG) + s * MOE_ROWS};
                    pg8::gemm_phase<pg8::EpiSwiglu, pg8::MoeOrder, true, true>(lds, g, S, E);
                    GRID_BAR();
                }
                if (PH(16 + 2 * s)) {
                    PHASE_ENTER();
                    const int npan = (int)__builtin_amdgcn_readfirstlane(ld_u32_agent(WSP(unsigned, WS_MOE + MO_NPAN) + s));
                    pg8::Gemm g{WSP(bf16_t, WS_X + X_ACT), WSP(bf16_t, WS_WMOE + WM_DN), DFF, DFF, DFF}; pg8::MoeOrder S; S.init(npan, D / 256, G, bid, WSP(unsigned, WS_MOE + MO_PEXP) + s * 256);
                    pg8::EpiMoeDown E{p.out, WSP(int, WS_MOE + MO_ROWL) + s * MOE_ROWS, WSP(float, WS_MOE + MO_WROW) + s * MOE_ROWS};
                    pg8::gemm_phase<pg8::EpiMoeDown, pg8::MoeOrder, true, true>(lds, g, S, E);
                    GRID_BAR();
                }
            }
        }
    }
    if (p.l_hi == DEPTH && PH(19)) {
        PHASE_ENTER();
        const float* gf = p.in[I_FINAL]; float* H = p.out;
        for (int m = gw; m < T; m += NGW) { f32x4* xr = (f32x4*)(H + (size_t)m * D) + lane; f32x4 v[4]; float s = 0.f;
#pragma unroll
            for (int j = 0; j < 4; ++j) { v[j] = xr[64 * j]; s += (v[j].x * v[j].x + v[j].y * v[j].y) + (v[j].z * v[j].z + v[j].w * v[j].w); }
            const float rstd = 1.f / sqrtf(wave_sum(s) * (1.f / D) + EPS);
#pragma unroll
            for (int j = 0; j < 4; ++j) { const f32x4 g4 = *((const f32x4*)gf + lane + 64 * j); xr[64 * j] = v[j] * rstd * g4; } }
    }
#undef PH
#undef GRID_BAR
}

extern "C" void kernel_launch(void* const* d_in, const int* in_sizes, int n_in, void* d_out, int out_size, void* d_ws, size_t ws_size, hipStream_t stream) {
    static int grid = 0;
    if (grid == 0) {
        if (n_in != 28 || out_size != T * D || ws_size < WS_END) { fprintf(stderr, "kernel_launch: unexpected problem (n_in %d, out %d, ws %zu < %zu)\n", n_in, out_size, ws_size, (size_t)WS_END); grid = -1; return; }
        int dev = 0, cus = 0;
        if (hipGetDevice(&dev) != hipSuccess || hipDeviceGetAttribute(&cus, hipDeviceAttributeMultiprocessorCount, dev) != hipSuccess) { grid = -1; return; }
        if (hipFuncSetAttribute((const void*)mk_fwd, hipFuncAttributeMaxDynamicSharedMemorySize, LDS_BYTES) != hipSuccess) { fprintf(stderr, "kernel_launch: hipFuncSetAttribute failed\n"); grid = -1; return; }
        int per_cu = 0;
        if (hipOccupancyMaxActiveBlocksPerMultiprocessor(&per_cu, (const void*)mk_fwd, 512, LDS_BYTES) != hipSuccess || per_cu < 1) { fprintf(stderr, "kernel_launch: occupancy query says %d\n", per_cu); (void)hipGetLastError(); }
        grid = cus;
    }
    if (grid < 0) return;
    (void)hipMemsetAsync((char*)d_ws + WS_CTL, 0, 1 * MiB, stream);
    Params p{};
    for (int i = 0; i < 28; ++i) p.in[i] = (const float*)d_in[i];
    p.out = (float*)d_out; p.ws = (unsigned char*)d_ws;
#if MK_ONE_LAUNCH
    p.l_lo = 0; p.l_hi = DEPTH; p.ph_lo = 0; p.ph_hi = 20;
    hipLaunchKernelGGL(mk_fwd, dim3(grid), dim3(512), LDS_BYTES, stream, p);
#else
    auto launch = [&](int l, int ph) { p.l_lo = l; p.l_hi = l + 1; p.ph_lo = ph; p.ph_hi = ph + 1; hipLaunchKernelGGL(mk_fwd, dim3(grid), dim3(512), LDS_BYTES, stream, p); };
    launch(0, 0); launch(0, 1);
    for (int l = 0; l < DEPTH; ++l) { const int last = (l & 1) ? 18 : 15; for (int ph = 2; ph <= last; ++ph) launch(l, ph); }
    launch(DEPTH - 1, 19);
#endif
}
```

```cpp
#include <hip/hip_runtime.h>
#include <cstdio>
#include <cstdint>

#define LAS __attribute__((address_space(3)))
#define GAS __attribute__((address_space(1)))
typedef unsigned short bf16_t;
typedef short bf16x8 __attribute__((ext_vector_type(8)));
typedef float f32x4 __attribute__((ext_vector_type(4)));
typedef float f32x2 __attribute__((ext_vector_type(2)));
typedef unsigned u32x4 __attribute__((ext_vector_type(4)));
typedef unsigned u32x2 __attribute__((ext_vector_type(2)));

#ifndef MK_ONE_LAUNCH
#define MK_ONE_LAUNCH 1
#endif

constexpr int T = 32768, D = 1024, SEQ = 2048, NBATCH = 16, DEPTH = 4, MEMLEN = 256, TM = NBATCH * MEMLEN;
constexpr int INW = 5904, NPROJ = 5888, DFF = 2816, NEXP = 8;
constexpr int MOE_ROWS = T + NEXP * 256;
constexpr int MOE_PAN = MOE_ROWS / 256;
constexpr float EPS = 1e-6f;

constexpr size_t MiB = 1u << 20;
constexpr size_t WS_CTL = 0;
constexpr size_t WS_RS = 1 * MiB;
constexpr size_t WS_RSMEM = WS_RS + 256 * 1024;
constexpr size_t WS_DT = 2 * MiB;
constexpr size_t WS_MOE = 4 * MiB;
constexpr size_t WS_KM = 8 * MiB;
constexpr size_t WS_VTM = 24 * MiB;
constexpr size_t WS_MEMB = 40 * MiB;
constexpr size_t WS_HB = 48 * MiB;
constexpr size_t WS_W = 112 * MiB;
constexpr size_t W_IN = 0, W_SSDO = W_IN + (size_t)NPROJ * 1024 * 2, W_SBO = W_SSDO + 2 * MiB, W_OUT = W_SBO + 1 * MiB, W_Q = W_OUT + 2 * MiB, W_O = W_Q + 1 * MiB, W_LAYER = W_O + 1 * MiB;
constexpr size_t WS_WKV = WS_W + 4 * W_LAYER;
constexpr size_t WS_WFF = WS_WKV + 8 * MiB;
constexpr size_t W_GU = 0, W_DN = (size_t)2 * DFF * 1024 * 2, W_FF = W_DN + (size_t)1024 * DFF * 2;
constexpr size_t WS_WMOE = WS_WFF + 2 * W_FF;
constexpr size_t WM_GU = 0, WM_DN = (size_t)NEXP * 2 * DFF * 1024 * 2;
constexpr size_t WS_X = WS_WMOE + NEXP * W_FF;
constexpr size_t X_Z = 0, X_XBC = X_Z + 64 * MiB, X_XC = X_XBC + 80 * MiB, X_Q = X_XC + 80 * MiB, X_K = X_Q + 32 * MiB, X_V = X_K + 32 * MiB, X_GS = X_V + 32 * MiB, X_END = X_GS + 128 * MiB;
constexpr size_t X_ACT = 0;
constexpr size_t X_XG = 192 * MiB;
constexpr size_t WS_END = WS_X + X_END;
static_assert(X_XG + (size_t)2 * MOE_ROWS * 1024 * 2 <= X_END, "moe region");
static_assert((size_t)MOE_ROWS * DFF * 2 <= X_XG, "act region");
constexpr size_t MO_TE = 0, MO_TW = MO_TE + 2 * T * 4, MO_TP = MO_TW + 2 * T * 4, MO_ROWL = MO_TP + 2 * T * 4, MO_WROW = MO_ROWL + 2 * MOE_ROWS * 4, MO_RSG = MO_WROW + 2 * MOE_ROWS * 4,
                 MO_PEXP = MO_RSG + 2 * MOE_ROWS * 4, MO_NPAN = MO_PEXP + 2 * 256 * 4, MO_END = MO_NPAN + 256;
static_assert(MO_END <= 4 * MiB, "moe tables");
constexpr int CW_BAR = 4096;
constexpr int CW_CNT = 16384;

constexpr int RING_BYTES = 155648;
constexpr int LDSCTL_OFF = RING_BYTES;
constexpr int LDS_BYTES = 160 * 1024;

__device__ __forceinline__ float bf2f(unsigned b) { return __builtin_bit_cast(float, b << 16); }
__device__ __forceinline__ float bflo(unsigned w) { return __builtin_bit_cast(float, w << 16); }
__device__ __forceinline__ float bfhi(unsigned w) { return __builtin_bit_cast(float, w & 0xffff0000u); }
__device__ __forceinline__ unsigned cvt_pk_bf16(float lo, float hi) { unsigned r; asm volatile("v_cvt_pk_bf16_f32 %0, %1, %2" : "=v"(r) : "v"(lo), "v"(hi)); return r; }
__device__ __forceinline__ unsigned short f2bf(float f) { return (unsigned short)(cvt_pk_bf16(f, 0.f) & 0xffffu); }
__device__ __forceinline__ float wave_sum(float v) {
#pragma unroll
    for (int o = 1; o < 64; o <<= 1) v += __shfl_xor(v, o);
    return v;
}
__device__ __forceinline__ float wave_max(float v) {
#pragma unroll
    for (int o = 1; o < 64; o <<= 1) v = fmaxf(v, __shfl_xor(v, o));
    return v;
}
__device__ __forceinline__ float fexp(float x) { return __builtin_amdgcn_exp2f(1.4426950408889634f * x); }
__device__ __forceinline__ float softplusf_(float x) { return fmaxf(x, 0.f) + 0.6931471805599453f * __builtin_amdgcn_logf(1.f + __builtin_amdgcn_exp2f(-1.4426950408889634f * fabsf(x))); }
__device__ __forceinline__ float sigmoidf_(float x) { return __builtin_amdgcn_rcpf(1.f + __builtin_amdgcn_exp2f(-1.4426950408889634f * x)); }
__device__ __forceinline__ unsigned ld_u32_agent(const unsigned* p) { return __hip_atomic_load(p, __ATOMIC_RELAXED, __HIP_MEMORY_SCOPE_AGENT); }
__device__ __forceinline__ float ld_f32_agent(const float* p) { return __builtin_bit_cast(float, __hip_atomic_load((const unsigned*)p, __ATOMIC_RELAXED, __HIP_MEMORY_SCOPE_AGENT)); }
#define LDS_WAIT() asm volatile("s_waitcnt lgkmcnt(0)" ::: "memory")
__device__ __forceinline__ int lane_id_opaque() { int l; asm volatile("v_mbcnt_lo_u32_b32 %0, -1, 0\n\tv_mbcnt_hi_u32_b32 %0, -1, %0" : "=v"(l)); return l; }

namespace pg8 {
constexpr int BM = 256, BK = 64, HALF = 128, HTB = HALF * BK * 2, STAGE_BYTES = 8 * HTB, NXCD = 8, WGM = 8;
__host__ __device__ __forceinline__ int lds_byte(int r, int c) { const int st = (r >> 4) * 2 + (c >> 5), rr = r & 15, cc = c & 31, ob = rr * 64 + cc * 2; return st * 1024 + (ob ^ (((ob >> 9) & 1) << 5)); }
__host__ __device__ __forceinline__ void stage_rc(int b, int& R, int& C) { const unsigned ub = (unsigned)b, st = ub >> 10, sb = ub & 1023u, swz = sb ^ (((sb >> 9) & 1u) << 5); R = (int)((st >> 1) * 16u + (swz >> 6)); C = (int)((st & 1u) * 32u + ((swz & 63u) >> 1)); }
__host__ __device__ __forceinline__ int perm32(int rho) { const int n = rho >> 4, i = rho & 15; return 8 * (i >> 2) + 4 * n + (i & 3); }

struct Unit { int pm, pn, pb; };
struct Gemm { const bf16_t* A; const bf16_t* Bt; int lda, ldb, K; };

struct StaticOrder {
    int nM, nN, nwg, G, c;
    __device__ void init(int M, int N, int G_, int c_) { nM = M / BM; nN = N / BM; nwg = nM * nN; G = G_; c = c_; }
    __device__ bool next(int i, Unit& u) const {
        const long L = (long)i * G + c; if (L >= nwg) return false;
        int wgid = (int)L; { const int q = nwg / NXCD, r = nwg % NXCD, xcd = wgid % NXCD, off = wgid / NXCD; wgid = (xcd < r ? xcd * (q + 1) : r * (q + 1) + (xcd - r) * q) + off; }
        const int nig = WGM * nN, gid = wgid / nig, fm = gid * WGM, gsz = (nM - fm) < WGM ? (nM - fm) : WGM;
        u.pm = fm + ((wgid % nig) % gsz); u.pn = (wgid % nig) / gsz; u.pb = u.pn; return true;
    }
};
struct MoeOrder {
    int nM, nN, nwg, G, c; const unsigned* pexp;
    __device__ void init(int nM_, int nN_, int G_, int c_, const unsigned* pexp_) { nM = nM_; nN = nN_; nwg = nM * nN; G = G_; c = c_; pexp = pexp_; }
    __device__ bool next(int i, Unit& u) const {
        const long L = (long)i * G + c; if (L >= nwg) return false;
        int wgid = (int)L; { const int q = nwg / NXCD, r = nwg % NXCD, xcd = wgid % NXCD, off = wgid / NXCD; wgid = (xcd < r ? xcd * (q + 1) : r * (q + 1) + (xcd - r) * q) + off; }
        const int nig = WGM * nN, gid = wgid / nig, fm = gid * WGM, gsz = (nM - fm) < WGM ? (nM - fm) : WGM;
        u.pm = fm + ((wgid % nig) % gsz); u.pn = (wgid % nig) / gsz;
        const int e = (int)__builtin_amdgcn_readfirstlane(ld_u32_agent(pexp + u.pm)); u.pb = e * nN + u.pn; return true;
    }
};

template <class Epi, class Sched, bool ALIGN_EPI = false, bool SP2 = false>
__device__ __forceinline__ void gemm_phase(LAS unsigned char* lds, const Gemm g, const Sched& S, const Epi& E, const int wave0) {
    int tid_ = wave0 * 64 + lane_id_opaque();
    const int tid = tid_, wid = __builtin_amdgcn_readfirstlane(tid >> 6), lane = tid & 63, wr = wid >> 2, wc = wid & 3, fr = lane & 15, fq = lane >> 4;
    const int K = g.K, nt = K / BK;
    unsigned voffA[2], voffB[2];
    { int R, C; stage_rc(tid * 16, R, C); const int Rb = Epi::PERM ? ((R & ~31) + perm32(R & 31)) : R;
      voffA[0] = (unsigned)(R * g.lda + C) * 2u; voffB[0] = (unsigned)(Rb * g.ldb + C) * 2u; voffA[1] = voffA[0] + (unsigned)(64 * g.lda) * 2u; voffB[1] = voffB[0] + (unsigned)(64 * g.ldb) * 2u; }
    const size_t kstep = (size_t)(BK * 2);
    const size_t hsA = (size_t)HALF * g.lda * 2, hsB = (size_t)HALF * g.ldb * 2;
    const size_t tsA = 2 * hsA, tsB = 2 * hsB;
    const unsigned ldsw = (unsigned)wid * 1024u;
    const int swz_ = (fr * 64 + fq * 16) ^ ((fr & 8) << 2); const int aoff = wr * 8192 + swz_, boff = wc * 4096 + swz_;
#define PG8_SA(b, h) (((b) * 2 + (h)) * HTB)
#define PG8_SB(b, h) ((4 + (b) * 2 + (h)) * HTB)
#define PG8_STAGE(bufoff, gbase, voff) do { _Pragma("unroll") for (int _i = 0; _i < 2; ++_i) \
        __builtin_amdgcn_global_load_lds((const unsigned*)((const char*)(gbase) + (voff)[_i]), (LAS unsigned*)(lds + (bufoff) + ldsw + _i * 8192), 16, 0, 0); } while (0)
#define PG8_LDA(dst, b, h) do { _Pragma("unroll") for (int m = 0; m < 4; ++m) _Pragma("unroll") for (int k = 0; k < 2; ++k) dst[m][k] = *(const LAS bf16x8*)(lds + PG8_SA(b, h) + aoff + m * 2048 + k * 1024); } while (0)
#define PG8_LDB(dst, b, h) do { _Pragma("unroll") for (int n = 0; n < 2; ++n) _Pragma("unroll") for (int k = 0; k < 2; ++k) dst[n][k] = *(const LAS bf16x8*)(lds + PG8_SB(b, h) + boff + n * 2048 + k * 1024); } while (0)
#define PG8_MMA(ai, bj, At, Bt) do { __builtin_amdgcn_s_setprio(1); _Pragma("unroll") for (int m = 0; m < 4; ++m) _Pragma("unroll") for (int n = 0; n < 2; ++n) _Pragma("unroll") for (int k = 0; k < 2; ++k) \
        acc[ai][bj][m][n] = __builtin_amdgcn_mfma_f32_16x16x32_bf16(Bt[n][k], At[m][k], acc[ai][bj][m][n], 0, 0, 0); __builtin_amdgcn_s_setprio(0); } while (0)
#define PG8_WAIT_V(n) asm volatile("s_waitcnt vmcnt(" #n ")" ::: "memory")
#define PG8_WAIT_L(n) asm volatile("s_waitcnt lgkmcnt(" #n ")" ::: "memory")
#define PG8_BAR __builtin_amdgcn_s_barrier()
#define PG8_SCHED __builtin_amdgcn_sched_barrier(0)
    Unit cur, nxt; int ui = 0;
    if (!S.next(0, cur)) return;
    f32x4 acc[2][2][4][2];
#pragma unroll
    for (int a = 0; a < 2; ++a)
#pragma unroll
        for (int b = 0; b < 2; ++b)
#pragma unroll
            for (int m = 0; m < 4; ++m)
#pragma unroll
                for (int n = 0; n < 2; ++n) acc[a][b][m][n] = (f32x4){0.f, 0.f, 0.f, 0.f};
    bf16x8 At[4][2], B0[2][2], B1[2][2];
    const char* cA = (const char*)g.A + (size_t)cur.pm * tsA; const char* cB = (const char*)g.Bt + (size_t)cur.pb * tsB;
    if constexpr (SP2) {
        PG8_STAGE(PG8_SB(0, 0), cB, voffB); PG8_STAGE(PG8_SB(0, 1), cB + hsB, voffB); PG8_STAGE(PG8_SA(0, 0), cA, voffA); PG8_STAGE(PG8_SA(0, 1), cA + hsA, voffA);
        if (wr == 1) PG8_BAR;
        PG8_WAIT_V(2); PG8_BAR;
        PG8_STAGE(PG8_SB(1, 0), cB + kstep, voffB); PG8_STAGE(PG8_SA(1, 0), cA + kstep, voffA); PG8_STAGE(PG8_SB(1, 1), cB + hsB + kstep, voffB);
        PG8_WAIT_V(6); PG8_BAR;
    } else {
        PG8_STAGE(PG8_SB(0, 0), cB, voffB); PG8_STAGE(PG8_SA(0, 0), cA, voffA); PG8_STAGE(PG8_SB(0, 1), cB + hsB, voffB); PG8_STAGE(PG8_SA(0, 1), cA + hsA, voffA);
        if (wr == 1) PG8_BAR;
        PG8_WAIT_V(4); PG8_BAR;
        PG8_STAGE(PG8_SB(1, 0), cB + kstep, voffB); PG8_STAGE(PG8_SA(1, 0), cA + kstep, voffA); PG8_STAGE(PG8_SB(1, 1), cB + hsB + kstep, voffB);
        PG8_WAIT_V(6); PG8_BAR;
    }
    for (;;) {
        const bool has_next = S.next(ui + 1, nxt);
        const char* nA = has_next ? (const char*)g.A + (size_t)nxt.pm * tsA : cA; const char* nB = has_next ? (const char*)g.Bt + (size_t)nxt.pb * tsB : cB;
        for (int t = 0; t < nt; t += 2) {
            const bool last = (t == nt - 2);
            const char* a1 = cA + (size_t)(t + 1) * kstep;
            const char* a2 = last ? nA : cA + (size_t)(t + 2) * kstep; const char* b2 = last ? nB : cB + (size_t)(t + 2) * kstep;
            const char* a3 = a2 + kstep; const char* b3 = b2 + kstep;
            if constexpr (SP2) {
            PG8_LDB(B0, 0, 0); PG8_LDB(B1, 0, 1); PG8_SCHED; PG8_LDA(At, 0, 0); PG8_STAGE(PG8_SA(1, 1), a1 + hsA, voffA);
            PG8_WAIT_V(8); PG8_WAIT_L(0); PG8_BAR; PG8_MMA(0, 0, At, B0); PG8_MMA(0, 1, At, B1); PG8_BAR; PG8_SCHED;
            PG8_LDA(At, 0, 1); PG8_STAGE(PG8_SB(0, 0), b2, voffB); PG8_STAGE(PG8_SB(0, 1), b2 + hsB, voffB); PG8_STAGE(PG8_SA(0, 0), a2, voffA);
            PG8_WAIT_V(8); PG8_WAIT_L(0); PG8_BAR; PG8_MMA(1, 0, At, B0); PG8_MMA(1, 1, At, B1); PG8_BAR; PG8_SCHED;
            PG8_LDB(B0, 1, 0); PG8_LDB(B1, 1, 1); PG8_SCHED; PG8_LDA(At, 1, 0); PG8_STAGE(PG8_SA(0, 1), a2 + hsA, voffA);
            PG8_WAIT_V(8); PG8_WAIT_L(0); PG8_BAR; PG8_MMA(0, 0, At, B0); PG8_MMA(0, 1, At, B1); PG8_BAR; PG8_SCHED;
            PG8_LDA(At, 1, 1); PG8_STAGE(PG8_SB(1, 0), b3, voffB); PG8_STAGE(PG8_SB(1, 1), b3 + hsB, voffB); PG8_STAGE(PG8_SA(1, 0), a3, voffA);
            PG8_WAIT_V(8); PG8_WAIT_L(0); PG8_BAR; PG8_MMA(1, 0, At, B0); PG8_MMA(1, 1, At, B1); PG8_BAR; PG8_SCHED;
            } else {
            PG8_LDB(B0, 0, 0); PG8_SCHED; PG8_LDA(At, 0, 0); PG8_STAGE(PG8_SA(1, 1), a1 + hsA, voffA);
            PG8_WAIT_L(8); PG8_BAR; PG8_WAIT_L(0); PG8_MMA(0, 0, At, B0); PG8_BAR; PG8_SCHED;
            PG8_LDB(B1, 0, 1); PG8_STAGE(PG8_SB(0, 0), b2, voffB);
            PG8_BAR; PG8_WAIT_L(0); PG8_MMA(0, 1, At, B1); PG8_BAR;
            PG8_LDA(At, 0, 1); PG8_STAGE(PG8_SA(0, 0), a2, voffA);
            PG8_BAR; PG8_WAIT_L(0); PG8_MMA(1, 0, At, B0); PG8_BAR; PG8_SCHED;
            PG8_STAGE(PG8_SB(0, 1), b2 + hsB, voffB);
            PG8_WAIT_V(6); PG8_BAR; PG8_MMA(1, 1, At, B1); PG8_BAR;
            PG8_LDB(B0, 1, 0); PG8_SCHED; PG8_LDA(At, 1, 0); PG8_STAGE(PG8_SA(0, 1), a2 + hsA, voffA);
            PG8_WAIT_L(8); PG8_BAR; PG8_WAIT_L(0); PG8_MMA(0, 0, At, B0); PG8_BAR; PG8_SCHED;
            PG8_LDB(B1, 1, 1); PG8_STAGE(PG8_SB(1, 0), b3, voffB);
            PG8_BAR; PG8_WAIT_L(0); PG8_MMA(0, 1, At, B1); PG8_BAR;
            PG8_LDA(At, 1, 1); PG8_STAGE(PG8_SA(1, 0), a3, voffA);
            PG8_BAR; PG8_WAIT_L(0); PG8_MMA(1, 0, At, B0); PG8_BAR; PG8_SCHED;
            PG8_STAGE(PG8_SB(1, 1), b3 + hsB, voffB);
            PG8_WAIT_V(6); PG8_BAR; PG8_MMA(1, 1, At, B1); PG8_BAR;
            }
        }
        if constexpr (ALIGN_EPI) { if (wr == 0) PG8_BAR; }
        E(acc, cur, wr, wc, fr, fq);
        if (!has_next) break;
#pragma unroll
        for (int a = 0; a < 2; ++a)
#pragma unroll
            for (int b = 0; b < 2; ++b)
#pragma unroll
                for (int m = 0; m < 4; ++m)
#pragma unroll
                    for (int n = 0; n < 2; ++n) acc[a][b][m][n] = (f32x4){0.f, 0.f, 0.f, 0.f};
        cur = nxt; cA = nA; cB = nB; ++ui;
        if constexpr (ALIGN_EPI) { if (wr == 1) PG8_BAR; }
    }
    PG8_WAIT_V(0);
    if constexpr (!ALIGN_EPI) { if (wr == 0) PG8_BAR; }
    PG8_BAR;
#undef PG8_SA
#undef PG8_SB
#undef PG8_STAGE
#undef PG8_LDA
#undef PG8_LDB
#undef PG8_MMA
#undef PG8_WAIT_V
#undef PG8_WAIT_L
#undef PG8_BAR
#undef PG8_SCHED
}

typedef const f32x4 (&AccT)[2][2][4][2];
#define EPI_FENCE() asm volatile("" ::: "memory")

struct EpiInProj {
    static constexpr bool PERM = true;
    unsigned char* xbase; const float* rs;
    __device__ __forceinline__ void operator()(AccT acc, const Unit& u, int wr, int wc, int fr, int fq) const {
        const int pn = u.pn; size_t boff; int ld, ct; bool sig = false;
        float sc = 1.f;
        if (pn < 4) { boff = X_Z; ld = 1024; ct = pn; }
        else if (pn < 9) { boff = X_XBC; ld = 1280; ct = pn - 4; }
        else if (pn < 11) { boff = X_Q; ld = 512; ct = pn - 9; sc = 0.18033688011112042f; }
        else if (pn < 13) { boff = X_K; ld = 512; ct = pn - 11; }
        else { boff = X_GS; ld = 2048; ct = pn - 13; sig = true; }
        const unsigned lo = (unsigned)(fr * ld + 8 * fq) * 2u;
        unsigned char* tb = xbase + boff + ((size_t)(u.pm * BM + wr * 64) * ld + ct * BM + wc * 32) * 2;
        const float* rsb = rs + u.pm * BM + wr * 64;
#pragma unroll
        for (int ai = 0; ai < 2; ++ai)
#pragma unroll
            for (int m = 0; m < 4; ++m) { const float r = rsb[ai * HALF + m * 16 + fr] * sc; unsigned char* rowp = tb + (size_t)(ai * HALF + m * 16) * ld * 2;
#pragma unroll
                for (int bj = 0; bj < 2; ++bj) { f32x4 v0 = acc[ai][bj][m][0] * r, v1 = acc[ai][bj][m][1] * r;
                    if (sig) {
#pragma unroll
                        for (int j = 0; j < 4; ++j) { v0[j] = sigmoidf_(v0[j]); v1[j] = sigmoidf_(v1[j]); } }
                    u32x4 w; w.x = cvt_pk_bf16(v0[0], v0[1]); w.y = cvt_pk_bf16(v0[2], v0[3]); w.z = cvt_pk_bf16(v1[0], v1[1]); w.w = cvt_pk_bf16(v1[2], v1[3]);
                    *(u32x4*)(rowp + lo + bj * HALF * 2) = w; }
                EPI_FENCE(); }
    }
};
struct EpiBf16Rs {
    static constexpr bool PERM = true;
    bf16_t* O; int ldc; const float* rs; float sc;
    __device__ __forceinline__ void operator()(AccT acc, const Unit& u, int wr, int wc, int fr, int fq) const {
        const unsigned lo = (unsigned)(fr * ldc + 8 * fq) * 2u;
        unsigned char* tb = (unsigned char*)O + ((size_t)(u.pm * BM + wr * 64) * ldc + u.pn * BM + wc * 32) * 2;
        const float* rsb = rs + u.pm * BM + wr * 64;
#pragma unroll
        for (int ai = 0; ai < 2; ++ai)
#pragma unroll
            for (int m = 0; m < 4; ++m) { const float r = rsb[ai * HALF + m * 16 + fr] * sc; unsigned char* rowp = tb + (size_t)(ai * HALF + m * 16) * ldc * 2;
#pragma unroll
                for (int bj = 0; bj < 2; ++bj) { const f32x4 v0 = acc[ai][bj][m][0] * r, v1 = acc[ai][bj][m][1] * r;
                    u32x4 w; w.x = cvt_pk_bf16(v0[0], v0[1]); w.y = cvt_pk_bf16(v0[2], v0[3]); w.z = cvt_pk_bf16(v1[0], v1[1]); w.w = cvt_pk_bf16(v1[2], v1[3]);
                    *(u32x4*)(rowp + lo + bj * HALF * 2) = w; }
                EPI_FENCE(); }
    }
};
struct EpiBf16Cs {
    static constexpr bool PERM = true;
    bf16_t* O; int ldc; const float* cs; float sc;
    __device__ __forceinline__ void operator()(AccT acc, const Unit& u, int wr, int wc, int fr, int fq) const {
        const unsigned lo = (unsigned)(fr * ldc + 8 * fq) * 2u;
        unsigned char* tb = (unsigned char*)O + ((size_t)(u.pm * BM + wr * 64) * ldc + u.pn * BM + wc * 32) * 2;
        const float* csb = cs + u.pn * BM + wc * 32 + 8 * fq;
        f32x4 c0[2], c1[2];
#pragma unroll
        for (int bj = 0; bj < 2; ++bj) { c0[bj] = *(const f32x4*)(csb + bj * HALF) * sc; c1[bj] = *(const f32x4*)(csb + bj * HALF + 4) * sc; }
#pragma unroll
        for (int ai = 0; ai < 2; ++ai)
#pragma unroll
            for (int m = 0; m < 4; ++m) { unsigned char* rowp = tb + (size_t)(ai * HALF + m * 16) * ldc * 2;
#pragma unroll
                for (int bj = 0; bj < 2; ++bj) { const f32x4 v0 = acc[ai][bj][m][0] * c0[bj], v1 = acc[ai][bj][m][1] * c1[bj];
                    u32x4 w; w.x = cvt_pk_bf16(v0[0], v0[1]); w.y = cvt_pk_bf16(v0[2], v0[3]); w.z = cvt_pk_bf16(v1[0], v1[1]); w.w = cvt_pk_bf16(v1[2], v1[3]);
                    *(u32x4*)(rowp + lo + bj * HALF * 2) = w; }
                EPI_FENCE(); }
    }
};
template <bool ADD> struct EpiGate {
    static constexpr bool PERM = true;
    bf16_t* O; const bf16_t* GS; int gcol0;
    __device__ __forceinline__ void operator()(AccT acc, const Unit& u, int wr, int wc, int fr, int fq) const {
        const unsigned lo = (unsigned)(fr * 1024 + 8 * fq) * 2u, lg = (unsigned)(fr * 2048 + 8 * fq) * 2u;
        unsigned char* tb = (unsigned char*)O + ((size_t)(u.pm * BM + wr * 64) * 1024 + u.pn * BM + wc * 32) * 2;
        const unsigned char* gb = (const unsigned char*)GS + ((size_t)(u.pm * BM + wr * 64) * 2048 + gcol0 + u.pn * BM + wc * 32) * 2;
#pragma unroll
        for (int ai = 0; ai < 2; ++ai)
#pragma unroll
            for (int m = 0; m < 4; ++m) { unsigned char* rowp = tb + (size_t)(ai * HALF + m * 16) * 1024 * 2; const unsigned char* gp = gb + (size_t)(ai * HALF + m * 16) * 2048 * 2;
#pragma unroll
                for (int bj = 0; bj < 2; ++bj) { const u32x4 gw = *(const u32x4*)(gp + lg + bj * HALF * 2); f32x4 v0 = acc[ai][bj][m][0], v1 = acc[ai][bj][m][1];
                    v0[0] *= bflo(gw.x); v0[1] *= bfhi(gw.x); v0[2] *= bflo(gw.y); v0[3] *= bfhi(gw.y); v1[0] *= bflo(gw.z); v1[1] *= bfhi(gw.z); v1[2] *= bflo(gw.w); v1[3] *= bfhi(gw.w);
                    if (ADD) { const u32x4 pw = *(const u32x4*)(rowp + lo + bj * HALF * 2);
                        v0[0] += bflo(pw.x); v0[1] += bfhi(pw.x); v0[2] += bflo(pw.y); v0[3] += bfhi(pw.y); v1[0] += bflo(pw.z); v1[1] += bfhi(pw.z); v1[2] += bflo(pw.w); v1[3] += bfhi(pw.w); }
                    u32x4 w; w.x = cvt_pk_bf16(v0[0], v0[1]); w.y = cvt_pk_bf16(v0[2], v0[3]); w.z = cvt_pk_bf16(v1[0], v1[1]); w.w = cvt_pk_bf16(v1[2], v1[3]);
                    *(u32x4*)(rowp + lo + bj * HALF * 2) = w; }
                EPI_FENCE(); }
    }
};
struct EpiResid {
    static constexpr bool PERM = false;
    const float* Hin; float* Hout;
    __device__ __forceinline__ void operator()(AccT acc, const Unit& u, int wr, int wc, int fr, int fq) const {
        const unsigned lo = (unsigned)(fr * 1024 + 4 * fq) * 4u;
        const size_t ub = ((size_t)(u.pm * BM + wr * 64) * 1024 + u.pn * BM + wc * 32) * 4;
#pragma unroll
        for (int ai = 0; ai < 2; ++ai)
#pragma unroll
            for (int m = 0; m < 4; ++m) { const size_t ro = ub + (size_t)(ai * HALF + m * 16) * 1024 * 4; const unsigned char* hi = (const unsigned char*)Hin + ro; unsigned char* ho = (unsigned char*)Hout + ro;
                f32x4 hv[2][2];
#pragma unroll
                for (int bj = 0; bj < 2; ++bj)
#pragma unroll
                    for (int n = 0; n < 2; ++n) hv[bj][n] = *(const f32x4*)(hi + lo + (bj * HALF + n * 16) * 4);
#pragma unroll
                for (int bj = 0; bj < 2; ++bj)
#pragma unroll
                    for (int n = 0; n < 2; ++n) *(f32x4*)(ho + lo + (bj * HALF + n * 16) * 4) = hv[bj][n] + acc[ai][bj][m][n];
                EPI_FENCE(); }
    }
};
struct EpiSwiglu {
    static constexpr bool PERM = true;
    bf16_t* ACT; const float* rs;
    __device__ __forceinline__ void operator()(AccT acc, const Unit& u, int wr, int wc, int fr, int fq) const {
        const unsigned lo = (unsigned)(fr * DFF + 8 * fq) * 2u;
        unsigned char* tb = (unsigned char*)ACT + ((size_t)(u.pm * BM + wr * 64) * DFF + u.pn * HALF + wc * 32) * 2;
        const float* rsb = rs + u.pm * BM + wr * 64;
#pragma unroll
        for (int ai = 0; ai < 2; ++ai)
#pragma unroll
            for (int m = 0; m < 4; ++m) { const float r = rsb[ai * HALF + m * 16 + fr];
                float o[8];
#pragma unroll
                for (int n = 0; n < 2; ++n)
#pragma unroll
                    for (int j = 0; j < 4; ++j) { const float gt = acc[ai][0][m][n][j] * r, up = acc[ai][1][m][n][j] * r; o[n * 4 + j] = gt * sigmoidf_(gt) * up; }
                u32x4 w; w.x = cvt_pk_bf16(o[0], o[1]); w.y = cvt_pk_bf16(o[2], o[3]); w.z = cvt_pk_bf16(o[4], o[5]); w.w = cvt_pk_bf16(o[6], o[7]);
                *(u32x4*)(tb + (size_t)(ai * HALF + m * 16) * DFF * 2 + lo) = w;
                EPI_FENCE(); }
    }
};
struct EpiMoeDown {
    static constexpr bool PERM = false;
    float* H; const int* rowl; const float* wrow;
    __device__ __forceinline__ void operator()(AccT acc, const Unit& u, int wr, int wc, int fr, int fq) const {
        const int rb = u.pm * BM + wr * 64; const unsigned cb = (unsigned)(u.pn * BM + wc * 32 + 4 * fq) * 4u;
#pragma unroll
        for (int ai = 0; ai < 2; ++ai)
#pragma unroll
            for (int m = 0; m < 4; ++m) { const int row = rb + ai * HALF + m * 16 + fr; const int tok = rowl[row]; const float w = wrow[row];
                if (tok >= 0) { unsigned char* hp = (unsigned char*)H + (size_t)tok * 4096 + cb;
                    f32x4 hv[2][2];
#pragma unroll
                    for (int bj = 0; bj < 2; ++bj)
#pragma unroll
                        for (int n = 0; n < 2; ++n) hv[bj][n] = *(const f32x4*)(hp + (bj * HALF + n * 16) * 4);
#pragma unroll
                    for (int bj = 0; bj < 2; ++bj)
#pragma unroll
                        for (int n = 0; n < 2; ++n) *(f32x4*)(hp + (bj * HALF + n * 16) * 4) = hv[bj][n] + acc[ai][bj][m][n] * w; }
                EPI_FENCE(); }
    }
};
}

#define XB_TMO      128
#define XB_XCNT(j)  (256  + 64 * (j))
#define XB_XSUB(j)  (1280 + 64 * (j))
#define XB_XGEN(j)  (2304 + 64 * (j))
#define XB_TOP      3328
#define XB_TOPGEN   3392
#define XCD_BAR_WORDS 3456
#define XB_SPIN_CAP (1u << 22)
__device__ __forceinline__ unsigned xb_ld(unsigned* p)              { return __hip_atomic_load(p, __ATOMIC_RELAXED, __HIP_MEMORY_SCOPE_AGENT); }
__device__ __forceinline__ unsigned xb_add(unsigned* p, unsigned v) { return __hip_atomic_fetch_add(p, v, __ATOMIC_RELAXED, __HIP_MEMORY_SCOPE_AGENT); }
__device__ __forceinline__ unsigned xb_xcc_id() { return (unsigned)__builtin_amdgcn_s_getreg((3 << 11) | 20) & 0xFu; }
#define XB_SPIN(cond, bar) do { unsigned _sp = 0; while (cond) { __builtin_amdgcn_s_sleep(1); \
    if ((++_sp & 255u) == 0u) { if (xb_ld(&(bar)[XB_TMO])) break; if (_sp > XB_SPIN_CAP) { atomicAdd(&(bar)[XB_TMO], 1u); break; } } } } while (0)
struct XcdBarrier { unsigned* bar; unsigned x; volatile LAS unsigned* st; };
__device__ __forceinline__ XcdBarrier xcd_barrier_post(unsigned* bar, volatile LAS unsigned* st) {
    XcdBarrier b; b.bar = bar; b.x = xb_xcc_id(); b.st = st;
    if (threadIdx.x == 0) (void)xb_add(&bar[XB_XCNT(b.x)], 1u);
    return b;
}
__device__ __forceinline__ void xcd_barrier_complete(unsigned* bar, unsigned x, unsigned& nloc, unsigned& nx) {
    const unsigned G = gridDim.x * gridDim.y * gridDim.z;
    unsigned sum, cnt, mine, sp = 0u;
    for (;;) {
        sum = 0u; cnt = 0u; mine = 0u;
#pragma unroll
        for (unsigned j = 0; j < 16; ++j) { const unsigned c = xb_ld(&bar[XB_XCNT(j)]); sum += c; cnt += (c > 0u) ? 1u : 0u; mine = (j == x) ? c : mine; }
        if (sum == G) break;
        __builtin_amdgcn_s_sleep(1);
        if ((++sp & 255u) == 0u) { if (xb_ld(&bar[XB_TMO])) break; if (sp > XB_SPIN_CAP) { atomicAdd(&bar[XB_TMO], 1u); break; } }
    }
    nloc = mine > 0u ? mine : 1u; nx = cnt > 0u ? cnt : 1u;
}
__device__ __forceinline__ void xcd_barrier(const XcdBarrier& b, const bool leader_thread) {
    asm volatile("s_waitcnt vmcnt(0)" ::: "memory");
    __syncthreads();
    if (leader_thread) {
        unsigned* bar = b.bar;
        __builtin_amdgcn_s_waitcnt(0);
        unsigned nloc = b.st[0], nx = b.st[1];
        if (nloc == 0u) { xcd_barrier_complete(bar, b.x, nloc, nx); b.st[0] = nloc; b.st[1] = nx; }
        const unsigned old = xb_add(&bar[XB_XSUB(b.x)], 1u);
        const unsigned gen = old / nloc;
        if (old + 1u == (gen + 1u) * nloc) {
            __builtin_amdgcn_fence(__ATOMIC_RELEASE, "agent");
            asm volatile("s_waitcnt vmcnt(0)" ::: "memory");
            const unsigned og = xb_add(&bar[XB_TOP], 1u);
            const unsigned tg = og / nx;
            if (og + 1u == (tg + 1u) * nx) xb_add(&bar[XB_TOPGEN], 1u);
            else XB_SPIN(xb_ld(&bar[XB_TOPGEN]) == tg, bar);
            __builtin_amdgcn_fence(__ATOMIC_ACQUIRE, "agent");
            xb_add(&bar[XB_XGEN(b.x)], 1u);
            asm volatile("s_waitcnt vmcnt(0)" ::: "memory");
        } else {
            XB_SPIN(xb_ld(&bar[XB_XGEN(b.x)]) == gen, bar);
            __builtin_amdgcn_fence(__ATOMIC_ACQUIRE, "agent");
            asm volatile("s_waitcnt vmcnt(0)" ::: "memory");
        }
    }
    __syncthreads();
}

struct Params {
    const float* in[28];
    float* out;
    unsigned char* ws;
    int l_lo, l_hi, ph_lo, ph_hi;
};
enum { I_X = 0, I_MEM, I_NORM_MIX, I_W_IN, I_CONV_W, I_CONV_B, I_DT_BIAS, I_A_LOG, I_D_SKIP, I_SSD_NORM, I_W_SSD_O, I_W_SB_O, I_W_OUT, I_NORM_XA, I_NORM_MEM,
       I_XA_WQ, I_XA_WK, I_XA_WV, I_XA_WO, I_NORM_FFN, I_FFN_G, I_FFN_U, I_FFN_D, I_MOE_R, I_MOE_G, I_MOE_U, I_MOE_D, I_FINAL };

__device__ __forceinline__ void tr_item(const float* W, int ldw, int k0, int n0, const float* gain, bf16_t* WT, int ldt, int drow0, LAS float* scr, int lane) {
#pragma unroll 8
    for (int i = 0; i < 32; ++i) { const int kk = 2 * i + (lane >> 5); const float gk = gain ? gain[k0 + kk] : 1.f; scr[kk * 33 + (lane & 31)] = W[(size_t)(k0 + kk) * ldw + n0 + (lane & 31)] * gk; }
    LDS_WAIT();
    const int c = lane & 7;
#pragma unroll
    for (int j = 0; j < 4; ++j) { const int n = (lane >> 3) + 8 * j; const LAS float* s = scr + (8 * c) * 33 + n;
        u32x4 o; o.x = cvt_pk_bf16(s[0 * 33], s[1 * 33]); o.y = cvt_pk_bf16(s[2 * 33], s[3 * 33]); o.z = cvt_pk_bf16(s[4 * 33], s[5 * 33]); o.w = cvt_pk_bf16(s[6 * 33], s[7 * 33]);
        *(u32x4*)(WT + (size_t)(drow0 + n) * ldt + k0 + 8 * c) = o; }
    LDS_WAIT();
}
struct TrJob { const float* W; int ldw, K, col0, ncols; const float* gain; bf16_t* WT; int dbase, dgroup; };
__device__ __forceinline__ void run_job(const TrJob& j, int& base, int gw, int NGW, LAS float* scr, int lane) {
    const int nblk = j.ncols / 32, nitems = (j.K / 64) * nblk;
    int start = (gw - base) % NGW; if (start < 0) start += NGW;
    for (int it = start; it < nitems; it += NGW) { const int kb = it / nblk, nb = it % nblk, c0 = nb * 32;
        tr_item(j.W, j.ldw, kb * 64, j.col0 + c0, j.gain, j.WT, j.K, j.dbase + (c0 / 128) * j.dgroup + (c0 % 128), scr, lane); }
    base = (base + nitems) % NGW;
}

template <int NE>
__device__ __forceinline__ float rowpass_row(const float* xrow, bf16_t* brow, int lane, const LAS float* wsm, float (&ex)[NE > 0 ? NE : 1]) {
    const f32x4* xr = (const f32x4*)xrow + lane;
    f32x4 v[4]; float s = 0.f;
#pragma unroll
    for (int j = 0; j < 4; ++j) { v[j] = xr[64 * j]; s += (v[j].x * v[j].x + v[j].y * v[j].y) + (v[j].z * v[j].z + v[j].w * v[j].w); }
    const float rstd = __builtin_amdgcn_rsqf(wave_sum(s) * (1.f / D) + EPS);
    u32x2* o8 = (u32x2*)brow + lane;
#pragma unroll
    for (int j = 0; j < 4; ++j) { u32x2 w; w.x = cvt_pk_bf16(v[j].x, v[j].y); w.y = cvt_pk_bf16(v[j].z, v[j].w); o8[64 * j] = w; }
    if constexpr (NE > 0) {
#pragma unroll
        for (int e = 0; e < NE; ++e) { float p = 0.f;
#pragma unroll
            for (int j = 0; j < 4; ++j) { const f32x4 w4 = *(const LAS f32x4*)(wsm + e * 1024 + 256 * j + 4 * lane); p += (v[j].x * w4.x + v[j].y * w4.y) + (v[j].z * w4.z + v[j].w * w4.w); }
            ex[e] = wave_sum(p) * rstd; }
    }
    return rstd;
}

typedef float f32x16 __attribute__((ext_vector_type(16)));
#define MFMA32(a, b, c) __builtin_amdgcn_mfma_f32_32x32x16_bf16((a), (b), (c), 0, 0, 0)
__device__ __forceinline__ bf16x8 ldg8(const bf16_t* p) { return *(const bf16x8*)p; }
__device__ __forceinline__ bf16x8 pack8(const float* v) { u32x4 w; w.x = cvt_pk_bf16(v[0], v[1]); w.y = cvt_pk_bf16(v[2], v[3]); w.z = cvt_pk_bf16(v[4], v[5]); w.w = cvt_pk_bf16(v[6], v[7]); return __builtin_bit_cast(bf16x8, w); }
__device__ __forceinline__ int pi32(int r) { return 16 * ((r >> 2) & 1) + 4 * (r >> 3) + (r & 3); }

__device__ __forceinline__ void sb_attn_mfma(bf16_t* Q, const bf16_t* Kb, const bf16_t* Vt, int w, int NW, int lane) {
    const int c = lane & 31, hh = lane >> 5, pr = pi32(c);
    bf16x8 U[2];
#pragma unroll
    for (int kk = 0; kk < 2; ++kk) { u32x4 uw;
#pragma unroll
        for (int q = 0; q < 4; ++q) uw[q] = ((16 * hh + 8 * kk + 2 * q > pr) ? 0x3F80u : 0u) | ((16 * hh + 8 * kk + 2 * q + 1 > pr) ? 0x3F800000u : 0u);
        U[kk] = __builtin_bit_cast(bf16x8, uw); }
    for (int j = w; j < NBATCH * 8 * 64; j += NW) {
        const int bh = j & 127, slot = j >> 7, k4 = slot >> 4, a = slot & 15;
        const int qblk = k4 == 0 ? a : k4 == 1 ? 31 - a : k4 == 2 ? 32 + a : 63 - a;
        const int b = bh >> 3, h = bh & 7, t0 = qblk * 32;
        bf16_t* qp = Q + (size_t)(b * SEQ + t0 + c) * 512 + h * 64;
        bf16x8 qf[4];
#pragma unroll
        for (int jj = 0; jj < 4; ++jj) qf[jj] = ldg8(qp + 16 * jj + 8 * hh);
        const bf16_t* kbase = Kb + (size_t)(b * SEQ + pr) * 512 + h * 64 + 8 * hh;
        const bf16_t* vbase = Vt + (size_t)(h * 64 + c) * T + b * SEQ + 16 * hh;
        f32x16 o0, o1;
#pragma unroll
        for (int i = 0; i < 16; ++i) { o0[i] = 0.f; o1[i] = 0.f; }
        float R = 0.f;
        bf16x8 kf[4], vf[4], kn[4], vn[4];
#pragma unroll
        for (int jj = 0; jj < 4; ++jj) { kf[jj] = ldg8(kbase + (size_t)t0 * 512 + 16 * jj); vf[jj] = ldg8(vbase + (size_t)(jj >> 1) * 32 * T + t0 + 8 * (jj & 1)); }
        for (int kb = qblk; kb >= 0; --kb) {
            const int s0 = kb * 32;
            if (kb > 0) {
#pragma unroll
                for (int jj = 0; jj < 4; ++jj) { kn[jj] = ldg8(kbase + (size_t)(s0 - 32) * 512 + 16 * jj); vn[jj] = ldg8(vbase + (size_t)(jj >> 1) * 32 * T + (s0 - 32) + 8 * (jj & 1)); }
            }
            f32x16 s;
#pragma unroll
            for (int i = 0; i < 16; ++i) s[i] = 0.f;
#pragma unroll
            for (int jj = 0; jj < 4; ++jj) s = MFMA32(kf[jj], qf[jj], s);
            const bool diag = (kb == qblk);
            float sp[16]; float rsum = 0.f;
#pragma unroll
            for (int i = 0; i < 16; ++i) { const float x = s[i]; float v = fmaxf(x, 0.f) + __builtin_amdgcn_logf(1.f + __builtin_amdgcn_exp2f(-fabsf(x)));
                if (diag && !(16 * hh + i < c)) v = 0.f;
                sp[i] = v; rsum += v; }
            f32x16 E;
#pragma unroll
            for (int i = 0; i < 16; ++i) E[i] = 0.f;
            E = MFMA32(U[0], pack8(sp), E); E = MFMA32(U[1], pack8(sp + 8), E);
            float at[16];
#pragma unroll
            for (int i = 0; i < 16; ++i) { float av = __builtin_amdgcn_exp2f(s[i] - sp[i] - E[i] - R); if (diag && !(16 * hh + i < c)) av = 0.f; at[i] = av; }
            const bf16x8 a0 = pack8(at), a1 = pack8(at + 8);
            o0 = MFMA32(vf[0], a0, o0); o0 = MFMA32(vf[1], a1, o0);
            o1 = MFMA32(vf[2], a0, o1); o1 = MFMA32(vf[3], a1, o1);
            rsum += __shfl_xor(rsum, 32); R += rsum;
            if (__all(R > 160.f)) break;
#pragma unroll
            for (int jj = 0; jj < 4; ++jj) { kf[jj] = kn[jj]; vf[jj] = vn[jj]; }
        }
#pragma unroll
        for (int g = 0; g < 4; ++g) { u32x2 w0, w1; w0.x = cvt_pk_bf16(o0[4 * g], o0[4 * g + 1]); w0.y = cvt_pk_bf16(o0[4 * g + 2], o0[4 * g + 3]); w1.x = cvt_pk_bf16(o1[4 * g], o1[4 * g + 1]); w1.y = cvt_pk_bf16(o1[4 * g + 2], o1[4 * g + 3]);
            *(u32x2*)(qp + 8 * g + 4 * hh) = w0; *(u32x2*)(qp + 32 + 8 * g + 4 * hh) = w1; }
    }
}

__device__ __forceinline__ void xattn_mfma(const bf16_t* XQ, const bf16_t* KMl, const bf16_t* VtMl, bf16_t* XO, int w, int NW, int lane) {
    const int c = lane & 31, hh = lane >> 5, pr = pi32(c);
    for (int j = w; j < NBATCH * 4 * 64; j += NW) {
        const int qblk = j & 63, hd = (j >> 6) & 3, b = j >> 8, t0 = qblk * 32;
        const bf16_t* qp = XQ + (size_t)(b * SEQ + t0 + c) * 512 + hd * 128 + 8 * hh;
        bf16x8 qf[8];
#pragma unroll
        for (int jj = 0; jj < 8; ++jj) qf[jj] = ldg8(qp + 16 * jj);
        const bf16_t* kbase = KMl + (size_t)(b * MEMLEN + pr) * 2048 + hd * 128 + 8 * hh;
        const bf16_t* vbase = VtMl + (size_t)(hd * 128 + c) * TM + b * MEMLEN + 16 * hh;
        float mx = -3.0e38f;
        for (int kb = 0; kb < 8; ++kb) { f32x16 s;
#pragma unroll
            for (int i = 0; i < 16; ++i) s[i] = 0.f;
#pragma unroll
            for (int jj = 0; jj < 8; ++jj) s = MFMA32(ldg8(kbase + (size_t)kb * 32 * 2048 + 16 * jj), qf[jj], s);
#pragma unroll
            for (int i = 0; i < 16; ++i) mx = fmaxf(mx, s[i]); }
        mx = fmaxf(mx, __shfl_xor(mx, 32));
        f32x16 o[4];
#pragma unroll
        for (int db = 0; db < 4; ++db)
#pragma unroll
            for (int i = 0; i < 16; ++i) o[db][i] = 0.f;
        float sum = 0.f;
        for (int kb = 0; kb < 8; ++kb) { f32x16 s;
#pragma unroll
            for (int i = 0; i < 16; ++i) s[i] = 0.f;
#pragma unroll
            for (int jj = 0; jj < 8; ++jj) s = MFMA32(ldg8(kbase + (size_t)kb * 32 * 2048 + 16 * jj), qf[jj], s);
            float pv[16];
#pragma unroll
            for (int i = 0; i < 16; ++i) { pv[i] = __builtin_amdgcn_exp2f(s[i] - mx); sum += pv[i]; }
            const bf16x8 p0 = pack8(pv), p1 = pack8(pv + 8);
#pragma unroll
            for (int db = 0; db < 4; ++db) { const bf16_t* vp = vbase + (size_t)db * 32 * TM + kb * 32; o[db] = MFMA32(ldg8(vp), p0, o[db]); o[db] = MFMA32(ldg8(vp + 8), p1, o[db]); } }
        sum += __shfl_xor(sum, 32);
        const float inv = 1.f / sum;
        bf16_t* op = XO + (size_t)(b * SEQ + t0 + c) * 512 + hd * 128 + 4 * hh;
#pragma unroll
        for (int db = 0; db < 4; ++db)
#pragma unroll
            for (int g = 0; g < 4; ++g) { u32x2 w0; w0.x = cvt_pk_bf16(o[db][4 * g] * inv, o[db][4 * g + 1] * inv); w0.y = cvt_pk_bf16(o[db][4 * g + 2] * inv, o[db][4 * g + 3] * inv);
                *(u32x2*)(op + 32 * db + 8 * g) = w0; }
    }
}

#define PHASE_ENTER() unsigned char* ws = p.ws; asm volatile("" : "+s"(ws)); int tid_ = wave0 * 64 + lane_id_opaque(); int bid_ = blockIdx.x; asm volatile("" : "+s"(bid_)); \
    const int tid = tid_, lane = tid & 63, wave = __builtin_amdgcn_readfirstlane(tid >> 6); \
    const int G = gridDim.x, bid = bid_, gw = bid * 8 + wave, NGW = G * 8; (void)lane; (void)gw; (void)NGW; (void)wave; (void)bid; (void)G
#define WSP(type, off) ((type*)(ws + (off)))
__global__ void __launch_bounds__(512, 2) mk_fwd(Params p) {
    extern __shared__ __attribute__((aligned(16))) unsigned char lds_raw[];
    LAS unsigned char* lds = (LAS unsigned char*)lds_raw;
    volatile LAS unsigned* ldsctl = (volatile LAS unsigned*)(lds + LDSCTL_OFF);
    if (threadIdx.x < 64) ldsctl[threadIdx.x] = 0u;
    int wave0 = __builtin_amdgcn_readfirstlane((int)threadIdx.x >> 6); asm volatile("" : "+s"(wave0));
    __syncthreads();
    const int ph_lo = p.ph_lo, ph_hi = p.ph_hi;
    const bool use_bar = (ph_hi - ph_lo) > 1 || (p.l_hi - p.l_lo) > 1;
    XcdBarrier bar; bar.bar = (unsigned*)(p.ws + WS_CTL) + CW_BAR; bar.x = 0; bar.st = nullptr;
    if (use_bar) bar = xcd_barrier_post((unsigned*)(p.ws + WS_CTL) + CW_BAR, ldsctl + 8);
#define PH(k) (ph_lo <= (k) && (k) < ph_hi)
#define GRID_BAR() do { if (use_bar) xcd_barrier(bar, wave0 == 0 && lane_id_opaque() == 0); } while (0)

    if (p.l_lo == 0 && PH(0)) {
        PHASE_ENTER();
        LAS float* scr = (LAS float*)(lds + wave * 16384);
        int base = 0;
        for (int jb = 0; jb < 4 * 11 + 2 * 3; ++jb) {
            TrJob j;
            if (jb < 44) { const int l = jb / 11, k = jb % 11; unsigned char* wl = ws + WS_W + (size_t)l * W_LAYER;
                switch (k) {
                case 0: j = TrJob{p.in[I_W_IN] + (size_t)l * D * INW, INW, D, 0, 2304, p.in[I_NORM_MIX] + l * D, (bf16_t*)(wl + W_IN), 0, 128}; break;
                case 1: j = TrJob{p.in[I_W_IN] + (size_t)l * D * INW, INW, D, 2320, 1024, p.in[I_NORM_MIX] + l * D, (bf16_t*)(wl + W_IN), 2304, 128}; break;
                case 9: j = TrJob{p.in[I_W_IN] + (size_t)l * D * INW, INW, D, 3344, 512, p.in[I_NORM_MIX] + l * D, (bf16_t*)(wl + W_IN), 5376, 128}; break;
                case 10: j = TrJob{p.in[I_W_IN] + (size_t)l * D * INW, INW, D, 3856, 2048, p.in[I_NORM_MIX] + l * D, (bf16_t*)(wl + W_IN), 3328, 128}; break;
                case 2: j = TrJob{p.in[I_W_SSD_O] + (size_t)l * D * D, D, D, 0, D, p.in[I_SSD_NORM] + l * D, (bf16_t*)(wl + W_SSDO), 0, 128}; break;
                case 3: j = TrJob{p.in[I_W_SB_O] + (size_t)l * 512 * D, D, 512, 0, D, nullptr, (bf16_t*)(wl + W_SBO), 0, 128}; break;
                case 4: j = TrJob{p.in[I_W_OUT] + (size_t)l * D * D, D, D, 0, D, nullptr, (bf16_t*)(wl + W_OUT), 0, 128}; break;
                case 5: j = TrJob{p.in[I_XA_WQ] + (size_t)l * D * 512, 512, D, 0, 512, p.in[I_NORM_XA] + l * D, (bf16_t*)(wl + W_Q), 0, 128}; break;
                case 6: j = TrJob{p.in[I_XA_WK] + (size_t)l * D * 512, 512, D, 0, 512, p.in[I_NORM_MEM] + l * D, (bf16_t*)(ws + WS_WKV), l * 512, 128}; break;
                case 7: j = TrJob{p.in[I_XA_WV] + (size_t)l * D * 512, 512, D, 0, 512, p.in[I_NORM_MEM] + l * D, (bf16_t*)(ws + WS_WKV), 2048 + l * 512, 128}; break;
                case 8: j = TrJob{p.in[I_XA_WO] + (size_t)l * 512 * D, D, 512, 0, D, nullptr, (bf16_t*)(wl + W_O), 0, 128}; break;
                }
            } else { const int jj = (jb - 44) / 3, k = (jb - 44) % 3; unsigned char* wf = ws + WS_WFF + (size_t)jj * W_FF; const float* gn = p.in[I_NORM_FFN] + (2 * jj) * D;
                if (k == 0) j = TrJob{p.in[I_FFN_G] + (size_t)jj * D * DFF, DFF, D, 0, DFF, gn, (bf16_t*)(wf + W_GU), 0, 256};
                else if (k == 1) j = TrJob{p.in[I_FFN_U] + (size_t)jj * D * DFF, DFF, D, 0, DFF, gn, (bf16_t*)(wf + W_GU), 128, 256};
                else j = TrJob{p.in[I_FFN_D] + (size_t)jj * DFF * D, D, DFF, 0, D, nullptr, (bf16_t*)(wf + W_DN), 0, 128};
            }
            run_job(j, base, gw, NGW, scr, lane);
        }
        float dummy[1]; bf16_t* MEMB = WSP(bf16_t, WS_MEMB); float* RSMEM = WSP(float, WS_RSMEM);
        for (int m = gw; m < TM; m += NGW) { const float r = rowpass_row<0>(p.in[I_MEM] + (size_t)m * D, MEMB + (size_t)m * D, lane, nullptr, dummy); if (lane == 0) RSMEM[m] = r; }
        GRID_BAR();
    }
    if (p.l_lo == 0 && PH(1)) {
        PHASE_ENTER();
        { pg8::Gemm g{WSP(bf16_t, WS_MEMB), WSP(bf16_t, WS_WKV), D, D, D}; pg8::StaticOrder S; S.init(TM, 2048, G, bid);
          pg8::EpiBf16Rs E{WSP(bf16_t, WS_KM), 2048, WSP(float, WS_RSMEM), 1.f};
          pg8::gemm_phase<pg8::EpiBf16Rs, pg8::StaticOrder, true, true>(lds, g, S, E, wave0); }
        { pg8::Gemm g{WSP(bf16_t, WS_WKV) + (size_t)2048 * 1024, WSP(bf16_t, WS_MEMB), D, D, D}; pg8::StaticOrder S; S.init(2048, TM, G, (bid + G / 2) % G);
          pg8::EpiBf16Cs E{WSP(bf16_t, WS_VTM), TM, WSP(float, WS_RSMEM), 1.f};
          pg8::gemm_phase<pg8::EpiBf16Cs, pg8::StaticOrder, true, true>(lds, g, S, E, wave0); }
        GRID_BAR();
    }

    for (int l = p.l_lo; l < p.l_hi; ++l) {
        const bool moe = (l & 1) != 0; const int jf = l >> 1;

        if (PH(2)) {
            PHASE_ENTER();
            const float* Hin = (l == 0) ? p.in[I_X] : p.out; bf16_t* HB = WSP(bf16_t, WS_HB); float* RS = WSP(float, WS_RS); float* DT = WSP(float, WS_DT);
            LAS float* wsm = (LAS float*)lds;
            for (int i = tid; i < 16 * 1024; i += 512) { const int e = i >> 10, k = i & 1023; wsm[i] = p.in[I_W_IN][(size_t)l * D * INW + (size_t)k * INW + 2304 + e] * p.in[I_NORM_MIX][l * D + k]; }
            __syncthreads();
            for (int m = gw; m < T; m += NGW) { float ex[16];
                const float r = rowpass_row<16>(Hin + (size_t)m * D, HB + (size_t)m * D, lane, wsm, ex);
                if (lane == 0) RS[m] = r;
                float mine = 0.f;
#pragma unroll
                for (int e = 0; e < 16; ++e) mine = (lane == e) ? ex[e] : mine;
                if (lane < 16) { const float xv = mine + p.in[I_DT_BIAS][l * 16 + lane]; DT[(size_t)m * 16 + lane] = softplusf_(xv); }
            }
            __syncthreads();
            if (moe) {
                LAS float* scr = (LAS float*)(lds + 65536 + wave * 8704);
                int base = 0; const float* gn = p.in[I_NORM_FFN] + l * D;
                for (int jb = 0; jb < NEXP * 3; ++jb) { const int e = jb / 3, k = jb % 3; TrJob j; const size_t eo = ((size_t)jf * NEXP + e) * D * DFF;
                    if (k == 0) j = TrJob{p.in[I_MOE_G] + eo, DFF, D, 0, DFF, gn, (bf16_t*)(ws + WS_WMOE + WM_GU) + (size_t)e * 2 * DFF * 1024, 0, 256};
                    else if (k == 1) j = TrJob{p.in[I_MOE_U] + eo, DFF, D, 0, DFF, gn, (bf16_t*)(ws + WS_WMOE + WM_GU) + (size_t)e * 2 * DFF * 1024, 128, 256};
                    else j = TrJob{p.in[I_MOE_D] + eo, D, DFF, 0, D, nullptr, (bf16_t*)(ws + WS_WMOE + WM_DN) + (size_t)e * 1024 * DFF, 0, 128};
                    run_job(j, base, gw, NGW, scr, lane); }
            }
            GRID_BAR();
        }
        if (PH(3)) {
            PHASE_ENTER();
            { pg8::Gemm g{WSP(bf16_t, WS_HB), (const bf16_t*)(ws + WS_W + (size_t)l * W_LAYER + W_IN), D, D, D}; pg8::StaticOrder S; S.init(T, NPROJ - 512, G, bid);
              pg8::EpiInProj E{ws + WS_X, WSP(float, WS_RS)};
              pg8::gemm_phase<pg8::EpiInProj, pg8::StaticOrder, true, true>(lds, g, S, E, wave0); }
            { pg8::Gemm g{(const bf16_t*)(ws + WS_W + (size_t)l * W_LAYER + W_IN) + (size_t)(NPROJ - 512) * 1024, WSP(bf16_t, WS_HB), D, D, D}; pg8::StaticOrder S; S.init(512, T, G, bid);
              pg8::EpiBf16Cs E{WSP(bf16_t, WS_X + X_V), T, WSP(float, WS_RS), 1.f};
              pg8::gemm_phase<pg8::EpiBf16Cs, pg8::StaticOrder, true, true>(lds, g, S, E, wave0); }
            GRID_BAR();
        }
        if (PH(4)) {
            PHASE_ENTER();
            const bf16_t* XBC = WSP(bf16_t, WS_X + X_XBC); bf16_t* XC = WSP(bf16_t, WS_X + X_XC);
            const float* cw = p.in[I_CONV_W] + (size_t)l * 4 * 1280; const float* cb = p.in[I_CONV_B] + (size_t)l * 1280;
            for (int it = bid * 512 + tid; it < T * 160; it += G * 512) { const int tk = it / 160, c8 = (it % 160) * 8, s = tk & (SEQ - 1);
                float a[8];
#pragma unroll
                for (int j = 0; j < 8; ++j) a[j] = cb[c8 + j];
#pragma unroll
                for (int k = 0; k < 4; ++k) { if (s - 3 + k >= 0) { const u32x4 w = *(const u32x4*)(XBC + (size_t)(tk - 3 + k) * 1280 + c8); const float* wk = cw + k * 1280 + c8;
                    a[0] += bflo(w.x) * wk[0]; a[1] += bfhi(w.x) * wk[1]; a[2] += bflo(w.y) * wk[2]; a[3] += bfhi(w.y) * wk[3]; a[4] += bflo(w.z) * wk[4]; a[5] += bfhi(w.z) * wk[5]; a[6] += bflo(w.w) * wk[6]; a[7] += bfhi(w.w) * wk[7]; } }
#pragma unroll
                for (int j = 0; j < 8; ++j) a[j] = a[j] * sigmoidf_(a[j]);
                u32x4 o; o.x = cvt_pk_bf16(a[0], a[1]); o.y = cvt_pk_bf16(a[2], a[3]); o.z = cvt_pk_bf16(a[4], a[5]); o.w = cvt_pk_bf16(a[6], a[7]);
                *(u32x4*)(XC + (size_t)tk * 1280 + c8) = o; }
            GRID_BAR();
        }
        if (PH(5)) {
            PHASE_ENTER();
            if (bid < 32) {
                const bf16_t* XC = WSP(bf16_t, WS_X + X_XC); const bf16_t* Zb = WSP(bf16_t, WS_X + X_Z); bf16_t* YSSD = WSP(bf16_t, WS_X + X_XBC); const float* DT = WSP(float, WS_DT);
                const int b = bid >> 1, gI = bid & 1, hh = wave, pch = lane, head = gI * 8 + hh, ch = gI * 512 + hh * 64 + pch;
                LAS float* BC = (LAS float*)lds;
                LAS float* YB = (LAS float*)(lds + 16384);
                LAS float* RSL = (LAS float*)(lds + 16384 + 65536);
                const float negA = -fexp(p.in[I_A_LOG][l * 16 + head]), dsk = p.in[I_D_SKIP][l * 16 + head];
                float S[64];
#pragma unroll
                for (int n = 0; n < 64; ++n) S[n] = 0.f;
                for (int t0 = 0; t0 < SEQ; t0 += 32) {
                    __syncthreads();
                    for (int i = tid; i < 32 * 128; i += 512) { const int tt = i >> 7, c = i & 127; BC[i] = bf2f(XC[(size_t)(b * SEQ + t0 + tt) * 1280 + 1024 + (c >> 6) * 128 + gI * 64 + (c & 63)]); }
                    __syncthreads();
                    for (int tt = 0; tt < 32; ++tt) { const size_t row = (size_t)(b * SEQ + t0 + tt);
                        const float xv = bf2f(XC[row * 1280 + ch]); const float dtv = ld_f32_agent(DT + row * 16 + head); const float ea = fexp(dtv * negA); const float xdt = xv * dtv;
                        float y = 0.f;
#pragma unroll
                        for (int n = 0; n < 64; ++n) { S[n] = S[n] * ea + xdt * BC[tt * 128 + n]; y += BC[tt * 128 + 64 + n] * S[n]; }
                        y += xv * dsk; const float zv = bf2f(Zb[row * 1024 + ch]); y *= zv * sigmoidf_(zv);
                        YB[tt * 512 + tid] = y; }
                    __syncthreads();
                    for (int tt = wave; tt < 32; tt += 8) { float s = 0.f;
#pragma unroll
                        for (int j = 0; j < 8; ++j) { const float v = YB[tt * 512 + lane + 64 * j]; s += v * v; }
                        s = wave_sum(s); if (lane == 0) RSL[tt] = __builtin_amdgcn_rsqf(s * (1.f / 512.f) + EPS); }
                    __syncthreads();
                    for (int tt = 0; tt < 32; ++tt) YSSD[(size_t)(b * SEQ + t0 + tt) * 1024 + ch] = f2bf(YB[tt * 512 + tid] * RSL[tt]);
                }
            } else {
                sb_attn_mfma(WSP(bf16_t, WS_X + X_Q), WSP(bf16_t, WS_X + X_K), WSP(bf16_t, WS_X + X_V), (bid - 32) * 8 + wave, (G - 32) * 8, lane);
            }
            GRID_BAR();
        }
        if (PH(6)) {
            PHASE_ENTER();
            pg8::Gemm g{WSP(bf16_t, WS_X + X_XBC), (const bf16_t*)(ws + WS_W + (size_t)l * W_LAYER + W_SSDO), D, D, D}; pg8::StaticOrder S; S.init(T, D, G, bid);
            pg8::EpiGate<false> E{WSP(bf16_t, WS_X + X_Z), WSP(bf16_t, WS_X + X_GS), 0};
            pg8::gemm_phase<pg8::EpiGate<false>, pg8::StaticOrder, true, true>(lds, g, S, E, wave0);
            GRID_BAR();
        }
        if (PH(7)) {
            PHASE_ENTER();
            pg8::Gemm g{WSP(bf16_t, WS_X + X_Q), (const bf16_t*)(ws + WS_W + (size_t)l * W_LAYER + W_SBO), 512, 512, 512}; pg8::StaticOrder S; S.init(T, D, G, bid);
            pg8::EpiGate<true> E{WSP(bf16_t, WS_X + X_Z), WSP(bf16_t, WS_X + X_GS), 1024};
            pg8::gemm_phase<pg8::EpiGate<true>, pg8::StaticOrder, true, true>(lds, g, S, E, wave0);
            GRID_BAR();
        }
        if (PH(8)) {
            PHASE_ENTER();
            pg8::Gemm g{WSP(bf16_t, WS_X + X_Z), (const bf16_t*)(ws + WS_W + (size_t)l * W_LAYER + W_OUT), D, D, D}; pg8::StaticOrder S; S.init(T, D, G, bid);
            pg8::EpiResid E{(l == 0) ? p.in[I_X] : p.out, p.out};
            pg8::gemm_phase<pg8::EpiResid, pg8::StaticOrder, true, true>(lds, g, S, E, wave0);
            GRID_BAR();
        }
        if (PH(9)) {
            PHASE_ENTER();
            float dummy[1]; bf16_t* HB = WSP(bf16_t, WS_HB); float* RS = WSP(float, WS_RS); const float* H = p.out;
            for (int m = gw; m < T; m += NGW) { const float r = rowpass_row<0>(H + (size_t)m * D, HB + (size_t)m * D, lane, nullptr, dummy); if (lane == 0) RS[m] = r; }
            GRID_BAR();
        }
        if (PH(10)) {
            PHASE_ENTER();
            pg8::Gemm g{WSP(bf16_t, WS_HB), (const bf16_t*)(ws + WS_W + (size_t)l * W_LAYER + W_Q), D, D, D}; pg8::StaticOrder S; S.init(T, 512, G, bid);
            pg8::EpiBf16Rs E{WSP(bf16_t, WS_X + X_K), 512, WSP(float, WS_RS), 0.12751743082459868f};
            pg8::gemm_phase<pg8::EpiBf16Rs, pg8::StaticOrder, true, true>(lds, g, S, E, wave0);
            GRID_BAR();
        }
        if (PH(11)) {
            PHASE_ENTER();
            xattn_mfma(WSP(bf16_t, WS_X + X_K), WSP(bf16_t, WS_KM) + l * 512, WSP(bf16_t, WS_VTM) + (size_t)l * 512 * TM, WSP(bf16_t, WS_X + X_V), gw, NGW, lane);
            GRID_BAR();
        }
        if (PH(12)) {
            PHASE_ENTER();
            pg8::Gemm g{WSP(bf16_t, WS_X + X_V), (const bf16_t*)(ws + WS_W + (size_t)l * W_LAYER + W_O), 512, 512, 512}; pg8::StaticOrder S; S.init(T, D, G, bid);
            pg8::EpiResid E{p.out, p.out};
            pg8::gemm_phase<pg8::EpiResid, pg8::StaticOrder, true, true>(lds, g, S, E, wave0);
            GRID_BAR();
        }
        if (PH(13)) {
            PHASE_ENTER();
            bf16_t* HB = WSP(bf16_t, WS_HB); float* RS = WSP(float, WS_RS); const float* H = p.out;
            if (!moe) { float dummy[1];
                for (int m = gw; m < T; m += NGW) { const float r = rowpass_row<0>(H + (size_t)m * D, HB + (size_t)m * D, lane, nullptr, dummy); if (lane == 0) RS[m] = r; }
            } else {
                int* TE = WSP(int, WS_MOE + MO_TE); float* TW = WSP(float, WS_MOE + MO_TW); int* TP = WSP(int, WS_MOE + MO_TP); unsigned* CNT = WSP(unsigned, WS_CTL) + CW_CNT + jf * 16;
                LAS float* wsm = (LAS float*)lds;
                for (int i = tid; i < 8 * 1024; i += 512) { const int e = i >> 10, k = i & 1023; wsm[i] = p.in[I_MOE_R][(size_t)jf * D * NEXP + (size_t)k * NEXP + e] * p.in[I_NORM_FFN][l * D + k]; }
                __syncthreads();
                for (int m = gw; m < T; m += NGW) { float lg[8];
                    const float r = rowpass_row<8>(H + (size_t)m * D, HB + (size_t)m * D, lane, wsm, lg);
                    if (lane == 0) { RS[m] = r;
                        int i0 = 0; float v0 = lg[0];
#pragma unroll
                        for (int e = 1; e < 8; ++e) if (lg[e] > v0) { v0 = lg[e]; i0 = e; }
                        int i1 = -1; float v1 = -3.0e38f;
#pragma unroll
                        for (int e = 0; e < 8; ++e) if (e != i0 && lg[e] > v1) { v1 = lg[e]; i1 = e; }
                        const float w0 = __builtin_amdgcn_rcpf(1.f + fexp(v1 - v0));
                        const unsigned p0 = atomicAdd(CNT + i0, 1u), p1 = atomicAdd(CNT + 8 + i1, 1u);
                        TE[m] = i0; TE[T + m] = i1; TW[m] = w0; TW[T + m] = 1.f - w0; TP[m] = (int)p0; TP[T + m] = (int)p1; }
                }
            }
            GRID_BAR();
        }
        if (!moe) {
            if (PH(14)) {
                PHASE_ENTER();
                pg8::Gemm g{WSP(bf16_t, WS_HB), (const bf16_t*)(ws + WS_WFF + (size_t)jf * W_FF + W_GU), D, D, D}; pg8::StaticOrder S; S.init(T, 2 * DFF, G, bid);
                pg8::EpiSwiglu E{WSP(bf16_t, WS_X + X_ACT), WSP(float, WS_RS)};
                pg8::gemm_phase<pg8::EpiSwiglu, pg8::StaticOrder, true, true>(lds, g, S, E, wave0);
                GRID_BAR();
            }
            if (PH(15)) {
                PHASE_ENTER();
                pg8::Gemm g{WSP(bf16_t, WS_X + X_ACT), (const bf16_t*)(ws + WS_WFF + (size_t)jf * W_FF + W_DN), DFF, DFF, DFF}; pg8::StaticOrder S; S.init(T, D, G, bid);
                pg8::EpiResid E{p.out, p.out};
                pg8::gemm_phase<pg8::EpiResid, pg8::StaticOrder, true, true>(lds, g, S, E, wave0);
                GRID_BAR();
            }
        } else {
            if (PH(14)) {
                PHASE_ENTER();
                const bf16_t* HB = WSP(bf16_t, WS_HB); const float* RS = WSP(float, WS_RS); bf16_t* XG = WSP(bf16_t, WS_X + X_XG);
                const int* TE = WSP(int, WS_MOE + MO_TE); const float* TW = WSP(float, WS_MOE + MO_TW); const int* TP = WSP(int, WS_MOE + MO_TP); unsigned* CNT = WSP(unsigned, WS_CTL) + CW_CNT + jf * 16;
                int* ROWL = WSP(int, WS_MOE + MO_ROWL); float* WROW = WSP(float, WS_MOE + MO_WROW); float* RSG = WSP(float, WS_MOE + MO_RSG);
                unsigned* PEXP = WSP(unsigned, WS_MOE + MO_PEXP); unsigned* NPAN = WSP(unsigned, WS_MOE + MO_NPAN);
#pragma unroll
                for (int s = 0; s < 2; ++s) {
                    int off[9]; { int a = 0;
#pragma unroll
                        for (int e = 0; e < 8; ++e) { off[e] = a; a += ((int)__builtin_amdgcn_readfirstlane(ld_u32_agent(CNT + s * 8 + e)) + 255) & ~255; }
                        off[8] = a; }
                    if (bid == 0 && tid == 0) { NPAN[s] = (unsigned)(off[8] >> 8);
#pragma unroll
                        for (int e = 0; e < 8; ++e) for (int pnl = off[e] >> 8; pnl < (off[e + 1] >> 8); ++pnl) PEXP[s * 256 + pnl] = (unsigned)e; }
                    for (int m = gw; m < T; m += NGW) { const int e = TE[s * T + m]; int o = 0;
#pragma unroll
                        for (int k = 0; k < 8; ++k) o = (e == k) ? off[k] : o;
                        const int row = o + TP[s * T + m];
                        const u32x4* src = (const u32x4*)(HB + (size_t)m * D); u32x4* dst = (u32x4*)(XG + ((size_t)s * MOE_ROWS + row) * D);
                        dst[lane] = src[lane]; dst[lane + 64] = src[lane + 64];
                        if (lane == 0) { ROWL[s * MOE_ROWS + row] = m; WROW[s * MOE_ROWS + row] = TW[s * T + m]; RSG[s * MOE_ROWS + row] = RS[m]; } }
#pragma unroll
                    for (int e = 0; e < 8; ++e) { const int c = (int)__builtin_amdgcn_readfirstlane(ld_u32_agent(CNT + s * 8 + e)); const int lo = off[e] + c, hi = off[e + 1];
                        for (int row = lo + gw; row < hi; row += NGW) { u32x4* dst = (u32x4*)(XG + ((size_t)s * MOE_ROWS + row) * D); const u32x4 zz = {0u, 0u, 0u, 0u}; dst[lane] = zz; dst[lane + 64] = zz;
                            if (lane == 0) { ROWL[s * MOE_ROWS + row] = -1; WROW[s * MOE_ROWS + row] = 0.f; RSG[s * MOE_ROWS + row] = 0.f; } } }
                }
                GRID_BAR();
            }
#pragma unroll
            for (int s = 0; s < 2; ++s) {
                if (PH(15 + 2 * s)) {
                    PHASE_ENTER();
                    const int npan = (int)__builtin_amdgcn_readfirstlane(ld_u32_agent(WSP(unsigned, WS_MOE + MO_NPAN) + s));
                    pg8::Gemm g{WSP(bf16_t, WS_X + X_XG) + (size_t)s * MOE_ROWS * D, WSP(bf16_t, WS_WMOE + WM_GU), D, D, D}; pg8::MoeOrder S; S.init(npan, 2 * DFF / 256, G, bid, WSP(unsigned, WS_MOE + MO_PEXP) + s * 256);
                    pg8::EpiSwiglu E{WSP(bf16_t, WS_X + X_ACT), WSP(float, WS_MOE + MO_RSG) + s * MOE_ROWS};
                    pg8::gemm_phase<pg8::EpiSwiglu, pg8::MoeOrder, true, true>(lds, g, S, E, wave0);
                    GRID_BAR();
                }
                if (PH(16 + 2 * s)) {
                    PHASE_ENTER();
                    const int npan = (int)__builtin_amdgcn_readfirstlane(ld_u32_agent(WSP(unsigned, WS_MOE + MO_NPAN) + s));
                    pg8::Gemm g{WSP(bf16_t, WS_X + X_ACT), WSP(bf16_t, WS_WMOE + WM_DN), DFF, DFF, DFF}; pg8::MoeOrder S; S.init(npan, D / 256, G, bid, WSP(unsigned, WS_MOE + MO_PEXP) + s * 256);
                    pg8::EpiMoeDown E{p.out, WSP(int, WS_MOE + MO_ROWL) + s * MOE_ROWS, WSP(float, WS_MOE + MO_WROW) + s * MOE_ROWS};
                    pg8::gemm_phase<pg8::EpiMoeDown, pg8::MoeOrder, true, true>(lds, g, S, E, wave0);
                    GRID_BAR();
                }
            }
        }
    }
    if (p.l_hi == DEPTH && PH(19)) {
        PHASE_ENTER();
        const float* gf = p.in[I_FINAL]; float* H = p.out;
        for (int m = gw; m < T; m += NGW) { f32x4* xr = (f32x4*)(H + (size_t)m * D) + lane; f32x4 v[4]; float s = 0.f;
#pragma unroll
            for (int j = 0; j < 4; ++j) { v[j] = xr[64 * j]; s += (v[j].x * v[j].x + v[j].y * v[j].y) + (v[j].z * v[j].z + v[j].w * v[j].w); }
            const float rstd = __builtin_amdgcn_rsqf(wave_sum(s) * (1.f / D) + EPS);
#pragma unroll
            for (int j = 0; j < 4; ++j) { const f32x4 g4 = *((const f32x4*)gf + lane + 64 * j); xr[64 * j] = v[j] * rstd * g4; } }
    }
#undef PH
#undef GRID_BAR
}

extern "C" void kernel_launch(void* const* d_in, const int* in_sizes, int n_in, void* d_out, int out_size, void* d_ws, size_t ws_size, hipStream_t stream) {
    static int grid = 0;
    if (grid == 0) {
        if (n_in != 28 || out_size != T * D || ws_size < WS_END) { fprintf(stderr, "kernel_launch: unexpected problem (n_in %d, out %d, ws %zu < %zu)\n", n_in, out_size, ws_size, (size_t)WS_END); grid = -1; return; }
        int dev = 0, cus = 0;
        if (hipGetDevice(&dev) != hipSuccess || hipDeviceGetAttribute(&cus, hipDeviceAttributeMultiprocessorCount, dev) != hipSuccess) { grid = -1; return; }
        if (hipFuncSetAttribute((const void*)mk_fwd, hipFuncAttributeMaxDynamicSharedMemorySize, LDS_BYTES) != hipSuccess) { fprintf(stderr, "kernel_launch: hipFuncSetAttribute failed\n"); grid = -1; return; }
        int per_cu = 0;
        if (hipOccupancyMaxActiveBlocksPerMultiprocessor(&per_cu, (const void*)mk_fwd, 512, LDS_BYTES) != hipSuccess || per_cu < 1) { fprintf(stderr, "kernel_launch: occupancy query says %d\n", per_cu); (void)hipGetLastError(); }
        grid = cus;
    }
    if (grid < 0) return;
    (void)hipMemsetAsync((char*)d_ws + WS_CTL, 0, 1 * MiB, stream);
    Params p{};
    for (int i = 0; i < 28; ++i) p.in[i] = (const float*)d_in[i];
    p.out = (float*)d_out; p.ws = (unsigned char*)d_ws;
#if MK_ONE_LAUNCH
    p.l_lo = 0; p.l_hi = DEPTH; p.ph_lo = 0; p.ph_hi = 20;
    hipLaunchKernelGGL(mk_fwd, dim3(grid), dim3(512), LDS_BYTES, stream, p);
#else
    auto launch = [&](int l, int ph) { p.l_lo = l; p.l_hi = l + 1; p.ph_lo = ph; p.ph_hi = ph + 1; hipLaunchKernelGGL(mk_fwd, dim3(grid), dim3(512), LDS_BYTES, stream, p); };
    launch(0, 0); launch(0, 1);
    for (int l = 0; l < DEPTH; ++l) { const int last = (l & 1) ? 18 : 15; for (int ph = 2; ph <= last; ++ph) launch(l, ph); }
    launch(DEPTH - 1, 19);
#endif
}
```

```cpp
#include <hip/hip_runtime.h>
#include <cstdio>
#include <cstdint>

#define LAS __attribute__((address_space(3)))
#define GAS __attribute__((address_space(1)))
typedef unsigned short bf16_t;
typedef short bf16x8 __attribute__((ext_vector_type(8)));
typedef float f32x4 __attribute__((ext_vector_type(4)));
typedef float f32x2 __attribute__((ext_vector_type(2)));
typedef unsigned u32x4 __attribute__((ext_vector_type(4)));
typedef unsigned u32x2 __attribute__((ext_vector_type(2)));

#ifndef MK_ONE_LAUNCH
#define MK_ONE_LAUNCH 1
#endif

constexpr int T = 32768, D = 1024, SEQ = 2048, NBATCH = 16, DEPTH = 4, MEMLEN = 256, TM = NBATCH * MEMLEN;
constexpr int INW = 5904, NPROJ = 5888, DFF = 2816, NEXP = 8;
constexpr int MOE_ROWS = T + NEXP * 256;
constexpr int MOE_PAN = MOE_ROWS / 256;
constexpr float EPS = 1e-6f;

constexpr size_t MiB = 1u << 20;
constexpr size_t WS_CTL = 0;
constexpr size_t WS_RS = 1 * MiB;
constexpr size_t WS_RSMEM = WS_RS + 256 * 1024;
constexpr size_t WS_DT = 2 * MiB;
constexpr size_t WS_MOE = 4 * MiB;
constexpr size_t WS_KM = 8 * MiB;
constexpr size_t WS_VTM = 24 * MiB;
constexpr size_t WS_MEMB = 40 * MiB;
constexpr size_t WS_HB = 48 * MiB;
constexpr size_t WS_W = 112 * MiB;
constexpr size_t W_IN = 0, W_SSDO = W_IN + (size_t)NPROJ * 1024 * 2, W_SBO = W_SSDO + 2 * MiB, W_OUT = W_SBO + 1 * MiB, W_Q = W_OUT + 2 * MiB, W_O = W_Q + 1 * MiB, W_LAYER = W_O + 1 * MiB;
constexpr size_t WS_WKV = WS_W + 4 * W_LAYER;
constexpr size_t WS_WFF = WS_WKV + 8 * MiB;
constexpr size_t W_GU = 0, W_DN = (size_t)2 * DFF * 1024 * 2, W_FF = W_DN + (size_t)1024 * DFF * 2;
constexpr size_t WS_WMOE = WS_WFF + 2 * W_FF;
constexpr size_t WM_GU = 0, WM_DN = (size_t)NEXP * 2 * DFF * 1024 * 2;
constexpr size_t WS_X = WS_WMOE + NEXP * W_FF;
constexpr size_t X_Z = 0, X_XBC = X_Z + 64 * MiB, X_XT = X_XBC + 80 * MiB, X_BR = X_XT + 64 * MiB, X_BT = X_BR + 8 * MiB, X_CR = X_BT + 8 * MiB, X_Q = X_CR + 8 * MiB, X_K = X_Q + 32 * MiB, X_V = X_K + 32 * MiB,
                 X_GS = X_V + 32 * MiB, X_PREV = X_GS + 128 * MiB, X_END = X_PREV + 32 * MiB;
constexpr size_t X_ACT = 0;
constexpr size_t X_XG = 192 * MiB;
constexpr size_t WS_END = WS_X + X_END;
static_assert(X_XG + (size_t)2 * MOE_ROWS * 1024 * 2 <= X_END, "moe region");
static_assert((size_t)MOE_ROWS * DFF * 2 <= X_XG, "act region");
constexpr size_t MO_TE = 0, MO_TW = MO_TE + 2 * T * 4, MO_TP = MO_TW + 2 * T * 4, MO_ROWL = MO_TP + 2 * T * 4, MO_WROW = MO_ROWL + 2 * MOE_ROWS * 4, MO_RSG = MO_WROW + 2 * MOE_ROWS * 4,
                 MO_PEXP = MO_RSG + 2 * MOE_ROWS * 4, MO_NPAN = MO_PEXP + 2 * 256 * 4, MO_END = MO_NPAN + 256;
static_assert(MO_END <= 4 * MiB, "moe tables");
constexpr int CW_BAR = 4096;
constexpr int CW_CNT = 16384;

constexpr int RING_BYTES = 155648;
constexpr int LDSCTL_OFF = RING_BYTES;
constexpr int LDS_BYTES = 160 * 1024;

__device__ __forceinline__ float bf2f(unsigned b) { return __builtin_bit_cast(float, b << 16); }
__device__ __forceinline__ float bflo(unsigned w) { return __builtin_bit_cast(float, w << 16); }
__device__ __forceinline__ float bfhi(unsigned w) { return __builtin_bit_cast(float, w & 0xffff0000u); }
__device__ __forceinline__ unsigned cvt_pk_bf16(float lo, float hi) { unsigned r; asm volatile("v_cvt_pk_bf16_f32 %0, %1, %2" : "=v"(r) : "v"(lo), "v"(hi)); return r; }
__device__ __forceinline__ unsigned short f2bf(float f) { return (unsigned short)(cvt_pk_bf16(f, 0.f) & 0xffffu); }
__device__ __forceinline__ float wave_sum(float v) {
#pragma unroll
    for (int o = 1; o < 64; o <<= 1) v += __shfl_xor(v, o);
    return v;
}
__device__ __forceinline__ float wave_max(float v) {
#pragma unroll
    for (int o = 1; o < 64; o <<= 1) v = fmaxf(v, __shfl_xor(v, o));
    return v;
}
__device__ __forceinline__ float fexp(float x) { return __builtin_amdgcn_exp2f(1.4426950408889634f * x); }
__device__ __forceinline__ float softplusf_(float x) { return fmaxf(x, 0.f) + 0.6931471805599453f * __builtin_amdgcn_logf(1.f + __builtin_amdgcn_exp2f(-1.4426950408889634f * fabsf(x))); }
__device__ __forceinline__ float sigmoidf_(float x) { return __builtin_amdgcn_rcpf(1.f + __builtin_amdgcn_exp2f(-1.4426950408889634f * x)); }
__device__ __forceinline__ unsigned ld_u32_agent(const unsigned* p) { return __hip_atomic_load(p, __ATOMIC_RELAXED, __HIP_MEMORY_SCOPE_AGENT); }
__device__ __forceinline__ float ld_f32_agent(const float* p) { return __builtin_bit_cast(float, __hip_atomic_load((const unsigned*)p, __ATOMIC_RELAXED, __HIP_MEMORY_SCOPE_AGENT)); }
#define LDS_WAIT() asm volatile("s_waitcnt lgkmcnt(0)" ::: "memory")
__device__ __forceinline__ int lane_id_opaque() { int l; asm volatile("v_mbcnt_lo_u32_b32 %0, -1, 0\n\tv_mbcnt_hi_u32_b32 %0, -1, %0" : "=v"(l)); return l; }

namespace pg8 {
constexpr int BM = 256, BK = 64, HALF = 128, HTB = HALF * BK * 2, STAGE_BYTES = 8 * HTB, NXCD = 8, WGM = 8;
__host__ __device__ __forceinline__ int lds_byte(int r, int c) { const int st = (r >> 4) * 2 + (c >> 5), rr = r & 15, cc = c & 31, ob = rr * 64 + cc * 2; return st * 1024 + (ob ^ (((ob >> 9) & 1) << 5)); }
__host__ __device__ __forceinline__ void stage_rc(int b, int& R, int& C) { const unsigned ub = (unsigned)b, st = ub >> 10, sb = ub & 1023u, swz = sb ^ (((sb >> 9) & 1u) << 5); R = (int)((st >> 1) * 16u + (swz >> 6)); C = (int)((st & 1u) * 32u + ((swz & 63u) >> 1)); }
__host__ __device__ __forceinline__ int perm32(int rho) { const int n = rho >> 4, i = rho & 15; return 8 * (i >> 2) + 4 * n + (i & 3); }

struct Unit { int pm, pn, pb; };
struct Gemm { const bf16_t* A; const bf16_t* Bt; int lda, ldb, K; };

struct StaticOrder {
    int nM, nN, nwg, G, c;
    __device__ void init(int M, int N, int G_, int c_) { nM = M / BM; nN = N / BM; nwg = nM * nN; G = G_; c = c_; }
    __device__ bool next(int i, Unit& u) const {
        const long L = (long)i * G + c; if (L >= nwg) return false;
        int wgid = (int)L; { const int q = nwg / NXCD, r = nwg % NXCD, xcd = wgid % NXCD, off = wgid / NXCD; wgid = (xcd < r ? xcd * (q + 1) : r * (q + 1) + (xcd - r) * q) + off; }
        const int nig = WGM * nN, gid = wgid / nig, fm = gid * WGM, gsz = (nM - fm) < WGM ? (nM - fm) : WGM;
        u.pm = fm + ((wgid % nig) % gsz); u.pn = (wgid % nig) / gsz; u.pb = u.pn; return true;
    }
};
struct MoeOrder {
    int nM, nN, nwg, G, c; const unsigned* pexp;
    __device__ void init(int nM_, int nN_, int G_, int c_, const unsigned* pexp_) { nM = nM_; nN = nN_; nwg = nM * nN; G = G_; c = c_; pexp = pexp_; }
    __device__ bool next(int i, Unit& u) const {
        const long L = (long)i * G + c; if (L >= nwg) return false;
        int wgid = (int)L; { const int q = nwg / NXCD, r = nwg % NXCD, xcd = wgid % NXCD, off = wgid / NXCD; wgid = (xcd < r ? xcd * (q + 1) : r * (q + 1) + (xcd - r) * q) + off; }
        const int nig = WGM * nN, gid = wgid / nig, fm = gid * WGM, gsz = (nM - fm) < WGM ? (nM - fm) : WGM;
        u.pm = fm + ((wgid % nig) % gsz); u.pn = (wgid % nig) / gsz;
        const int e = (int)__builtin_amdgcn_readfirstlane(ld_u32_agent(pexp + u.pm)); u.pb = e * nN + u.pn; return true;
    }
};

template <class Epi, class Sched, bool ALIGN_EPI = false, bool SP2 = false>
__device__ __forceinline__ void gemm_phase(LAS unsigned char* lds, const Gemm g, const Sched& S, const Epi& E, const int wave0) {
    int tid_ = wave0 * 64 + lane_id_opaque();
    const int tid = tid_, wid = __builtin_amdgcn_readfirstlane(tid >> 6), lane = tid & 63, wr = wid >> 2, wc = wid & 3, fr = lane & 15, fq = lane >> 4;
    const int K = g.K, nt = K / BK;
    unsigned voffA[2], voffB[2];
    { int R, C; stage_rc(tid * 16, R, C); const int Rb = Epi::PERM ? ((R & ~31) + perm32(R & 31)) : R;
      voffA[0] = (unsigned)(R * g.lda + C) * 2u; voffB[0] = (unsigned)(Rb * g.ldb + C) * 2u; voffA[1] = voffA[0] + (unsigned)(64 * g.lda) * 2u; voffB[1] = voffB[0] + (unsigned)(64 * g.ldb) * 2u; }
    const size_t kstep = (size_t)(BK * 2);
    const size_t hsA = (size_t)HALF * g.lda * 2, hsB = (size_t)HALF * g.ldb * 2;
    const size_t tsA = 2 * hsA, tsB = 2 * hsB;
    const unsigned ldsw = (unsigned)wid * 1024u;
    const int swz_ = (fr * 64 + fq * 16) ^ ((fr & 8) << 2); const int aoff = wr * 8192 + swz_, boff = wc * 4096 + swz_;
#define PG8_SA(b, h) (((b) * 2 + (h)) * HTB)
#define PG8_SB(b, h) ((4 + (b) * 2 + (h)) * HTB)
#define PG8_STAGE(bufoff, gbase, voff) do { _Pragma("unroll") for (int _i = 0; _i < 2; ++_i) \
        __builtin_amdgcn_global_load_lds((const unsigned*)((const char*)(gbase) + (voff)[_i]), (LAS unsigned*)(lds + (bufoff) + ldsw + _i * 8192), 16, 0, 0); } while (0)
#define PG8_LDA(dst, b, h) do { _Pragma("unroll") for (int m = 0; m < 4; ++m) _Pragma("unroll") for (int k = 0; k < 2; ++k) dst[m][k] = *(const LAS bf16x8*)(lds + PG8_SA(b, h) + aoff + m * 2048 + k * 1024); } while (0)
#define PG8_LDB(dst, b, h) do { _Pragma("unroll") for (int n = 0; n < 2; ++n) _Pragma("unroll") for (int k = 0; k < 2; ++k) dst[n][k] = *(const LAS bf16x8*)(lds + PG8_SB(b, h) + boff + n * 2048 + k * 1024); } while (0)
#define PG8_MMA(ai, bj, At, Bt) do { __builtin_amdgcn_s_setprio(1); _Pragma("unroll") for (int m = 0; m < 4; ++m) _Pragma("unroll") for (int n = 0; n < 2; ++n) _Pragma("unroll") for (int k = 0; k < 2; ++k) \
        acc[ai][bj][m][n] = __builtin_amdgcn_mfma_f32_16x16x32_bf16(Bt[n][k], At[m][k], acc[ai][bj][m][n], 0, 0, 0); __builtin_amdgcn_s_setprio(0); } while (0)
#define PG8_WAIT_V(n) asm volatile("s_waitcnt vmcnt(" #n ")" ::: "memory")
#define PG8_WAIT_L(n) asm volatile("s_waitcnt lgkmcnt(" #n ")" ::: "memory")
#define PG8_BAR __builtin_amdgcn_s_barrier()
#define PG8_SCHED __builtin_amdgcn_sched_barrier(0)
    Unit cur, nxt; int ui = 0;
    if (!S.next(0, cur)) return;
    f32x4 acc[2][2][4][2];
#pragma unroll
    for (int a = 0; a < 2; ++a)
#pragma unroll
        for (int b = 0; b < 2; ++b)
#pragma unroll
            for (int m = 0; m < 4; ++m)
#pragma unroll
                for (int n = 0; n < 2; ++n) acc[a][b][m][n] = (f32x4){0.f, 0.f, 0.f, 0.f};
    bf16x8 At[4][2], B0[2][2], B1[2][2];
    const char* cA = (const char*)g.A + (size_t)cur.pm * tsA; const char* cB = (const char*)g.Bt + (size_t)cur.pb * tsB;
    if constexpr (SP2) {
        PG8_STAGE(PG8_SB(0, 0), cB, voffB); PG8_STAGE(PG8_SB(0, 1), cB + hsB, voffB); PG8_STAGE(PG8_SA(0, 0), cA, voffA); PG8_STAGE(PG8_SA(0, 1), cA + hsA, voffA);
        if (wr == 1) PG8_BAR;
        PG8_WAIT_V(2); PG8_BAR;
        PG8_STAGE(PG8_SB(1, 0), cB + kstep, voffB); PG8_STAGE(PG8_SA(1, 0), cA + kstep, voffA); PG8_STAGE(PG8_SB(1, 1), cB + hsB + kstep, voffB);
        PG8_WAIT_V(6); PG8_BAR;
    } else {
        PG8_STAGE(PG8_SB(0, 0), cB, voffB); PG8_STAGE(PG8_SA(0, 0), cA, voffA); PG8_STAGE(PG8_SB(0, 1), cB + hsB, voffB); PG8_STAGE(PG8_SA(0, 1), cA + hsA, voffA);
        if (wr == 1) PG8_BAR;
        PG8_WAIT_V(4); PG8_BAR;
        PG8_STAGE(PG8_SB(1, 0), cB + kstep, voffB); PG8_STAGE(PG8_SA(1, 0), cA + kstep, voffA); PG8_STAGE(PG8_SB(1, 1), cB + hsB + kstep, voffB);
        PG8_WAIT_V(6); PG8_BAR;
    }
    for (;;) {
        const bool has_next = S.next(ui + 1, nxt);
        const char* nA = has_next ? (const char*)g.A + (size_t)nxt.pm * tsA : cA; const char* nB = has_next ? (const char*)g.Bt + (size_t)nxt.pb * tsB : cB;
        for (int t = 0; t < nt; t += 2) {
            const bool last = (t == nt - 2);
            const char* a1 = cA + (size_t)(t + 1) * kstep;
            const char* a2 = last ? nA : cA + (size_t)(t + 2) * kstep; const char* b2 = last ? nB : cB + (size_t)(t + 2) * kstep;
            const char* a3 = a2 + kstep; const char* b3 = b2 + kstep;
            if constexpr (SP2) {
            PG8_LDB(B0, 0, 0); PG8_LDB(B1, 0, 1); PG8_SCHED; PG8_LDA(At, 0, 0); PG8_STAGE(PG8_SA(1, 1), a1 + hsA, voffA);
            PG8_WAIT_V(8); PG8_WAIT_L(0); PG8_BAR; PG8_MMA(0, 0, At, B0); PG8_MMA(0, 1, At, B1); PG8_BAR; PG8_SCHED;
            PG8_LDA(At, 0, 1); PG8_STAGE(PG8_SB(0, 0), b2, voffB); PG8_STAGE(PG8_SB(0, 1), b2 + hsB, voffB); PG8_STAGE(PG8_SA(0, 0), a2, voffA);
            PG8_WAIT_V(8); PG8_WAIT_L(0); PG8_BAR; PG8_MMA(1, 0, At, B0); PG8_MMA(1, 1, At, B1); PG8_BAR; PG8_SCHED;
            PG8_LDB(B0, 1, 0); PG8_LDB(B1, 1, 1); PG8_SCHED; PG8_LDA(At, 1, 0); PG8_STAGE(PG8_SA(0, 1), a2 + hsA, voffA);
            PG8_WAIT_V(8); PG8_WAIT_L(0); PG8_BAR; PG8_MMA(0, 0, At, B0); PG8_MMA(0, 1, At, B1); PG8_BAR; PG8_SCHED;
            PG8_LDA(At, 1, 1); PG8_STAGE(PG8_SB(1, 0), b3, voffB); PG8_STAGE(PG8_SB(1, 1), b3 + hsB, voffB); PG8_STAGE(PG8_SA(1, 0), a3, voffA);
            PG8_WAIT_V(8); PG8_WAIT_L(0); PG8_BAR; PG8_MMA(1, 0, At, B0); PG8_MMA(1, 1, At, B1); PG8_BAR; PG8_SCHED;
            } else {
            PG8_LDB(B0, 0, 0); PG8_SCHED; PG8_LDA(At, 0, 0); PG8_STAGE(PG8_SA(1, 1), a1 + hsA, voffA);
            PG8_WAIT_L(8); PG8_BAR; PG8_WAIT_L(0); PG8_MMA(0, 0, At, B0); PG8_BAR; PG8_SCHED;
            PG8_LDB(B1, 0, 1); PG8_STAGE(PG8_SB(0, 0), b2, voffB);
            PG8_BAR; PG8_WAIT_L(0); PG8_MMA(0, 1, At, B1); PG8_BAR;
            PG8_LDA(At, 0, 1); PG8_STAGE(PG8_SA(0, 0), a2, voffA);
            PG8_BAR; PG8_WAIT_L(0); PG8_MMA(1, 0, At, B0); PG8_BAR; PG8_SCHED;
            PG8_STAGE(PG8_SB(0, 1), b2 + hsB, voffB);
            PG8_WAIT_V(6); PG8_BAR; PG8_MMA(1, 1, At, B1); PG8_BAR;
            PG8_LDB(B0, 1, 0); PG8_SCHED; PG8_LDA(At, 1, 0); PG8_STAGE(PG8_SA(0, 1), a2 + hsA, voffA);
            PG8_WAIT_L(8); PG8_BAR; PG8_WAIT_L(0); PG8_MMA(0, 0, At, B0); PG8_BAR; PG8_SCHED;
            PG8_LDB(B1, 1, 1); PG8_STAGE(PG8_SB(1, 0), b3, voffB);
            PG8_BAR; PG8_WAIT_L(0); PG8_MMA(0, 1, At, B1); PG8_BAR;
            PG8_LDA(At, 1, 1); PG8_STAGE(PG8_SA(1, 0), a3, voffA);
            PG8_BAR; PG8_WAIT_L(0); PG8_MMA(1, 0, At, B0); PG8_BAR; PG8_SCHED;
            PG8_STAGE(PG8_SB(1, 1), b3 + hsB, voffB);
            PG8_WAIT_V(6); PG8_BAR; PG8_MMA(1, 1, At, B1); PG8_BAR;
            }
        }
        if constexpr (ALIGN_EPI) { if (wr == 0) PG8_BAR; }
        E(acc, cur, wr, wc, fr, fq);
        if (!has_next) break;
#pragma unroll
        for (int a = 0; a < 2; ++a)
#pragma unroll
            for (int b = 0; b < 2; ++b)
#pragma unroll
                for (int m = 0; m < 4; ++m)
#pragma unroll
                    for (int n = 0; n < 2; ++n) acc[a][b][m][n] = (f32x4){0.f, 0.f, 0.f, 0.f};
        cur = nxt; cA = nA; cB = nB; ++ui;
        if constexpr (ALIGN_EPI) { if (wr == 1) PG8_BAR; }
    }
    PG8_WAIT_V(0);
    if constexpr (!ALIGN_EPI) { if (wr == 0) PG8_BAR; }
    PG8_BAR;
#undef PG8_SA
#undef PG8_SB
#undef PG8_STAGE
#undef PG8_LDA
#undef PG8_LDB
#undef PG8_MMA
#undef PG8_WAIT_V
#undef PG8_WAIT_L
#undef PG8_BAR
#undef PG8_SCHED
}

typedef const f32x4 (&AccT)[2][2][4][2];
#define EPI_FENCE() asm volatile("" ::: "memory")

struct EpiInProj {
    static constexpr bool PERM = true;
    unsigned char* xbase; const float* rs;
    __device__ __forceinline__ void operator()(AccT acc, const Unit& u, int wr, int wc, int fr, int fq) const {
        const int pn = u.pn; size_t boff; int ld, ct; bool sig = false;
        float sc = 1.f;
        if (pn < 4) { boff = X_Z; ld = 1024; ct = pn; }
        else if (pn < 9) { boff = X_XBC; ld = 1280; ct = pn - 4; }
        else if (pn < 11) { boff = X_Q; ld = 512; ct = pn - 9; sc = 0.18033688011112042f; }
        else if (pn < 13) { boff = X_K; ld = 512; ct = pn - 11; }
        else { boff = X_GS; ld = 2048; ct = pn - 13; sig = true; }
        const unsigned lo = (unsigned)(fr * ld + 8 * fq) * 2u;
        unsigned char* tb = xbase + boff + ((size_t)(u.pm * BM + wr * 64) * ld + ct * BM + wc * 32) * 2;
        const float* rsb = rs + u.pm * BM + wr * 64;
#pragma unroll
        for (int ai = 0; ai < 2; ++ai)
#pragma unroll
            for (int m = 0; m < 4; ++m) { const float r = rsb[ai * HALF + m * 16 + fr] * sc; unsigned char* rowp = tb + (size_t)(ai * HALF + m * 16) * ld * 2;
#pragma unroll
                for (int bj = 0; bj < 2; ++bj) { f32x4 v0 = acc[ai][bj][m][0] * r, v1 = acc[ai][bj][m][1] * r;
                    if (sig) {
#pragma unroll
                        for (int j = 0; j < 4; ++j) { v0[j] = sigmoidf_(v0[j]); v1[j] = sigmoidf_(v1[j]); } }
                    u32x4 w; w.x = cvt_pk_bf16(v0[0], v0[1]); w.y = cvt_pk_bf16(v0[2], v0[3]); w.z = cvt_pk_bf16(v1[0], v1[1]); w.w = cvt_pk_bf16(v1[2], v1[3]);
                    *(u32x4*)(rowp + lo + bj * HALF * 2) = w; }
                EPI_FENCE(); }
    }
};
struct EpiBf16Rs {
    static constexpr bool PERM = true;
    bf16_t* O; int ldc; const float* rs; float sc;
    __device__ __forceinline__ void operator()(AccT acc, const Unit& u, int wr, int wc, int fr, int fq) const {
        const unsigned lo = (unsigned)(fr * ldc + 8 * fq) * 2u;
        unsigned char* tb = (unsigned char*)O + ((size_t)(u.pm * BM + wr * 64) * ldc + u.pn * BM + wc * 32) * 2;
        const float* rsb = rs + u.pm * BM + wr * 64;
#pragma unroll
        for (int ai = 0; ai < 2; ++ai)
#pragma unroll
            for (int m = 0; m < 4; ++m) { const float r = rsb[ai * HALF + m * 16 + fr] * sc; unsigned char* rowp = tb + (size_t)(ai * HALF + m * 16) * ldc * 2;
#pragma unroll
                for (int bj = 0; bj < 2; ++bj) { const f32x4 v0 = acc[ai][bj][m][0] * r, v1 = acc[ai][bj][m][1] * r;
                    u32x4 w; w.x = cvt_pk_bf16(v0[0], v0[1]); w.y = cvt_pk_bf16(v0[2], v0[3]); w.z = cvt_pk_bf16(v1[0], v1[1]); w.w = cvt_pk_bf16(v1[2], v1[3]);
                    *(u32x4*)(rowp + lo + bj * HALF * 2) = w; }
                EPI_FENCE(); }
    }
};
struct EpiBf16Cs {
    static constexpr bool PERM = true;
    bf16_t* O; int ldc; const float* cs; float sc;
    __device__ __forceinline__ void operator()(AccT acc, const Unit& u, int wr, int wc, int fr, int fq) const {
        const unsigned lo = (unsigned)(fr * ldc + 8 * fq) * 2u;
        unsigned char* tb = (unsigned char*)O + ((size_t)(u.pm * BM + wr * 64) * ldc + u.pn * BM + wc * 32) * 2;
        const float* csb = cs + u.pn * BM + wc * 32 + 8 * fq;
        f32x4 c0[2], c1[2];
#pragma unroll
        for (int bj = 0; bj < 2; ++bj) { c0[bj] = *(const f32x4*)(csb + bj * HALF) * sc; c1[bj] = *(const f32x4*)(csb + bj * HALF + 4) * sc; }
#pragma unroll
        for (int ai = 0; ai < 2; ++ai)
#pragma unroll
            for (int m = 0; m < 4; ++m) { unsigned char* rowp = tb + (size_t)(ai * HALF + m * 16) * ldc * 2;
#pragma unroll
                for (int bj = 0; bj < 2; ++bj) { const f32x4 v0 = acc[ai][bj][m][0] * c0[bj], v1 = acc[ai][bj][m][1] * c1[bj];
                    u32x4 w; w.x = cvt_pk_bf16(v0[0], v0[1]); w.y = cvt_pk_bf16(v0[2], v0[3]); w.z = cvt_pk_bf16(v1[0], v1[1]); w.w = cvt_pk_bf16(v1[2], v1[3]);
                    *(u32x4*)(rowp + lo + bj * HALF * 2) = w; }
                EPI_FENCE(); }
    }
};
template <bool ADD> struct EpiGate {
    static constexpr bool PERM = true;
    bf16_t* O; const bf16_t* GS; int gcol0;
    __device__ __forceinline__ void operator()(AccT acc, const Unit& u, int wr, int wc, int fr, int fq) const {
        const unsigned lo = (unsigned)(fr * 1024 + 8 * fq) * 2u, lg = (unsigned)(fr * 2048 + 8 * fq) * 2u;
        unsigned char* tb = (unsigned char*)O + ((size_t)(u.pm * BM + wr * 64) * 1024 + u.pn * BM + wc * 32) * 2;
        const unsigned char* gb = (const unsigned char*)GS + ((size_t)(u.pm * BM + wr * 64) * 2048 + gcol0 + u.pn * BM + wc * 32) * 2;
#pragma unroll
        for (int ai = 0; ai < 2; ++ai)
#pragma unroll
            for (int m = 0; m < 4; ++m) { unsigned char* rowp = tb + (size_t)(ai * HALF + m * 16) * 1024 * 2; const unsigned char* gp = gb + (size_t)(ai * HALF + m * 16) * 2048 * 2;
#pragma unroll
                for (int bj = 0; bj < 2; ++bj) { const u32x4 gw = *(const u32x4*)(gp + lg + bj * HALF * 2); f32x4 v0 = acc[ai][bj][m][0], v1 = acc[ai][bj][m][1];
                    v0[0] *= bflo(gw.x); v0[1] *= bfhi(gw.x); v0[2] *= bflo(gw.y); v0[3] *= bfhi(gw.y); v1[0] *= bflo(gw.z); v1[1] *= bfhi(gw.z); v1[2] *= bflo(gw.w); v1[3] *= bfhi(gw.w);
                    if (ADD) { const u32x4 pw = *(const u32x4*)(rowp + lo + bj * HALF * 2);
                        v0[0] += bflo(pw.x); v0[1] += bfhi(pw.x); v0[2] += bflo(pw.y); v0[3] += bfhi(pw.y); v1[0] += bflo(pw.z); v1[1] += bfhi(pw.z); v1[2] += bflo(pw.w); v1[3] += bfhi(pw.w); }
                    u32x4 w; w.x = cvt_pk_bf16(v0[0], v0[1]); w.y = cvt_pk_bf16(v0[2], v0[3]); w.z = cvt_pk_bf16(v1[0], v1[1]); w.w = cvt_pk_bf16(v1[2], v1[3]);
                    *(u32x4*)(rowp + lo + bj * HALF * 2) = w; }
                EPI_FENCE(); }
    }
};
struct EpiResid {
    static constexpr bool PERM = false;
    const float* Hin; float* Hout;
    __device__ __forceinline__ void operator()(AccT acc, const Unit& u, int wr, int wc, int fr, int fq) const {
        const unsigned lo = (unsigned)(fr * 1024 + 4 * fq) * 4u;
        const size_t ub = ((size_t)(u.pm * BM + wr * 64) * 1024 + u.pn * BM + wc * 32) * 4;
#pragma unroll
        for (int ai = 0; ai < 2; ++ai)
#pragma unroll
            for (int m = 0; m < 4; ++m) { const size_t ro = ub + (size_t)(ai * HALF + m * 16) * 1024 * 4; const unsigned char* hi = (const unsigned char*)Hin + ro; unsigned char* ho = (unsigned char*)Hout + ro;
                f32x4 hv[2][2];
#pragma unroll
                for (int bj = 0; bj < 2; ++bj)
#pragma unroll
                    for (int n = 0; n < 2; ++n) hv[bj][n] = *(const f32x4*)(hi + lo + (bj * HALF + n * 16) * 4);
#pragma unroll
                for (int bj = 0; bj < 2; ++bj)
#pragma unroll
                    for (int n = 0; n < 2; ++n) *(f32x4*)(ho + lo + (bj * HALF + n * 16) * 4) = hv[bj][n] + acc[ai][bj][m][n];
                EPI_FENCE(); }
    }
};
struct EpiSwiglu {
    static constexpr bool PERM = true;
    bf16_t* ACT; const float* rs;
    __device__ __forceinline__ void operator()(AccT acc, const Unit& u, int wr, int wc, int fr, int fq) const {
        const unsigned lo = (unsigned)(fr * DFF + 8 * fq) * 2u;
        unsigned char* tb = (unsigned char*)ACT + ((size_t)(u.pm * BM + wr * 64) * DFF + u.pn * HALF + wc * 32) * 2;
        const float* rsb = rs + u.pm * BM + wr * 64;
#pragma unroll
        for (int ai = 0; ai < 2; ++ai)
#pragma unroll
            for (int m = 0; m < 4; ++m) { const float r = rsb[ai * HALF + m * 16 + fr];
                float o[8];
#pragma unroll
                for (int n = 0; n < 2; ++n)
#pragma unroll
                    for (int j = 0; j < 4; ++j) { const float gt = acc[ai][0][m][n][j] * r, up = acc[ai][1][m][n][j] * r; o[n * 4 + j] = gt * sigmoidf_(gt) * up; }
                u32x4 w; w.x = cvt_pk_bf16(o[0], o[1]); w.y = cvt_pk_bf16(o[2], o[3]); w.z = cvt_pk_bf16(o[4], o[5]); w.w = cvt_pk_bf16(o[6], o[7]);
                *(u32x4*)(tb + (size_t)(ai * HALF + m * 16) * DFF * 2 + lo) = w;
                EPI_FENCE(); }
    }
};
struct EpiMoeDown {
    static constexpr bool PERM = false;
    float* H; const int* rowl; const float* wrow;
    __device__ __forceinline__ void operator()(AccT acc, const Unit& u, int wr, int wc, int fr, int fq) const {
        const int rb = u.pm * BM + wr * 64; const unsigned cb = (unsigned)(u.pn * BM + wc * 32 + 4 * fq) * 4u;
#pragma unroll
        for (int ai = 0; ai < 2; ++ai)
#pragma unroll
            for (int m = 0; m < 4; ++m) { const int row = rb + ai * HALF + m * 16 + fr; const int tok = rowl[row]; const float w = wrow[row];
                if (tok >= 0) { unsigned char* hp = (unsigned char*)H + (size_t)tok * 4096 + cb;
                    f32x4 hv[2][2];
#pragma unroll
                    for (int bj = 0; bj < 2; ++bj)
#pragma unroll
                        for (int n = 0; n < 2; ++n) hv[bj][n] = *(const f32x4*)(hp + (bj * HALF + n * 16) * 4);
#pragma unroll
                    for (int bj = 0; bj < 2; ++bj)
#pragma unroll
                        for (int n = 0; n < 2; ++n) *(f32x4*)(hp + (bj * HALF + n * 16) * 4) = hv[bj][n] + acc[ai][bj][m][n] * w; }
                EPI_FENCE(); }
    }
};
}

#define XB_TMO      128
#define XB_XCNT(j)  (256  + 64 * (j))
#define XB_XSUB(j)  (1280 + 64 * (j))
#define XB_XGEN(j)  (2304 + 64 * (j))
#define XB_TOP      3328
#define XB_TOPGEN   3392
#define XCD_BAR_WORDS 3456
#define XB_SPIN_CAP (1u << 22)
__device__ __forceinline__ unsigned xb_ld(unsigned* p)              { return __hip_atomic_load(p, __ATOMIC_RELAXED, __HIP_MEMORY_SCOPE_AGENT); }
__device__ __forceinline__ unsigned xb_add(unsigned* p, unsigned v) { return __hip_atomic_fetch_add(p, v, __ATOMIC_RELAXED, __HIP_MEMORY_SCOPE_AGENT); }
__device__ __forceinline__ unsigned xb_xcc_id() { return (unsigned)__builtin_amdgcn_s_getreg((3 << 11) | 20) & 0xFu; }
#define XB_SPIN(cond, bar) do { unsigned _sp = 0; while (cond) { __builtin_amdgcn_s_sleep(1); \
    if ((++_sp & 255u) == 0u) { if (xb_ld(&(bar)[XB_TMO])) break; if (_sp > XB_SPIN_CAP) { atomicAdd(&(bar)[XB_TMO], 1u); break; } } } } while (0)
struct XcdBarrier { unsigned* bar; unsigned x; volatile LAS unsigned* st; };
__device__ __forceinline__ XcdBarrier xcd_barrier_post(unsigned* bar, volatile LAS unsigned* st) {
    XcdBarrier b; b.bar = bar; b.x = xb_xcc_id(); b.st = st;
    if (threadIdx.x == 0) (void)xb_add(&bar[XB_XCNT(b.x)], 1u);
    return b;
}
__device__ __forceinline__ void xcd_barrier_complete(unsigned* bar, unsigned x, unsigned& nloc, unsigned& nx) {
    const unsigned G = gridDim.x * gridDim.y * gridDim.z;
    unsigned sum, cnt, mine, sp = 0u;
    for (;;) {
        sum = 0u; cnt = 0u; mine = 0u;
#pragma unroll
        for (unsigned j = 0; j < 16; ++j) { const unsigned c = xb_ld(&bar[XB_XCNT(j)]); sum += c; cnt += (c > 0u) ? 1u : 0u; mine = (j == x) ? c : mine; }
        if (sum == G) break;
        __builtin_amdgcn_s_sleep(1);
        if ((++sp & 255u) == 0u) { if (xb_ld(&bar[XB_TMO])) break; if (sp > XB_SPIN_CAP) { atomicAdd(&bar[XB_TMO], 1u); break; } }
    }
    nloc = mine > 0u ? mine : 1u; nx = cnt > 0u ? cnt : 1u;
}
__device__ __forceinline__ void xcd_barrier(const XcdBarrier& b, const bool leader_thread) {
    asm volatile("s_waitcnt vmcnt(0)" ::: "memory");
    __syncthreads();
    if (leader_thread) {
        unsigned* bar = b.bar;
        __builtin_amdgcn_s_waitcnt(0);
        unsigned nloc = b.st[0], nx = b.st[1];
        if (nloc == 0u) { xcd_barrier_complete(bar, b.x, nloc, nx); b.st[0] = nloc; b.st[1] = nx; }
        const unsigned old = xb_add(&bar[XB_XSUB(b.x)], 1u);
        const unsigned gen = old / nloc;
        if (old + 1u == (gen + 1u) * nloc) {
            __builtin_amdgcn_fence(__ATOMIC_RELEASE, "agent");
            asm volatile("s_waitcnt vmcnt(0)" ::: "memory");
            const unsigned og = xb_add(&bar[XB_TOP], 1u);
            const unsigned tg = og / nx;
            if (og + 1u == (tg + 1u) * nx) xb_add(&bar[XB_TOPGEN], 1u);
            else XB_SPIN(xb_ld(&bar[XB_TOPGEN]) == tg, bar);
            __builtin_amdgcn_fence(__ATOMIC_ACQUIRE, "agent");
            xb_add(&bar[XB_XGEN(b.x)], 1u);
            asm volatile("s_waitcnt vmcnt(0)" ::: "memory");
        } else {
            XB_SPIN(xb_ld(&bar[XB_XGEN(b.x)]) == gen, bar);
            __builtin_amdgcn_fence(__ATOMIC_ACQUIRE, "agent");
            asm volatile("s_waitcnt vmcnt(0)" ::: "memory");
        }
    }
    __syncthreads();
}

struct Params {
    const float* in[28];
    float* out;
    unsigned char* ws;
    int l_lo, l_hi, ph_lo, ph_hi;
};
enum { I_X = 0, I_MEM, I_NORM_MIX, I_W_IN, I_CONV_W, I_CONV_B, I_DT_BIAS, I_A_LOG, I_D_SKIP, I_SSD_NORM, I_W_SSD_O, I_W_SB_O, I_W_OUT, I_NORM_XA, I_NORM_MEM,
       I_XA_WQ, I_XA_WK, I_XA_WV, I_XA_WO, I_NORM_FFN, I_FFN_G, I_FFN_U, I_FFN_D, I_MOE_R, I_MOE_G, I_MOE_U, I_MOE_D, I_FINAL };

__device__ __forceinline__ void tr_item(const float* W, int ldw, int k0, int n0, const float* gain, bf16_t* WT, int ldt, int drow0, LAS float* scr, int lane) {
#pragma unroll 8
    for (int i = 0; i < 32; ++i) { const int kk = 2 * i + (lane >> 5); const float gk = gain ? gain[k0 + kk] : 1.f; scr[kk * 33 + (lane & 31)] = W[(size_t)(k0 + kk) * ldw + n0 + (lane & 31)] * gk; }
    LDS_WAIT();
    const int c = lane & 7;
#pragma unroll
    for (int j = 0; j < 4; ++j) { const int n = (lane >> 3) + 8 * j; const LAS float* s = scr + (8 * c) * 33 + n;
        u32x4 o; o.x = cvt_pk_bf16(s[0 * 33], s[1 * 33]); o.y = cvt_pk_bf16(s[2 * 33], s[3 * 33]); o.z = cvt_pk_bf16(s[4 * 33], s[5 * 33]); o.w = cvt_pk_bf16(s[6 * 33], s[7 * 33]);
        *(u32x4*)(WT + (size_t)(drow0 + n) * ldt + k0 + 8 * c) = o; }
    LDS_WAIT();
}
struct TrJob { const float* W; int ldw, K, col0, ncols; const float* gain; bf16_t* WT; int dbase, dgroup; };
__device__ __forceinline__ void run_job(const TrJob& j, int& base, int gw, int NGW, LAS float* scr, int lane) {
    const int nblk = j.ncols / 32, nitems = (j.K / 64) * nblk;
    int start = (gw - base) % NGW; if (start < 0) start += NGW;
    for (int it = start; it < nitems; it += NGW) { const int kb = it / nblk, nb = it % nblk, c0 = nb * 32;
        tr_item(j.W, j.ldw, kb * 64, j.col0 + c0, j.gain, j.WT, j.K, j.dbase + (c0 / 128) * j.dgroup + (c0 % 128), scr, lane); }
    base = (base + nitems) % NGW;
}

template <int NE>
__device__ __forceinline__ float rowpass_row(const float* xrow, bf16_t* brow, int lane, const LAS float* wsm, float (&ex)[NE > 0 ? NE : 1]) {
    const f32x4* xr = (const f32x4*)xrow + lane;
    f32x4 v[4]; float s = 0.f;
#pragma unroll
    for (int j = 0; j < 4; ++j) { v[j] = xr[64 * j]; s += (v[j].x * v[j].x + v[j].y * v[j].y) + (v[j].z * v[j].z + v[j].w * v[j].w); }
    const float rstd = __builtin_amdgcn_rsqf(wave_sum(s) * (1.f / D) + EPS);
    u32x2* o8 = (u32x2*)brow + lane;
#pragma unroll
    for (int j = 0; j < 4; ++j) { u32x2 w; w.x = cvt_pk_bf16(v[j].x, v[j].y); w.y = cvt_pk_bf16(v[j].z, v[j].w); o8[64 * j] = w; }
    if constexpr (NE > 0) {
#pragma unroll
        for (int e = 0; e < NE; ++e) { float p = 0.f;
#pragma unroll
            for (int j = 0; j < 4; ++j) { const f32x4 w4 = *(const LAS f32x4*)(wsm + e * 1024 + 256 * j + 4 * lane); p += (v[j].x * w4.x + v[j].y * w4.y) + (v[j].z * w4.z + v[j].w * w4.w); }
            ex[e] = wave_sum(p) * rstd; }
    }
    return rstd;
}

typedef float f32x16 __attribute__((ext_vector_type(16)));
#define MFMA32(a, b, c) __builtin_amdgcn_mfma_f32_32x32x16_bf16((a), (b), (c), 0, 0, 0)
__device__ __forceinline__ bf16x8 ldg8(const bf16_t* p) { return *(const bf16x8*)p; }
__device__ __forceinline__ bf16x8 pack8(const float* v) { u32x4 w; w.x = cvt_pk_bf16(v[0], v[1]); w.y = cvt_pk_bf16(v[2], v[3]); w.z = cvt_pk_bf16(v[4], v[5]); w.w = cvt_pk_bf16(v[6], v[7]); return __builtin_bit_cast(bf16x8, w); }
__device__ __forceinline__ int pi32(int r) { return 16 * ((r >> 2) & 1) + 4 * (r >> 3) + (r & 3); }

__device__ __forceinline__ void sb_attn_mfma(bf16_t* Q, const bf16_t* Kb, const bf16_t* Vt, int w, int NW, int lane) {
    const int c = lane & 31, hh = lane >> 5, pr = pi32(c);
    bf16x8 U[2];
#pragma unroll
    for (int kk = 0; kk < 2; ++kk) { u32x4 uw;
#pragma unroll
        for (int q = 0; q < 4; ++q) uw[q] = ((16 * hh + 8 * kk + 2 * q > pr) ? 0x3F80u : 0u) | ((16 * hh + 8 * kk + 2 * q + 1 > pr) ? 0x3F800000u : 0u);
        U[kk] = __builtin_bit_cast(bf16x8, uw); }
    for (int j = w; j < NBATCH * 8 * 64; j += NW) {
        const int bh = j & 127, slot = j >> 7, k4 = slot >> 4, a = slot & 15;
        const int qblk = k4 == 0 ? a : k4 == 1 ? 31 - a : k4 == 2 ? 32 + a : 63 - a;
        const int b = bh >> 3, h = bh & 7, t0 = qblk * 32;
        bf16_t* qp = Q + (size_t)(b * SEQ + t0 + c) * 512 + h * 64;
        bf16x8 qf[4];
#pragma unroll
        for (int jj = 0; jj < 4; ++jj) qf[jj] = ldg8(qp + 16 * jj + 8 * hh);
        const bf16_t* kbase = Kb + (size_t)(b * SEQ + pr) * 512 + h * 64 + 8 * hh;
        const bf16_t* vbase = Vt + (size_t)(h * 64 + c) * T + b * SEQ + 16 * hh;
        f32x16 o0, o1;
#pragma unroll
        for (int i = 0; i < 16; ++i) { o0[i] = 0.f; o1[i] = 0.f; }
        float R = 0.f;
        bf16x8 kf[4], vf[4], kn[4], vn[4];
#pragma unroll
        for (int jj = 0; jj < 4; ++jj) { kf[jj] = ldg8(kbase + (size_t)t0 * 512 + 16 * jj); vf[jj] = ldg8(vbase + (size_t)(jj >> 1) * 32 * T + t0 + 8 * (jj & 1)); }
        for (int kb = qblk; kb >= 0; --kb) {
            const int s0 = kb * 32;
            if (kb > 0) {
#pragma unroll
                for (int jj = 0; jj < 4; ++jj) { kn[jj] = ldg8(kbase + (size_t)(s0 - 32) * 512 + 16 * jj); vn[jj] = ldg8(vbase + (size_t)(jj >> 1) * 32 * T + (s0 - 32) + 8 * (jj & 1)); }
            }
            f32x16 s;
#pragma unroll
            for (int i = 0; i < 16; ++i) s[i] = 0.f;
#pragma unroll
            for (int jj = 0; jj < 4; ++jj) s = MFMA32(kf[jj], qf[jj], s);
            const bool diag = (kb == qblk);
            float sp[16]; float rsum = 0.f;
#pragma unroll
            for (int i = 0; i < 16; ++i) { const float x = s[i]; float v = fmaxf(x, 0.f) + __builtin_amdgcn_logf(1.f + __builtin_amdgcn_exp2f(-fabsf(x)));
                if (diag && !(16 * hh + i < c)) v = 0.f;
                sp[i] = v; rsum += v; }
            f32x16 E;
#pragma unroll
            for (int i = 0; i < 16; ++i) E[i] = 0.f;
            E = MFMA32(U[0], pack8(sp), E); E = MFMA32(U[1], pack8(sp + 8), E);
            float at[16];
#pragma unroll
            for (int i = 0; i < 16; ++i) { float av = __builtin_amdgcn_exp2f(s[i] - sp[i] - E[i] - R); if (diag && !(16 * hh + i < c)) av = 0.f; at[i] = av; }
            const bf16x8 a0 = pack8(at), a1 = pack8(at + 8);
            o0 = MFMA32(vf[0], a0, o0); o0 = MFMA32(vf[1], a1, o0);
            o1 = MFMA32(vf[2], a0, o1); o1 = MFMA32(vf[3], a1, o1);
            rsum += __shfl_xor(rsum, 32); R += rsum;
            if (__all(R > 160.f)) break;
#pragma unroll
            for (int jj = 0; jj < 4; ++jj) { kf[jj] = kn[jj]; vf[jj] = vn[jj]; }
        }
#pragma unroll
        for (int g = 0; g < 4; ++g) { u32x2 w0, w1; w0.x = cvt_pk_bf16(o0[4 * g], o0[4 * g + 1]); w0.y = cvt_pk_bf16(o0[4 * g + 2], o0[4 * g + 3]); w1.x = cvt_pk_bf16(o1[4 * g], o1[4 * g + 1]); w1.y = cvt_pk_bf16(o1[4 * g + 2], o1[4 * g + 3]);
            *(u32x2*)(qp + 8 * g + 4 * hh) = w0; *(u32x2*)(qp + 32 + 8 * g + 4 * hh) = w1; }
    }
}

__device__ __forceinline__ void xattn_mfma(const bf16_t* XQ, const bf16_t* KMl, const bf16_t* VtMl, bf16_t* XO, int w, int NW, int lane) {
    const int c = lane & 31, hh = lane >> 5, pr = pi32(c);
    for (int j = w; j < NBATCH * 4 * 64; j += NW) {
        const int qblk = j & 63, hd = (j >> 6) & 3, b = j >> 8, t0 = qblk * 32;
        const bf16_t* qp = XQ + (size_t)(b * SEQ + t0 + c) * 512 + hd * 128 + 8 * hh;
        bf16x8 qf[8];
#pragma unroll
        for (int jj = 0; jj < 8; ++jj) qf[jj] = ldg8(qp + 16 * jj);
        const bf16_t* kbase = KMl + (size_t)(b * MEMLEN + pr) * 2048 + hd * 128 + 8 * hh;
        const bf16_t* vbase = VtMl + (size_t)(hd * 128 + c) * TM + b * MEMLEN + 16 * hh;
        float mx = -3.0e38f;
        for (int kb = 0; kb < 8; ++kb) { f32x16 s;
#pragma unroll
            for (int i = 0; i < 16; ++i) s[i] = 0.f;
#pragma unroll
            for (int jj = 0; jj < 8; ++jj) s = MFMA32(ldg8(kbase + (size_t)kb * 32 * 2048 + 16 * jj), qf[jj], s);
#pragma unroll
            for (int i = 0; i < 16; ++i) mx = fmaxf(mx, s[i]); }
        mx = fmaxf(mx, __shfl_xor(mx, 32));
        f32x16 o[4];
#pragma unroll
        for (int db = 0; db < 4; ++db)
#pragma unroll
            for (int i = 0; i < 16; ++i) o[db][i] = 0.f;
        float sum = 0.f;
        for (int kb = 0; kb < 8; ++kb) { f32x16 s;
#pragma unroll
            for (int i = 0; i < 16; ++i) s[i] = 0.f;
#pragma unroll
            for (int jj = 0; jj < 8; ++jj) s = MFMA32(ldg8(kbase + (size_t)kb * 32 * 2048 + 16 * jj), qf[jj], s);
            float pv[16];
#pragma unroll
            for (int i = 0; i < 16; ++i) { pv[i] = __builtin_amdgcn_exp2f(s[i] - mx); sum += pv[i]; }
            const bf16x8 p0 = pack8(pv), p1 = pack8(pv + 8);
#pragma unroll
            for (int db = 0; db < 4; ++db) { const bf16_t* vp = vbase + (size_t)db * 32 * TM + kb * 32; o[db] = MFMA32(ldg8(vp), p0, o[db]); o[db] = MFMA32(ldg8(vp + 8), p1, o[db]); } }
        sum += __shfl_xor(sum, 32);
        const float inv = 1.f / sum;
        bf16_t* op = XO + (size_t)(b * SEQ + t0 + c) * 512 + hd * 128 + 4 * hh;
#pragma unroll
        for (int db = 0; db < 4; ++db)
#pragma unroll
            for (int g = 0; g < 4; ++g) { u32x2 w0; w0.x = cvt_pk_bf16(o[db][4 * g] * inv, o[db][4 * g + 1] * inv); w0.y = cvt_pk_bf16(o[db][4 * g + 2] * inv, o[db][4 * g + 3] * inv);
                *(u32x2*)(op + 32 * db + 8 * g) = w0; }
    }
}

__device__ __forceinline__ float wave_incl_scan(float v, int lane) {
#pragma unroll
    for (int d = 1; d < 64; d <<= 1) { const float n = __shfl_up(v, d); if (lane >= d) v += n; }
    return v;
}
__device__ __forceinline__ void conv_unit(const bf16_t* XBC, const float* cw, const float* cb, bf16_t* XT, bf16_t* BR, bf16_t* BT, bf16_t* CR, int u, int lane) {
    const int tb = u / 10, cbk = u - tb * 10, tok0 = tb * 64, ch0 = cbk * 128 + 2 * lane;
    float w[4][2], bs[2];
#pragma unroll
    for (int k = 0; k < 4; ++k) { w[k][0] = cw[k * 1280 + ch0]; w[k][1] = cw[k * 1280 + ch0 + 1]; }
    bs[0] = cb[ch0]; bs[1] = cb[ch0 + 1];
    const bf16_t* src = XBC + (size_t)tok0 * 1280 + ch0;
    float h0[2] = {0.f, 0.f}, h1[2] = {0.f, 0.f}, h2[2] = {0.f, 0.f};
    if ((tok0 & (SEQ - 1)) != 0) { const unsigned a = *(const unsigned*)(src - 3 * 1280), b = *(const unsigned*)(src - 2 * 1280), c = *(const unsigned*)(src - 1280);
        h0[0] = bflo(a); h0[1] = bfhi(a); h1[0] = bflo(b); h1[1] = bfhi(b); h2[0] = bflo(c); h2[1] = bfhi(c); }
    unsigned ylo[32], yhi[32]; float pe0 = 0.f, pe1 = 0.f;
    bf16_t* rdst = (cbk == 8) ? BR : CR;
#pragma unroll
    for (int tt = 0; tt < 64; ++tt) { const unsigned xw = *(const unsigned*)(src + (size_t)tt * 1280); const float x0 = bflo(xw), x1 = bfhi(xw);
        float v0 = bs[0] + w[0][0] * h0[0] + w[1][0] * h1[0] + w[2][0] * h2[0] + w[3][0] * x0, v1 = bs[1] + w[0][1] * h0[1] + w[1][1] * h1[1] + w[2][1] * h2[1] + w[3][1] * x1;
        v0 *= sigmoidf_(v0); v1 *= sigmoidf_(v1);
        h0[0] = h1[0]; h0[1] = h1[1]; h1[0] = h2[0]; h1[1] = h2[1]; h2[0] = x0; h2[1] = x1;
        if (cbk >= 8) *(unsigned*)(rdst + (size_t)(tok0 + tt) * 128 + 2 * lane) = cvt_pk_bf16(v0, v1);
        if (tt & 1) { ylo[tt >> 1] = cvt_pk_bf16(pe0, v0); yhi[tt >> 1] = cvt_pk_bf16(pe1, v1); } else { pe0 = v0; pe1 = v1; } }
    if (cbk <= 8) { bf16_t* tbase = (cbk < 8) ? XT + (size_t)ch0 * T + tok0 : BT + (size_t)(2 * lane) * T + tok0;
#pragma unroll
        for (int q = 0; q < 8; ++q) { u32x4 a, b; a.x = ylo[4 * q]; a.y = ylo[4 * q + 1]; a.z = ylo[4 * q + 2]; a.w = ylo[4 * q + 3]; b.x = yhi[4 * q]; b.y = yhi[4 * q + 1]; b.z = yhi[4 * q + 2]; b.w = yhi[4 * q + 3];
            *(u32x4*)(tbase + 8 * q) = a; *(u32x4*)(tbase + T + 8 * q) = b; } }
}
__device__ __forceinline__ void ssd_scan_unit(const bf16_t* XT, const bf16_t* BT, const float* DTT, bf16_t* PREV, float negA, int b, int h, int pblk, int nblk, LAS float* wl, int lane) {
    const int c32 = lane & 31, hh = lane >> 5, g = h >> 3;
    const bf16_t* xrow = XT + (size_t)(h * 64 + pblk * 32 + c32) * T + b * SEQ + 8 * hh;
    const bf16_t* brow = BT + (size_t)(g * 64 + nblk * 32 + c32) * T + b * SEQ + 8 * hh;
    const float* dtp = DTT + (size_t)h * T + b * SEQ + lane;
    f32x16 st;
#pragma unroll
    for (int i = 0; i < 16; ++i) st[i] = 0.f;
    for (int c = 0; c < 16; ++c) {
        bf16_t* pv = PREV + ((size_t)((b * 16 + c) * 16 + h) * 64 + pblk * 32) * 64 + nblk * 32 + c32;
#pragma unroll
        for (int i = 0; i < 16; ++i) pv[(8 * (i >> 2) + 4 * hh + (i & 3)) * 64] = f2bf(st[i]);
        const float d0 = dtp[c * 128], d1 = dtp[c * 128 + 64];
        const float s0 = wave_incl_scan(d0 * negA, lane); const float tot0 = __shfl(s0, 63);
        const float s1 = wave_incl_scan(d1 * negA, lane) + tot0; const float last = __shfl(s1, 63);
        wl[lane] = d0 * fexp(last - s0); wl[64 + lane] = d1 * fexp(last - s1);
        const float dec = fexp(last);
#pragma unroll
        for (int i = 0; i < 16; ++i) st[i] *= dec;
#pragma unroll
        for (int ks = 0; ks < 8; ++ks) { const u32x4 xw = *(const u32x4*)(xrow + c * 128 + 16 * ks); const bf16x8 bfr = ldg8(brow + c * 128 + 16 * ks);
            const f32x4 wa = *(const LAS f32x4*)(wl + 16 * ks + 8 * hh), wb = *(const LAS f32x4*)(wl + 16 * ks + 8 * hh + 4);
            float xs[8]; xs[0] = bflo(xw.x) * wa.x; xs[1] = bfhi(xw.x) * wa.y; xs[2] = bflo(xw.y) * wa.z; xs[3] = bfhi(xw.y) * wa.w; xs[4] = bflo(xw.z) * wb.x; xs[5] = bfhi(xw.z) * wb.y; xs[6] = bflo(xw.w) * wb.z; xs[7] = bfhi(xw.w) * wb.w;
            st = MFMA32(pack8(xs), bfr, st); }
    }
}
__device__ __forceinline__ void ssd_out_unit(const bf16_t* XT, const bf16_t* BR, const bf16_t* CR, const float* DTT, const bf16_t* PREV, const bf16_t* Zb, bf16_t* Y, float negA, float dsk,
                                             int b, int c, int g, int tq, int wave, int lane, LAS float* tab  , LAS float* red  ) {
    const int c32 = lane & 31, hh = lane >> 5, pr = pi32(c32), h = g * 8 + wave;
    const int tokc = b * SEQ + c * 128;
    const float* dtp = DTT + (size_t)h * T + tokc + lane;
    const float d0 = dtp[0], d1 = dtp[64];
    const float s0 = wave_incl_scan(d0 * negA, lane); const float tot0 = __shfl(s0, 63);
    const float s1 = wave_incl_scan(d1 * negA, lane) + tot0;
    tab[lane] = s0; tab[64 + lane] = s1; tab[128 + lane] = d0; tab[192 + lane] = d1;
    const float acum_t = tab[tq * 32 + c32];
    const size_t tokg = (size_t)(tokc + tq * 32 + c32);
    bf16x8 cf[4];
#pragma unroll
    for (int ks = 0; ks < 4; ++ks) cf[ks] = ldg8(CR + tokg * 128 + g * 64 + 16 * ks + 8 * hh);
    f32x16 y0, y1;
#pragma unroll
    for (int i = 0; i < 16; ++i) { y0[i] = 0.f; y1[i] = 0.f; }
    const bf16_t* xrow = XT + (size_t)(h * 64 + c32) * T + tokc + 16 * hh;
    for (int j = 0; j <= tq; ++j) {
        const bf16_t* brow = BR + (size_t)(tokc + 32 * j + pr) * 128 + g * 64 + 8 * hh;
        f32x16 cbt;
#pragma unroll
        for (int i = 0; i < 16; ++i) cbt[i] = 0.f;
#pragma unroll
        for (int ks = 0; ks < 4; ++ks) cbt = MFMA32(ldg8(brow + 16 * ks), cf[ks], cbt);
        float m[16];
#pragma unroll
        for (int q = 0; q < 4; ++q) { const f32x4 as = *(const LAS f32x4*)(tab + 32 * j + 16 * hh + 4 * q), ds = *(const LAS f32x4*)(tab + 128 + 32 * j + 16 * hh + 4 * q);
#pragma unroll
            for (int e = 0; e < 4; ++e) { const int i = 4 * q + e; float v = cbt[i] * ds[e] * fexp(acum_t - as[e]);
                if (j == tq) { if (16 * hh + i > c32) v = 0.f; if (16 * hh + i == c32) v += dsk; }
                m[i] = v; } }
        const bf16x8 m0 = pack8(m), m1 = pack8(m + 8);
        y0 = MFMA32(ldg8(xrow + 32 * j), m0, y0); y0 = MFMA32(ldg8(xrow + 32 * j + 8), m1, y0);
        y1 = MFMA32(ldg8(xrow + (size_t)32 * T + 32 * j), m0, y1); y1 = MFMA32(ldg8(xrow + (size_t)32 * T + 32 * j + 8), m1, y1);
    }
    { const bf16_t* pv = PREV + ((size_t)((b * 16 + c) * 16 + h) * 64 + c32) * 64 + 8 * hh;
      f32x16 f0, f1;
#pragma unroll
      for (int i = 0; i < 16; ++i) { f0[i] = 0.f; f1[i] = 0.f; }
#pragma unroll
      for (int ks = 0; ks < 4; ++ks) { f0 = MFMA32(ldg8(pv + 16 * ks), cf[ks], f0); f1 = MFMA32(ldg8(pv + 32 * 64 + 16 * ks), cf[ks], f1); }
      const float ea = fexp(acum_t);
#pragma unroll
      for (int i = 0; i < 16; ++i) { y0[i] += f0[i] * ea; y1[i] += f1[i] * ea; } }
    const bf16_t* zp = Zb + tokg * 1024 + h * 64 + 4 * hh; float ss = 0.f;
#pragma unroll
    for (int gq = 0; gq < 4; ++gq) { const u32x2 za = *(const u32x2*)(zp + 8 * gq), zb2 = *(const u32x2*)(zp + 32 + 8 * gq);
        const float z0[4] = {bflo(za.x), bfhi(za.x), bflo(za.y), bfhi(za.y)}, z1[4] = {bflo(zb2.x), bfhi(zb2.x), bflo(zb2.y), bfhi(zb2.y)};
#pragma unroll
        for (int e = 0; e < 4; ++e) { const int i = 4 * gq + e; y0[i] *= z0[e] * sigmoidf_(z0[e]); y1[i] *= z1[e] * sigmoidf_(z1[e]); ss += y0[i] * y0[i] + y1[i] * y1[i]; } }
    ss += __shfl_xor(ss, 32);
    if (hh == 0) red[wave * 32 + c32] = ss;
    __syncthreads();
    float tot = 0.f;
#pragma unroll
    for (int w8 = 0; w8 < 8; ++w8) tot += red[w8 * 32 + c32];
    const float rstd = __builtin_amdgcn_rsqf(tot * (1.f / 512.f) + EPS);
    bf16_t* yp = Y + tokg * 1024 + h * 64 + 4 * hh;
#pragma unroll
    for (int gq = 0; gq < 4; ++gq) { u32x2 o0, o1; o0.x = cvt_pk_bf16(y0[4 * gq] * rstd, y0[4 * gq + 1] * rstd); o0.y = cvt_pk_bf16(y0[4 * gq + 2] * rstd, y0[4 * gq + 3] * rstd);
        o1.x = cvt_pk_bf16(y1[4 * gq] * rstd, y1[4 * gq + 1] * rstd); o1.y = cvt_pk_bf16(y1[4 * gq + 2] * rstd, y1[4 * gq + 3] * rstd);
        *(u32x2*)(yp + 8 * gq) = o0; *(u32x2*)(yp + 32 + 8 * gq) = o1; }
}

#define PHASE_ENTER() unsigned char* ws = p.ws; asm volatile("" : "+s"(ws)); int tid_ = wave0 * 64 + lane_id_opaque(); int bid_ = blockIdx.x; asm volatile("" : "+s"(bid_)); \
    const int tid = tid_, lane = tid & 63, wave = __builtin_amdgcn_readfirstlane(tid >> 6); \
    const int G = gridDim.x, bid = bid_, gw = bid * 8 + wave, NGW = G * 8; (void)lane; (void)gw; (void)NGW; (void)wave; (void)bid; (void)G
#define WSP(type, off) ((type*)(ws + (off)))
__global__ void __launch_bounds__(512, 2) mk_fwd(Params p) {
    extern __shared__ __attribute__((aligned(16))) unsigned char lds_raw[];
    LAS unsigned char* lds = (LAS unsigned char*)lds_raw;
    volatile LAS unsigned* ldsctl = (volatile LAS unsigned*)(lds + LDSCTL_OFF);
    if (threadIdx.x < 64) ldsctl[threadIdx.x] = 0u;
    int wave0 = __builtin_amdgcn_readfirstlane((int)threadIdx.x >> 6); asm volatile("" : "+s"(wave0));
    __syncthreads();
    const int ph_lo = p.ph_lo, ph_hi = p.ph_hi;
    const bool use_bar = (ph_hi - ph_lo) > 1 || (p.l_hi - p.l_lo) > 1;
    XcdBarrier bar; bar.bar = (unsigned*)(p.ws + WS_CTL) + CW_BAR; bar.x = 0; bar.st = nullptr;
    if (use_bar) bar = xcd_barrier_post((unsigned*)(p.ws + WS_CTL) + CW_BAR, ldsctl + 8);
#define PH(k) (ph_lo <= (k) && (k) < ph_hi)
#define GRID_BAR() do { if (use_bar) xcd_barrier(bar, wave0 == 0 && lane_id_opaque() == 0); } while (0)

    if (p.l_lo == 0 && PH(0)) {
        PHASE_ENTER();
        LAS float* scr = (LAS float*)(lds + wave * 16384);
        int base = 0;
        for (int jb = 0; jb < 4 * 11 + 2 * 3; ++jb) {
            TrJob j;
            if (jb < 44) { const int l = jb / 11, k = jb % 11; unsigned char* wl = ws + WS_W + (size_t)l * W_LAYER;
                switch (k) {
                case 0: j = TrJob{p.in[I_W_IN] + (size_t)l * D * INW, INW, D, 0, 2304, p.in[I_NORM_MIX] + l * D, (bf16_t*)(wl + W_IN), 0, 128}; break;
                case 1: j = TrJob{p.in[I_W_IN] + (size_t)l * D * INW, INW, D, 2320, 1024, p.in[I_NORM_MIX] + l * D, (bf16_t*)(wl + W_IN), 2304, 128}; break;
                case 9: j = TrJob{p.in[I_W_IN] + (size_t)l * D * INW, INW, D, 3344, 512, p.in[I_NORM_MIX] + l * D, (bf16_t*)(wl + W_IN), 5376, 128}; break;
                case 10: j = TrJob{p.in[I_W_IN] + (size_t)l * D * INW, INW, D, 3856, 2048, p.in[I_NORM_MIX] + l * D, (bf16_t*)(wl + W_IN), 3328, 128}; break;
                case 2: j = TrJob{p.in[I_W_SSD_O] + (size_t)l * D * D, D, D, 0, D, p.in[I_SSD_NORM] + l * D, (bf16_t*)(wl + W_SSDO), 0, 128}; break;
                case 3: j = TrJob{p.in[I_W_SB_O] + (size_t)l * 512 * D, D, 512, 0, D, nullptr, (bf16_t*)(wl + W_SBO), 0, 128}; break;
                case 4: j = TrJob{p.in[I_W_OUT] + (size_t)l * D * D, D, D, 0, D, nullptr, (bf16_t*)(wl + W_OUT), 0, 128}; break;
                case 5: j = TrJob{p.in[I_XA_WQ] + (size_t)l * D * 512, 512, D, 0, 512, p.in[I_NORM_XA] + l * D, (bf16_t*)(wl + W_Q), 0, 128}; break;
                case 6: j = TrJob{p.in[I_XA_WK] + (size_t)l * D * 512, 512, D, 0, 512, p.in[I_NORM_MEM] + l * D, (bf16_t*)(ws + WS_WKV), l * 512, 128}; break;
                case 7: j = TrJob{p.in[I_XA_WV] + (size_t)l * D * 512, 512, D, 0, 512, p.in[I_NORM_MEM] + l * D, (bf16_t*)(ws + WS_WKV), 2048 + l * 512, 128}; break;
                case 8: j = TrJob{p.in[I_XA_WO] + (size_t)l * 512 * D, D, 512, 0, D, nullptr, (bf16_t*)(wl + W_O), 0, 128}; break;
                }
            } else { const int jj = (jb - 44) / 3, k = (jb - 44) % 3; unsigned char* wf = ws + WS_WFF + (size_t)jj * W_FF; const float* gn = p.in[I_NORM_FFN] + (2 * jj) * D;
                if (k == 0) j = TrJob{p.in[I_FFN_G] + (size_t)jj * D * DFF, DFF, D, 0, DFF, gn, (bf16_t*)(wf + W_GU), 0, 256};
                else if (k == 1) j = TrJob{p.in[I_FFN_U] + (size_t)jj * D * DFF, DFF, D, 0, DFF, gn, (bf16_t*)(wf + W_GU), 128, 256};
                else j = TrJob{p.in[I_FFN_D] + (size_t)jj * DFF * D, D, DFF, 0, D, nullptr, (bf16_t*)(wf + W_DN), 0, 128};
            }
            run_job(j, base, gw, NGW, scr, lane);
        }
        float dummy[1]; bf16_t* MEMB = WSP(bf16_t, WS_MEMB); float* RSMEM = WSP(float, WS_RSMEM);
        for (int m = gw; m < TM; m += NGW) { const float r = rowpass_row<0>(p.in[I_MEM] + (size_t)m * D, MEMB + (size_t)m * D, lane, nullptr, dummy); if (lane == 0) RSMEM[m] = r; }
        GRID_BAR();
    }
    if (p.l_lo == 0 && PH(1)) {
        PHASE_ENTER();
        { pg8::Gemm g{WSP(bf16_t, WS_MEMB), WSP(bf16_t, WS_WKV), D, D, D}; pg8::StaticOrder S; S.init(TM, 2048, G, bid);
          pg8::EpiBf16Rs E{WSP(bf16_t, WS_KM), 2048, WSP(float, WS_RSMEM), 1.f};
          pg8::gemm_phase<pg8::EpiBf16Rs, pg8::StaticOrder, true, true>(lds, g, S, E, wave0); }
        { pg8::Gemm g{WSP(bf16_t, WS_WKV) + (size_t)2048 * 1024, WSP(bf16_t, WS_MEMB), D, D, D}; pg8::StaticOrder S; S.init(2048, TM, G, (bid + G / 2) % G);
          pg8::EpiBf16Cs E{WSP(bf16_t, WS_VTM), TM, WSP(float, WS_RSMEM), 1.f};
          pg8::gemm_phase<pg8::EpiBf16Cs, pg8::StaticOrder, true, true>(lds, g, S, E, wave0); }
        GRID_BAR();
    }

    for (int l = p.l_lo; l < p.l_hi; ++l) {
        const bool moe = (l & 1) != 0; const int jf = l >> 1;

        if (PH(2)) {
            PHASE_ENTER();
            const float* Hin = (l == 0) ? p.in[I_X] : p.out; bf16_t* HB = WSP(bf16_t, WS_HB); float* RS = WSP(float, WS_RS); float* DT = WSP(float, WS_DT);
            LAS float* wsm = (LAS float*)lds;
            for (int i = tid; i < 16 * 1024; i += 512) { const int e = i >> 10, k = i & 1023; wsm[i] = p.in[I_W_IN][(size_t)l * D * INW + (size_t)k * INW + 2304 + e] * p.in[I_NORM_MIX][l * D + k]; }
            __syncthreads();
            for (int m = gw; m < T; m += NGW) { float ex[16];
                const float r = rowpass_row<16>(Hin + (size_t)m * D, HB + (size_t)m * D, lane, wsm, ex);
                if (lane == 0) RS[m] = r;
                float mine = 0.f;
#pragma unroll
                for (int e = 0; e < 16; ++e) mine = (lane == e) ? ex[e] : mine;
                if (lane < 16) { const float xv = mine + p.in[I_DT_BIAS][l * 16 + lane]; DT[(size_t)lane * T + m] = softplusf_(xv); }
            }
            __syncthreads();
            if (moe) {
                LAS float* scr = (LAS float*)(lds + 65536 + wave * 8704);
                int base = 0; const float* gn = p.in[I_NORM_FFN] + l * D;
                for (int jb = 0; jb < NEXP * 3; ++jb) { const int e = jb / 3, k = jb % 3; TrJob j; const size_t eo = ((size_t)jf * NEXP + e) * D * DFF;
                    if (k == 0) j = TrJob{p.in[I_MOE_G] + eo, DFF, D, 0, DFF, gn, (bf16_t*)(ws + WS_WMOE + WM_GU) + (size_t)e * 2 * DFF * 1024, 0, 256};
                    else if (k == 1) j = TrJob{p.in[I_MOE_U] + eo, DFF, D, 0, DFF, gn, (bf16_t*)(ws + WS_WMOE + WM_GU) + (size_t)e * 2 * DFF * 1024, 128, 256};
                    else j = TrJob{p.in[I_MOE_D] + eo, D, DFF, 0, D, nullptr, (bf16_t*)(ws + WS_WMOE + WM_DN) + (size_t)e * 1024 * DFF, 0, 128};
                    run_job(j, base, gw, NGW, scr, lane); }
            }
            GRID_BAR();
        }
        if (PH(3)) {
            PHASE_ENTER();
            { pg8::Gemm g{WSP(bf16_t, WS_HB), (const bf16_t*)(ws + WS_W + (size_t)l * W_LAYER + W_IN), D, D, D}; pg8::StaticOrder S; S.init(T, NPROJ - 512, G, bid);
              pg8::EpiInProj E{ws + WS_X, WSP(float, WS_RS)};
              pg8::gemm_phase<pg8::EpiInProj, pg8::StaticOrder, true, true>(lds, g, S, E, wave0); }
            { pg8::Gemm g{(const bf16_t*)(ws + WS_W + (size_t)l * W_LAYER + W_IN) + (size_t)(NPROJ - 512) * 1024, WSP(bf16_t, WS_HB), D, D, D}; pg8::StaticOrder S; S.init(512, T, G, bid);
              pg8::EpiBf16Cs E{WSP(bf16_t, WS_X + X_V), T, WSP(float, WS_RS), 1.f};
              pg8::gemm_phase<pg8::EpiBf16Cs, pg8::StaticOrder, true, true>(lds, g, S, E, wave0); }
            GRID_BAR();
        }
        if (PH(4)) {
            PHASE_ENTER();
            const float* cw = p.in[I_CONV_W] + (size_t)l * 4 * 1280; const float* cb = p.in[I_CONV_B] + (size_t)l * 1280;
            for (int u = gw; u < (T / 64) * 10; u += NGW) conv_unit(WSP(bf16_t, WS_X + X_XBC), cw, cb, WSP(bf16_t, WS_X + X_XT), WSP(bf16_t, WS_X + X_BR), WSP(bf16_t, WS_X + X_BT), WSP(bf16_t, WS_X + X_CR), u, lane);
            GRID_BAR();
        }
        if (PH(5)) {
            PHASE_ENTER();
            if (gw < NBATCH * 16 * 4) { const int b = gw >> 6, h = (gw >> 2) & 15, pblk = (gw >> 1) & 1, nblk = gw & 1;
                ssd_scan_unit(WSP(bf16_t, WS_X + X_XT), WSP(bf16_t, WS_X + X_BT), WSP(float, WS_DT), WSP(bf16_t, WS_X + X_PREV), -fexp(p.in[I_A_LOG][l * 16 + h]), b, h, pblk, nblk, (LAS float*)(lds + wave * 1024), lane); }
            sb_attn_mfma(WSP(bf16_t, WS_X + X_Q), WSP(bf16_t, WS_X + X_K), WSP(bf16_t, WS_X + X_V), gw, NGW, lane);
            GRID_BAR();
        }
        if (PH(6)) {
            PHASE_ENTER();
            int par = 0;
            for (int u = bid; u < 2048; u += G) { const int tq = (u >> 8) & 3, r = (u & 255) | ((u >> 10) << 8), b = r >> 5, c = (r >> 1) & 15, g = r & 1; const int h = g * 8 + wave;
                ssd_out_unit(WSP(bf16_t, WS_X + X_XT), WSP(bf16_t, WS_X + X_BR), WSP(bf16_t, WS_X + X_CR), WSP(float, WS_DT), WSP(bf16_t, WS_X + X_PREV), WSP(bf16_t, WS_X + X_Z), WSP(bf16_t, WS_X + X_XBC),
                             -fexp(p.in[I_A_LOG][l * 16 + h]), p.in[I_D_SKIP][l * 16 + h], b, c, g, tq, wave, lane, (LAS float*)(lds + wave * 1024), (LAS float*)(lds + 8192 + par * 1024));
                par ^= 1; }
            GRID_BAR();
        }
        if (PH(7)) {
            PHASE_ENTER();
            pg8::Gemm g{WSP(bf16_t, WS_X + X_XBC), (const bf16_t*)(ws + WS_W + (size_t)l * W_LAYER + W_SSDO), D, D, D}; pg8::StaticOrder S; S.init(T, D, G, bid);
            pg8::EpiGate<false> E{WSP(bf16_t, WS_X + X_Z), WSP(bf16_t, WS_X + X_GS), 0};
            pg8::gemm_phase<pg8::EpiGate<false>, pg8::StaticOrder, true, true>(lds, g, S, E, wave0);
            GRID_BAR();
        }
        if (PH(8)) {
            PHASE_ENTER();
            pg8::Gemm g{WSP(bf16_t, WS_X + X_Q), (const bf16_t*)(ws + WS_W + (size_t)l * W_LAYER + W_SBO), 512, 512, 512}; pg8::StaticOrder S; S.init(T, D, G, bid);
            pg8::EpiGate<true> E{WSP(bf16_t, WS_X + X_Z), WSP(bf16_t, WS_X + X_GS), 1024};
            pg8::gemm_phase<pg8::EpiGate<true>, pg8::StaticOrder, true, true>(lds, g, S, E, wave0);
            GRID_BAR();
        }
        if (PH(9)) {
            PHASE_ENTER();
            pg8::Gemm g{WSP(bf16_t, WS_X + X_Z), (const bf16_t*)(ws + WS_W + (size_t)l * W_LAYER + W_OUT), D, D, D}; pg8::StaticOrder S; S.init(T, D, G, bid);
            pg8::EpiResid E{(l == 0) ? p.in[I_X] : p.out, p.out};
            pg8::gemm_phase<pg8::EpiResid, pg8::StaticOrder, true, true>(lds, g, S, E, wave0);
            GRID_BAR();
        }
        if (PH(10)) {
            PHASE_ENTER();
            float dummy[1]; bf16_t* HB = WSP(bf16_t, WS_HB); float* RS = WSP(float, WS_RS); const float* H = p.out;
            for (int m = gw; m < T; m += NGW) { const float r = rowpass_row<0>(H + (size_t)m * D, HB + (size_t)m * D, lane, nullptr, dummy); if (lane == 0) RS[m] = r; }
            GRID_BAR();
        }
        if (PH(11)) {
            PHASE_ENTER();
            pg8::Gemm g{WSP(bf16_t, WS_HB), (const bf16_t*)(ws + WS_W + (size_t)l * W_LAYER + W_Q), D, D, D}; pg8::StaticOrder S; S.init(T, 512, G, bid);
            pg8::EpiBf16Rs E{WSP(bf16_t, WS_X + X_K), 512, WSP(float, WS_RS), 0.12751743082459868f};
            pg8::gemm_phase<pg8::EpiBf16Rs, pg8::StaticOrder, true, true>(lds, g, S, E, wave0);
            GRID_BAR();
        }
        if (PH(12)) {
            PHASE_ENTER();
            xattn_mfma(WSP(bf16_t, WS_X + X_K), WSP(bf16_t, WS_KM) + l * 512, WSP(bf16_t, WS_VTM) + (size_t)l * 512 * TM, WSP(bf16_t, WS_X + X_V), gw, NGW, lane);
            GRID_BAR();
        }
        if (PH(13)) {
            PHASE_ENTER();
            pg8::Gemm g{WSP(bf16_t, WS_X + X_V), (const bf16_t*)(ws + WS_W + (size_t)l * W_LAYER + W_O), 512, 512, 512}; pg8::StaticOrder S; S.init(T, D, G, bid);
            pg8::EpiResid E{p.out, p.out};
            pg8::gemm_phase<pg8::EpiResid, pg8::StaticOrder, true, true>(lds, g, S, E, wave0);
            GRID_BAR();
        }
        if (PH(14)) {
            PHASE_ENTER();
            bf16_t* HB = WSP(bf16_t, WS_HB); float* RS = WSP(float, WS_RS); const float* H = p.out;
            if (!moe) { float dummy[1];
                for (int m = gw; m < T; m += NGW) { const float r = rowpass_row<0>(H + (size_t)m * D, HB + (size_t)m * D, lane, nullptr, dummy); if (lane == 0) RS[m] = r; }
            } else {
                int* TE = WSP(int, WS_MOE + MO_TE); float* TW = WSP(float, WS_MOE + MO_TW); int* TP = WSP(int, WS_MOE + MO_TP); unsigned* CNT = WSP(unsigned, WS_CTL) + CW_CNT + jf * 16;
                LAS float* wsm = (LAS float*)lds;
                for (int i = tid; i < 8 * 1024; i += 512) { const int e = i >> 10, k = i & 1023; wsm[i] = p.in[I_MOE_R][(size_t)jf * D * NEXP + (size_t)k * NEXP + e] * p.in[I_NORM_FFN][l * D + k]; }
                __syncthreads();
                for (int m = gw; m < T; m += NGW) { float lg[8];
                    const float r = rowpass_row<8>(H + (size_t)m * D, HB + (size_t)m * D, lane, wsm, lg);
                    if (lane == 0) { RS[m] = r;
                        int i0 = 0; float v0 = lg[0];
#pragma unroll
                        for (int e = 1; e < 8; ++e) if (lg[e] > v0) { v0 = lg[e]; i0 = e; }
                        int i1 = -1; float v1 = -3.0e38f;
#pragma unroll
                        for (int e = 0; e < 8; ++e) if (e != i0 && lg[e] > v1) { v1 = lg[e]; i1 = e; }
                        const float w0 = __builtin_amdgcn_rcpf(1.f + fexp(v1 - v0));
                        const unsigned p0 = atomicAdd(CNT + i0, 1u), p1 = atomicAdd(CNT + 8 + i1, 1u);
                        TE[m] = i0; TE[T + m] = i1; TW[m] = w0; TW[T + m] = 1.f - w0; TP[m] = (int)p0; TP[T + m] = (int)p1; }
                }
            }
            GRID_BAR();
        }
        if (!moe) {
            if (PH(15)) {
                PHASE_ENTER();
                pg8::Gemm g{WSP(bf16_t, WS_HB), (const bf16_t*)(ws + WS_WFF + (size_t)jf * W_FF + W_GU), D, D, D}; pg8::StaticOrder S; S.init(T, 2 * DFF, G, bid);
                pg8::EpiSwiglu E{WSP(bf16_t, WS_X + X_ACT), WSP(float, WS_RS)};
                pg8::gemm_phase<pg8::EpiSwiglu, pg8::StaticOrder, true, true>(lds, g, S, E, wave0);
                GRID_BAR();
            }
            if (PH(16)) {
                PHASE_ENTER();
                pg8::Gemm g{WSP(bf16_t, WS_X + X_ACT), (const bf16_t*)(ws + WS_WFF + (size_t)jf * W_FF + W_DN), DFF, DFF, DFF}; pg8::StaticOrder S; S.init(T, D, G, bid);
                pg8::EpiResid E{p.out, p.out};
                pg8::gemm_phase<pg8::EpiResid, pg8::StaticOrder, true, true>(lds, g, S, E, wave0);
                GRID_BAR();
            }
        } else {
            if (PH(15)) {
                PHASE_ENTER();
                const bf16_t* HB = WSP(bf16_t, WS_HB); const float* RS = WSP(float, WS_RS); bf16_t* XG = WSP(bf16_t, WS_X + X_XG);
                const int* TE = WSP(int, WS_MOE + MO_TE); const float* TW = WSP(float, WS_MOE + MO_TW); const int* TP = WSP(int, WS_MOE + MO_TP); unsigned* CNT = WSP(unsigned, WS_CTL) + CW_CNT + jf * 16;
                int* ROWL = WSP(int, WS_MOE + MO_ROWL); float* WROW = WSP(float, WS_MOE + MO_WROW); float* RSG = WSP(float, WS_MOE + MO_RSG);
                unsigned* PEXP = WSP(unsigned, WS_MOE + MO_PEXP); unsigned* NPAN = WSP(unsigned, WS_MOE + MO_NPAN);
#pragma unroll
                for (int s = 0; s < 2; ++s) {
                    int off[9]; { int a = 0;
#pragma unroll
                        for (int e = 0; e < 8; ++e) { off[e] = a; a += ((int)__builtin_amdgcn_readfirstlane(ld_u32_agent(CNT + s * 8 + e)) + 255) & ~255; }
                        off[8] = a; }
                    if (bid == 0 && tid == 0) { NPAN[s] = (unsigned)(off[8] >> 8);
#pragma unroll
                        for (int e = 0; e < 8; ++e) for (int pnl = off[e] >> 8; pnl < (off[e + 1] >> 8); ++pnl) PEXP[s * 256 + pnl] = (unsigned)e; }
                    for (int m = gw; m < T; m += NGW) { const int e = TE[s * T + m]; int o = 0;
#pragma unroll
                        for (int k = 0; k < 8; ++k) o = (e == k) ? off[k] : o;
                        const int row = o + TP[s * T + m];
                        const u32x4* src = (const u32x4*)(HB + (size_t)m * D); u32x4* dst = (u32x4*)(XG + ((size_t)s * MOE_ROWS + row) * D);
                        dst[lane] = src[lane]; dst[lane + 64] = src[lane + 64];
                        if (lane == 0) { ROWL[s * MOE_ROWS + row] = m; WROW[s * MOE_ROWS + row] = TW[s * T + m]; RSG[s * MOE_ROWS + row] = RS[m]; } }
#pragma unroll
                    for (int e = 0; e < 8; ++e) { const int c = (int)__builtin_amdgcn_readfirstlane(ld_u32_agent(CNT + s * 8 + e)); const int lo = off[e] + c, hi = off[e + 1];
                        for (int row = lo + gw; row < hi; row += NGW) { u32x4* dst = (u32x4*)(XG + ((size_t)s * MOE_ROWS + row) * D); const u32x4 zz = {0u, 0u, 0u, 0u}; dst[lane] = zz; dst[lane + 64] = zz;
                            if (lane == 0) { ROWL[s * MOE_ROWS + row] = -1; WROW[s * MOE_ROWS + row] = 0.f; RSG[s * MOE_ROWS + row] = 0.f; } } }
                }
                GRID_BAR();
            }
#pragma unroll
            for (int s = 0; s < 2; ++s) {
                if (PH(16 + 2 * s)) {
                    PHASE_ENTER();
                    const int npan = (int)__builtin_amdgcn_readfirstlane(ld_u32_agent(WSP(unsigned, WS_MOE + MO_NPAN) + s));
                    pg8::Gemm g{WSP(bf16_t, WS_X + X_XG) + (size_t)s * MOE_ROWS * D, WSP(bf16_t, WS_WMOE + WM_GU), D, D, D}; pg8::MoeOrder S; S.init(npan, 2 * DFF / 256, G, bid, WSP(unsigned, WS_MOE + MO_PEXP) + s * 256);
                    pg8::EpiSwiglu E{WSP(bf16_t, WS_X + X_ACT), WSP(float, WS_MOE + MO_RSG) + s * MOE_ROWS};
                    pg8::gemm_phase<pg8::EpiSwiglu, pg8::MoeOrder, true, true>(lds, g, S, E, wave0);
                    GRID_BAR();
                }
                if (PH(17 + 2 * s)) {
                    PHASE_ENTER();
                    const int npan = (int)__builtin_amdgcn_readfirstlane(ld_u32_agent(WSP(unsigned, WS_MOE + MO_NPAN) + s));
                    pg8::Gemm g{WSP(bf16_t, WS_X + X_ACT), WSP(bf16_t, WS_WMOE + WM_DN), DFF, DFF, DFF}; pg8::MoeOrder S; S.init(npan, D / 256, G, bid, WSP(unsigned, WS_MOE + MO_PEXP) + s * 256);
                    pg8::EpiMoeDown E{p.out, WSP(int, WS_MOE + MO_ROWL) + s * MOE_ROWS, WSP(float, WS_MOE + MO_WROW) + s * MOE_ROWS};
                    pg8::gemm_phase<pg8::EpiMoeDown, pg8::MoeOrder, true, true>(lds, g, S, E, wave0);
                    GRID_BAR();
                }
            }
        }
    }
    if (p.l_hi == DEPTH && PH(20)) {
        PHASE_ENTER();
        const float* gf = p.in[I_FINAL]; float* H = p.out;
        for (int m = gw; m < T; m += NGW) { f32x4* xr = (f32x4*)(H + (size_t)m * D) + lane; f32x4 v[4]; float s = 0.f;
#pragma unroll
            for (int j = 0; j < 4; ++j) { v[j] = xr[64 * j]; s += (v[j].x * v[j].x + v[j].y * v[j].y) + (v[j].z * v[j].z + v[j].w * v[j].w); }
            const float rstd = __builtin_amdgcn_rsqf(wave_sum(s) * (1.f / D) + EPS);
#pragma unroll
            for (int j = 0; j < 4; ++j) { const f32x4 g4 = *((const f32x4*)gf + lane + 64 * j); xr[64 * j] = v[j] * rstd * g4; } }
    }
#undef PH
#undef GRID_BAR
}

extern "C" void kernel_launch(void* const* d_in, const int* in_sizes, int n_in, void* d_out, int out_size, void* d_ws, size_t ws_size, hipStream_t stream) {
    static int grid = 0;
    if (grid == 0) {
        if (n_in != 28 || out_size != T * D || ws_size < WS_END) { fprintf(stderr, "kernel_launch: unexpected problem (n_in %d, out %d, ws %zu < %zu)\n", n_in, out_size, ws_size, (size_t)WS_END); grid = -1; return; }
        int dev = 0, cus = 0;
        if (hipGetDevice(&dev) != hipSuccess || hipDeviceGetAttribute(&cus, hipDeviceAttributeMultiprocessorCount, dev) != hipSuccess) { grid = -1; return; }
        if (hipFuncSetAttribute((const void*)mk_fwd, hipFuncAttributeMaxDynamicSharedMemorySize, LDS_BYTES) != hipSuccess) { fprintf(stderr, "kernel_launch: hipFuncSetAttribute failed\n"); grid = -1; return; }
        int per_cu = 0;
        if (hipOccupancyMaxActiveBlocksPerMultiprocessor(&per_cu, (const void*)mk_fwd, 512, LDS_BYTES) != hipSuccess || per_cu < 1) { fprintf(stderr, "kernel_launch: occupancy query says %d\n", per_cu); (void)hipGetLastError(); }
        grid = cus;
    }
    if (grid < 0) return;
    (void)hipMemsetAsync((char*)d_ws + WS_CTL, 0, 1 * MiB, stream);
    Params p{};
    for (int i = 0; i < 28; ++i) p.in[i] = (const float*)d_in[i];
    p.out = (float*)d_out; p.ws = (unsigned char*)d_ws;
#if MK_ONE_LAUNCH
    p.l_lo = 0; p.l_hi = DEPTH; p.ph_lo = 0; p.ph_hi = 21;
    hipLaunchKernelGGL(mk_fwd, dim3(grid), dim3(512), LDS_BYTES, stream, p);
#else
    auto launch = [&](int l, int ph) { p.l_lo = l; p.l_hi = l + 1; p.ph_lo = ph; p.ph_hi = ph + 1; hipLaunchKernelGGL(mk_fwd, dim3(grid), dim3(512), LDS_BYTES, stream, p); };
    launch(0, 0); launch(0, 1);
    for (int l = 0; l < DEPTH; ++l) { const int last = (l & 1) ? 19 : 16; for (int ph = 2; ph <= last; ++ph) launch(l, ph); }
    launch(DEPTH - 1, 20);
#endif
}
```

```cpp
#include <hip/hip_runtime.h>
#include <cstdio>
#include <cstdint>

#define LAS __attribute__((address_space(3)))
#define GAS __attribute__((address_space(1)))
typedef unsigned short bf16_t;
typedef short bf16x8 __attribute__((ext_vector_type(8)));
typedef float f32x4 __attribute__((ext_vector_type(4)));
typedef float f32x2 __attribute__((ext_vector_type(2)));
typedef unsigned u32x4 __attribute__((ext_vector_type(4)));
typedef unsigned u32x2 __attribute__((ext_vector_type(2)));

#ifndef PROBE_MASK
#define PROBE_MASK 0u
#endif
#define NREP(k) ((int)((PROBE_MASK >> (k)) & 1u) + 1)
#ifndef MK_ONE_LAUNCH
#define MK_ONE_LAUNCH 1
#endif

constexpr int T = 32768, D = 1024, SEQ = 2048, NBATCH = 16, DEPTH = 4, MEMLEN = 256, TM = NBATCH * MEMLEN;
constexpr int INW = 5904, NPROJ = 5888, DFF = 2816, NEXP = 8;
constexpr int MOE_ROWS = T + NEXP * 256;
constexpr int MOE_PAN = MOE_ROWS / 256;
constexpr float EPS = 1e-6f;

constexpr size_t MiB = 1u << 20;
constexpr size_t WS_CTL = 0;
constexpr size_t WS_RS = 1 * MiB;
constexpr size_t WS_RSMEM = WS_RS + 256 * 1024;
constexpr size_t WS_DT = 2 * MiB;
constexpr size_t WS_MOE = 4 * MiB;
constexpr size_t WS_KM = 8 * MiB;
constexpr size_t WS_VTM = 24 * MiB;
constexpr size_t WS_MEMB = 40 * MiB;
constexpr size_t WS_HB = 48 * MiB;
constexpr size_t WS_W = 112 * MiB;
constexpr size_t W_IN = 0, W_SSDO = W_IN + (size_t)NPROJ * 1024 * 2, W_SBO = W_SSDO + 2 * MiB, W_OUT = W_SBO + 1 * MiB, W_Q = W_OUT + 2 * MiB, W_O = W_Q + 1 * MiB, W_LAYER = W_O + 1 * MiB;
constexpr size_t WS_WKV = WS_W + 4 * W_LAYER;
constexpr size_t WS_WFF = WS_WKV + 8 * MiB;
constexpr size_t W_GU = 0, W_DN = (size_t)2 * DFF * 1024 * 2, W_FF = W_DN + (size_t)1024 * DFF * 2;
constexpr size_t WS_WMOE = WS_WFF + 2 * W_FF;
constexpr size_t WM_GU = 0, WM_DN = (size_t)NEXP * 2 * DFF * 1024 * 2;
constexpr size_t WS_X = WS_WMOE + NEXP * W_FF;
constexpr size_t X_Z = 0, X_XBC = X_Z + 64 * MiB, X_XT = X_XBC + 80 * MiB, X_BR = X_XT + 64 * MiB, X_BT = X_BR + 8 * MiB, X_CR = X_BT + 8 * MiB, X_Q = X_CR + 8 * MiB, X_K = X_Q + 32 * MiB, X_V = X_K + 32 * MiB,
                 X_GS = X_V + 32 * MiB, X_PREV = X_GS + 128 * MiB, X_END = X_PREV + 32 * MiB;
constexpr size_t X_ACT = 0;
constexpr size_t X_XG = 192 * MiB;
constexpr size_t WS_END = WS_X + X_END;
static_assert(X_XG + (size_t)2 * MOE_ROWS * 1024 * 2 <= X_END, "moe region");
static_assert((size_t)MOE_ROWS * DFF * 2 <= X_XG, "act region");
constexpr size_t MO_TE = 0, MO_TW = MO_TE + 2 * T * 4, MO_TP = MO_TW + 2 * T * 4, MO_ROWL = MO_TP + 2 * T * 4, MO_WROW = MO_ROWL + 2 * MOE_ROWS * 4, MO_RSG = MO_WROW + 2 * MOE_ROWS * 4,
                 MO_PEXP = MO_RSG + 2 * MOE_ROWS * 4, MO_NPAN = MO_PEXP + 2 * 256 * 4, MO_END = MO_NPAN + 256;
static_assert(MO_END <= 4 * MiB, "moe tables");
constexpr int CW_BAR = 4096;
constexpr int CW_CNT = 16384;

constexpr int RING_BYTES = 155648;
constexpr int LDSCTL_OFF = RING_BYTES;
constexpr int LDS_BYTES = 160 * 1024;

__device__ __forceinline__ float bf2f(unsigned b) { return __builtin_bit_cast(float, b << 16); }
__device__ __forceinline__ float bflo(unsigned w) { return __builtin_bit_cast(float, w << 16); }
__device__ __forceinline__ float bfhi(unsigned w) { return __builtin_bit_cast(float, w & 0xffff0000u); }
__device__ __forceinline__ unsigned cvt_pk_bf16(float lo, float hi) { unsigned r; asm volatile("v_cvt_pk_bf16_f32 %0, %1, %2" : "=v"(r) : "v"(lo), "v"(hi)); return r; }
__device__ __forceinline__ unsigned short f2bf(float f) { return (unsigned short)(cvt_pk_bf16(f, 0.f) & 0xffffu); }
__device__ __forceinline__ float wave_sum(float v) {
#pragma unroll
    for (int o = 1; o < 64; o <<= 1) v += __shfl_xor(v, o);
    return v;
}
__device__ __forceinline__ float wave_max(float v) {
#pragma unroll
    for (int o = 1; o < 64; o <<= 1) v = fmaxf(v, __shfl_xor(v, o));
    return v;
}
__device__ __forceinline__ float fexp(float x) { return __builtin_amdgcn_exp2f(1.4426950408889634f * x); }
__device__ __forceinline__ float softplusf_(float x) { return fmaxf(x, 0.f) + 0.6931471805599453f * __builtin_amdgcn_logf(1.f + __builtin_amdgcn_exp2f(-1.4426950408889634f * fabsf(x))); }
__device__ __forceinline__ float sigmoidf_(float x) { return __builtin_amdgcn_rcpf(1.f + __builtin_amdgcn_exp2f(-1.4426950408889634f * x)); }
__device__ __forceinline__ unsigned ld_u32_agent(const unsigned* p) { return __hip_atomic_load(p, __ATOMIC_RELAXED, __HIP_MEMORY_SCOPE_AGENT); }
__device__ __forceinline__ float ld_f32_agent(const float* p) { return __builtin_bit_cast(float, __hip_atomic_load((const unsigned*)p, __ATOMIC_RELAXED, __HIP_MEMORY_SCOPE_AGENT)); }
#define LDS_WAIT() asm volatile("s_waitcnt lgkmcnt(0)" ::: "memory")
__device__ __forceinline__ int lane_id_opaque() { int l; asm volatile("v_mbcnt_lo_u32_b32 %0, -1, 0\n\tv_mbcnt_hi_u32_b32 %0, -1, %0" : "=v"(l)); return l; }

namespace pg8 {
constexpr int BM = 256, BK = 64, HALF = 128, HTB = HALF * BK * 2, STAGE_BYTES = 8 * HTB, NXCD = 8, WGM = 8;
__host__ __device__ __forceinline__ int lds_byte(int r, int c) { const int st = (r >> 4) * 2 + (c >> 5), rr = r & 15, cc = c & 31, ob = rr * 64 + cc * 2; return st * 1024 + (ob ^ (((ob >> 9) & 1) << 5)); }
__host__ __device__ __forceinline__ void stage_rc(int b, int& R, int& C) { const unsigned ub = (unsigned)b, st = ub >> 10, sb = ub & 1023u, swz = sb ^ (((sb >> 9) & 1u) << 5); R = (int)((st >> 1) * 16u + (swz >> 6)); C = (int)((st & 1u) * 32u + ((swz & 63u) >> 1)); }
__host__ __device__ __forceinline__ int perm32(int rho) { const int n = rho >> 4, i = rho & 15; return 8 * (i >> 2) + 4 * n + (i & 3); }

struct Unit { int pm, pn, pb; };
struct Gemm { const bf16_t* A; const bf16_t* Bt; int lda, ldb, K; };

struct StaticOrder {
    int nM, nN, nwg, G, c;
    __device__ void init(int M, int N, int G_, int c_) { nM = M / BM; nN = N / BM; nwg = nM * nN; G = G_; c = c_; }
    __device__ bool next(int i, Unit& u) const {
        const long L = (long)i * G + c; if (L >= nwg) return false;
        int wgid = (int)L; { const int q = nwg / NXCD, r = nwg % NXCD, xcd = wgid % NXCD, off = wgid / NXCD; wgid = (xcd < r ? xcd * (q + 1) : r * (q + 1) + (xcd - r) * q) + off; }
        const int nig = WGM * nN, gid = wgid / nig, fm = gid * WGM, gsz = (nM - fm) < WGM ? (nM - fm) : WGM;
        u.pm = fm + ((wgid % nig) % gsz); u.pn = (wgid % nig) / gsz; u.pb = u.pn; return true;
    }
};
struct MoeOrder {
    int nM, nN, nwg, G, c; const unsigned* pexp;
    __device__ void init(int nM_, int nN_, int G_, int c_, const unsigned* pexp_) { nM = nM_; nN = nN_; nwg = nM * nN; G = G_; c = c_; pexp = pexp_; }
    __device__ bool next(int i, Unit& u) const {
        const long L = (long)i * G + c; if (L >= nwg) return false;
        int wgid = (int)L; { const int q = nwg / NXCD, r = nwg % NXCD, xcd = wgid % NXCD, off = wgid / NXCD; wgid = (xcd < r ? xcd * (q + 1) : r * (q + 1) + (xcd - r) * q) + off; }
        const int nig = WGM * nN, gid = wgid / nig, fm = gid * WGM, gsz = (nM - fm) < WGM ? (nM - fm) : WGM;
        u.pm = fm + ((wgid % nig) % gsz); u.pn = (wgid % nig) / gsz;
        const int e = (int)__builtin_amdgcn_readfirstlane(ld_u32_agent(pexp + u.pm)); u.pb = e * nN + u.pn; return true;
    }
};

template <class Epi, class Sched, bool ALIGN_EPI = false, bool SP2 = false>
__device__ __forceinline__ void gemm_phase(LAS unsigned char* lds, const Gemm g, const Sched& S, const Epi& E, const int wave0) {
    int tid_ = wave0 * 64 + lane_id_opaque();
    const int tid = tid_, wid = __builtin_amdgcn_readfirstlane(tid >> 6), lane = tid & 63, wr = wid >> 2, wc = wid & 3, fr = lane & 15, fq = lane >> 4;
    const int K = g.K, nt = K / BK;
    unsigned voffA[2], voffB[2];
    { int R, C; stage_rc(tid * 16, R, C); const int Rb = Epi::PERM ? ((R & ~31) + perm32(R & 31)) : R;
      voffA[0] = (unsigned)(R * g.lda + C) * 2u; voffB[0] = (unsigned)(Rb * g.ldb + C) * 2u; voffA[1] = voffA[0] + (unsigned)(64 * g.lda) * 2u; voffB[1] = voffB[0] + (unsigned)(64 * g.ldb) * 2u; }
    const size_t kstep = (size_t)(BK * 2);
    const size_t hsA = (size_t)HALF * g.lda * 2, hsB = (size_t)HALF * g.ldb * 2;
    const size_t tsA = 2 * hsA, tsB = 2 * hsB;
    const unsigned ldsw = (unsigned)wid * 1024u;
    const int swz_ = (fr * 64 + fq * 16) ^ ((fr & 8) << 2); const int aoff = wr * 8192 + swz_, boff = wc * 4096 + swz_;
#define PG8_SA(b, h) (((b) * 2 + (h)) * HTB)
#define PG8_SB(b, h) ((4 + (b) * 2 + (h)) * HTB)
#define PG8_STAGE(bufoff, gbase, voff) do { _Pragma("unroll") for (int _i = 0; _i < 2; ++_i) \
        __builtin_amdgcn_global_load_lds((const unsigned*)((const char*)(gbase) + (voff)[_i]), (LAS unsigned*)(lds + (bufoff) + ldsw + _i * 8192), 16, 0, 0); } while (0)
#define PG8_LDA(dst, b, h) do { _Pragma("unroll") for (int m = 0; m < 4; ++m) _Pragma("unroll") for (int k = 0; k < 2; ++k) dst[m][k] = *(const LAS bf16x8*)(lds + PG8_SA(b, h) + aoff + m * 2048 + k * 1024); } while (0)
#define PG8_LDB(dst, b, h) do { _Pragma("unroll") for (int n = 0; n < 2; ++n) _Pragma("unroll") for (int k = 0; k < 2; ++k) dst[n][k] = *(const LAS bf16x8*)(lds + PG8_SB(b, h) + boff + n * 2048 + k * 1024); } while (0)
#define PG8_MMA(ai, bj, At, Bt) do { __builtin_amdgcn_s_setprio(1); _Pragma("unroll") for (int m = 0; m < 4; ++m) _Pragma("unroll") for (int n = 0; n < 2; ++n) _Pragma("unroll") for (int k = 0; k < 2; ++k) \
        acc[ai][bj][m][n] = __builtin_amdgcn_mfma_f32_16x16x32_bf16(Bt[n][k], At[m][k], acc[ai][bj][m][n], 0, 0, 0); __builtin_amdgcn_s_setprio(0); } while (0)
#define PG8_WAIT_V(n) asm volatile("s_waitcnt vmcnt(" #n ")" ::: "memory")
#define PG8_WAIT_L(n) asm volatile("s_waitcnt lgkmcnt(" #n ")" ::: "memory")
#define PG8_BAR __builtin_amdgcn_s_barrier()
#define PG8_SCHED __builtin_amdgcn_sched_barrier(0)
    Unit cur, nxt; int ui = 0;
    if (!S.next(0, cur)) return;
    f32x4 acc[2][2][4][2];
#pragma unroll
    for (int a = 0; a < 2; ++a)
#pragma unroll
        for (int b = 0; b < 2; ++b)
#pragma unroll
            for (int m = 0; m < 4; ++m)
#pragma unroll
                for (int n = 0; n < 2; ++n) acc[a][b][m][n] = (f32x4){0.f, 0.f, 0.f, 0.f};
    bf16x8 At[4][2], B0[2][2], B1[2][2];
    const char* cA = (const char*)g.A + (size_t)cur.pm * tsA; const char* cB = (const char*)g.Bt + (size_t)cur.pb * tsB;
    if constexpr (SP2) {
        PG8_STAGE(PG8_SB(0, 0), cB, voffB); PG8_STAGE(PG8_SB(0, 1), cB + hsB, voffB); PG8_STAGE(PG8_SA(0, 0), cA, voffA); PG8_STAGE(PG8_SA(0, 1), cA + hsA, voffA);
        if (wr == 1) PG8_BAR;
        PG8_WAIT_V(2); PG8_BAR;
        PG8_STAGE(PG8_SB(1, 0), cB + kstep, voffB); PG8_STAGE(PG8_SA(1, 0), cA + kstep, voffA); PG8_STAGE(PG8_SB(1, 1), cB + hsB + kstep, voffB);
        PG8_WAIT_V(6); PG8_BAR;
    } else {
        PG8_STAGE(PG8_SB(0, 0), cB, voffB); PG8_STAGE(PG8_SA(0, 0), cA, voffA); PG8_STAGE(PG8_SB(0, 1), cB + hsB, voffB); PG8_STAGE(PG8_SA(0, 1), cA + hsA, voffA);
        if (wr == 1) PG8_BAR;
        PG8_WAIT_V(4); PG8_BAR;
        PG8_STAGE(PG8_SB(1, 0), cB + kstep, voffB); PG8_STAGE(PG8_SA(1, 0), cA + kstep, voffA); PG8_STAGE(PG8_SB(1, 1), cB + hsB + kstep, voffB);
        PG8_WAIT_V(6); PG8_BAR;
    }
    for (;;) {
        const bool has_next = S.next(ui + 1, nxt);
        const char* nA = has_next ? (const char*)g.A + (size_t)nxt.pm * tsA : cA; const char* nB = has_next ? (const char*)g.Bt + (size_t)nxt.pb * tsB : cB;
        for (int t = 0; t < nt; t += 2) {
            const bool last = (t == nt - 2);
            const char* a1 = cA + (size_t)(t + 1) * kstep;
            const char* a2 = last ? nA : cA + (size_t)(t + 2) * kstep; const char* b2 = last ? nB : cB + (size_t)(t + 2) * kstep;
            const char* a3 = a2 + kstep; const char* b3 = b2 + kstep;
            if constexpr (SP2) {
            PG8_LDB(B0, 0, 0); PG8_LDB(B1, 0, 1); PG8_SCHED; PG8_LDA(At, 0, 0); PG8_STAGE(PG8_SA(1, 1), a1 + hsA, voffA);
            PG8_WAIT_V(8); PG8_WAIT_L(0); PG8_BAR; PG8_MMA(0, 0, At, B0); PG8_MMA(0, 1, At, B1); PG8_BAR; PG8_SCHED;
            PG8_LDA(At, 0, 1); PG8_STAGE(PG8_SB(0, 0), b2, voffB); PG8_STAGE(PG8_SB(0, 1), b2 + hsB, voffB); PG8_STAGE(PG8_SA(0, 0), a2, voffA);
            PG8_WAIT_V(8); PG8_WAIT_L(0); PG8_BAR; PG8_MMA(1, 0, At, B0); PG8_MMA(1, 1, At, B1); PG8_BAR; PG8_SCHED;
            PG8_LDB(B0, 1, 0); PG8_LDB(B1, 1, 1); PG8_SCHED; PG8_LDA(At, 1, 0); PG8_STAGE(PG8_SA(0, 1), a2 + hsA, voffA);
            PG8_WAIT_V(8); PG8_WAIT_L(0); PG8_BAR; PG8_MMA(0, 0, At, B0); PG8_MMA(0, 1, At, B1); PG8_BAR; PG8_SCHED;
            PG8_LDA(At, 1, 1); PG8_STAGE(PG8_SB(1, 0), b3, voffB); PG8_STAGE(PG8_SB(1, 1), b3 + hsB, voffB); PG8_STAGE(PG8_SA(1, 0), a3, voffA);
            PG8_WAIT_V(8); PG8_WAIT_L(0); PG8_BAR; PG8_MMA(1, 0, At, B0); PG8_MMA(1, 1, At, B1); PG8_BAR; PG8_SCHED;
            } else {
            PG8_LDB(B0, 0, 0); PG8_SCHED; PG8_LDA(At, 0, 0); PG8_STAGE(PG8_SA(1, 1), a1 + hsA, voffA);
            PG8_WAIT_L(8); PG8_BAR; PG8_WAIT_L(0); PG8_MMA(0, 0, At, B0); PG8_BAR; PG8_SCHED;
            PG8_LDB(B1, 0, 1); PG8_STAGE(PG8_SB(0, 0), b2, voffB);
            PG8_BAR; PG8_WAIT_L(0); PG8_MMA(0, 1, At, B1); PG8_BAR;
            PG8_LDA(At, 0, 1); PG8_STAGE(PG8_SA(0, 0), a2, voffA);
            PG8_BAR; PG8_WAIT_L(0); PG8_MMA(1, 0, At, B0); PG8_BAR; PG8_SCHED;
            PG8_STAGE(PG8_SB(0, 1), b2 + hsB, voffB);
            PG8_WAIT_V(6); PG8_BAR; PG8_MMA(1, 1, At, B1); PG8_BAR;
            PG8_LDB(B0, 1, 0); PG8_SCHED; PG8_LDA(At, 1, 0); PG8_STAGE(PG8_SA(0, 1), a2 + hsA, voffA);
            PG8_WAIT_L(8); PG8_BAR; PG8_WAIT_L(0); PG8_MMA(0, 0, At, B0); PG8_BAR; PG8_SCHED;
            PG8_LDB(B1, 1, 1); PG8_STAGE(PG8_SB(1, 0), b3, voffB);
            PG8_BAR; PG8_WAIT_L(0); PG8_MMA(0, 1, At, B1); PG8_BAR;
            PG8_LDA(At, 1, 1); PG8_STAGE(PG8_SA(1, 0), a3, voffA);
            PG8_BAR; PG8_WAIT_L(0); PG8_MMA(1, 0, At, B0); PG8_BAR; PG8_SCHED;
            PG8_STAGE(PG8_SB(1, 1), b3 + hsB, voffB);
            PG8_WAIT_V(6); PG8_BAR; PG8_MMA(1, 1, At, B1); PG8_BAR;
            }
        }
        if constexpr (ALIGN_EPI) { if (wr == 0) PG8_BAR; }
        E(acc, cur, wr, wc, fr, fq);
        if (!has_next) break;
#pragma unroll
        for (int a = 0; a < 2; ++a)
#pragma unroll
            for (int b = 0; b < 2; ++b)
#pragma unroll
                for (int m = 0; m < 4; ++m)
#pragma unroll
                    for (int n = 0; n < 2; ++n) acc[a][b][m][n] = (f32x4){0.f, 0.f, 0.f, 0.f};
        cur = nxt; cA = nA; cB = nB; ++ui;
        if constexpr (ALIGN_EPI) { if (wr == 1) PG8_BAR; }
    }
    PG8_WAIT_V(0);
    if constexpr (!ALIGN_EPI) { if (wr == 0) PG8_BAR; }
    PG8_BAR;
#undef PG8_SA
#undef PG8_SB
#undef PG8_STAGE
#undef PG8_LDA
#undef PG8_LDB
#undef PG8_MMA
#undef PG8_WAIT_V
#undef PG8_WAIT_L
#undef PG8_BAR
#undef PG8_SCHED
}

typedef const f32x4 (&AccT)[2][2][4][2];
#define EPI_FENCE() asm volatile("" ::: "memory")

struct EpiInProj {
    static constexpr bool PERM = true;
    unsigned char* xbase; const float* rs;
    __device__ __forceinline__ void operator()(AccT acc, const Unit& u, int wr, int wc, int fr, int fq) const {
        const int pn = u.pn; size_t boff; int ld, ct; bool sig = false;
        float sc = 1.f;
        if (pn < 4) { boff = X_Z; ld = 1024; ct = pn; }
        else if (pn < 9) { boff = X_XBC; ld = 1280; ct = pn - 4; }
        else if (pn < 11) { boff = X_Q; ld = 512; ct = pn - 9; sc = 0.18033688011112042f; }
        else if (pn < 13) { boff = X_K; ld = 512; ct = pn - 11; }
        else { boff = X_GS; ld = 2048; ct = pn - 13; sig = true; }
        const unsigned lo = (unsigned)(fr * ld + 8 * fq) * 2u;
        unsigned char* tb = xbase + boff + ((size_t)(u.pm * BM + wr * 64) * ld + ct * BM + wc * 32) * 2;
        const float* rsb = rs + u.pm * BM + wr * 64;
#pragma unroll
        for (int ai = 0; ai < 2; ++ai)
#pragma unroll
            for (int m = 0; m < 4; ++m) { const float r = rsb[ai * HALF + m * 16 + fr] * sc; unsigned char* rowp = tb + (size_t)(ai * HALF + m * 16) * ld * 2;
#pragma unroll
                for (int bj = 0; bj < 2; ++bj) { f32x4 v0 = acc[ai][bj][m][0] * r, v1 = acc[ai][bj][m][1] * r;
                    if (sig) {
#pragma unroll
                        for (int j = 0; j < 4; ++j) { v0[j] = sigmoidf_(v0[j]); v1[j] = sigmoidf_(v1[j]); } }
                    u32x4 w; w.x = cvt_pk_bf16(v0[0], v0[1]); w.y = cvt_pk_bf16(v0[2], v0[3]); w.z = cvt_pk_bf16(v1[0], v1[1]); w.w = cvt_pk_bf16(v1[2], v1[3]);
                    *(u32x4*)(rowp + lo + bj * HALF * 2) = w; }
                EPI_FENCE(); }
    }
};
struct EpiBf16Rs {
    static constexpr bool PERM = true;
    bf16_t* O; int ldc; const float* rs; float sc;
    __device__ __forceinline__ void operator()(AccT acc, const Unit& u, int wr, int wc, int fr, int fq) const {
        const unsigned lo = (unsigned)(fr * ldc + 8 * fq) * 2u;
        unsigned char* tb = (unsigned char*)O + ((size_t)(u.pm * BM + wr * 64) * ldc + u.pn * BM + wc * 32) * 2;
        const float* rsb = rs + u.pm * BM + wr * 64;
#pragma unroll
        for (int ai = 0; ai < 2; ++ai)
#pragma unroll
            for (int m = 0; m < 4; ++m) { const float r = rsb[ai * HALF + m * 16 + fr] * sc; unsigned char* rowp = tb + (size_t)(ai * HALF + m * 16) * ldc * 2;
#pragma unroll
                for (int bj = 0; bj < 2; ++bj) { const f32x4 v0 = acc[ai][bj][m][0] * r, v1 = acc[ai][bj][m][1] * r;
                    u32x4 w; w.x = cvt_pk_bf16(v0[0], v0[1]); w.y = cvt_pk_bf16(v0[2], v0[3]); w.z = cvt_pk_bf16(v1[0], v1[1]); w.w = cvt_pk_bf16(v1[2], v1[3]);
                    *(u32x4*)(rowp + lo + bj * HALF * 2) = w; }
                EPI_FENCE(); }
    }
};
struct EpiBf16Cs {
    static constexpr bool PERM = true;
    bf16_t* O; int ldc; const float* cs; float sc;
    __device__ __forceinline__ void operator()(AccT acc, const Unit& u, int wr, int wc, int fr, int fq) const {
        const unsigned lo = (unsigned)(fr * ldc + 8 * fq) * 2u;
        unsigned char* tb = (unsigned char*)O + ((size_t)(u.pm * BM + wr * 64) * ldc + u.pn * BM + wc * 32) * 2;
        const float* csb = cs + u.pn * BM + wc * 32 + 8 * fq;
        f32x4 c0[2], c1[2];
#pragma unroll
        for (int bj = 0; bj < 2; ++bj) { c0[bj] = *(const f32x4*)(csb + bj * HALF) * sc; c1[bj] = *(const f32x4*)(csb + bj * HALF + 4) * sc; }
#pragma unroll
        for (int ai = 0; ai < 2; ++ai)
#pragma unroll
            for (int m = 0; m < 4; ++m) { unsigned char* rowp = tb + (size_t)(ai * HALF + m * 16) * ldc * 2;
#pragma unroll
                for (int bj = 0; bj < 2; ++bj) { const f32x4 v0 = acc[ai][bj][m][0] * c0[bj], v1 = acc[ai][bj][m][1] * c1[bj];
                    u32x4 w; w.x = cvt_pk_bf16(v0[0], v0[1]); w.y = cvt_pk_bf16(v0[2], v0[3]); w.z = cvt_pk_bf16(v1[0], v1[1]); w.w = cvt_pk_bf16(v1[2], v1[3]);
                    *(u32x4*)(rowp + lo + bj * HALF * 2) = w; }
                EPI_FENCE(); }
    }
};
template <bool ADD> struct EpiGate {
    static constexpr bool PERM = true;
    bf16_t* O; const bf16_t* GS; int gcol0; const bf16_t* Oin;
    __device__ __forceinline__ void operator()(AccT acc, const Unit& u, int wr, int wc, int fr, int fq) const {
        const unsigned lo = (unsigned)(fr * 1024 + 8 * fq) * 2u, lg = (unsigned)(fr * 2048 + 8 * fq) * 2u;
        unsigned char* tb = (unsigned char*)O + ((size_t)(u.pm * BM + wr * 64) * 1024 + u.pn * BM + wc * 32) * 2;
        const unsigned char* ib = (const unsigned char*)Oin + ((size_t)(u.pm * BM + wr * 64) * 1024 + u.pn * BM + wc * 32) * 2;
        const unsigned char* gb = (const unsigned char*)GS + ((size_t)(u.pm * BM + wr * 64) * 2048 + gcol0 + u.pn * BM + wc * 32) * 2;
#pragma unroll
        for (int ai = 0; ai < 2; ++ai)
#pragma unroll
            for (int m = 0; m < 4; ++m) { unsigned char* rowp = tb + (size_t)(ai * HALF + m * 16) * 1024 * 2; const unsigned char* inp = ib + (size_t)(ai * HALF + m * 16) * 1024 * 2; const unsigned char* gp = gb + (size_t)(ai * HALF + m * 16) * 2048 * 2;
#pragma unroll
                for (int bj = 0; bj < 2; ++bj) { const u32x4 gw = *(const u32x4*)(gp + lg + bj * HALF * 2); f32x4 v0 = acc[ai][bj][m][0], v1 = acc[ai][bj][m][1];
                    v0[0] *= bflo(gw.x); v0[1] *= bfhi(gw.x); v0[2] *= bflo(gw.y); v0[3] *= bfhi(gw.y); v1[0] *= bflo(gw.z); v1[1] *= bfhi(gw.z); v1[2] *= bflo(gw.w); v1[3] *= bfhi(gw.w);
                    if (ADD) { const u32x4 pw = *(const u32x4*)(inp + lo + bj * HALF * 2);
                        v0[0] += bflo(pw.x); v0[1] += bfhi(pw.x); v0[2] += bflo(pw.y); v0[3] += bfhi(pw.y); v1[0] += bflo(pw.z); v1[1] += bfhi(pw.z); v1[2] += bflo(pw.w); v1[3] += bfhi(pw.w); }
                    u32x4 w; w.x = cvt_pk_bf16(v0[0], v0[1]); w.y = cvt_pk_bf16(v0[2], v0[3]); w.z = cvt_pk_bf16(v1[0], v1[1]); w.w = cvt_pk_bf16(v1[2], v1[3]);
                    *(u32x4*)(rowp + lo + bj * HALF * 2) = w; }
                EPI_FENCE(); }
    }
};
struct EpiResid {
    static constexpr bool PERM = false;
    const float* Hin; float* Hout;
    __device__ __forceinline__ void operator()(AccT acc, const Unit& u, int wr, int wc, int fr, int fq) const {
        const unsigned lo = (unsigned)(fr * 1024 + 4 * fq) * 4u;
        const size_t ub = ((size_t)(u.pm * BM + wr * 64) * 1024 + u.pn * BM + wc * 32) * 4;
#pragma unroll
        for (int ai = 0; ai < 2; ++ai)
#pragma unroll
            for (int m = 0; m < 4; ++m) { const size_t ro = ub + (size_t)(ai * HALF + m * 16) * 1024 * 4; const unsigned char* hi = (const unsigned char*)Hin + ro; unsigned char* ho = (unsigned char*)Hout + ro;
                f32x4 hv[2][2];
#pragma unroll
                for (int bj = 0; bj < 2; ++bj)
#pragma unroll
                    for (int n = 0; n < 2; ++n) hv[bj][n] = *(const f32x4*)(hi + lo + (bj * HALF + n * 16) * 4);
#pragma unroll
                for (int bj = 0; bj < 2; ++bj)
#pragma unroll
                    for (int n = 0; n < 2; ++n) *(f32x4*)(ho + lo + (bj * HALF + n * 16) * 4) = hv[bj][n] + acc[ai][bj][m][n];
                EPI_FENCE(); }
    }
};
struct EpiSwiglu {
    static constexpr bool PERM = true;
    bf16_t* ACT; const float* rs;
    __device__ __forceinline__ void operator()(AccT acc, const Unit& u, int wr, int wc, int fr, int fq) const {
        const unsigned lo = (unsigned)(fr * DFF + 8 * fq) * 2u;
        unsigned char* tb = (unsigned char*)ACT + ((size_t)(u.pm * BM + wr * 64) * DFF + u.pn * HALF + wc * 32) * 2;
        const float* rsb = rs + u.pm * BM + wr * 64;
#pragma unroll
        for (int ai = 0; ai < 2; ++ai)
#pragma unroll
            for (int m = 0; m < 4; ++m) { const float r = rsb[ai * HALF + m * 16 + fr];
                float o[8];
#pragma unroll
                for (int n = 0; n < 2; ++n)
#pragma unroll
                    for (int j = 0; j < 4; ++j) { const float gt = acc[ai][0][m][n][j] * r, up = acc[ai][1][m][n][j] * r; o[n * 4 + j] = gt * sigmoidf_(gt) * up; }
                u32x4 w; w.x = cvt_pk_bf16(o[0], o[1]); w.y = cvt_pk_bf16(o[2], o[3]); w.z = cvt_pk_bf16(o[4], o[5]); w.w = cvt_pk_bf16(o[6], o[7]);
                *(u32x4*)(tb + (size_t)(ai * HALF + m * 16) * DFF * 2 + lo) = w;
                EPI_FENCE(); }
    }
};
struct EpiMoeDown {
    static constexpr bool PERM = false;
    float* H; const int* rowl; const float* wrow; float* Hout;
    __device__ __forceinline__ void operator()(AccT acc, const Unit& u, int wr, int wc, int fr, int fq) const {
        const int rb = u.pm * BM + wr * 64; const unsigned cb = (unsigned)(u.pn * BM + wc * 32 + 4 * fq) * 4u;
#pragma unroll
        for (int ai = 0; ai < 2; ++ai)
#pragma unroll
            for (int m = 0; m < 4; ++m) { const int row = rb + ai * HALF + m * 16 + fr; const int tok = rowl[row]; const float w = wrow[row];
                if (tok >= 0) { unsigned char* hp = (unsigned char*)H + (size_t)tok * 4096 + cb; unsigned char* op = (unsigned char*)Hout + (size_t)tok * 4096 + cb;
                    f32x4 hv[2][2];
#pragma unroll
                    for (int bj = 0; bj < 2; ++bj)
#pragma unroll
                        for (int n = 0; n < 2; ++n) hv[bj][n] = *(const f32x4*)(hp + (bj * HALF + n * 16) * 4);
#pragma unroll
                    for (int bj = 0; bj < 2; ++bj)
#pragma unroll
                        for (int n = 0; n < 2; ++n) *(f32x4*)(op + (bj * HALF + n * 16) * 4) = hv[bj][n] + acc[ai][bj][m][n] * w; }
                EPI_FENCE(); }
    }
};
}

#define XB_TMO      128
#define XB_XCNT(j)  (256  + 64 * (j))
#define XB_XSUB(j)  (1280 + 64 * (j))
#define XB_XGEN(j)  (2304 + 64 * (j))
#define XB_TOP      3328
#define XB_TOPGEN   3392
#define XCD_BAR_WORDS 3456
#define XB_SPIN_CAP (1u << 22)
__device__ __forceinline__ unsigned xb_ld(unsigned* p)              { return __hip_atomic_load(p, __ATOMIC_RELAXED, __HIP_MEMORY_SCOPE_AGENT); }
__device__ __forceinline__ unsigned xb_add(unsigned* p, unsigned v) { return __hip_atomic_fetch_add(p, v, __ATOMIC_RELAXED, __HIP_MEMORY_SCOPE_AGENT); }
__device__ __forceinline__ unsigned xb_xcc_id() { return (unsigned)__builtin_amdgcn_s_getreg((3 << 11) | 20) & 0xFu; }
#define XB_SPIN(cond, bar) do { unsigned _sp = 0; while (cond) { __builtin_amdgcn_s_sleep(1); \
    if ((++_sp & 255u) == 0u) { if (xb_ld(&(bar)[XB_TMO])) break; if (_sp > XB_SPIN_CAP) { atomicAdd(&(bar)[XB_TMO], 1u); break; } } } } while (0)
struct XcdBarrier { unsigned* bar; unsigned x; volatile LAS unsigned* st; };
__device__ __forceinline__ XcdBarrier xcd_barrier_post(unsigned* bar, volatile LAS unsigned* st) {
    XcdBarrier b; b.bar = bar; b.x = xb_xcc_id(); b.st = st;
    if (threadIdx.x == 0) (void)xb_add(&bar[XB_XCNT(b.x)], 1u);
    return b;
}
__device__ __forceinline__ void xcd_barrier_complete(unsigned* bar, unsigned x, unsigned& nloc, unsigned& nx) {
    const unsigned G = gridDim.x * gridDim.y * gridDim.z;
    unsigned sum, cnt, mine, sp = 0u;
    for (;;) {
        sum = 0u; cnt = 0u; mine = 0u;
#pragma unroll
        for (unsigned j = 0; j < 16; ++j) { const unsigned c = xb_ld(&bar[XB_XCNT(j)]); sum += c; cnt += (c > 0u) ? 1u : 0u; mine = (j == x) ? c : mine; }
        if (sum == G) break;
        __builtin_amdgcn_s_sleep(1);
        if ((++sp & 255u) == 0u) { if (xb_ld(&bar[XB_TMO])) break; if (sp > XB_SPIN_CAP) { atomicAdd(&bar[XB_TMO], 1u); break; } }
    }
    nloc = mine > 0u ? mine : 1u; nx = cnt > 0u ? cnt : 1u;
}
__device__ __forceinline__ void xcd_barrier(const XcdBarrier& b, const bool leader_thread) {
    asm volatile("s_waitcnt vmcnt(0)" ::: "memory");
    __syncthreads();
    if (leader_thread) {
        unsigned* bar = b.bar;
        __builtin_amdgcn_s_waitcnt(0);
        unsigned nloc = b.st[0], nx = b.st[1];
        if (nloc == 0u) { xcd_barrier_complete(bar, b.x, nloc, nx); b.st[0] = nloc; b.st[1] = nx; }
        const unsigned old = xb_add(&bar[XB_XSUB(b.x)], 1u);
        const unsigned gen = old / nloc;
        if (old + 1u == (gen + 1u) * nloc) {
            __builtin_amdgcn_fence(__ATOMIC_RELEASE, "agent");
            asm volatile("s_waitcnt vmcnt(0)" ::: "memory");
            const unsigned og = xb_add(&bar[XB_TOP], 1u);
            const unsigned tg = og / nx;
            if (og + 1u == (tg + 1u) * nx) xb_add(&bar[XB_TOPGEN], 1u);
            else XB_SPIN(xb_ld(&bar[XB_TOPGEN]) == tg, bar);
            __builtin_amdgcn_fence(__ATOMIC_ACQUIRE, "agent");
            xb_add(&bar[XB_XGEN(b.x)], 1u);
            asm volatile("s_waitcnt vmcnt(0)" ::: "memory");
        } else {
            XB_SPIN(xb_ld(&bar[XB_XGEN(b.x)]) == gen, bar);
            __builtin_amdgcn_fence(__ATOMIC_ACQUIRE, "agent");
            asm volatile("s_waitcnt vmcnt(0)" ::: "memory");
        }
    }
    __syncthreads();
}

struct Params {
    const float* in[28];
    float* out;
    unsigned char* ws;
    int l_lo, l_hi, ph_lo, ph_hi;
};
enum { I_X = 0, I_MEM, I_NORM_MIX, I_W_IN, I_CONV_W, I_CONV_B, I_DT_BIAS, I_A_LOG, I_D_SKIP, I_SSD_NORM, I_W_SSD_O, I_W_SB_O, I_W_OUT, I_NORM_XA, I_NORM_MEM,
       I_XA_WQ, I_XA_WK, I_XA_WV, I_XA_WO, I_NORM_FFN, I_FFN_G, I_FFN_U, I_FFN_D, I_MOE_R, I_MOE_G, I_MOE_U, I_MOE_D, I_FINAL };

__device__ __forceinline__ void tr_item(const float* W, int ldw, int k0, int n0, const float* gain, bf16_t* WT, int ldt, int drow0, LAS float* scr, int lane) {
    const int hl = lane >> 5, nl = lane & 31;
    const float* src = W + (size_t)(k0 + hl) * ldw + n0 + nl;
    float v[32];
#pragma unroll
    for (int i = 0; i < 32; ++i) v[i] = src[(size_t)(2 * i) * ldw];
#pragma unroll
    for (int i = 0; i < 32; ++i) scr[(2 * i + hl) * 33 + nl] = v[i];
    LDS_WAIT();
    const int c = lane & 7;
    f32x4 g0 = {1.f, 1.f, 1.f, 1.f}, g1 = {1.f, 1.f, 1.f, 1.f};
    if (gain) { g0 = *(const f32x4*)(gain + k0 + 8 * c); g1 = *(const f32x4*)(gain + k0 + 8 * c + 4); }
#pragma unroll
    for (int j = 0; j < 4; ++j) { const int n = (lane >> 3) + 8 * j; const LAS float* s = scr + (8 * c) * 33 + n;
        u32x4 o; o.x = cvt_pk_bf16(s[0 * 33] * g0.x, s[1 * 33] * g0.y); o.y = cvt_pk_bf16(s[2 * 33] * g0.z, s[3 * 33] * g0.w); o.z = cvt_pk_bf16(s[4 * 33] * g1.x, s[5 * 33] * g1.y); o.w = cvt_pk_bf16(s[6 * 33] * g1.z, s[7 * 33] * g1.w);
        *(u32x4*)(WT + (size_t)(drow0 + n) * ldt + k0 + 8 * c) = o; }
    LDS_WAIT();
}
struct TrJob { const float* W; int ldw, K, col0, ncols; const float* gain; bf16_t* WT; int dbase, dgroup; };
__device__ __forceinline__ void run_job(const TrJob& j, int& base, int gw, int NGW, LAS float* scr, int lane) {
    const int nblk = j.ncols / 32, nitems = (j.K / 64) * nblk;
    int start = (gw - base) % NGW; if (start < 0) start += NGW;
    for (int it = start; it < nitems; it += NGW) { const int kb = it / nblk, nb = it % nblk, c0 = nb * 32;
        tr_item(j.W, j.ldw, kb * 64, j.col0 + c0, j.gain, j.WT, j.K, j.dbase + (c0 / 128) * j.dgroup + (c0 % 128), scr, lane); }
    base = (base + nitems) % NGW;
}

template <int NE>
__device__ __forceinline__ float rowpass_row(const float* xrow, bf16_t* brow, int lane, const LAS float* wsm, float (&ex)[NE > 0 ? NE : 1]) {
    const f32x4* xr = (const f32x4*)xrow + lane;
    f32x4 v[4]; float s = 0.f;
#pragma unroll
    for (int j = 0; j < 4; ++j) { v[j] = xr[64 * j]; s += (v[j].x * v[j].x + v[j].y * v[j].y) + (v[j].z * v[j].z + v[j].w * v[j].w); }
    const float rstd = __builtin_amdgcn_rsqf(wave_sum(s) * (1.f / D) + EPS);
    u32x2* o8 = (u32x2*)brow + lane;
#pragma unroll
    for (int j = 0; j < 4; ++j) { u32x2 w; w.x = cvt_pk_bf16(v[j].x, v[j].y); w.y = cvt_pk_bf16(v[j].z, v[j].w); o8[64 * j] = w; }
    if constexpr (NE > 0) {
#pragma unroll
        for (int e = 0; e < NE; ++e) { float p = 0.f;
#pragma unroll
            for (int j = 0; j < 4; ++j) { const f32x4 w4 = *(const LAS f32x4*)(wsm + e * 1024 + 256 * j + 4 * lane); p += (v[j].x * w4.x + v[j].y * w4.y) + (v[j].z * w4.z + v[j].w * w4.w); }
            ex[e] = wave_sum(p) * rstd; }
    }
    return rstd;
}

typedef float f32x16 __attribute__((ext_vector_type(16)));
#define MFMA32(a, b, c) __builtin_amdgcn_mfma_f32_32x32x16_bf16((a), (b), (c), 0, 0, 0)
__device__ __forceinline__ bf16x8 ldg8(const bf16_t* p) { return *(const bf16x8*)p; }
__device__ __forceinline__ bf16x8 pack8(const float* v) { u32x4 w; w.x = cvt_pk_bf16(v[0], v[1]); w.y = cvt_pk_bf16(v[2], v[3]); w.z = cvt_pk_bf16(v[4], v[5]); w.w = cvt_pk_bf16(v[6], v[7]); return __builtin_bit_cast(bf16x8, w); }
__device__ __forceinline__ int pi32(int r) { return 16 * ((r >> 2) & 1) + 4 * (r >> 3) + (r & 3); }

__device__ __forceinline__ void sb_attn_mfma(const bf16_t* Q, const bf16_t* Kb, const bf16_t* Vt, bf16_t* Yo, int w, int NW, int lane) {
    const int c = lane & 31, hh = lane >> 5, pr = pi32(c);
    bf16x8 U[2];
#pragma unroll
    for (int kk = 0; kk < 2; ++kk) { u32x4 uw;
#pragma unroll
        for (int q = 0; q < 4; ++q) uw[q] = ((16 * hh + 8 * kk + 2 * q > pr) ? 0x3F80u : 0u) | ((16 * hh + 8 * kk + 2 * q + 1 > pr) ? 0x3F800000u : 0u);
        U[kk] = __builtin_bit_cast(bf16x8, uw); }
    for (int j = w; j < NBATCH * 8 * 64; j += NW) {
        const int bh = j & 127, slot = j >> 7, k4 = slot >> 4, a = slot & 15;
        const int qblk = k4 == 0 ? a : k4 == 1 ? 31 - a : k4 == 2 ? 32 + a : 63 - a;
        const int b = bh >> 3, h = bh & 7, t0 = qblk * 32;
        const bf16_t* qp = Q + (size_t)(b * SEQ + t0 + c) * 512 + h * 64; bf16_t* yp = Yo + (size_t)(b * SEQ + t0 + c) * 512 + h * 64;
        bf16x8 qf[4];
#pragma unroll
        for (int jj = 0; jj < 4; ++jj) qf[jj] = ldg8(qp + 16 * jj + 8 * hh);
        const bf16_t* kbase = Kb + (size_t)(b * SEQ + pr) * 512 + h * 64 + 8 * hh;
        const bf16_t* vbase = Vt + (size_t)(h * 64 + c) * T + b * SEQ + 16 * hh;
        f32x16 o0, o1;
#pragma unroll
        for (int i = 0; i < 16; ++i) { o0[i] = 0.f; o1[i] = 0.f; }
        float R = 0.f;
        bf16x8 kf[4], vf[4], kn[4], vn[4];
#pragma unroll
        for (int jj = 0; jj < 4; ++jj) { kf[jj] = ldg8(kbase + (size_t)t0 * 512 + 16 * jj); vf[jj] = ldg8(vbase + (size_t)(jj >> 1) * 32 * T + t0 + 8 * (jj & 1)); }
        for (int kb = qblk; kb >= 0; --kb) {
            const int s0 = kb * 32;
            if (kb > 0) {
#pragma unroll
                for (int jj = 0; jj < 4; ++jj) { kn[jj] = ldg8(kbase + (size_t)(s0 - 32) * 512 + 16 * jj); vn[jj] = ldg8(vbase + (size_t)(jj >> 1) * 32 * T + (s0 - 32) + 8 * (jj & 1)); }
            }
            f32x16 s;
#pragma unroll
            for (int i = 0; i < 16; ++i) s[i] = 0.f;
#pragma unroll
            for (int jj = 0; jj < 4; ++jj) s = MFMA32(kf[jj], qf[jj], s);
            const bool diag = (kb == qblk);
            float sp[16]; float rsum = 0.f;
#pragma unroll
            for (int i = 0; i < 16; ++i) { const float x = s[i]; float v = fmaxf(x, 0.f) + __builtin_amdgcn_logf(1.f + __builtin_amdgcn_exp2f(-fabsf(x)));
                if (diag && !(16 * hh + i < c)) v = 0.f;
                sp[i] = v; rsum += v; }
            f32x16 E;
#pragma unroll
            for (int i = 0; i < 16; ++i) E[i] = 0.f;
            E = MFMA32(U[0], pack8(sp), E); E = MFMA32(U[1], pack8(sp + 8), E);
            float at[16];
#pragma unroll
            for (int i = 0; i < 16; ++i) { float av = __builtin_amdgcn_exp2f(s[i] - sp[i] - E[i] - R); if (diag && !(16 * hh + i < c)) av = 0.f; at[i] = av; }
            const bf16x8 a0 = pack8(at), a1 = pack8(at + 8);
            o0 = MFMA32(vf[0], a0, o0); o0 = MFMA32(vf[1], a1, o0);
            o1 = MFMA32(vf[2], a0, o1); o1 = MFMA32(vf[3], a1, o1);
            rsum += __shfl_xor(rsum, 32); R += rsum;
            if (__all(R > 160.f)) break;
#pragma unroll
            for (int jj = 0; jj < 4; ++jj) { kf[jj] = kn[jj]; vf[jj] = vn[jj]; }
        }
#pragma unroll
        for (int g = 0; g < 4; ++g) { u32x2 w0, w1; w0.x = cvt_pk_bf16(o0[4 * g], o0[4 * g + 1]); w0.y = cvt_pk_bf16(o0[4 * g + 2], o0[4 * g + 3]); w1.x = cvt_pk_bf16(o1[4 * g], o1[4 * g + 1]); w1.y = cvt_pk_bf16(o1[4 * g + 2], o1[4 * g + 3]);
            *(u32x2*)(yp + 8 * g + 4 * hh) = w0; *(u32x2*)(yp + 32 + 8 * g + 4 * hh) = w1; }
    }
}

__device__ __forceinline__ void xattn_mfma(const bf16_t* XQ, const bf16_t* KMl, const bf16_t* VtMl, bf16_t* XO, int w, int NW, int lane) {
    const int c = lane & 31, hh = lane >> 5, pr = pi32(c);
    for (int j = w; j < NBATCH * 4 * 64; j += NW) {
        const int qblk = j & 63, hd = (j >> 6) & 3, b = j >> 8, t0 = qblk * 32;
        const bf16_t* qp = XQ + (size_t)(b * SEQ + t0 + c) * 512 + hd * 128 + 8 * hh;
        bf16x8 qf[8];
#pragma unroll
        for (int jj = 0; jj < 8; ++jj) qf[jj] = ldg8(qp + 16 * jj);
        const bf16_t* kbase = KMl + (size_t)(b * MEMLEN + pr) * 2048 + hd * 128 + 8 * hh;
        const bf16_t* vbase = VtMl + (size_t)(hd * 128 + c) * TM + b * MEMLEN + 16 * hh;
        float mx = -3.0e38f;
        for (int kb = 0; kb < 8; ++kb) { f32x16 s;
#pragma unroll
            for (int i = 0; i < 16; ++i) s[i] = 0.f;
#pragma unroll
            for (int jj = 0; jj < 8; ++jj) s = MFMA32(ldg8(kbase + (size_t)kb * 32 * 2048 + 16 * jj), qf[jj], s);
#pragma unroll
            for (int i = 0; i < 16; ++i) mx = fmaxf(mx, s[i]); }
        mx = fmaxf(mx, __shfl_xor(mx, 32));
        f32x16 o[4];
#pragma unroll
        for (int db = 0; db < 4; ++db)
#pragma unroll
            for (int i = 0; i < 16; ++i) o[db][i] = 0.f;
        float sum = 0.f;
        for (int kb = 0; kb < 8; ++kb) { f32x16 s;
#pragma unroll
            for (int i = 0; i < 16; ++i) s[i] = 0.f;
#pragma unroll
            for (int jj = 0; jj < 8; ++jj) s = MFMA32(ldg8(kbase + (size_t)kb * 32 * 2048 + 16 * jj), qf[jj], s);
            float pv[16];
#pragma unroll
            for (int i = 0; i < 16; ++i) { pv[i] = __builtin_amdgcn_exp2f(s[i] - mx); sum += pv[i]; }
            const bf16x8 p0 = pack8(pv), p1 = pack8(pv + 8);
#pragma unroll
            for (int db = 0; db < 4; ++db) { const bf16_t* vp = vbase + (size_t)db * 32 * TM + kb * 32; o[db] = MFMA32(ldg8(vp), p0, o[db]); o[db] = MFMA32(ldg8(vp + 8), p1, o[db]); } }
        sum += __shfl_xor(sum, 32);
        const float inv = 1.f / sum;
        bf16_t* op = XO + (size_t)(b * SEQ + t0 + c) * 512 + hd * 128 + 4 * hh;
#pragma unroll
        for (int db = 0; db < 4; ++db)
#pragma unroll
            for (int g = 0; g < 4; ++g) { u32x2 w0; w0.x = cvt_pk_bf16(o[db][4 * g] * inv, o[db][4 * g + 1] * inv); w0.y = cvt_pk_bf16(o[db][4 * g + 2] * inv, o[db][4 * g + 3] * inv);
                *(u32x2*)(op + 32 * db + 8 * g) = w0; }
    }
}

__device__ __forceinline__ float wave_incl_scan(float v, int lane) {
#pragma unroll
    for (int d = 1; d < 64; d <<= 1) { const float n = __shfl_up(v, d); if (lane >= d) v += n; }
    return v;
}
__device__ __forceinline__ void conv_unit(const bf16_t* XBC, const float* cw, const float* cb, bf16_t* XT, bf16_t* BR, bf16_t* BT, bf16_t* CR, int u, int lane) {
    const int tb = u / 10, cbk = u - tb * 10, tok0 = tb * 64, ch0 = cbk * 128 + 2 * lane;
    float w[4][2], bs[2];
#pragma unroll
    for (int k = 0; k < 4; ++k) { w[k][0] = cw[k * 1280 + ch0]; w[k][1] = cw[k * 1280 + ch0 + 1]; }
    bs[0] = cb[ch0]; bs[1] = cb[ch0 + 1];
    const bf16_t* src = XBC + (size_t)tok0 * 1280 + ch0;
    float h0[2] = {0.f, 0.f}, h1[2] = {0.f, 0.f}, h2[2] = {0.f, 0.f};
    if ((tok0 & (SEQ - 1)) != 0) { const unsigned a = *(const unsigned*)(src - 3 * 1280), b = *(const unsigned*)(src - 2 * 1280), c = *(const unsigned*)(src - 1280);
        h0[0] = bflo(a); h0[1] = bfhi(a); h1[0] = bflo(b); h1[1] = bfhi(b); h2[0] = bflo(c); h2[1] = bfhi(c); }
    unsigned ylo[32], yhi[32]; float pe0 = 0.f, pe1 = 0.f;
    bf16_t* rdst = (cbk == 8) ? BR : CR;
#pragma unroll
    for (int tt = 0; tt < 64; ++tt) { const unsigned xw = *(const unsigned*)(src + (size_t)tt * 1280); const float x0 = bflo(xw), x1 = bfhi(xw);
        float v0 = bs[0] + w[0][0] * h0[0] + w[1][0] * h1[0] + w[2][0] * h2[0] + w[3][0] * x0, v1 = bs[1] + w[0][1] * h0[1] + w[1][1] * h1[1] + w[2][1] * h2[1] + w[3][1] * x1;
        v0 *= sigmoidf_(v0); v1 *= sigmoidf_(v1);
        h0[0] = h1[0]; h0[1] = h1[1]; h1[0] = h2[0]; h1[1] = h2[1]; h2[0] = x0; h2[1] = x1;
        if (cbk >= 8) *(unsigned*)(rdst + (size_t)(tok0 + tt) * 128 + 2 * lane) = cvt_pk_bf16(v0, v1);
        if (tt & 1) { ylo[tt >> 1] = cvt_pk_bf16(pe0, v0); yhi[tt >> 1] = cvt_pk_bf16(pe1, v1); } else { pe0 = v0; pe1 = v1; } }
    if (cbk <= 8) { bf16_t* tbase = (cbk < 8) ? XT + (size_t)ch0 * T + tok0 : BT + (size_t)(2 * lane) * T + tok0;
#pragma unroll
        for (int q = 0; q < 8; ++q) { u32x4 a, b; a.x = ylo[4 * q]; a.y = ylo[4 * q + 1]; a.z = ylo[4 * q + 2]; a.w = ylo[4 * q + 3]; b.x = yhi[4 * q]; b.y = yhi[4 * q + 1]; b.z = yhi[4 * q + 2]; b.w = yhi[4 * q + 3];
            *(u32x4*)(tbase + 8 * q) = a; *(u32x4*)(tbase + T + 8 * q) = b; } }
}
__device__ __forceinline__ void ssd_scan_unit(const bf16_t* XT, const bf16_t* BT, const float* DTT, bf16_t* PREV, float negA, int b, int h, int pblk, int nblk, LAS float* wl, int lane) {
    const int c32 = lane & 31, hh = lane >> 5, g = h >> 3;
    const bf16_t* xrow = XT + (size_t)(h * 64 + pblk * 32 + c32) * T + b * SEQ + 8 * hh;
    const bf16_t* brow = BT + (size_t)(g * 64 + nblk * 32 + c32) * T + b * SEQ + 8 * hh;
    const float* dtp = DTT + (size_t)h * T + b * SEQ + lane;
    f32x16 st;
#pragma unroll
    for (int i = 0; i < 16; ++i) st[i] = 0.f;
    for (int c = 0; c < 16; ++c) {
        bf16_t* pv = PREV + ((size_t)((b * 16 + c) * 16 + h) * 64 + pblk * 32) * 64 + nblk * 32 + c32;
#pragma unroll
        for (int i = 0; i < 16; ++i) pv[(8 * (i >> 2) + 4 * hh + (i & 3)) * 64] = f2bf(st[i]);
        const float d0 = dtp[c * 128], d1 = dtp[c * 128 + 64];
        const float s0 = wave_incl_scan(d0 * negA, lane); const float tot0 = __shfl(s0, 63);
        const float s1 = wave_incl_scan(d1 * negA, lane) + tot0; const float last = __shfl(s1, 63);
        wl[lane] = d0 * fexp(last - s0); wl[64 + lane] = d1 * fexp(last - s1);
        const float dec = fexp(last);
#pragma unroll
        for (int i = 0; i < 16; ++i) st[i] *= dec;
#pragma unroll
        for (int ks = 0; ks < 8; ++ks) { const u32x4 xw = *(const u32x4*)(xrow + c * 128 + 16 * ks); const bf16x8 bfr = ldg8(brow + c * 128 + 16 * ks);
            const f32x4 wa = *(const LAS f32x4*)(wl + 16 * ks + 8 * hh), wb = *(const LAS f32x4*)(wl + 16 * ks + 8 * hh + 4);
            float xs[8]; xs[0] = bflo(xw.x) * wa.x; xs[1] = bfhi(xw.x) * wa.y; xs[2] = bflo(xw.y) * wa.z; xs[3] = bfhi(xw.y) * wa.w; xs[4] = bflo(xw.z) * wb.x; xs[5] = bfhi(xw.z) * wb.y; xs[6] = bflo(xw.w) * wb.z; xs[7] = bfhi(xw.w) * wb.w;
            st = MFMA32(pack8(xs), bfr, st); }
    }
}
__device__ __forceinline__ void ssd_out_unit(const bf16_t* XT, const bf16_t* BR, const bf16_t* CR, const float* DTT, const bf16_t* PREV, const bf16_t* Zb, bf16_t* Y, float negA, float dsk,
                                             int b, int c, int g, int tq, int wave, int lane, LAS float* tab  , LAS float* red  ) {
    const int c32 = lane & 31, hh = lane >> 5, pr = pi32(c32), h = g * 8 + wave;
    const int tokc = b * SEQ + c * 128;
    const float* dtp = DTT + (size_t)h * T + tokc + lane;
    const float d0 = dtp[0], d1 = dtp[64];
    const float s0 = wave_incl_scan(d0 * negA, lane); const float tot0 = __shfl(s0, 63);
    const float s1 = wave_incl_scan(d1 * negA, lane) + tot0;
    tab[lane] = s0; tab[64 + lane] = s1; tab[128 + lane] = d0; tab[192 + lane] = d1;
    const float acum_t = tab[tq * 32 + c32];
    const size_t tokg = (size_t)(tokc + tq * 32 + c32);
    bf16x8 cf[4];
#pragma unroll
    for (int ks = 0; ks < 4; ++ks) cf[ks] = ldg8(CR + tokg * 128 + g * 64 + 16 * ks + 8 * hh);
    f32x16 y0, y1;
#pragma unroll
    for (int i = 0; i < 16; ++i) { y0[i] = 0.f; y1[i] = 0.f; }
    const bf16_t* xrow = XT + (size_t)(h * 64 + c32) * T + tokc + 16 * hh;
    for (int j = 0; j <= tq; ++j) {
        const bf16_t* brow = BR + (size_t)(tokc + 32 * j + pr) * 128 + g * 64 + 8 * hh;
        f32x16 cbt;
#pragma unroll
        for (int i = 0; i < 16; ++i) cbt[i] = 0.f;
#pragma unroll
        for (int ks = 0; ks < 4; ++ks) cbt = MFMA32(ldg8(brow + 16 * ks), cf[ks], cbt);
        float m[16];
#pragma unroll
        for (int q = 0; q < 4; ++q) { const f32x4 as = *(const LAS f32x4*)(tab + 32 * j + 16 * hh + 4 * q), ds = *(const LAS f32x4*)(tab + 128 + 32 * j + 16 * hh + 4 * q);
#pragma unroll
            for (int e = 0; e < 4; ++e) { const int i = 4 * q + e; float v = cbt[i] * ds[e] * fexp(acum_t - as[e]);
                if (j == tq) { if (16 * hh + i > c32) v = 0.f; if (16 * hh + i == c32) v += dsk; }
                m[i] = v; } }
        const bf16x8 m0 = pack8(m), m1 = pack8(m + 8);
        y0 = MFMA32(ldg8(xrow + 32 * j), m0, y0); y0 = MFMA32(ldg8(xrow + 32 * j + 8), m1, y0);
        y1 = MFMA32(ldg8(xrow + (size_t)32 * T + 32 * j), m0, y1); y1 = MFMA32(ldg8(xrow + (size_t)32 * T + 32 * j + 8), m1, y1);
    }
    { const bf16_t* pv = PREV + ((size_t)((b * 16 + c) * 16 + h) * 64 + c32) * 64 + 8 * hh;
      f32x16 f0, f1;
#pragma unroll
      for (int i = 0; i < 16; ++i) { f0[i] = 0.f; f1[i] = 0.f; }
#pragma unroll
      for (int ks = 0; ks < 4; ++ks) { f0 = MFMA32(ldg8(pv + 16 * ks), cf[ks], f0); f1 = MFMA32(ldg8(pv + 32 * 64 + 16 * ks), cf[ks], f1); }
      const float ea = fexp(acum_t);
#pragma unroll
      for (int i = 0; i < 16; ++i) { y0[i] += f0[i] * ea; y1[i] += f1[i] * ea; } }
    const bf16_t* zp = Zb + tokg * 1024 + h * 64 + 4 * hh; float ss = 0.f;
#pragma unroll
    for (int gq = 0; gq < 4; ++gq) { const u32x2 za = *(const u32x2*)(zp + 8 * gq), zb2 = *(const u32x2*)(zp + 32 + 8 * gq);
        const float z0[4] = {bflo(za.x), bfhi(za.x), bflo(za.y), bfhi(za.y)}, z1[4] = {bflo(zb2.x), bfhi(zb2.x), bflo(zb2.y), bfhi(zb2.y)};
#pragma unroll
        for (int e = 0; e < 4; ++e) { const int i = 4 * gq + e; y0[i] *= z0[e] * sigmoidf_(z0[e]); y1[i] *= z1[e] * sigmoidf_(z1[e]); ss += y0[i] * y0[i] + y1[i] * y1[i]; } }
    ss += __shfl_xor(ss, 32);
    if (hh == 0) red[wave * 32 + c32] = ss;
    __syncthreads();
    float tot = 0.f;
#pragma unroll
    for (int w8 = 0; w8 < 8; ++w8) tot += red[w8 * 32 + c32];
    const float rstd = __builtin_amdgcn_rsqf(tot * (1.f / 512.f) + EPS);
    bf16_t* yp = Y + tokg * 1024 + h * 64 + 4 * hh;
#pragma unroll
    for (int gq = 0; gq < 4; ++gq) { u32x2 o0, o1; o0.x = cvt_pk_bf16(y0[4 * gq] * rstd, y0[4 * gq + 1] * rstd); o0.y = cvt_pk_bf16(y0[4 * gq + 2] * rstd, y0[4 * gq + 3] * rstd);
        o1.x = cvt_pk_bf16(y1[4 * gq] * rstd, y1[4 * gq + 1] * rstd); o1.y = cvt_pk_bf16(y1[4 * gq + 2] * rstd, y1[4 * gq + 3] * rstd);
        *(u32x2*)(yp + 8 * gq) = o0; *(u32x2*)(yp + 32 + 8 * gq) = o1; }
}

#define PHASE_ENTER() unsigned char* ws = p.ws; asm volatile("" : "+s"(ws)); int tid_ = wave0 * 64 + lane_id_opaque(); int bid_ = blockIdx.x; asm volatile("" : "+s"(bid_)); \
    const int tid = tid_, lane = tid & 63, wave = __builtin_amdgcn_readfirstlane(tid >> 6); \
    const int G = gridDim.x, bid = bid_, gw = bid * 8 + wave, NGW = G * 8; (void)lane; (void)gw; (void)NGW; (void)wave; (void)bid; (void)G
#define WSP(type, off) ((type*)(ws + (off)))
__global__ void __launch_bounds__(512, 2) mk_fwd(Params p) {
    extern __shared__ __attribute__((aligned(16))) unsigned char lds_raw[];
    LAS unsigned char* lds = (LAS unsigned char*)lds_raw;
    volatile LAS unsigned* ldsctl = (volatile LAS unsigned*)(lds + LDSCTL_OFF);
    if (threadIdx.x < 64) ldsctl[threadIdx.x] = 0u;
    int wave0 = __builtin_amdgcn_readfirstlane((int)threadIdx.x >> 6); asm volatile("" : "+s"(wave0));
    __syncthreads();
    const int ph_lo = p.ph_lo, ph_hi = p.ph_hi;
    const bool use_bar = (ph_hi - ph_lo) > 1 || (p.l_hi - p.l_lo) > 1;
    XcdBarrier bar; bar.bar = (unsigned*)(p.ws + WS_CTL) + CW_BAR; bar.x = 0; bar.st = nullptr;
    if (use_bar) bar = xcd_barrier_post((unsigned*)(p.ws + WS_CTL) + CW_BAR, ldsctl + 8);
#define PH(k) (ph_lo <= (k) && (k) < ph_hi)
#define GRID_BAR() do { if (use_bar) xcd_barrier(bar, wave0 == 0 && lane_id_opaque() == 0); } while (0)

    if (p.l_lo == 0 && PH(0)) {
        PHASE_ENTER();
        LAS float* scr = (LAS float*)(lds + wave * 16384);
        int base = 0;
        for (int jb = 0; jb < 4 * 11 + 2 * 3; ++jb) {
            TrJob j;
            if (jb < 44) { const int l = jb / 11, k = jb % 11; unsigned char* wl = ws + WS_W + (size_t)l * W_LAYER;
                switch (k) {
                case 0: j = TrJob{p.in[I_W_IN] + (size_t)l * D * INW, INW, D, 0, 2304, p.in[I_NORM_MIX] + l * D, (bf16_t*)(wl + W_IN), 0, 128}; break;
                case 1: j = TrJob{p.in[I_W_IN] + (size_t)l * D * INW, INW, D, 2320, 1024, p.in[I_NORM_MIX] + l * D, (bf16_t*)(wl + W_IN), 2304, 128}; break;
                case 9: j = TrJob{p.in[I_W_IN] + (size_t)l * D * INW, INW, D, 3344, 512, p.in[I_NORM_MIX] + l * D, (bf16_t*)(wl + W_IN), 5376, 128}; break;
                case 10: j = TrJob{p.in[I_W_IN] + (size_t)l * D * INW, INW, D, 3856, 2048, p.in[I_NORM_MIX] + l * D, (bf16_t*)(wl + W_IN), 3328, 128}; break;
                case 2: j = TrJob{p.in[I_W_SSD_O] + (size_t)l * D * D, D, D, 0, D, p.in[I_SSD_NORM] + l * D, (bf16_t*)(wl + W_SSDO), 0, 128}; break;
                case 3: j = TrJob{p.in[I_W_SB_O] + (size_t)l * 512 * D, D, 512, 0, D, nullptr, (bf16_t*)(wl + W_SBO), 0, 128}; break;
                case 4: j = TrJob{p.in[I_W_OUT] + (size_t)l * D * D, D, D, 0, D, nullptr, (bf16_t*)(wl + W_OUT), 0, 128}; break;
                case 5: j = TrJob{p.in[I_XA_WQ] + (size_t)l * D * 512, 512, D, 0, 512, p.in[I_NORM_XA] + l * D, (bf16_t*)(wl + W_Q), 0, 128}; break;
                case 6: j = TrJob{p.in[I_XA_WK] + (size_t)l * D * 512, 512, D, 0, 512, p.in[I_NORM_MEM] + l * D, (bf16_t*)(ws + WS_WKV), l * 512, 128}; break;
                case 7: j = TrJob{p.in[I_XA_WV] + (size_t)l * D * 512, 512, D, 0, 512, p.in[I_NORM_MEM] + l * D, (bf16_t*)(ws + WS_WKV), 2048 + l * 512, 128}; break;
                case 8: j = TrJob{p.in[I_XA_WO] + (size_t)l * 512 * D, D, 512, 0, D, nullptr, (bf16_t*)(wl + W_O), 0, 128}; break;
                }
            } else { const int jj = (jb - 44) / 3, k = (jb - 44) % 3; unsigned char* wf = ws + WS_WFF + (size_t)jj * W_FF; const float* gn = p.in[I_NORM_FFN] + (2 * jj) * D;
                if (k == 0) j = TrJob{p.in[I_FFN_G] + (size_t)jj * D * DFF, DFF, D, 0, DFF, gn, (bf16_t*)(wf + W_GU), 0, 256};
                else if (k == 1) j = TrJob{p.in[I_FFN_U] + (size_t)jj * D * DFF, DFF, D, 0, DFF, gn, (bf16_t*)(wf + W_GU), 128, 256};
                else j = TrJob{p.in[I_FFN_D] + (size_t)jj * DFF * D, D, DFF, 0, D, nullptr, (bf16_t*)(wf + W_DN), 0, 128};
            }
            run_job(j, base, gw, NGW, scr, lane);
        }
        float dummy[1]; bf16_t* MEMB = WSP(bf16_t, WS_MEMB); float* RSMEM = WSP(float, WS_RSMEM);
        for (int m = gw; m < TM; m += NGW) { const float r = rowpass_row<0>(p.in[I_MEM] + (size_t)m * D, MEMB + (size_t)m * D, lane, nullptr, dummy); if (lane == 0) RSMEM[m] = r; }
        GRID_BAR();
    }
    if (p.l_lo == 0 && PH(1)) {
        PHASE_ENTER();
        { pg8::Gemm g{WSP(bf16_t, WS_MEMB), WSP(bf16_t, WS_WKV), D, D, D}; pg8::StaticOrder S; S.init(TM, 2048, G, bid);
          pg8::EpiBf16Rs E{WSP(bf16_t, WS_KM), 2048, WSP(float, WS_RSMEM), 1.f};
          pg8::gemm_phase<pg8::EpiBf16Rs, pg8::StaticOrder, true, true>(lds, g, S, E, wave0); }
        { pg8::Gemm g{WSP(bf16_t, WS_WKV) + (size_t)2048 * 1024, WSP(bf16_t, WS_MEMB), D, D, D}; pg8::StaticOrder S; S.init(2048, TM, G, (bid + G / 2) % G);
          pg8::EpiBf16Cs E{WSP(bf16_t, WS_VTM), TM, WSP(float, WS_RSMEM), 1.f};
          pg8::gemm_phase<pg8::EpiBf16Cs, pg8::StaticOrder, true, true>(lds, g, S, E, wave0); }
        GRID_BAR();
    }

    for (int l = p.l_lo; l < p.l_hi; ++l) {
        const bool moe = (l & 1) != 0; const int jf = l >> 1;

        if (PH(2)) for (int rep = 0; rep < NREP(2); ++rep) {
            PHASE_ENTER();
            const float* Hin = (l == 0) ? p.in[I_X] : p.out; bf16_t* HB = WSP(bf16_t, WS_HB); float* RS = WSP(float, WS_RS); float* DT = WSP(float, WS_DT);
            LAS float* wsm = (LAS float*)lds;
            for (int i = tid; i < 16 * 1024; i += 512) { const int e = i >> 10, k = i & 1023; wsm[i] = p.in[I_W_IN][(size_t)l * D * INW + (size_t)k * INW + 2304 + e] * p.in[I_NORM_MIX][l * D + k]; }
            __syncthreads();
            for (int m = gw; m < T; m += NGW) { float ex[16];
                const float r = rowpass_row<16>(Hin + (size_t)m * D, HB + (size_t)m * D, lane, wsm, ex);
                if (lane == 0) RS[m] = r;
                float mine = 0.f;
#pragma unroll
                for (int e = 0; e < 16; ++e) mine = (lane == e) ? ex[e] : mine;
                if (lane < 16) { const float xv = mine + p.in[I_DT_BIAS][l * 16 + lane]; DT[(size_t)lane * T + m] = softplusf_(xv); }
            }
            __syncthreads();
            if (moe) {
                LAS float* scr = (LAS float*)(lds + 65536 + wave * 8704);
                int base = 0; const float* gn = p.in[I_NORM_FFN] + l * D;
                for (int jb = 0; jb < NEXP * 3; ++jb) { const int e = jb / 3, k = jb % 3; TrJob j; const size_t eo = ((size_t)jf * NEXP + e) * D * DFF;
                    if (k == 0) j = TrJob{p.in[I_MOE_G] + eo, DFF, D, 0, DFF, gn, (bf16_t*)(ws + WS_WMOE + WM_GU) + (size_t)e * 2 * DFF * 1024, 0, 256};
                    else if (k == 1) j = TrJob{p.in[I_MOE_U] + eo, DFF, D, 0, DFF, gn, (bf16_t*)(ws + WS_WMOE + WM_GU) + (size_t)e * 2 * DFF * 1024, 128, 256};
                    else j = TrJob{p.in[I_MOE_D] + eo, D, DFF, 0, D, nullptr, (bf16_t*)(ws + WS_WMOE + WM_DN) + (size_t)e * 1024 * DFF, 0, 128};
                    run_job(j, base, gw, NGW, scr, lane); }
            }
            GRID_BAR();
        }
        if (PH(3)) for (int rep = 0; rep < NREP(3); ++rep) {
            PHASE_ENTER();
            { pg8::Gemm g{WSP(bf16_t, WS_HB), (const bf16_t*)(ws + WS_W + (size_t)l * W_LAYER + W_IN), D, D, D}; pg8::StaticOrder S; S.init(T, NPROJ - 512, G, bid);
              pg8::EpiInProj E{ws + WS_X, WSP(float, WS_RS)};
              pg8::gemm_phase<pg8::EpiInProj, pg8::StaticOrder, true, true>(lds, g, S, E, wave0); }
            { pg8::Gemm g{(const bf16_t*)(ws + WS_W + (size_t)l * W_LAYER + W_IN) + (size_t)(NPROJ - 512) * 1024, WSP(bf16_t, WS_HB), D, D, D}; pg8::StaticOrder S; S.init(512, T, G, bid);
              pg8::EpiBf16Cs E{WSP(bf16_t, WS_X + X_V), T, WSP(float, WS_RS), 1.f};
              pg8::gemm_phase<pg8::EpiBf16Cs, pg8::StaticOrder, true, true>(lds, g, S, E, wave0); }
            GRID_BAR();
        }
        if (PH(4)) for (int rep = 0; rep < NREP(4); ++rep) {
            PHASE_ENTER();
            const float* cw = p.in[I_CONV_W] + (size_t)l * 4 * 1280; const float* cb = p.in[I_CONV_B] + (size_t)l * 1280;
            for (int u = gw; u < (T / 64) * 10; u += NGW) conv_unit(WSP(bf16_t, WS_X + X_XBC), cw, cb, WSP(bf16_t, WS_X + X_XT), WSP(bf16_t, WS_X + X_BR), WSP(bf16_t, WS_X + X_BT), WSP(bf16_t, WS_X + X_CR), u, lane);
            GRID_BAR();
        }
        if (PH(5)) for (int rep = 0; rep < NREP(5); ++rep) {
            PHASE_ENTER();
            if (gw < NBATCH * 16 * 4) { const int b = gw >> 6, h = (gw >> 2) & 15, pblk = (gw >> 1) & 1, nblk = gw & 1;
                ssd_scan_unit(WSP(bf16_t, WS_X + X_XT), WSP(bf16_t, WS_X + X_BT), WSP(float, WS_DT), WSP(bf16_t, WS_X + X_PREV), -fexp(p.in[I_A_LOG][l * 16 + h]), b, h, pblk, nblk, (LAS float*)(lds + wave * 1024), lane); }
            sb_attn_mfma(WSP(bf16_t, WS_X + X_Q), WSP(bf16_t, WS_X + X_K), WSP(bf16_t, WS_X + X_V), (rep + 1 < NREP(5)) ? WSP(bf16_t, WS_X + X_XBC) : WSP(bf16_t, WS_X + X_Q), gw, NGW, lane);
            GRID_BAR();
        }
        if (PH(6)) for (int rep = 0; rep < NREP(6); ++rep) {
            PHASE_ENTER();
            int par = 0;
            for (int u = bid; u < 2048; u += G) { const int tq = (u >> 8) & 3, r = (u & 255) | ((u >> 10) << 8), b = r >> 5, c = (r >> 1) & 15, g = r & 1; const int h = g * 8 + wave;
                ssd_out_unit(WSP(bf16_t, WS_X + X_XT), WSP(bf16_t, WS_X + X_BR), WSP(bf16_t, WS_X + X_CR), WSP(float, WS_DT), WSP(bf16_t, WS_X + X_PREV), WSP(bf16_t, WS_X + X_Z), WSP(bf16_t, WS_X + X_XBC),
                             -fexp(p.in[I_A_LOG][l * 16 + h]), p.in[I_D_SKIP][l * 16 + h], b, c, g, tq, wave, lane, (LAS float*)(lds + wave * 1024), (LAS float*)(lds + 8192 + par * 1024));
                par ^= 1; }
            GRID_BAR();
        }
        if (PH(7)) for (int rep = 0; rep < NREP(7); ++rep) {
            PHASE_ENTER();
            pg8::Gemm g{WSP(bf16_t, WS_X + X_XBC), (const bf16_t*)(ws + WS_W + (size_t)l * W_LAYER + W_SSDO), D, D, D}; pg8::StaticOrder S; S.init(T, D, G, bid);
            pg8::EpiGate<false> E{WSP(bf16_t, WS_X + X_Z), WSP(bf16_t, WS_X + X_GS), 0, WSP(bf16_t, WS_X + X_Z)};
            pg8::gemm_phase<pg8::EpiGate<false>, pg8::StaticOrder, true, true>(lds, g, S, E, wave0);
            GRID_BAR();
        }
        if (PH(8)) for (int rep = 0; rep < NREP(8); ++rep) {
            PHASE_ENTER();
            pg8::Gemm g{WSP(bf16_t, WS_X + X_Q), (const bf16_t*)(ws + WS_W + (size_t)l * W_LAYER + W_SBO), 512, 512, 512}; pg8::StaticOrder S; S.init(T, D, G, bid);
            pg8::EpiGate<true> E{(rep + 1 < NREP(8)) ? WSP(bf16_t, WS_X + X_XT) : WSP(bf16_t, WS_X + X_Z), WSP(bf16_t, WS_X + X_GS), 1024, WSP(bf16_t, WS_X + X_Z)};
            pg8::gemm_phase<pg8::EpiGate<true>, pg8::StaticOrder, true, true>(lds, g, S, E, wave0);
            GRID_BAR();
        }
        if (PH(9)) for (int rep = 0; rep < NREP(9); ++rep) {
            PHASE_ENTER();
            pg8::Gemm g{WSP(bf16_t, WS_X + X_Z), (const bf16_t*)(ws + WS_W + (size_t)l * W_LAYER + W_OUT), D, D, D}; pg8::StaticOrder S; S.init(T, D, G, bid);
            pg8::EpiResid E{(l == 0) ? p.in[I_X] : p.out, (rep + 1 < NREP(9)) ? WSP(float, WS_X + X_GS) : p.out};
            pg8::gemm_phase<pg8::EpiResid, pg8::StaticOrder, true, true>(lds, g, S, E, wave0);
            GRID_BAR();
        }
        if (PH(10)) for (int rep = 0; rep < NREP(10); ++rep) {
            PHASE_ENTER();
            float dummy[1]; bf16_t* HB = WSP(bf16_t, WS_HB); float* RS = WSP(float, WS_RS); const float* H = p.out;
            for (int m = gw; m < T; m += NGW) { const float r = rowpass_row<0>(H + (size_t)m * D, HB + (size_t)m * D, lane, nullptr, dummy); if (lane == 0) RS[m] = r; }
            GRID_BAR();
        }
        if (PH(11)) for (int rep = 0; rep < NREP(11); ++rep) {
            PHASE_ENTER();
            pg8::Gemm g{WSP(bf16_t, WS_HB), (const bf16_t*)(ws + WS_W + (size_t)l * W_LAYER + W_Q), D, D, D}; pg8::StaticOrder S; S.init(T, 512, G, bid);
            pg8::EpiBf16Rs E{WSP(bf16_t, WS_X + X_K), 512, WSP(float, WS_RS), 0.12751743082459868f};
            pg8::gemm_phase<pg8::EpiBf16Rs, pg8::StaticOrder, true, true>(lds, g, S, E, wave0);
            GRID_BAR();
        }
        if (PH(12)) for (int rep = 0; rep < NREP(12); ++rep) {
            PHASE_ENTER();
            xattn_mfma(WSP(bf16_t, WS_X + X_K), WSP(bf16_t, WS_KM) + l * 512, WSP(bf16_t, WS_VTM) + (size_t)l * 512 * TM, WSP(bf16_t, WS_X + X_V), gw, NGW, lane);
            GRID_BAR();
        }
        if (PH(13)) for (int rep = 0; rep < NREP(13); ++rep) {
            PHASE_ENTER();
            pg8::Gemm g{WSP(bf16_t, WS_X + X_V), (const bf16_t*)(ws + WS_W + (size_t)l * W_LAYER + W_O), 512, 512, 512}; pg8::StaticOrder S; S.init(T, D, G, bid);
            pg8::EpiResid E{p.out, (rep + 1 < NREP(13)) ? WSP(float, WS_X + X_GS) : p.out};
            pg8::gemm_phase<pg8::EpiResid, pg8::StaticOrder, true, true>(lds, g, S, E, wave0);
            GRID_BAR();
        }
        if (PH(14)) for (int rep = 0; rep < NREP(14); ++rep) {
            PHASE_ENTER();
            bf16_t* HB = WSP(bf16_t, WS_HB); float* RS = WSP(float, WS_RS); const float* H = p.out;
            if (!moe || rep + 1 < NREP(14)) { float dummy[1];
                for (int m = gw; m < T; m += NGW) { const float r = rowpass_row<0>(H + (size_t)m * D, HB + (size_t)m * D, lane, nullptr, dummy); if (lane == 0) RS[m] = r; }
            } else {
                int* TE = WSP(int, WS_MOE + MO_TE); float* TW = WSP(float, WS_MOE + MO_TW); int* TP = WSP(int, WS_MOE + MO_TP); unsigned* CNT = WSP(unsigned, WS_CTL) + CW_CNT + jf * 16;
                LAS float* wsm = (LAS float*)lds;
                for (int i = tid; i < 8 * 1024; i += 512) { const int e = i >> 10, k = i & 1023; wsm[i] = p.in[I_MOE_R][(size_t)jf * D * NEXP + (size_t)k * NEXP + e] * p.in[I_NORM_FFN][l * D + k]; }
                __syncthreads();
                for (int m = gw; m < T; m += NGW) { float lg[8];
                    const float r = rowpass_row<8>(H + (size_t)m * D, HB + (size_t)m * D, lane, wsm, lg);
                    if (lane == 0) { RS[m] = r;
                        int i0 = 0; float v0 = lg[0];
#pragma unroll
                        for (int e = 1; e < 8; ++e) if (lg[e] > v0) { v0 = lg[e]; i0 = e; }
                        int i1 = -1; float v1 = -3.0e38f;
#pragma unroll
                        for (int e = 0; e < 8; ++e) if (e != i0 && lg[e] > v1) { v1 = lg[e]; i1 = e; }
                        const float w0 = __builtin_amdgcn_rcpf(1.f + fexp(v1 - v0));
                        const unsigned p0 = atomicAdd(CNT + i0, 1u), p1 = atomicAdd(CNT + 8 + i1, 1u);
                        TE[m] = i0; TE[T + m] = i1; TW[m] = w0; TW[T + m] = 1.f - w0; TP[m] = (int)p0; TP[T + m] = (int)p1; }
                }
            }
            GRID_BAR();
        }
        if (!moe) {
            if (PH(15)) for (int rep = 0; rep < NREP(15); ++rep) {
                PHASE_ENTER();
                pg8::Gemm g{WSP(bf16_t, WS_HB), (const bf16_t*)(ws + WS_WFF + (size_t)jf * W_FF + W_GU), D, D, D}; pg8::StaticOrder S; S.init(T, 2 * DFF, G, bid);
                pg8::EpiSwiglu E{WSP(bf16_t, WS_X + X_ACT), WSP(float, WS_RS)};
                pg8::gemm_phase<pg8::EpiSwiglu, pg8::StaticOrder, true, true>(lds, g, S, E, wave0);
                GRID_BAR();
            }
            if (PH(16)) for (int rep = 0; rep < NREP(16); ++rep) {
                PHASE_ENTER();
                pg8::Gemm g{WSP(bf16_t, WS_X + X_ACT), (const bf16_t*)(ws + WS_WFF + (size_t)jf * W_FF + W_DN), DFF, DFF, DFF}; pg8::StaticOrder S; S.init(T, D, G, bid);
                pg8::EpiResid E{p.out, (rep + 1 < NREP(16)) ? WSP(float, WS_X + X_GS) : p.out};
                pg8::gemm_phase<pg8::EpiResid, pg8::StaticOrder, true, true>(lds, g, S, E, wave0);
                GRID_BAR();
            }
        } else {
            if (PH(15)) for (int rep = 0; rep < NREP(15); ++rep) {
                PHASE_ENTER();
                const bf16_t* HB = WSP(bf16_t, WS_HB); const float* RS = WSP(float, WS_RS); bf16_t* XG = WSP(bf16_t, WS_X + X_XG);
                const int* TE = WSP(int, WS_MOE + MO_TE); const float* TW = WSP(float, WS_MOE + MO_TW); const int* TP = WSP(int, WS_MOE + MO_TP); unsigned* CNT = WSP(unsigned, WS_CTL) + CW_CNT + jf * 16;
                int* ROWL = WSP(int, WS_MOE + MO_ROWL); float* WROW = WSP(float, WS_MOE + MO_WROW); float* RSG = WSP(float, WS_MOE + MO_RSG);
                unsigned* PEXP = WSP(unsigned, WS_MOE + MO_PEXP); unsigned* NPAN = WSP(unsigned, WS_MOE + MO_NPAN);
#pragma unroll
                for (int s = 0; s < 2; ++s) {
                    int off[9]; { int a = 0;
#pragma unroll
                        for (int e = 0; e < 8; ++e) { off[e] = a; a += ((int)__builtin_amdgcn_readfirstlane(ld_u32_agent(CNT + s * 8 + e)) + 255) & ~255; }
                        off[8] = a; }
                    if (bid == 0 && tid == 0) { NPAN[s] = (unsigned)(off[8] >> 8);
#pragma unroll
                        for (int e = 0; e < 8; ++e) for (int pnl = off[e] >> 8; pnl < (off[e + 1] >> 8); ++pnl) PEXP[s * 256 + pnl] = (unsigned)e; }
                    for (int m = gw; m < T; m += NGW) { const int e = TE[s * T + m]; int o = 0;
#pragma unroll
                        for (int k = 0; k < 8; ++k) o = (e == k) ? off[k] : o;
                        const int row = o + TP[s * T + m];
                        const u32x4* src = (const u32x4*)(HB + (size_t)m * D); u32x4* dst = (u32x4*)(XG + ((size_t)s * MOE_ROWS + row) * D);
                        dst[lane] = src[lane]; dst[lane + 64] = src[lane + 64];
                        if (lane == 0) { ROWL[s * MOE_ROWS + row] = m; WROW[s * MOE_ROWS + row] = TW[s * T + m]; RSG[s * MOE_ROWS + row] = RS[m]; } }
#pragma unroll
                    for (int e = 0; e < 8; ++e) { const int c = (int)__builtin_amdgcn_readfirstlane(ld_u32_agent(CNT + s * 8 + e)); const int lo = off[e] + c, hi = off[e + 1];
                        for (int row = lo + gw; row < hi; row += NGW) { u32x4* dst = (u32x4*)(XG + ((size_t)s * MOE_ROWS + row) * D); const u32x4 zz = {0u, 0u, 0u, 0u}; dst[lane] = zz; dst[lane + 64] = zz;
                            if (lane == 0) { ROWL[s * MOE_ROWS + row] = -1; WROW[s * MOE_ROWS + row] = 0.f; RSG[s * MOE_ROWS + row] = 0.f; } } }
                }
                GRID_BAR();
            }
#pragma unroll
            for (int s = 0; s < 2; ++s) {
                if (PH(16 + 2 * s)) for (int rep = 0; rep < NREP(16 + 2 * s); ++rep) {
                    PHASE_ENTER();
                    const int npan = (int)__builtin_amdgcn_readfirstlane(ld_u32_agent(WSP(unsigned, WS_MOE + MO_NPAN) + s));
                    pg8::Gemm g{WSP(bf16_t, WS_X + X_XG) + (size_t)s * MOE_ROWS * D, WSP(bf16_t, WS_WMOE + WM_GU), D, D, D}; pg8::MoeOrder S; S.init(npan, 2 * DFF / 256, G, bid, WSP(unsigned, WS_MOE + MO_PEXP) + s * 256);
                    pg8::EpiSwiglu E{WSP(bf16_t, WS_X + X_ACT), WSP(float, WS_MOE + MO_RSG) + s * MOE_ROWS};
                    pg8::gemm_phase<pg8::EpiSwiglu, pg8::MoeOrder, true, true>(lds, g, S, E, wave0);
                    GRID_BAR();
                }
                if (PH(17 + 2 * s)) for (int rep = 0; rep < NREP(17 + 2 * s); ++rep) {
                    PHASE_ENTER();
                    const int npan = (int)__builtin_amdgcn_readfirstlane(ld_u32_agent(WSP(unsigned, WS_MOE + MO_NPAN) + s));
                    pg8::Gemm g{WSP(bf16_t, WS_X + X_ACT), WSP(bf16_t, WS_WMOE + WM_DN), DFF, DFF, DFF}; pg8::MoeOrder S; S.init(npan, D / 256, G, bid, WSP(unsigned, WS_MOE + MO_PEXP) + s * 256);
                    pg8::EpiMoeDown E{p.out, WSP(int, WS_MOE + MO_ROWL) + s * MOE_ROWS, WSP(float, WS_MOE + MO_WROW) + s * MOE_ROWS, (rep + 1 < NREP(17 + 2 * s)) ? WSP(float, WS_X + X_GS) : p.out};
                    pg8::gemm_phase<pg8::EpiMoeDown, pg8::MoeOrder, true, true>(lds, g, S, E, wave0);
                    GRID_BAR();
                }
            }
        }
    }
    if (p.l_hi == DEPTH && PH(20)) {
        PHASE_ENTER();
        const float* gf = p.in[I_FINAL]; float* H = p.out;
        for (int m = gw; m < T; m += NGW) { f32x4* xr = (f32x4*)(H + (size_t)m * D) + lane; f32x4 v[4]; float s = 0.f;
#pragma unroll
            for (int j = 0; j < 4; ++j) { v[j] = xr[64 * j]; s += (v[j].x * v[j].x + v[j].y * v[j].y) + (v[j].z * v[j].z + v[j].w * v[j].w); }
            const float rstd = __builtin_amdgcn_rsqf(wave_sum(s) * (1.f / D) + EPS);
#pragma unroll
            for (int j = 0; j < 4; ++j) { const f32x4 g4 = *((const f32x4*)gf + lane + 64 * j); xr[64 * j] = v[j] * rstd * g4; } }
    }
#undef PH
#undef GRID_BAR
}

extern "C" void kernel_launch(void* const* d_in, const int* in_sizes, int n_in, void* d_out, int out_size, void* d_ws, size_t ws_size, hipStream_t stream) {
    static int grid = 0;
    if (grid == 0) {
        if (n_in != 28 || out_size != T * D || ws_size < WS_END) { fprintf(stderr, "kernel_launch: unexpected problem (n_in %d, out %d, ws %zu < %zu)\n", n_in, out_size, ws_size, (size_t)WS_END); grid = -1; return; }
        int dev = 0, cus = 0;
        if (hipGetDevice(&dev) != hipSuccess || hipDeviceGetAttribute(&cus, hipDeviceAttributeMultiprocessorCount, dev) != hipSuccess) { grid = -1; return; }
        if (hipFuncSetAttribute((const void*)mk_fwd, hipFuncAttributeMaxDynamicSharedMemorySize, LDS_BYTES) != hipSuccess) { fprintf(stderr, "kernel_launch: hipFuncSetAttribute failed\n"); grid = -1; return; }
        int per_cu = 0;
        if (hipOccupancyMaxActiveBlocksPerMultiprocessor(&per_cu, (const void*)mk_fwd, 512, LDS_BYTES) != hipSuccess || per_cu < 1) { fprintf(stderr, "kernel_launch: occupancy query says %d\n", per_cu); (void)hipGetLastError(); }
        grid = cus;
    }
    if (grid < 0) return;
    (void)hipMemsetAsync((char*)d_ws + WS_CTL, 0, 1 * MiB, stream);
    Params p{};
    for (int i = 0; i < 28; ++i) p.in[i] = (const float*)d_in[i];
    p.out = (float*)d_out; p.ws = (unsigned char*)d_ws;
#if MK_ONE_LAUNCH
    p.l_lo = 0; p.l_hi = DEPTH; p.ph_lo = 0; p.ph_hi = 21;
    hipLaunchKernelGGL(mk_fwd, dim3(grid), dim3(512), LDS_BYTES, stream, p);
#else
    auto launch = [&](int l, int ph) { p.l_lo = l; p.l_hi = l + 1; p.ph_lo = ph; p.ph_hi = ph + 1; hipLaunchKernelGGL(mk_fwd, dim3(grid), dim3(512), LDS_BYTES, stream, p); };
    launch(0, 0); launch(0, 1);
    for (int l = 0; l < DEPTH; ++l) { const int last = (l & 1) ? 19 : 16; for (int ph = 2; ph <= last; ++ph) launch(l, ph); }
    launch(DEPTH - 1, 20);
#endif
}
```

```cpp
#include <hip/hip_runtime.h>
#include <cstdio>
#include <cstdint>

#define LAS __attribute__((address_space(3)))
#define GAS __attribute__((address_space(1)))
typedef unsigned short bf16_t;
typedef short bf16x8 __attribute__((ext_vector_type(8)));
typedef float f32x4 __attribute__((ext_vector_type(4)));
typedef float f32x2 __attribute__((ext_vector_type(2)));
typedef unsigned u32x4 __attribute__((ext_vector_type(4)));
typedef unsigned u32x2 __attribute__((ext_vector_type(2)));

#ifndef PROBE_MASK
#define PROBE_MASK 0u
#endif
#define NREP(k) ((int)((PROBE_MASK >> (k)) & 1u) + 1)
#ifndef MK_ONE_LAUNCH
#define MK_ONE_LAUNCH 1
#endif

constexpr int T = 32768, D = 1024, SEQ = 2048, NBATCH = 16, DEPTH = 4, MEMLEN = 256, TM = NBATCH * MEMLEN;
constexpr int INW = 5904, NPROJ = 6144, NMAIN = 5632, DFF = 2816, NEXP = 8;
constexpr int MOE_ROWS = T + NEXP * 256;
constexpr int MOE_PAN = MOE_ROWS / 256;
constexpr float EPS = 1e-6f;

constexpr size_t MiB = 1u << 20;
constexpr size_t WS_CTL = 0;
constexpr size_t WS_RS = 1 * MiB;
constexpr size_t WS_RSMEM = WS_RS + 256 * 1024;
constexpr size_t WS_DT = 2 * MiB;
constexpr size_t WS_MOE = 4 * MiB;
constexpr size_t WS_SSQ_OLD_UNUSED = 6 * MiB;
constexpr size_t SSQ_BYTES = (size_t)T * 16;
constexpr size_t WS_KM = 8 * MiB;
constexpr size_t WS_VTM = 24 * MiB;
constexpr size_t WS_MEMB = 40 * MiB;
constexpr size_t WS_HB = 48 * MiB;
constexpr size_t WS_W = 112 * MiB;
constexpr size_t W_IN = 0, W_SSDO = W_IN + (size_t)NPROJ * 1024 * 2, W_SBO = W_SSDO + 2 * MiB, W_OUT = W_SBO + 1 * MiB, W_Q = W_OUT + 2 * MiB, W_O = W_Q + 1 * MiB, W_LAYER = W_O + 1 * MiB;
constexpr size_t WS_WKV = WS_W + 4 * W_LAYER;
constexpr size_t WS_WFF = WS_WKV + 8 * MiB;
constexpr size_t W_GU = 0, W_DN = (size_t)2 * DFF * 1024 * 2, W_FF = W_DN + (size_t)1024 * DFF * 2;
constexpr size_t WS_WMOE = WS_WFF + 2 * W_FF;
constexpr size_t WM_GU = 0, WM_DN = (size_t)NEXP * 2 * DFF * 1024 * 2;
constexpr size_t WS_X = WS_WMOE + NEXP * W_FF;
constexpr size_t X_Z = 0, X_XBC = X_Z + 64 * MiB, X_XT = X_XBC + 80 * MiB, X_BR = X_XT + 64 * MiB, X_BT = X_BR + 8 * MiB, X_CR = X_BT + 8 * MiB, X_Q = X_CR + 8 * MiB, X_K = X_Q + 32 * MiB, X_V = X_K + 32 * MiB,
                 X_GS = X_V + 32 * MiB, X_PREV = X_GS + 128 * MiB, X_END = X_PREV + 32 * MiB;
constexpr size_t X_ACT = 0;
constexpr size_t X_XG = 192 * MiB;
constexpr size_t WS_SSQ = WS_X + X_END;
constexpr size_t WS_END = WS_SSQ + 8 * MiB;
static_assert(X_XG + (size_t)2 * MOE_ROWS * 1024 * 2 <= X_END, "moe region");
static_assert((size_t)MOE_ROWS * DFF * 2 <= X_XG, "act region");
constexpr size_t MO_TE = 0, MO_TW = MO_TE + 2 * T * 4, MO_TP = MO_TW + 2 * T * 4, MO_ROWL = MO_TP + 2 * T * 4, MO_WROW = MO_ROWL + 2 * MOE_ROWS * 4, MO_RSG = MO_WROW + 2 * MOE_ROWS * 4,
                 MO_PEXP = MO_RSG + 2 * MOE_ROWS * 4, MO_NPAN = MO_PEXP + 2 * 256 * 4, MO_END = MO_NPAN + 256;
static_assert(MO_END <= 2 * MiB, "moe tables");
constexpr int CW_BAR = 4096;
constexpr int CW_CNT = 16384;

constexpr int RING_BYTES = 155648;
constexpr int LDSCTL_OFF = RING_BYTES;
constexpr int LDS_BYTES = 160 * 1024;

__device__ __forceinline__ float bf2f(unsigned b) { return __builtin_bit_cast(float, b << 16); }
__device__ __forceinline__ float bflo(unsigned w) { return __builtin_bit_cast(float, w << 16); }
__device__ __forceinline__ float bfhi(unsigned w) { return __builtin_bit_cast(float, w & 0xffff0000u); }
__device__ __forceinline__ unsigned cvt_pk_bf16(float lo, float hi) { unsigned r; asm volatile("v_cvt_pk_bf16_f32 %0, %1, %2" : "=v"(r) : "v"(lo), "v"(hi)); return r; }
__device__ __forceinline__ unsigned short f2bf(float f) { return (unsigned short)(cvt_pk_bf16(f, 0.f) & 0xffffu); }
__device__ __forceinline__ float wave_sum(float v) {
#pragma unroll
    for (int o = 1; o < 64; o <<= 1) v += __shfl_xor(v, o);
    return v;
}
__device__ __forceinline__ float wave_max(float v) {
#pragma unroll
    for (int o = 1; o < 64; o <<= 1) v = fmaxf(v, __shfl_xor(v, o));
    return v;
}
__device__ __forceinline__ float fexp(float x) { return __builtin_amdgcn_exp2f(1.4426950408889634f * x); }
__device__ __forceinline__ float softplusf_(float x) { return fmaxf(x, 0.f) + 0.6931471805599453f * __builtin_amdgcn_logf(1.f + __builtin_amdgcn_exp2f(-1.4426950408889634f * fabsf(x))); }
__device__ __forceinline__ float sigmoidf_(float x) { return __builtin_amdgcn_rcpf(1.f + __builtin_amdgcn_exp2f(-1.4426950408889634f * x)); }
__device__ __forceinline__ unsigned ld_u32_agent(const unsigned* p) { return __hip_atomic_load(p, __ATOMIC_RELAXED, __HIP_MEMORY_SCOPE_AGENT); }
__device__ __forceinline__ float ld_f32_agent(const float* p) { return __builtin_bit_cast(float, __hip_atomic_load((const unsigned*)p, __ATOMIC_RELAXED, __HIP_MEMORY_SCOPE_AGENT)); }
__device__ __forceinline__ float rstd_of(float sumsq) { return __builtin_amdgcn_rsqf(sumsq * (1.f / 1024.f) + 1e-6f); }
__device__ __forceinline__ float rstd4(const float* q4) { const f32x4 q = *(const f32x4*)q4; return rstd_of((q.x + q.y) + (q.z + q.w)); }
#define LDS_WAIT() asm volatile("s_waitcnt lgkmcnt(0)" ::: "memory")
__device__ __forceinline__ int lane_id_opaque() { int l; asm volatile("v_mbcnt_lo_u32_b32 %0, -1, 0\n\tv_mbcnt_hi_u32_b32 %0, -1, %0" : "=v"(l)); return l; }

namespace pg8 {
constexpr int BM = 256, BK = 64, HALF = 128, HTB = HALF * BK * 2, STAGE_BYTES = 8 * HTB, NXCD = 8, WGM = 8;
__host__ __device__ __forceinline__ int lds_byte(int r, int c) { const int st = (r >> 4) * 2 + (c >> 5), rr = r & 15, cc = c & 31, ob = rr * 64 + cc * 2; return st * 1024 + (ob ^ (((ob >> 9) & 1) << 5)); }
__host__ __device__ __forceinline__ void stage_rc(int b, int& R, int& C) { const unsigned ub = (unsigned)b, st = ub >> 10, sb = ub & 1023u, swz = sb ^ (((sb >> 9) & 1u) << 5); R = (int)((st >> 1) * 16u + (swz >> 6)); C = (int)((st & 1u) * 32u + ((swz & 63u) >> 1)); }
__host__ __device__ __forceinline__ int perm32(int rho) { const int n = rho >> 4, i = rho & 15; return 8 * (i >> 2) + 4 * n + (i & 3); }

struct Unit { int pm, pn, pb; };
struct Gemm { const bf16_t* A; const bf16_t* Bt; int lda, ldb, K; };

struct StaticOrder {
    int nM, nN, nwg, G, c;
    __device__ void init(int M, int N, int G_, int c_) { nM = M / BM; nN = N / BM; nwg = nM * nN; G = G_; c = c_; }
    __device__ bool next(int i, Unit& u) const {
        const long L = (long)i * G + c; if (L >= nwg) return false;
        int wgid = (int)L; { const int q = nwg / NXCD, r = nwg % NXCD, xcd = wgid % NXCD, off = wgid / NXCD; wgid = (xcd < r ? xcd * (q + 1) : r * (q + 1) + (xcd - r) * q) + off; }
        const int nig = WGM * nN, gid = wgid / nig, fm = gid * WGM, gsz = (nM - fm) < WGM ? (nM - fm) : WGM;
        u.pm = fm + ((wgid % nig) % gsz); u.pn = (wgid % nig) / gsz; u.pb = u.pn; return true;
    }
};
struct MoeOrder {
    int nM, nN, nwg, G, c; const unsigned* pexp;
    __device__ void init(int nM_, int nN_, int G_, int c_, const unsigned* pexp_) { nM = nM_; nN = nN_; nwg = nM * nN; G = G_; c = c_; pexp = pexp_; }
    __device__ bool next(int i, Unit& u) const {
        const long L = (long)i * G + c; if (L >= nwg) return false;
        int wgid = (int)L; { const int q = nwg / NXCD, r = nwg % NXCD, xcd = wgid % NXCD, off = wgid / NXCD; wgid = (xcd < r ? xcd * (q + 1) : r * (q + 1) + (xcd - r) * q) + off; }
        const int nig = WGM * nN, gid = wgid / nig, fm = gid * WGM, gsz = (nM - fm) < WGM ? (nM - fm) : WGM;
        u.pm = fm + ((wgid % nig) % gsz); u.pn = (wgid % nig) / gsz;
        const int e = (int)__builtin_amdgcn_readfirstlane(ld_u32_agent(pexp + u.pm)); u.pb = e * nN + u.pn; return true;
    }
};

template <class Epi, class Sched, bool ALIGN_EPI = false, bool SP2 = false>
__device__ __forceinline__ void gemm_phase(LAS unsigned char* lds, const Gemm g, const Sched& S, const Epi& E, const int wave0) {
    int tid_ = wave0 * 64 + lane_id_opaque();
    const int tid = tid_, wid = __builtin_amdgcn_readfirstlane(tid >> 6), lane = tid & 63, wr = wid >> 2, wc = wid & 3, fr = lane & 15, fq = lane >> 4;
    const int K = g.K, nt = K / BK;
    unsigned voffA[2], voffB[2];
    { int R, C; stage_rc(tid * 16, R, C); const int Rb = Epi::PERM ? ((R & ~31) + perm32(R & 31)) : R;
      voffA[0] = (unsigned)(R * g.lda + C) * 2u; voffB[0] = (unsigned)(Rb * g.ldb + C) * 2u; voffA[1] = voffA[0] + (unsigned)(64 * g.lda) * 2u; voffB[1] = voffB[0] + (unsigned)(64 * g.ldb) * 2u; }
    const size_t kstep = (size_t)(BK * 2);
    const size_t hsA = (size_t)HALF * g.lda * 2, hsB = (size_t)HALF * g.ldb * 2;
    const size_t tsA = 2 * hsA, tsB = 2 * hsB;
    const unsigned ldsw = (unsigned)wid * 1024u;
    const int swz_ = (fr * 64 + fq * 16) ^ ((fr & 8) << 2); const int aoff = wr * 8192 + swz_, boff = wc * 4096 + swz_;
#define PG8_SA(b, h) (((b) * 2 + (h)) * HTB)
#define PG8_SB(b, h) ((4 + (b) * 2 + (h)) * HTB)
#define PG8_STAGE(bufoff, gbase, voff) do { _Pragma("unroll") for (int _i = 0; _i < 2; ++_i) \
        __builtin_amdgcn_global_load_lds((const unsigned*)((const char*)(gbase) + (voff)[_i]), (LAS unsigned*)(lds + (bufoff) + ldsw + _i * 8192), 16, 0, 0); } while (0)
#define PG8_LDA(dst, b, h) do { _Pragma("unroll") for (int m = 0; m < 4; ++m) _Pragma("unroll") for (int k = 0; k < 2; ++k) dst[m][k] = *(const LAS bf16x8*)(lds + PG8_SA(b, h) + aoff + m * 2048 + k * 1024); } while (0)
#define PG8_LDB(dst, b, h) do { _Pragma("unroll") for (int n = 0; n < 2; ++n) _Pragma("unroll") for (int k = 0; k < 2; ++k) dst[n][k] = *(const LAS bf16x8*)(lds + PG8_SB(b, h) + boff + n * 2048 + k * 1024); } while (0)
#define PG8_MMA(ai, bj, At, Bt) do { __builtin_amdgcn_s_setprio(1); _Pragma("unroll") for (int m = 0; m < 4; ++m) _Pragma("unroll") for (int n = 0; n < 2; ++n) _Pragma("unroll") for (int k = 0; k < 2; ++k) \
        acc[ai][bj][m][n] = __builtin_amdgcn_mfma_f32_16x16x32_bf16(Bt[n][k], At[m][k], acc[ai][bj][m][n], 0, 0, 0); __builtin_amdgcn_s_setprio(0); } while (0)
#define PG8_WAIT_V(n) asm volatile("s_waitcnt vmcnt(" #n ")" ::: "memory")
#define PG8_WAIT_L(n) asm volatile("s_waitcnt lgkmcnt(" #n ")" ::: "memory")
#define PG8_BAR __builtin_amdgcn_s_barrier()
#define PG8_SCHED __builtin_amdgcn_sched_barrier(0)
    Unit cur, nxt; int ui = 0;
    if (!S.next(0, cur)) return;
    f32x4 acc[2][2][4][2];
#pragma unroll
    for (int a = 0; a < 2; ++a)
#pragma unroll
        for (int b = 0; b < 2; ++b)
#pragma unroll
            for (int m = 0; m < 4; ++m)
#pragma unroll
                for (int n = 0; n < 2; ++n) acc[a][b][m][n] = (f32x4){0.f, 0.f, 0.f, 0.f};
    bf16x8 At[4][2], B0[2][2], B1[2][2];
    const char* cA = (const char*)g.A + (size_t)cur.pm * tsA; const char* cB = (const char*)g.Bt + (size_t)cur.pb * tsB;
    if constexpr (SP2) {
        PG8_STAGE(PG8_SB(0, 0), cB, voffB); PG8_STAGE(PG8_SB(0, 1), cB + hsB, voffB); PG8_STAGE(PG8_SA(0, 0), cA, voffA); PG8_STAGE(PG8_SA(0, 1), cA + hsA, voffA);
        if (wr == 1) PG8_BAR;
        PG8_WAIT_V(2); PG8_BAR;
        PG8_STAGE(PG8_SB(1, 0), cB + kstep, voffB); PG8_STAGE(PG8_SA(1, 0), cA + kstep, voffA); PG8_STAGE(PG8_SB(1, 1), cB + hsB + kstep, voffB);
        PG8_WAIT_V(6); PG8_BAR;
    } else {
        PG8_STAGE(PG8_SB(0, 0), cB, voffB); PG8_STAGE(PG8_SA(0, 0), cA, voffA); PG8_STAGE(PG8_SB(0, 1), cB + hsB, voffB); PG8_STAGE(PG8_SA(0, 1), cA + hsA, voffA);
        if (wr == 1) PG8_BAR;
        PG8_WAIT_V(4); PG8_BAR;
        PG8_STAGE(PG8_SB(1, 0), cB + kstep, voffB); PG8_STAGE(PG8_SA(1, 0), cA + kstep, voffA); PG8_STAGE(PG8_SB(1, 1), cB + hsB + kstep, voffB);
        PG8_WAIT_V(6); PG8_BAR;
    }
    for (;;) {
        const bool has_next = S.next(ui + 1, nxt);
        const char* nA = has_next ? (const char*)g.A + (size_t)nxt.pm * tsA : cA; const char* nB = has_next ? (const char*)g.Bt + (size_t)nxt.pb * tsB : cB;
        for (int t = 0; t < nt; t += 2) {
            const bool last = (t == nt - 2);
            const char* a1 = cA + (size_t)(t + 1) * kstep;
            const char* a2 = last ? nA : cA + (size_t)(t + 2) * kstep; const char* b2 = last ? nB : cB + (size_t)(t + 2) * kstep;
            const char* a3 = a2 + kstep; const char* b3 = b2 + kstep;
            if constexpr (SP2) {
            PG8_LDB(B0, 0, 0); PG8_LDB(B1, 0, 1); PG8_SCHED; PG8_LDA(At, 0, 0); PG8_STAGE(PG8_SA(1, 1), a1 + hsA, voffA);
            PG8_WAIT_V(8); PG8_WAIT_L(0); PG8_BAR; PG8_MMA(0, 0, At, B0); PG8_MMA(0, 1, At, B1); PG8_BAR; PG8_SCHED;
            PG8_LDA(At, 0, 1); PG8_STAGE(PG8_SB(0, 0), b2, voffB); PG8_STAGE(PG8_SB(0, 1), b2 + hsB, voffB); PG8_STAGE(PG8_SA(0, 0), a2, voffA);
            PG8_WAIT_V(8); PG8_WAIT_L(0); PG8_BAR; PG8_MMA(1, 0, At, B0); PG8_MMA(1, 1, At, B1); PG8_BAR; PG8_SCHED;
            PG8_LDB(B0, 1, 0); PG8_LDB(B1, 1, 1); PG8_SCHED; PG8_LDA(At, 1, 0); PG8_STAGE(PG8_SA(0, 1), a2 + hsA, voffA);
            PG8_WAIT_V(8); PG8_WAIT_L(0); PG8_BAR; PG8_MMA(0, 0, At, B0); PG8_MMA(0, 1, At, B1); PG8_BAR; PG8_SCHED;
            PG8_LDA(At, 1, 1); PG8_STAGE(PG8_SB(1, 0), b3, voffB); PG8_STAGE(PG8_SB(1, 1), b3 + hsB, voffB); PG8_STAGE(PG8_SA(1, 0), a3, voffA);
            PG8_WAIT_V(8); PG8_WAIT_L(0); PG8_BAR; PG8_MMA(1, 0, At, B0); PG8_MMA(1, 1, At, B1); PG8_BAR; PG8_SCHED;
            } else {
            PG8_LDB(B0, 0, 0); PG8_SCHED; PG8_LDA(At, 0, 0); PG8_STAGE(PG8_SA(1, 1), a1 + hsA, voffA);
            PG8_WAIT_L(8); PG8_BAR; PG8_WAIT_L(0); PG8_MMA(0, 0, At, B0); PG8_BAR; PG8_SCHED;
            PG8_LDB(B1, 0, 1); PG8_STAGE(PG8_SB(0, 0), b2, voffB);
            PG8_BAR; PG8_WAIT_L(0); PG8_MMA(0, 1, At, B1); PG8_BAR;
            PG8_LDA(At, 0, 1); PG8_STAGE(PG8_SA(0, 0), a2, voffA);
            PG8_BAR; PG8_WAIT_L(0); PG8_MMA(1, 0, At, B0); PG8_BAR; PG8_SCHED;
            PG8_STAGE(PG8_SB(0, 1), b2 + hsB, voffB);
            PG8_WAIT_V(6); PG8_BAR; PG8_MMA(1, 1, At, B1); PG8_BAR;
            PG8_LDB(B0, 1, 0); PG8_SCHED; PG8_LDA(At, 1, 0); PG8_STAGE(PG8_SA(0, 1), a2 + hsA, voffA);
            PG8_WAIT_L(8); PG8_BAR; PG8_WAIT_L(0); PG8_MMA(0, 0, At, B0); PG8_BAR; PG8_SCHED;
            PG8_LDB(B1, 1, 1); PG8_STAGE(PG8_SB(1, 0), b3, voffB);
            PG8_BAR; PG8_WAIT_L(0); PG8_MMA(0, 1, At, B1); PG8_BAR;
            PG8_LDA(At, 1, 1); PG8_STAGE(PG8_SA(1, 0), a3, voffA);
            PG8_BAR; PG8_WAIT_L(0); PG8_MMA(1, 0, At, B0); PG8_BAR; PG8_SCHED;
            PG8_STAGE(PG8_SB(1, 1), b3 + hsB, voffB);
            PG8_WAIT_V(6); PG8_BAR; PG8_MMA(1, 1, At, B1); PG8_BAR;
            }
        }
        if constexpr (ALIGN_EPI) { if (wr == 0) PG8_BAR; }
        E(acc, cur, wr, wc, fr, fq);
        if (!has_next) break;
#pragma unroll
        for (int a = 0; a < 2; ++a)
#pragma unroll
            for (int b = 0; b < 2; ++b)
#pragma unroll
                for (int m = 0; m < 4; ++m)
#pragma unroll
                    for (int n = 0; n < 2; ++n) acc[a][b][m][n] = (f32x4){0.f, 0.f, 0.f, 0.f};
        cur = nxt; cA = nA; cB = nB; ++ui;
        if constexpr (ALIGN_EPI) { if (wr == 1) PG8_BAR; }
    }
    PG8_WAIT_V(0);
    if constexpr (!ALIGN_EPI) { if (wr == 0) PG8_BAR; }
    PG8_BAR;
#undef PG8_SA
#undef PG8_SB
#undef PG8_STAGE
#undef PG8_LDA
#undef PG8_LDB
#undef PG8_MMA
#undef PG8_WAIT_V
#undef PG8_WAIT_L
#undef PG8_BAR
#undef PG8_SCHED
}

typedef const f32x4 (&AccT)[2][2][4][2];
#define EPI_FENCE() asm volatile("" ::: "memory")

struct EpiInProj {
    static constexpr bool PERM = true;
    unsigned char* xbase; const float* ssq; float* rs_out; float* dtt; const float* dt_bias;
    __device__ __forceinline__ void operator()(AccT acc, const Unit& u, int wr, int wc, int fr, int fq) const {
        const int pn = u.pn; int bmib = (int)(X_Z >> 20), ld = 1024, ct = pn; bool sig = false;
        float sc = 1.f;
        if (pn < 4) { }
        else if (pn < 9) { bmib = (int)(X_XBC >> 20); ld = 1280; ct = pn - 4; }
        else if (pn < 11) { bmib = (int)(X_Q >> 20); ld = 512; ct = pn - 9; sc = 0.18033688011112042f; }
        else if (pn < 13) { bmib = (int)(X_K >> 20); ld = 512; ct = pn - 11; }
        else { bmib = (int)(X_GS >> 20); ld = 2048; ct = pn - 13; sig = true; }
        const unsigned lo = (unsigned)(fr * ld + 8 * fq) * 2u;
        unsigned char* tb = xbase + ((size_t)(unsigned)bmib << 20) + ((size_t)(u.pm * BM + wr * 64) * ld + ct * BM + wc * 32) * 2;
        const int rowb = u.pm * BM + wr * 64 + fr;
        if (pn == 21) {
            if (wc == 0 && fq < 2) {
                int fqo = fq; asm volatile("" : "+v"(fqo));
                float* dbase = dtt + (size_t)(8 * fqo) * T;
                const f32x4 b0 = *(const f32x4*)(dt_bias + 8 * fqo), b1 = *(const f32x4*)(dt_bias + 8 * fqo + 4);
#pragma unroll
                for (int ai = 0; ai < 2; ++ai)
#pragma unroll
                    for (int m = 0; m < 4; ++m) { const int row = rowb + ai * HALF + m * 16; const float r = rstd4(ssq + (size_t)row * 4); const f32x4 v0 = acc[ai][0][m][0] * r + b0, v1 = acc[ai][0][m][1] * r + b1;
#pragma unroll
                        for (int j = 0; j < 4; ++j) { dbase[(size_t)j * T + row] = softplusf_(v0[j]); dbase[(size_t)(4 + j) * T + row] = softplusf_(v1[j]); } }
            }
            return;
        }
#pragma unroll
        for (int ai = 0; ai < 2; ++ai)
#pragma unroll
            for (int m = 0; m < 4; ++m) { const int row = rowb + ai * HALF + m * 16; const float r0 = rstd4(ssq + (size_t)row * 4); const float r = r0 * sc; unsigned char* rowp = tb + (size_t)(ai * HALF + m * 16) * ld * 2;
                if (pn == 0 && wc == 0 && fq == 0) rs_out[row] = r0;
#pragma unroll
                for (int bj = 0; bj < 2; ++bj) { f32x4 v0 = acc[ai][bj][m][0] * r, v1 = acc[ai][bj][m][1] * r;
                    if (sig) {
#pragma unroll
                        for (int j = 0; j < 4; ++j) { v0[j] = sigmoidf_(v0[j]); v1[j] = sigmoidf_(v1[j]); } }
                    u32x4 w; w.x = cvt_pk_bf16(v0[0], v0[1]); w.y = cvt_pk_bf16(v0[2], v0[3]); w.z = cvt_pk_bf16(v1[0], v1[1]); w.w = cvt_pk_bf16(v1[2], v1[3]);
                    *(u32x4*)(rowp + lo + bj * HALF * 2) = w; }
                EPI_FENCE(); }
    }
};
struct EpiBf16Rs {
    static constexpr bool PERM = true;
    bf16_t* O; int ldc; const float* rs; float sc; int ssq16;
    __device__ __forceinline__ void operator()(AccT acc, const Unit& u, int wr, int wc, int fr, int fq) const {
        const unsigned lo = (unsigned)(fr * ldc + 8 * fq) * 2u;
        unsigned char* tb = (unsigned char*)O + ((size_t)(u.pm * BM + wr * 64) * ldc + u.pn * BM + wc * 32) * 2;
        const float* rsb = rs + (size_t)(u.pm * BM + wr * 64) * (ssq16 ? 4 : 1);
#pragma unroll
        for (int ai = 0; ai < 2; ++ai)
#pragma unroll
            for (int m = 0; m < 4; ++m) { const float r = (ssq16 ? rstd4(rsb + (size_t)(ai * HALF + m * 16 + fr) * 4) : rsb[ai * HALF + m * 16 + fr]) * sc; unsigned char* rowp = tb + (size_t)(ai * HALF + m * 16) * ldc * 2;
#pragma unroll
                for (int bj = 0; bj < 2; ++bj) { const f32x4 v0 = acc[ai][bj][m][0] * r, v1 = acc[ai][bj][m][1] * r;
                    u32x4 w; w.x = cvt_pk_bf16(v0[0], v0[1]); w.y = cvt_pk_bf16(v0[2], v0[3]); w.z = cvt_pk_bf16(v1[0], v1[1]); w.w = cvt_pk_bf16(v1[2], v1[3]);
                    *(u32x4*)(rowp + lo + bj * HALF * 2) = w; }
                EPI_FENCE(); }
    }
};
struct EpiBf16Cs {
    static constexpr bool PERM = true;
    bf16_t* O; int ldc; const float* cs; float sc; int chunk_rows;
    __device__ __forceinline__ void operator()(AccT acc, const Unit& u, int wr, int wc, int fr, int fq) const {
        const int rstride = chunk_rows ? 128 : ldc;
        const size_t bjstride = chunk_rows ? (size_t)chunk_rows * 128 : (size_t)HALF;
        const unsigned lo = (unsigned)(fr * rstride + 8 * fq) * 2u;
        unsigned char* tb = (unsigned char*)O + (chunk_rows ? ((size_t)(u.pn * 2) * chunk_rows * 128 + (size_t)(u.pm * BM + wr * 64) * 128 + wc * 32) : ((size_t)(u.pm * BM + wr * 64) * ldc + u.pn * BM + wc * 32)) * 2;
        const float* csb = cs + u.pn * BM + wc * 32 + 8 * fq;
        f32x4 c0[2], c1[2];
#pragma unroll
        for (int bj = 0; bj < 2; ++bj) { c0[bj] = *(const f32x4*)(csb + bj * HALF) * sc; c1[bj] = *(const f32x4*)(csb + bj * HALF + 4) * sc; }
#pragma unroll
        for (int ai = 0; ai < 2; ++ai)
#pragma unroll
            for (int m = 0; m < 4; ++m) { unsigned char* rowp = tb + (size_t)(ai * HALF + m * 16) * rstride * 2;
#pragma unroll
                for (int bj = 0; bj < 2; ++bj) { const f32x4 v0 = acc[ai][bj][m][0] * c0[bj], v1 = acc[ai][bj][m][1] * c1[bj];
                    u32x4 w; w.x = cvt_pk_bf16(v0[0], v0[1]); w.y = cvt_pk_bf16(v0[2], v0[3]); w.z = cvt_pk_bf16(v1[0], v1[1]); w.w = cvt_pk_bf16(v1[2], v1[3]);
                    *(u32x4*)(rowp + lo + bj * bjstride * 2) = w; }
                EPI_FENCE(); }
    }
};
template <bool ADD> struct EpiGate {
    static constexpr bool PERM = true;
    bf16_t* O; const bf16_t* GS; int gcol0; const bf16_t* Oin;
    __device__ __forceinline__ void operator()(AccT acc, const Unit& u, int wr, int wc, int fr, int fq) const {
        const unsigned lo = (unsigned)(fr * 1024 + 8 * fq) * 2u, lg = (unsigned)(fr * 2048 + 8 * fq) * 2u;
        unsigned char* tb = (unsigned char*)O + ((size_t)(u.pm * BM + wr * 64) * 1024 + u.pn * BM + wc * 32) * 2;
        const unsigned char* ib = (const unsigned char*)Oin + ((size_t)(u.pm * BM + wr * 64) * 1024 + u.pn * BM + wc * 32) * 2;
        const unsigned char* gb = (const unsigned char*)GS + ((size_t)(u.pm * BM + wr * 64) * 2048 + gcol0 + u.pn * BM + wc * 32) * 2;
#pragma unroll
        for (int ai = 0; ai < 2; ++ai)
#pragma unroll
            for (int m = 0; m < 4; ++m) { unsigned char* rowp = tb + (size_t)(ai * HALF + m * 16) * 1024 * 2; const unsigned char* inp = ib + (size_t)(ai * HALF + m * 16) * 1024 * 2; const unsigned char* gp = gb + (size_t)(ai * HALF + m * 16) * 2048 * 2;
#pragma unroll
                for (int bj = 0; bj < 2; ++bj) { const u32x4 gw = *(const u32x4*)(gp + lg + bj * HALF * 2); f32x4 v0 = acc[ai][bj][m][0], v1 = acc[ai][bj][m][1];
                    v0[0] *= bflo(gw.x); v0[1] *= bfhi(gw.x); v0[2] *= bflo(gw.y); v0[3] *= bfhi(gw.y); v1[0] *= bflo(gw.z); v1[1] *= bfhi(gw.z); v1[2] *= bflo(gw.w); v1[3] *= bfhi(gw.w);
                    if (ADD) { const u32x4 pw = *(const u32x4*)(inp + lo + bj * HALF * 2);
                        v0[0] += bflo(pw.x); v0[1] += bfhi(pw.x); v0[2] += bflo(pw.y); v0[3] += bfhi(pw.y); v1[0] += bflo(pw.z); v1[1] += bfhi(pw.z); v1[2] += bflo(pw.w); v1[3] += bfhi(pw.w); }
                    u32x4 w; w.x = cvt_pk_bf16(v0[0], v0[1]); w.y = cvt_pk_bf16(v0[2], v0[3]); w.z = cvt_pk_bf16(v1[0], v1[1]); w.w = cvt_pk_bf16(v1[2], v1[3]);
                    *(u32x4*)(rowp + lo + bj * HALF * 2) = w; }
                EPI_FENCE(); }
    }
};
struct EpiResidBf {
    static constexpr bool PERM = true;
    const bf16_t* Hin; bf16_t* Hout; float* ssq; LAS float* sl;
    __device__ __forceinline__ void operator()(AccT acc, const Unit& u, int wr, int wc, int fr, int fq) const {
        const unsigned lo = (unsigned)(fr * 1024 + 8 * fq) * 2u;
        const size_t ub = ((size_t)(u.pm * BM + wr * 64) * 1024 + u.pn * BM + wc * 32) * 2;
#pragma unroll
        for (int ai = 0; ai < 2; ++ai)
#pragma unroll
            for (int m = 0; m < 4; ++m) { const size_t ro = ub + (size_t)(ai * HALF + m * 16) * 1024 * 2; const unsigned char* hi = (const unsigned char*)Hin + ro; unsigned char* ho = (unsigned char*)Hout + ro;
                u32x4 hv[2];
#pragma unroll
                for (int bj = 0; bj < 2; ++bj) hv[bj] = *(const u32x4*)(hi + lo + bj * HALF * 2);
                float ss = 0.f;
#pragma unroll
                for (int bj = 0; bj < 2; ++bj) { const f32x4 a0 = acc[ai][bj][m][0], a1 = acc[ai][bj][m][1]; u32x4 w;
                    w.x = cvt_pk_bf16(bflo(hv[bj].x) + a0[0], bfhi(hv[bj].x) + a0[1]); w.y = cvt_pk_bf16(bflo(hv[bj].y) + a0[2], bfhi(hv[bj].y) + a0[3]);
                    w.z = cvt_pk_bf16(bflo(hv[bj].z) + a1[0], bfhi(hv[bj].z) + a1[1]); w.w = cvt_pk_bf16(bflo(hv[bj].w) + a1[2], bfhi(hv[bj].w) + a1[3]);
                    *(u32x4*)(ho + lo + bj * HALF * 2) = w;
                    ss += (bflo(w.x) * bflo(w.x) + bfhi(w.x) * bfhi(w.x)) + (bflo(w.y) * bflo(w.y) + bfhi(w.y) * bfhi(w.y)) + (bflo(w.z) * bflo(w.z) + bfhi(w.z) * bfhi(w.z)) + (bflo(w.w) * bflo(w.w) + bfhi(w.w) * bfhi(w.w)); }
                ss += __shfl_xor(ss, 16); ss += __shfl_xor(ss, 32);
                if (fq == 0) sl[wc * 256 + ai * HALF + wr * 64 + m * 16 + fr] = ss;
                EPI_FENCE(); }
        asm volatile("s_waitcnt lgkmcnt(0)" ::: "memory"); __builtin_amdgcn_s_barrier(); asm volatile("" ::: "memory");
        const int t = (wr * 4 + wc) * 64 + fq * 16 + fr;
        if (t < 256) ssq[(size_t)(u.pm * BM + t) * 4 + u.pn] = (sl[t] + sl[256 + t]) + (sl[512 + t] + sl[768 + t]);
    }
};
struct EpiSwiglu {
    static constexpr bool PERM = true;
    bf16_t* ACT; const float* rs; int ssq16;
    __device__ __forceinline__ void operator()(AccT acc, const Unit& u, int wr, int wc, int fr, int fq) const {
        const unsigned lo = (unsigned)(fr * DFF + 8 * fq) * 2u;
        unsigned char* tb = (unsigned char*)ACT + ((size_t)(u.pm * BM + wr * 64) * DFF + u.pn * HALF + wc * 32) * 2;
        const float* rsb = rs + (size_t)(u.pm * BM + wr * 64) * (ssq16 ? 4 : 1);
#pragma unroll
        for (int ai = 0; ai < 2; ++ai)
#pragma unroll
            for (int m = 0; m < 4; ++m) { const float r = ssq16 ? rstd4(rsb + (size_t)(ai * HALF + m * 16 + fr) * 4) : rsb[ai * HALF + m * 16 + fr];
                float o[8];
#pragma unroll
                for (int n = 0; n < 2; ++n)
#pragma unroll
                    for (int j = 0; j < 4; ++j) { const float gt = acc[ai][0][m][n][j] * r, up = acc[ai][1][m][n][j] * r; o[n * 4 + j] = gt * sigmoidf_(gt) * up; }
                u32x4 w; w.x = cvt_pk_bf16(o[0], o[1]); w.y = cvt_pk_bf16(o[2], o[3]); w.z = cvt_pk_bf16(o[4], o[5]); w.w = cvt_pk_bf16(o[6], o[7]);
                *(u32x4*)(tb + (size_t)(ai * HALF + m * 16) * DFF * 2 + lo) = w;
                EPI_FENCE(); }
    }
};
struct EpiMoeDown {
    static constexpr bool PERM = true;
    const bf16_t* H; const int* rowl; const float* wrow; bf16_t* Hout; float* ssq; LAS float* sl;
    __device__ __forceinline__ void operator()(AccT acc, const Unit& u, int wr, int wc, int fr, int fq) const {
        const int rb = u.pm * BM + wr * 64; const unsigned cb = (unsigned)(u.pn * BM + wc * 32 + 8 * fq) * 2u;
#pragma unroll
        for (int ai = 0; ai < 2; ++ai)
#pragma unroll
            for (int m = 0; m < 4; ++m) { const int row = rb + ai * HALF + m * 16 + fr; const int tok = rowl[row]; const float wt = wrow[row];
                const size_t to = (size_t)(tok < 0 ? 0 : tok);
                const unsigned char* hp = (const unsigned char*)H + to * 2048 + cb; unsigned char* op = (unsigned char*)Hout + to * 2048 + cb;
                float ss = 0.f;
                if (tok >= 0) {
                    u32x4 hv[2];
#pragma unroll
                    for (int bj = 0; bj < 2; ++bj) hv[bj] = *(const u32x4*)(hp + bj * HALF * 2);
#pragma unroll
                    for (int bj = 0; bj < 2; ++bj) { const f32x4 a0 = acc[ai][bj][m][0] * wt, a1 = acc[ai][bj][m][1] * wt; u32x4 w;
                        w.x = cvt_pk_bf16(bflo(hv[bj].x) + a0[0], bfhi(hv[bj].x) + a0[1]); w.y = cvt_pk_bf16(bflo(hv[bj].y) + a0[2], bfhi(hv[bj].y) + a0[3]);
                        w.z = cvt_pk_bf16(bflo(hv[bj].z) + a1[0], bfhi(hv[bj].z) + a1[1]); w.w = cvt_pk_bf16(bflo(hv[bj].w) + a1[2], bfhi(hv[bj].w) + a1[3]);
                        *(u32x4*)(op + bj * HALF * 2) = w;
                        ss += (bflo(w.x) * bflo(w.x) + bfhi(w.x) * bfhi(w.x)) + (bflo(w.y) * bflo(w.y) + bfhi(w.y) * bfhi(w.y)) + (bflo(w.z) * bflo(w.z) + bfhi(w.z) * bfhi(w.z)) + (bflo(w.w) * bflo(w.w) + bfhi(w.w) * bfhi(w.w)); } }
                ss += __shfl_xor(ss, 16); ss += __shfl_xor(ss, 32);
                if (ssq != nullptr && fq == 0) sl[wc * 256 + ai * HALF + wr * 64 + m * 16 + fr] = ss;
                EPI_FENCE(); }
        if (ssq != nullptr) {
            asm volatile("s_waitcnt lgkmcnt(0)" ::: "memory"); __builtin_amdgcn_s_barrier(); asm volatile("" ::: "memory");
            const int t = (wr * 4 + wc) * 64 + fq * 16 + fr;
            if (t < 256) { const int tok = rowl[u.pm * BM + t]; if (tok >= 0) ssq[(size_t)tok * 4 + u.pn] = (sl[t] + sl[256 + t]) + (sl[512 + t] + sl[768 + t]); }
        }
    }
};
}

#define XB_TMO      128
#define XB_XCNT(j)  (256  + 64 * (j))
#define XB_XSUB(j)  (1280 + 64 * (j))
#define XB_XGEN(j)  (2304 + 64 * (j))
#define XB_TOP      3328
#define XB_TOPGEN   3392
#define XCD_BAR_WORDS 3456
#define XB_SPIN_CAP (1u << 22)
__device__ __forceinline__ unsigned xb_ld(unsigned* p)              { return __hip_atomic_load(p, __ATOMIC_RELAXED, __HIP_MEMORY_SCOPE_AGENT); }
__device__ __forceinline__ unsigned xb_add(unsigned* p, unsigned v) { return __hip_atomic_fetch_add(p, v, __ATOMIC_RELAXED, __HIP_MEMORY_SCOPE_AGENT); }
__device__ __forceinline__ unsigned xb_xcc_id() { return (unsigned)__builtin_amdgcn_s_getreg((3 << 11) | 20) & 0xFu; }
#define XB_SPIN(cond, bar) do { unsigned _sp = 0; while (cond) { __builtin_amdgcn_s_sleep(1); \
    if ((++_sp & 255u) == 0u) { if (xb_ld(&(bar)[XB_TMO])) break; if (_sp > XB_SPIN_CAP) { atomicAdd(&(bar)[XB_TMO], 1u); break; } } } } while (0)
struct XcdBarrier { unsigned* bar; unsigned x; volatile LAS unsigned* st; };
__device__ __forceinline__ XcdBarrier xcd_barrier_post(unsigned* bar, volatile LAS unsigned* st) {
    XcdBarrier b; b.bar = bar; b.x = xb_xcc_id(); b.st = st;
    if (threadIdx.x == 0) (void)xb_add(&bar[XB_XCNT(b.x)], 1u);
    return b;
}
__device__ __forceinline__ void xcd_barrier_complete(unsigned* bar, unsigned x, unsigned& nloc, unsigned& nx) {
    const unsigned G = gridDim.x * gridDim.y * gridDim.z;
    unsigned sum, cnt, mine, sp = 0u;
    for (;;) {
        sum = 0u; cnt = 0u; mine = 0u;
#pragma unroll
        for (unsigned j = 0; j < 16; ++j) { const unsigned c = xb_ld(&bar[XB_XCNT(j)]); sum += c; cnt += (c > 0u) ? 1u : 0u; mine = (j == x) ? c : mine; }
        if (sum == G) break;
        __builtin_amdgcn_s_sleep(1);
        if ((++sp & 255u) == 0u) { if (xb_ld(&bar[XB_TMO])) break; if (sp > XB_SPIN_CAP) { atomicAdd(&bar[XB_TMO], 1u); break; } }
    }
    nloc = mine > 0u ? mine : 1u; nx = cnt > 0u ? cnt : 1u;
}
__device__ __forceinline__ void xcd_barrier(const XcdBarrier& b, const bool leader_thread) {
    asm volatile("s_waitcnt vmcnt(0)" ::: "memory");
    __syncthreads();
    if (leader_thread) {
        unsigned* bar = b.bar;
        __builtin_amdgcn_s_waitcnt(0);
        unsigned nloc = b.st[0], nx = b.st[1];
        if (nloc == 0u) { xcd_barrier_complete(bar, b.x, nloc, nx); b.st[0] = nloc; b.st[1] = nx; }
        const unsigned old = xb_add(&bar[XB_XSUB(b.x)], 1u);
        const unsigned gen = old / nloc;
        if (old + 1u == (gen + 1u) * nloc) {
            __builtin_amdgcn_fence(__ATOMIC_RELEASE, "agent");
            asm volatile("s_waitcnt vmcnt(0)" ::: "memory");
            const unsigned og = xb_add(&bar[XB_TOP], 1u);
            const unsigned tg = og / nx;
            if (og + 1u == (tg + 1u) * nx) xb_add(&bar[XB_TOPGEN], 1u);
            else XB_SPIN(xb_ld(&bar[XB_TOPGEN]) == tg, bar);
            __builtin_amdgcn_fence(__ATOMIC_ACQUIRE, "agent");
            xb_add(&bar[XB_XGEN(b.x)], 1u);
            asm volatile("s_waitcnt vmcnt(0)" ::: "memory");
        } else {
            XB_SPIN(xb_ld(&bar[XB_XGEN(b.x)]) == gen, bar);
            __builtin_amdgcn_fence(__ATOMIC_ACQUIRE, "agent");
            asm volatile("s_waitcnt vmcnt(0)" ::: "memory");
        }
    }
    __syncthreads();
}

struct Params {
    const float* in[28];
    float* out;
    unsigned char* ws;
    int l_lo, l_hi, ph_lo, ph_hi;
};
enum { I_X = 0, I_MEM, I_NORM_MIX, I_W_IN, I_CONV_W, I_CONV_B, I_DT_BIAS, I_A_LOG, I_D_SKIP, I_SSD_NORM, I_W_SSD_O, I_W_SB_O, I_W_OUT, I_NORM_XA, I_NORM_MEM,
       I_XA_WQ, I_XA_WK, I_XA_WV, I_XA_WO, I_NORM_FFN, I_FFN_G, I_FFN_U, I_FFN_D, I_MOE_R, I_MOE_G, I_MOE_U, I_MOE_D, I_FINAL };

__device__ __forceinline__ void tr_item(const float* W, int ldw, int k0, int n0, const float* gain, bf16_t* WT, int ldt, int drow0, LAS float* scr, int lane) {
    const int hl = lane >> 5, nl = lane & 31;
    const float* src = W + (size_t)(k0 + hl) * ldw + n0 + nl;
    float v[32];
#pragma unroll
    for (int i = 0; i < 32; ++i) v[i] = src[(size_t)(2 * i) * ldw];
#pragma unroll
    for (int i = 0; i < 32; ++i) scr[(2 * i + hl) * 33 + nl] = v[i];
    LDS_WAIT();
    const int c = lane & 7;
    f32x4 g0 = {1.f, 1.f, 1.f, 1.f}, g1 = {1.f, 1.f, 1.f, 1.f};
    if (gain) { g0 = *(const f32x4*)(gain + k0 + 8 * c); g1 = *(const f32x4*)(gain + k0 + 8 * c + 4); }
#pragma unroll
    for (int j = 0; j < 4; ++j) { const int n = (lane >> 3) + 8 * j; const LAS float* s = scr + (8 * c) * 33 + n;
        u32x4 o; o.x = cvt_pk_bf16(s[0 * 33] * g0.x, s[1 * 33] * g0.y); o.y = cvt_pk_bf16(s[2 * 33] * g0.z, s[3 * 33] * g0.w); o.z = cvt_pk_bf16(s[4 * 33] * g1.x, s[5 * 33] * g1.y); o.w = cvt_pk_bf16(s[6 * 33] * g1.z, s[7 * 33] * g1.w);
        *(u32x4*)(WT + (size_t)(drow0 + n) * ldt + k0 + 8 * c) = o; }
    LDS_WAIT();
}
struct TrJob { const float* W; int ldw, K, col0, ncols; const float* gain; bf16_t* WT; int dbase, dgroup; };
__device__ __forceinline__ void run_job(const TrJob& j, int& base, int gw, int NGW, LAS float* scr, int lane) {
    const int nblk = j.ncols / 32, nitems = (j.K / 64) * nblk;
    int start = (gw - base) % NGW; if (start < 0) start += NGW;
    for (int it = start; it < nitems; it += NGW) { const int kb = it / nblk, nb = it % nblk, c0 = nb * 32;
        tr_item(j.W, j.ldw, kb * 64, j.col0 + c0, j.gain, j.WT, j.K, j.dbase + (c0 / 128) * j.dgroup + (c0 % 128), scr, lane); }
    base = (base + nitems) % NGW;
}

__device__ __forceinline__ float row_to_bf16(const float* xrow, bf16_t* brow, int lane) {
    const f32x4* xr = (const f32x4*)xrow + lane; u32x2* o8 = (u32x2*)brow + lane; float s = 0.f;
#pragma unroll
    for (int j = 0; j < 4; ++j) { const f32x4 v = xr[64 * j]; u32x2 w; w.x = cvt_pk_bf16(v.x, v.y); w.y = cvt_pk_bf16(v.z, v.w); o8[64 * j] = w;
        s += (bflo(w.x) * bflo(w.x) + bfhi(w.x) * bfhi(w.x)) + (bflo(w.y) * bflo(w.y) + bfhi(w.y) * bfhi(w.y)); }
    return wave_sum(s);
}
template <int NE>
__device__ __forceinline__ void row_dots_bf16(const bf16_t* brow, int lane, const LAS float* wsm, float rstd, float (&ex)[NE]) {
    const u32x2* xr = (const u32x2*)brow + lane; f32x4 v[4];
#pragma unroll
    for (int j = 0; j < 4; ++j) { const u32x2 w = xr[64 * j]; v[j] = (f32x4){bflo(w.x), bfhi(w.x), bflo(w.y), bfhi(w.y)}; }
#pragma unroll
    for (int e = 0; e < NE; ++e) { float pp = 0.f;
#pragma unroll
        for (int j = 0; j < 4; ++j) { const f32x4 w4 = *(const LAS f32x4*)(wsm + e * 1024 + 256 * j + 4 * lane); pp += (v[j].x * w4.x + v[j].y * w4.y) + (v[j].z * w4.z + v[j].w * w4.w); }
        ex[e] = wave_sum(pp) * rstd; }
}

typedef float f32x16 __attribute__((ext_vector_type(16)));
#define MFMA32(a, b, c) __builtin_amdgcn_mfma_f32_32x32x16_bf16((a), (b), (c), 0, 0, 0)
__device__ __forceinline__ bf16x8 ldg8(const bf16_t* p) { return *(const bf16x8*)p; }
__device__ __forceinline__ bf16x8 pack8(const float* v) { u32x4 w; w.x = cvt_pk_bf16(v[0], v[1]); w.y = cvt_pk_bf16(v[2], v[3]); w.z = cvt_pk_bf16(v[4], v[5]); w.w = cvt_pk_bf16(v[6], v[7]); return __builtin_bit_cast(bf16x8, w); }
__device__ __forceinline__ int pi32(int r) { return 16 * ((r >> 2) & 1) + 4 * (r >> 3) + (r & 3); }

__device__ __forceinline__ void sb_attn_mfma(const bf16_t* Q, const bf16_t* Kb, const bf16_t* Vt, bf16_t* Yo, int bid, int G, int wave, int lane) {
    const int c = lane & 31, hh = lane >> 5, pr = pi32(c);
    bf16x8 U[2];
#pragma unroll
    for (int kk = 0; kk < 2; ++kk) { u32x4 uw;
#pragma unroll
        for (int q = 0; q < 4; ++q) uw[q] = ((16 * hh + 8 * kk + 2 * q > pr) ? 0x3F80u : 0u) | ((16 * hh + 8 * kk + 2 * q + 1 > pr) ? 0x3F800000u : 0u);
        U[kk] = __builtin_bit_cast(bf16x8, uw); }
    const int nu = wave < 4 ? 3 : 5, u0 = wave < 4 ? 20 + 3 * wave : 5 * (wave - 4);
    for (int vb = bid; vb < 256; vb += G)
    for (int iu = 0; iu < nu; ++iu) {
        const int ui = u0 + iu, k4 = ui >> 3, a = vb >> 4, bh = (vb & 15) * 8 + (ui & 7);
        const int qblk = k4 == 0 ? a : k4 == 1 ? 31 - a : k4 == 2 ? 32 + a : 63 - a;
        const int b = bh >> 3, h = bh & 7, t0 = qblk * 32;
        const bf16_t* qp = Q + (size_t)(b * SEQ + t0 + c) * 512 + h * 64; bf16_t* yp = Yo + (size_t)(b * SEQ + t0 + c) * 512 + h * 64;
        bf16x8 qf[4];
#pragma unroll
        for (int jj = 0; jj < 4; ++jj) qf[jj] = ldg8(qp + 16 * jj + 8 * hh);
        const bf16_t* kbase = Kb + (size_t)(b * SEQ + pr) * 512 + h * 64 + 8 * hh;
        const bf16_t* vbase = Vt + (size_t)(b * 16) * 512 * 128 + (size_t)(h * 64 + c) * 128 + 16 * hh;
        f32x16 o0, o1;
#pragma unroll
        for (int i = 0; i < 16; ++i) { o0[i] = 0.f; o1[i] = 0.f; }
        float R = 0.f;
        bf16x8 kf[4], vf[4], kn[4], vn[4];
#pragma unroll
        for (int jj = 0; jj < 4; ++jj) { kf[jj] = ldg8(kbase + (size_t)t0 * 512 + 16 * jj); vf[jj] = ldg8(vbase + (size_t)(t0 >> 7) * 512 * 128 + (t0 & 127) + (jj >> 1) * 32 * 128 + 8 * (jj & 1)); }
        for (int kb = qblk; kb >= 0; --kb) {
            const int s0 = kb * 32;
            if (kb > 0) {
#pragma unroll
                for (int jj = 0; jj < 4; ++jj) { kn[jj] = ldg8(kbase + (size_t)(s0 - 32) * 512 + 16 * jj); vn[jj] = ldg8(vbase + (size_t)((s0 - 32) >> 7) * 512 * 128 + ((s0 - 32) & 127) + (jj >> 1) * 32 * 128 + 8 * (jj & 1)); }
            }
            f32x16 s;
#pragma unroll
            for (int i = 0; i < 16; ++i) s[i] = 0.f;
#pragma unroll
            for (int jj = 0; jj < 4; ++jj) s = MFMA32(kf[jj], qf[jj], s);
            const bool diag = (kb == qblk);
            float sp[16]; float rsum = 0.f;
#pragma unroll
            for (int i = 0; i < 16; ++i) { const float x = s[i]; float v = fmaxf(x, 0.f) + __builtin_amdgcn_logf(1.f + __builtin_amdgcn_exp2f(-fabsf(x)));
                if (diag && !(16 * hh + i < c)) v = 0.f;
                sp[i] = v; rsum += v; }
            f32x16 E;
#pragma unroll
            for (int i = 0; i < 16; ++i) E[i] = 0.f;
            E = MFMA32(U[0], pack8(sp), E); E = MFMA32(U[1], pack8(sp + 8), E);
            float at[16];
#pragma unroll
            for (int i = 0; i < 16; ++i) { float av = __builtin_amdgcn_exp2f(s[i] - sp[i] - E[i] - R); if (diag && !(16 * hh + i < c)) av = 0.f; at[i] = av; }
            const bf16x8 a0 = pack8(at), a1 = pack8(at + 8);
            o0 = MFMA32(vf[0], a0, o0); o0 = MFMA32(vf[1], a1, o0);
            o1 = MFMA32(vf[2], a0, o1); o1 = MFMA32(vf[3], a1, o1);
            rsum += __shfl_xor(rsum, 32); R += rsum;
            if (__all(R > 160.f)) break;
#pragma unroll
            for (int jj = 0; jj < 4; ++jj) { kf[jj] = kn[jj]; vf[jj] = vn[jj]; }
        }
#pragma unroll
        for (int g = 0; g < 4; ++g) { u32x2 w0, w1; w0.x = cvt_pk_bf16(o0[4 * g], o0[4 * g + 1]); w0.y = cvt_pk_bf16(o0[4 * g + 2], o0[4 * g + 3]); w1.x = cvt_pk_bf16(o1[4 * g], o1[4 * g + 1]); w1.y = cvt_pk_bf16(o1[4 * g + 2], o1[4 * g + 3]);
            *(u32x2*)(yp + 8 * g + 4 * hh) = w0; *(u32x2*)(yp + 32 + 8 * g + 4 * hh) = w1; }
    }
}

__device__ __forceinline__ void xattn_lds(const bf16_t* XQ, const bf16_t* KMl, const bf16_t* VtMl, bf16_t* XO, int bid, int G, int tid, int wave, int lane, LAS unsigned char* lds) {
    constexpr int KP = 272, VP = 528;
    LAS unsigned char* Ks = lds; LAS unsigned char* Vs = lds + 256 * KP;
    const int c = lane & 31, hh = lane >> 5, pr = pi32(c);
    for (int u = bid; u < 256; u += G) { const int b = u >> 4, hd = (u >> 2) & 3, qz = u & 3;
        __syncthreads();
        { u32x4 kr[8], vr[8];
#pragma unroll
          for (int i = 0; i < 8; ++i) { const int idx = tid + 512 * i; kr[i] = *(const u32x4*)(KMl + (size_t)(b * MEMLEN + (idx >> 4)) * 2048 + hd * 128 + (idx & 15) * 8);
              vr[i] = *(const u32x4*)(VtMl + (size_t)(hd * 128 + (idx >> 5)) * TM + b * MEMLEN + (idx & 31) * 8); }
#pragma unroll
          for (int i = 0; i < 8; ++i) { const int idx = tid + 512 * i; *(LAS u32x4*)(Ks + (idx >> 4) * KP + (idx & 15) * 16) = kr[i]; *(LAS u32x4*)(Vs + (idx >> 5) * VP + (idx & 31) * 16) = vr[i]; } }
        __syncthreads();
        const LAS unsigned char* kl = Ks + pr * KP + 16 * hh;
        const LAS unsigned char* vl = Vs + c * VP + 32 * hh;
        for (int qi = 0; qi < 2; ++qi) { const int t0 = (qz * 16 + wave * 2 + qi) * 32;
            const bf16_t* qp = XQ + (size_t)(b * SEQ + t0 + c) * 512 + hd * 128 + 8 * hh;
            bf16x8 qf[8];
#pragma unroll
            for (int jj = 0; jj < 8; ++jj) qf[jj] = ldg8(qp + 16 * jj);
            float mx = -3.0e38f;
            for (int kb = 0; kb < 8; ++kb) { f32x16 sc;
#pragma unroll
                for (int i = 0; i < 16; ++i) sc[i] = 0.f;
#pragma unroll
                for (int jj = 0; jj < 8; ++jj) sc = MFMA32(*(const LAS bf16x8*)(kl + kb * 32 * KP + 32 * jj), qf[jj], sc);
#pragma unroll
                for (int i = 0; i < 16; ++i) mx = fmaxf(mx, sc[i]); }
            mx = fmaxf(mx, __shfl_xor(mx, 32));
            f32x16 o[4];
#pragma unroll
            for (int db = 0; db < 4; ++db)
#pragma unroll
                for (int i = 0; i < 16; ++i) o[db][i] = 0.f;
            float sum = 0.f;
            for (int kb = 0; kb < 8; ++kb) { f32x16 sc;
#pragma unroll
                for (int i = 0; i < 16; ++i) sc[i] = 0.f;
#pragma unroll
                for (int jj = 0; jj < 8; ++jj) sc = MFMA32(*(const LAS bf16x8*)(kl + kb * 32 * KP + 32 * jj), qf[jj], sc);
                float pv[16];
#pragma unroll
                for (int i = 0; i < 16; ++i) { pv[i] = __builtin_amdgcn_exp2f(sc[i] - mx); sum += pv[i]; }
                const bf16x8 p0 = pack8(pv), p1 = pack8(pv + 8);
#pragma unroll
                for (int db = 0; db < 4; ++db) { const LAS unsigned char* vp = vl + db * 32 * VP + kb * 64; o[db] = MFMA32(*(const LAS bf16x8*)vp, p0, o[db]); o[db] = MFMA32(*(const LAS bf16x8*)(vp + 16), p1, o[db]); } }
            sum += __shfl_xor(sum, 32);
            const float inv = 1.f / sum;
            bf16_t* op = XO + (size_t)(b * SEQ + t0 + c) * 512 + hd * 128 + 4 * hh;
#pragma unroll
            for (int db = 0; db < 4; ++db)
#pragma unroll
                for (int g = 0; g < 4; ++g) { u32x2 w0; w0.x = cvt_pk_bf16(o[db][4 * g] * inv, o[db][4 * g + 1] * inv); w0.y = cvt_pk_bf16(o[db][4 * g + 2] * inv, o[db][4 * g + 3] * inv);
                    *(u32x2*)(op + 32 * db + 8 * g) = w0; }
        }
    }
}

template <int CTRL, int ROWMASK> __device__ __forceinline__ float dpp_mov0(float v) { return __builtin_bit_cast(float, __builtin_amdgcn_update_dpp(0, __builtin_bit_cast(int, v), CTRL, ROWMASK, 0xF, false)); }
__device__ __forceinline__ float wave_incl_scan(float v, int) {
    v += dpp_mov0<0x111, 0xF>(v); v += dpp_mov0<0x112, 0xF>(v); v += dpp_mov0<0x114, 0xF>(v); v += dpp_mov0<0x118, 0xF>(v);
    v += dpp_mov0<0x142, 0xA>(v); v += dpp_mov0<0x143, 0xC>(v);
    return v;
}
__device__ __forceinline__ float lane63(float v) { return __builtin_bit_cast(float, __builtin_amdgcn_readlane(__builtin_bit_cast(int, v), 63)); }
__device__ __forceinline__ void conv_unit(const bf16_t* XBC, const float* cw, const float* cb, bf16_t* XT, bf16_t* BR, bf16_t* BT, bf16_t* CR, int u, int lane) {
    const int tb = u / 10, cbk = u - tb * 10, tok0 = tb * 64, ch0 = cbk * 128 + 2 * lane;
    float w[4][2], bs[2];
#pragma unroll
    for (int k = 0; k < 4; ++k) { w[k][0] = cw[k * 1280 + ch0]; w[k][1] = cw[k * 1280 + ch0 + 1]; }
    bs[0] = cb[ch0]; bs[1] = cb[ch0 + 1];
    const bf16_t* src = XBC + (size_t)tok0 * 1280 + ch0;
    float h0[2] = {0.f, 0.f}, h1[2] = {0.f, 0.f}, h2[2] = {0.f, 0.f};
    if ((tok0 & (SEQ - 1)) != 0) { const unsigned a = *(const unsigned*)(src - 3 * 1280), b = *(const unsigned*)(src - 2 * 1280), c = *(const unsigned*)(src - 1280);
        h0[0] = bflo(a); h0[1] = bfhi(a); h1[0] = bflo(b); h1[1] = bfhi(b); h2[0] = bflo(c); h2[1] = bfhi(c); }
    unsigned ylo[32], yhi[32]; float pe0 = 0.f, pe1 = 0.f;
    bf16_t* rdst = (cbk == 8) ? BR : CR;
#pragma unroll
    for (int tt = 0; tt < 64; ++tt) { const unsigned xw = *(const unsigned*)(src + (size_t)tt * 1280); const float x0 = bflo(xw), x1 = bfhi(xw);
        float v0 = bs[0] + w[0][0] * h0[0] + w[1][0] * h1[0] + w[2][0] * h2[0] + w[3][0] * x0, v1 = bs[1] + w[0][1] * h0[1] + w[1][1] * h1[1] + w[2][1] * h2[1] + w[3][1] * x1;
        v0 *= sigmoidf_(v0); v1 *= sigmoidf_(v1);
        h0[0] = h1[0]; h0[1] = h1[1]; h1[0] = h2[0]; h1[1] = h2[1]; h2[0] = x0; h2[1] = x1;
        if (cbk >= 8) *(unsigned*)(rdst + (size_t)(tok0 + tt) * 128 + 2 * lane) = cvt_pk_bf16(v0, v1);
        if (tt & 1) { ylo[tt >> 1] = cvt_pk_bf16(pe0, v0); yhi[tt >> 1] = cvt_pk_bf16(pe1, v1); } else { pe0 = v0; pe1 = v1; } }
    if (cbk <= 8) { bf16_t* tbase = (cbk < 8) ? XT + ((size_t)(tok0 >> 7) * 1024 + ch0) * 128 + (tok0 & 127) : BT + ((size_t)(tok0 >> 7) * 128 + 2 * lane) * 128 + (tok0 & 127);
#pragma unroll
        for (int q = 0; q < 8; ++q) { u32x4 a, b; a.x = ylo[4 * q]; a.y = ylo[4 * q + 1]; a.z = ylo[4 * q + 2]; a.w = ylo[4 * q + 3]; b.x = yhi[4 * q]; b.y = yhi[4 * q + 1]; b.z = yhi[4 * q + 2]; b.w = yhi[4 * q + 3];
            *(u32x4*)(tbase + 8 * q) = a; *(u32x4*)(tbase + 128 + 8 * q) = b; } }
}
__device__ __forceinline__ void ssd_scan_unit(const bf16_t* XT, const bf16_t* BT, const float* DTT, bf16_t* PREV, float negA, int b, int h, int pblk, int nblk, LAS float* wl, int lane) {
    const int c32 = lane & 31, hh = lane >> 5, g = h >> 3;
    const bf16_t* xrow = XT + ((size_t)(b * 16) * 1024 + h * 64 + pblk * 32 + c32) * 128 + 8 * hh;
    const bf16_t* brow = BT + ((size_t)(b * 16) * 128 + g * 64 + nblk * 32 + c32) * 128 + 8 * hh;
    const float* dtp = DTT + (size_t)h * T + b * SEQ + lane;
    f32x16 st;
#pragma unroll
    for (int i = 0; i < 16; ++i) st[i] = 0.f;
    u32x4 xa[8], xn[8]; bf16x8 ba[8], bn[8]; float d0 = dtp[0], d1 = dtp[64], e0 = 0.f, e1 = 0.f;
#pragma unroll
    for (int ks = 0; ks < 8; ++ks) { xa[ks] = *(const u32x4*)(xrow + 16 * ks); ba[ks] = ldg8(brow + 16 * ks); }
    for (int c = 0; c < 16; ++c) {
        if (c < 15) { e0 = dtp[(c + 1) * 128]; e1 = dtp[(c + 1) * 128 + 64];
#pragma unroll
            for (int ks = 0; ks < 8; ++ks) { xn[ks] = *(const u32x4*)(xrow + (size_t)(c + 1) * 1024 * 128 + 16 * ks); bn[ks] = ldg8(brow + (size_t)(c + 1) * 128 * 128 + 16 * ks); } }
        bf16_t* pv = PREV + ((size_t)((b * 16 + c) * 16 + h) * 64 + pblk * 32) * 64 + nblk * 32 + c32;
#pragma unroll
        for (int i = 0; i < 16; ++i) pv[(8 * (i >> 2) + 4 * hh + (i & 3)) * 64] = f2bf(st[i]);
        const float s0 = wave_incl_scan(d0 * negA, lane); const float tot0 = lane63(s0);
        const float s1 = wave_incl_scan(d1 * negA, lane) + tot0; const float last = lane63(s1);
        wl[lane] = d0 * fexp(last - s0); wl[64 + lane] = d1 * fexp(last - s1);
        const float dec = fexp(last);
#pragma unroll
        for (int i = 0; i < 16; ++i) st[i] *= dec;
#pragma unroll
        for (int ks = 0; ks < 8; ++ks) { const u32x4 xw = xa[ks];
            const f32x4 wa = *(const LAS f32x4*)(wl + 16 * ks + 8 * hh), wb = *(const LAS f32x4*)(wl + 16 * ks + 8 * hh + 4);
            float xs[8]; xs[0] = bflo(xw.x) * wa.x; xs[1] = bfhi(xw.x) * wa.y; xs[2] = bflo(xw.y) * wa.z; xs[3] = bfhi(xw.y) * wa.w; xs[4] = bflo(xw.z) * wb.x; xs[5] = bfhi(xw.z) * wb.y; xs[6] = bflo(xw.w) * wb.z; xs[7] = bfhi(xw.w) * wb.w;
            st = MFMA32(pack8(xs), ba[ks], st); }
        d0 = e0; d1 = e1;
#pragma unroll
        for (int ks = 0; ks < 8; ++ks) { xa[ks] = xn[ks]; ba[ks] = bn[ks]; }
    }
}
__device__ __forceinline__ void ssd_out_unit(const bf16_t* XT, const bf16_t* BR, const bf16_t* CR, const float* DTT, const bf16_t* PREV, const bf16_t* Zb, bf16_t* Y, float negA, float dsk,
                                             int b, int c, int g, int wave, int lane, LAS float* tab  , LAS float* red  ) {
    const int c32 = lane & 31, hh = lane >> 5, pr = pi32(c32), h = g * 8 + wave;
    const int tokc = b * SEQ + c * 128;
    const float* dtp = DTT + (size_t)h * T + tokc + lane;
    const float d0 = dtp[0], d1 = dtp[64];
    const bf16_t* pv = PREV + ((size_t)((b * 16 + c) * 16 + h) * 64 + c32) * 64 + 8 * hh;
    const bf16_t* xrow = XT + ((size_t)(b * 16 + c) * 1024 + h * 64 + c32) * 128 + 16 * hh;
    const bf16_t* brow = BR + (size_t)(tokc + pr) * 128 + g * 64 + 8 * hh;
    const float s0 = wave_incl_scan(d0 * negA, lane); const float tot0 = lane63(s0);
    const float s1 = wave_incl_scan(d1 * negA, lane) + tot0;
    tab[lane] = s0; tab[64 + lane] = s1; tab[128 + lane] = d0; tab[192 + lane] = d1;
    for (int tq = 0; tq < 4; ++tq) {
        const size_t tokg = (size_t)(tokc + tq * 32 + c32);
        bf16x8 cf[4], pf[8];
#pragma unroll
        for (int ks = 0; ks < 4; ++ks) cf[ks] = ldg8(CR + tokg * 128 + g * 64 + 16 * ks + 8 * hh);
#pragma unroll
        for (int ks = 0; ks < 4; ++ks) { pf[ks] = ldg8(pv + 16 * ks); pf[4 + ks] = ldg8(pv + 32 * 64 + 16 * ks); }
        bf16x8 bfr[4], xfr[4], bnx[4], xnx[4];
#pragma unroll
        for (int ks = 0; ks < 4; ++ks) bfr[ks] = ldg8(brow + 16 * ks);
        xfr[0] = ldg8(xrow); xfr[1] = ldg8(xrow + 8); xfr[2] = ldg8(xrow + 32 * 128); xfr[3] = ldg8(xrow + 32 * 128 + 8);
        const bf16_t* zp = Zb + tokg * 1024 + h * 64 + 4 * hh;
        u32x2 zr[8];
#pragma unroll
        for (int gq = 0; gq < 4; ++gq) { zr[gq] = *(const u32x2*)(zp + 8 * gq); zr[4 + gq] = *(const u32x2*)(zp + 32 + 8 * gq); }
        const float acum_t = tab[tq * 32 + c32];
        f32x16 y0, y1;
#pragma unroll
        for (int i = 0; i < 16; ++i) { y0[i] = 0.f; y1[i] = 0.f; }
#pragma unroll
        for (int ks = 0; ks < 4; ++ks) { y0 = MFMA32(pf[ks], cf[ks], y0); y1 = MFMA32(pf[4 + ks], cf[ks], y1); }
        { const float ea = fexp(acum_t);
#pragma unroll
          for (int i = 0; i < 16; ++i) { y0[i] *= ea; y1[i] *= ea; } }
        for (int j = 0; j <= tq; ++j) {
            if (j < tq) {
#pragma unroll
                for (int ks = 0; ks < 4; ++ks) bnx[ks] = ldg8(brow + (size_t)(32 * (j + 1)) * 128 + 16 * ks);
                xnx[0] = ldg8(xrow + 32 * (j + 1)); xnx[1] = ldg8(xrow + 32 * (j + 1) + 8); xnx[2] = ldg8(xrow + 32 * 128 + 32 * (j + 1)); xnx[3] = ldg8(xrow + 32 * 128 + 32 * (j + 1) + 8); }
            f32x16 cbt;
#pragma unroll
            for (int i = 0; i < 16; ++i) cbt[i] = 0.f;
#pragma unroll
            for (int ks = 0; ks < 4; ++ks) cbt = MFMA32(bfr[ks], cf[ks], cbt);
            float m[16];
#pragma unroll
            for (int q = 0; q < 4; ++q) { const f32x4 as = *(const LAS f32x4*)(tab + 32 * j + 16 * hh + 4 * q), ds = *(const LAS f32x4*)(tab + 128 + 32 * j + 16 * hh + 4 * q);
#pragma unroll
                for (int e = 0; e < 4; ++e) { const int i = 4 * q + e; float v = cbt[i] * ds[e] * fexp(acum_t - as[e]);
                    if (j == tq) { if (16 * hh + i > c32) v = 0.f; if (16 * hh + i == c32) v += dsk; }
                    m[i] = v; } }
            const bf16x8 m0 = pack8(m), m1 = pack8(m + 8);
            y0 = MFMA32(xfr[0], m0, y0); y0 = MFMA32(xfr[1], m1, y0);
            y1 = MFMA32(xfr[2], m0, y1); y1 = MFMA32(xfr[3], m1, y1);
#pragma unroll
            for (int ks = 0; ks < 4; ++ks) { bfr[ks] = bnx[ks]; xfr[ks] = xnx[ks]; }
        }
        float ss = 0.f;
#pragma unroll
        for (int gq = 0; gq < 4; ++gq) { const u32x2 za = zr[gq], zb2 = zr[4 + gq];
            const float z0[4] = {bflo(za.x), bfhi(za.x), bflo(za.y), bfhi(za.y)}, z1[4] = {bflo(zb2.x), bfhi(zb2.x), bflo(zb2.y), bfhi(zb2.y)};
#pragma unroll
            for (int e = 0; e < 4; ++e) { const int i = 4 * gq + e; y0[i] *= z0[e] * sigmoidf_(z0[e]); y1[i] *= z1[e] * sigmoidf_(z1[e]); ss += y0[i] * y0[i] + y1[i] * y1[i]; } }
        ss += __shfl_xor(ss, 32);
        LAS float* rd = red + (tq & 1) * 256;
        if (hh == 0) rd[wave * 32 + c32] = ss;
        asm volatile("s_waitcnt lgkmcnt(0)" ::: "memory"); __builtin_amdgcn_s_barrier(); asm volatile("" ::: "memory");
        float tot = 0.f;
#pragma unroll
        for (int w8 = 0; w8 < 8; ++w8) tot += rd[w8 * 32 + c32];
        const float rstd = __builtin_amdgcn_rsqf(tot * (1.f / 512.f) + EPS);
        bf16_t* yp = Y + tokg * 1024 + h * 64 + 4 * hh;
#pragma unroll
        for (int gq = 0; gq < 4; ++gq) { u32x2 o0, o1; o0.x = cvt_pk_bf16(y0[4 * gq] * rstd, y0[4 * gq + 1] * rstd); o0.y = cvt_pk_bf16(y0[4 * gq + 2] * rstd, y0[4 * gq + 3] * rstd);
            o1.x = cvt_pk_bf16(y1[4 * gq] * rstd, y1[4 * gq + 1] * rstd); o1.y = cvt_pk_bf16(y1[4 * gq + 2] * rstd, y1[4 * gq + 3] * rstd);
            *(u32x2*)(yp + 8 * gq) = o0; *(u32x2*)(yp + 32 + 8 * gq) = o1; }
    }
}

#define PHASE_ENTER() GAS unsigned char* ws_ = (GAS unsigned char*)p.ws; asm volatile("" : "+s"(ws_)); unsigned char* const ws = (unsigned char*)ws_;     \
    GAS float* out_ = (GAS float*)p.out; asm volatile("" : "+s"(out_)); float* const OUTP = (float*)out_; (void)OUTP; int tid_ = wave0 * 64 + lane_id_opaque(); int bid_ = blockIdx.x; asm volatile("" : "+s"(bid_)); \
    const int tid = tid_, lane = tid & 63, wave = __builtin_amdgcn_readfirstlane(tid >> 6); \
    const int G = gridDim.x, bid = bid_, gw = bid * 8 + wave, NGW = G * 8; (void)lane; (void)gw; (void)NGW; (void)wave; (void)bid; (void)G
#define WSP(type, off) ((type*)(ws + (off)))
__global__ void __launch_bounds__(512, 2) mk_fwd(Params p) {
    extern __shared__ __attribute__((aligned(16))) unsigned char lds_raw[];
    LAS unsigned char* lds = (LAS unsigned char*)lds_raw;
    volatile LAS unsigned* ldsctl = (volatile LAS unsigned*)(lds + LDSCTL_OFF);
    if (threadIdx.x < 64) ldsctl[threadIdx.x] = 0u;
    int wave0 = __builtin_amdgcn_readfirstlane((int)threadIdx.x >> 6); asm volatile("" : "+s"(wave0));
    __syncthreads();
    const int ph_lo = p.ph_lo, ph_hi = p.ph_hi;
    const bool use_bar = (ph_hi - ph_lo) > 1 || (p.l_hi - p.l_lo) > 1;
    XcdBarrier bar; bar.bar = (unsigned*)(p.ws + WS_CTL) + CW_BAR; bar.x = 0; bar.st = nullptr;
    if (use_bar) bar = xcd_barrier_post((unsigned*)(p.ws + WS_CTL) + CW_BAR, ldsctl + 8);
#define PH(k) (ph_lo <= (k) && (k) < ph_hi)
#define GRID_BAR() do { if (use_bar) xcd_barrier(bar, wave0 == 0 && lane_id_opaque() == 0); } while (0)

    if (p.l_lo == 0 && PH(0)) for (int rep = 0; rep < NREP(0); ++rep) {
        PHASE_ENTER();
        LAS float* scr = (LAS float*)(lds + wave * 16384);
        int base = 0;
        for (int jb = 0; jb < 4 * 12 + 2 * 3; ++jb) {
            TrJob j;
            if (jb < 48) { const int l = jb / 12, k = jb % 12; unsigned char* wl = ws + WS_W + (size_t)l * W_LAYER;
                switch (k) {
                case 0: j = TrJob{p.in[I_W_IN] + (size_t)l * D * INW, INW, D, 0, 2304, p.in[I_NORM_MIX] + l * D, (bf16_t*)(wl + W_IN), 0, 128}; break;
                case 1: j = TrJob{p.in[I_W_IN] + (size_t)l * D * INW, INW, D, 2320, 1024, p.in[I_NORM_MIX] + l * D, (bf16_t*)(wl + W_IN), 2304, 128}; break;
                case 9: j = TrJob{p.in[I_W_IN] + (size_t)l * D * INW, INW, D, 3344, 512, p.in[I_NORM_MIX] + l * D, (bf16_t*)(wl + W_IN), NMAIN, 128}; break;
                case 11: j = TrJob{p.in[I_W_IN] + (size_t)l * D * INW, INW, D, 2304, 32, p.in[I_NORM_MIX] + l * D, (bf16_t*)(wl + W_IN), 5376, 128}; break;
                case 10: j = TrJob{p.in[I_W_IN] + (size_t)l * D * INW, INW, D, 3856, 2048, p.in[I_NORM_MIX] + l * D, (bf16_t*)(wl + W_IN), 3328, 128}; break;
                case 2: j = TrJob{p.in[I_W_SSD_O] + (size_t)l * D * D, D, D, 0, D, p.in[I_SSD_NORM] + l * D, (bf16_t*)(wl + W_SSDO), 0, 128}; break;
                case 3: j = TrJob{p.in[I_W_SB_O] + (size_t)l * 512 * D, D, 512, 0, D, nullptr, (bf16_t*)(wl + W_SBO), 0, 128}; break;
                case 4: j = TrJob{p.in[I_W_OUT] + (size_t)l * D * D, D, D, 0, D, nullptr, (bf16_t*)(wl + W_OUT), 0, 128}; break;
                case 5: j = TrJob{p.in[I_XA_WQ] + (size_t)l * D * 512, 512, D, 0, 512, p.in[I_NORM_XA] + l * D, (bf16_t*)(wl + W_Q), 0, 128}; break;
                case 6: j = TrJob{p.in[I_XA_WK] + (size_t)l * D * 512, 512, D, 0, 512, p.in[I_NORM_MEM] + l * D, (bf16_t*)(ws + WS_WKV), l * 512, 128}; break;
                case 7: j = TrJob{p.in[I_XA_WV] + (size_t)l * D * 512, 512, D, 0, 512, p.in[I_NORM_MEM] + l * D, (bf16_t*)(ws + WS_WKV), 2048 + l * 512, 128}; break;
                case 8: j = TrJob{p.in[I_XA_WO] + (size_t)l * 512 * D, D, 512, 0, D, nullptr, (bf16_t*)(wl + W_O), 0, 128}; break;
                }
            } else { const int jj = (jb - 48) / 3, k = (jb - 48) % 3; unsigned char* wf = ws + WS_WFF + (size_t)jj * W_FF; const float* gn = p.in[I_NORM_FFN] + (2 * jj) * D;
                if (k == 0) j = TrJob{p.in[I_FFN_G] + (size_t)jj * D * DFF, DFF, D, 0, DFF, gn, (bf16_t*)(wf + W_GU), 0, 256};
                else if (k == 1) j = TrJob{p.in[I_FFN_U] + (size_t)jj * D * DFF, DFF, D, 0, DFF, gn, (bf16_t*)(wf + W_GU), 128, 256};
                else j = TrJob{p.in[I_FFN_D] + (size_t)jj * DFF * D, D, DFF, 0, D, nullptr, (bf16_t*)(wf + W_DN), 0, 128};
            }
            run_job(j, base, gw, NGW, scr, lane);
        }
        bf16_t* MEMB = WSP(bf16_t, WS_MEMB); float* RSMEM = WSP(float, WS_RSMEM);
        for (int m = gw; m < TM; m += NGW) { const float q = row_to_bf16(p.in[I_MEM] + (size_t)m * D, MEMB + (size_t)m * D, lane); if (lane == 0) RSMEM[m] = __builtin_amdgcn_rsqf(q * (1.f / D) + EPS); }
        { bf16_t* HB = WSP(bf16_t, WS_HB); float* SSQ = WSP(float, WS_SSQ + (size_t)(12) * SSQ_BYTES);
          for (int m = gw; m < T; m += NGW) { const float q = row_to_bf16(p.in[I_X] + (size_t)m * D, HB + (size_t)m * D, lane); if (lane < 4) SSQ[(size_t)m * 4 + lane] = lane == 0 ? q : 0.f; } }
        for (int it = gw; it < 4 * 224; it += NGW) { const int l = it / 224, r = 5408 + it % 224;
            u32x4* dst = (u32x4*)(WSP(bf16_t, WS_W + (size_t)l * W_LAYER + W_IN) + (size_t)r * 1024); const u32x4 zz = {0u, 0u, 0u, 0u}; dst[lane] = zz; dst[lane + 64] = zz; }
        GRID_BAR();
    }
    if (p.l_lo == 0 && PH(1)) for (int rep = 0; rep < NREP(1); ++rep) {
        PHASE_ENTER();
        { pg8::Gemm g{WSP(bf16_t, WS_MEMB), WSP(bf16_t, WS_WKV), D, D, D}; pg8::StaticOrder S; S.init(TM, 2048, G, bid);
          pg8::EpiBf16Rs E{WSP(bf16_t, WS_KM), 2048, WSP(float, WS_RSMEM), 1.f, 0};
          pg8::gemm_phase<pg8::EpiBf16Rs, pg8::StaticOrder, true, true>(lds, g, S, E, wave0); }
        { pg8::Gemm g{WSP(bf16_t, WS_WKV) + (size_t)2048 * 1024, WSP(bf16_t, WS_MEMB), D, D, D}; pg8::StaticOrder S; S.init(2048, TM, G, (bid + G / 2) % G);
          pg8::EpiBf16Cs E{WSP(bf16_t, WS_VTM), TM, WSP(float, WS_RSMEM), 1.f, 0};
          pg8::gemm_phase<pg8::EpiBf16Cs, pg8::StaticOrder, true, true>(lds, g, S, E, wave0); }
        GRID_BAR();
    }

    for (int l = p.l_lo; l < p.l_hi; ++l) {
        const bool moe = (l & 1) != 0; const int jf = l >> 1;

        if (PH(3)) for (int rep = 0; rep < NREP(3); ++rep) {
            PHASE_ENTER();
            pg8::Gemm g{WSP(bf16_t, WS_HB), (const bf16_t*)(ws + WS_W + (size_t)l * W_LAYER + W_IN), D, D, D}; pg8::StaticOrder S; S.init(T, NMAIN, G, bid);
            pg8::EpiInProj E{ws + WS_X, WSP(float, WS_SSQ + (size_t)(l == 0 ? 12 : 3 * l - 1) * SSQ_BYTES), WSP(float, WS_RS), WSP(float, WS_DT), p.in[I_DT_BIAS] + l * 16};
            pg8::gemm_phase<pg8::EpiInProj, pg8::StaticOrder, true, true>(lds, g, S, E, wave0);
            GRID_BAR();
        }
        if (PH(4)) for (int rep = 0; rep < NREP(4); ++rep) {
            PHASE_ENTER();
            const float* cw = p.in[I_CONV_W] + (size_t)l * 4 * 1280; const float* cb = p.in[I_CONV_B] + (size_t)l * 1280;
            for (int u = gw; u < (T / 64) * 10; u += NGW) conv_unit(WSP(bf16_t, WS_X + X_XBC), cw, cb, WSP(bf16_t, WS_X + X_XT), WSP(bf16_t, WS_X + X_BR), WSP(bf16_t, WS_X + X_BT), WSP(bf16_t, WS_X + X_CR), u, lane);
            { pg8::Gemm g{(const bf16_t*)(ws + WS_W + (size_t)l * W_LAYER + W_IN) + (size_t)NMAIN * 1024, WSP(bf16_t, WS_HB), D, D, D}; pg8::StaticOrder S; S.init(512, T, G, bid);
              pg8::EpiBf16Cs E{WSP(bf16_t, WS_X + X_V), T, WSP(float, WS_RS), 1.f, 512};
              pg8::gemm_phase<pg8::EpiBf16Cs, pg8::StaticOrder, true, true>(lds, g, S, E, wave0); }
            if (moe) {
                LAS float* scr = (LAS float*)(lds + wave * 16384);
                int base = 0; const float* gn = p.in[I_NORM_FFN] + l * D;
                for (int jb = 0; jb < NEXP * 3; ++jb) { const int e = jb / 3, k = jb % 3; TrJob j; const size_t eo = ((size_t)jf * NEXP + e) * D * DFF;
                    if (k == 0) j = TrJob{p.in[I_MOE_G] + eo, DFF, D, 0, DFF, gn, (bf16_t*)(ws + WS_WMOE + WM_GU) + (size_t)e * 2 * DFF * 1024, 0, 256};
                    else if (k == 1) j = TrJob{p.in[I_MOE_U] + eo, DFF, D, 0, DFF, gn, (bf16_t*)(ws + WS_WMOE + WM_GU) + (size_t)e * 2 * DFF * 1024, 128, 256};
                    else j = TrJob{p.in[I_MOE_D] + eo, D, DFF, 0, D, nullptr, (bf16_t*)(ws + WS_WMOE + WM_DN) + (size_t)e * 1024 * DFF, 0, 128};
                    run_job(j, base, gw, NGW, scr, lane); }
            }
            GRID_BAR();
        }
        if (PH(5)) for (int rep = 0; rep < NREP(5); ++rep) {
            PHASE_ENTER();
            if (wave < 4 && bid * 4 + wave < NBATCH * 16 * 4) { const int su = bid * 4 + wave, b = su >> 6, h = (su >> 2) & 15, pblk = (su >> 1) & 1, nblk = su & 1;
                ssd_scan_unit(WSP(bf16_t, WS_X + X_XT), WSP(bf16_t, WS_X + X_BT), WSP(float, WS_DT), WSP(bf16_t, WS_X + X_PREV), -fexp(p.in[I_A_LOG][l * 16 + h]), b, h, pblk, nblk, (LAS float*)(lds + wave * 1024), lane); }
            sb_attn_mfma(WSP(bf16_t, WS_X + X_Q), WSP(bf16_t, WS_X + X_K), WSP(bf16_t, WS_X + X_V), (rep + 1 < NREP(5)) ? WSP(bf16_t, WS_X + X_XBC) : WSP(bf16_t, WS_X + X_Q), bid, G, wave, lane);
            GRID_BAR();
        }
        if (PH(6)) for (int rep = 0; rep < NREP(6); ++rep) {
            PHASE_ENTER();
            for (int u = bid; u < 512; u += G) { const int b = u >> 5, c = (u >> 1) & 15, g = u & 1; const int h = g * 8 + wave;
                ssd_out_unit(WSP(bf16_t, WS_X + X_XT), WSP(bf16_t, WS_X + X_BR), WSP(bf16_t, WS_X + X_CR), WSP(float, WS_DT), WSP(bf16_t, WS_X + X_PREV), WSP(bf16_t, WS_X + X_Z), WSP(bf16_t, WS_X + X_XBC),
                             -fexp(p.in[I_A_LOG][l * 16 + h]), p.in[I_D_SKIP][l * 16 + h], b, c, g, wave, lane, (LAS float*)(lds + wave * 1024), (LAS float*)(lds + 8192)); }
            GRID_BAR();
        }
        if (PH(7)) for (int rep = 0; rep < NREP(7); ++rep) {
            PHASE_ENTER();
            pg8::Gemm g{WSP(bf16_t, WS_X + X_XBC), (const bf16_t*)(ws + WS_W + (size_t)l * W_LAYER + W_SSDO), D, D, D}; pg8::StaticOrder S; S.init(T, D, G, bid);
            pg8::EpiGate<false> E{WSP(bf16_t, WS_X + X_Z), WSP(bf16_t, WS_X + X_GS), 0, WSP(bf16_t, WS_X + X_Z)};
            pg8::gemm_phase<pg8::EpiGate<false>, pg8::StaticOrder, true, true>(lds, g, S, E, wave0);
        }
        if (PH(8)) for (int rep = 0; rep < NREP(8); ++rep) {
            PHASE_ENTER();
            pg8::Gemm g{WSP(bf16_t, WS_X + X_Q), (const bf16_t*)(ws + WS_W + (size_t)l * W_LAYER + W_SBO), 512, 512, 512}; pg8::StaticOrder S; S.init(T, D, G, bid);
            pg8::EpiGate<true> E{(rep + 1 < NREP(8)) ? WSP(bf16_t, WS_X + X_XT) : WSP(bf16_t, WS_X + X_Z), WSP(bf16_t, WS_X + X_GS), 1024, WSP(bf16_t, WS_X + X_Z)};
            pg8::gemm_phase<pg8::EpiGate<true>, pg8::StaticOrder, true, true>(lds, g, S, E, wave0);
            GRID_BAR();
        }
        if (PH(9)) for (int rep = 0; rep < NREP(9); ++rep) {
            PHASE_ENTER();
            pg8::Gemm g{WSP(bf16_t, WS_X + X_Z), (const bf16_t*)(ws + WS_W + (size_t)l * W_LAYER + W_OUT), D, D, D}; pg8::StaticOrder S; S.init(T, D, G, bid);
            pg8::EpiResidBf E{WSP(bf16_t, WS_HB), (rep + 1 < NREP(9)) ? WSP(bf16_t, WS_X + X_XT) : WSP(bf16_t, WS_HB), WSP(float, WS_SSQ + (size_t)((rep + 1 < NREP(9)) ? 13 : 3 * l) * SSQ_BYTES), (LAS float*)(lds + 131072)};
            pg8::gemm_phase<pg8::EpiResidBf, pg8::StaticOrder, true, true>(lds, g, S, E, wave0);
            GRID_BAR();
        }
        if (PH(11)) for (int rep = 0; rep < NREP(11); ++rep) {
            PHASE_ENTER();
            pg8::Gemm g{WSP(bf16_t, WS_HB), (const bf16_t*)(ws + WS_W + (size_t)l * W_LAYER + W_Q), D, D, D}; pg8::StaticOrder S; S.init(T, 512, G, bid);
            pg8::EpiBf16Rs E{WSP(bf16_t, WS_X + X_K), 512, WSP(float, WS_SSQ + (size_t)(3 * l) * SSQ_BYTES), 0.12751743082459868f, 1};
            pg8::gemm_phase<pg8::EpiBf16Rs, pg8::StaticOrder, true, true>(lds, g, S, E, wave0);
            GRID_BAR();
        }
        if (PH(12)) for (int rep = 0; rep < NREP(12); ++rep) {
            PHASE_ENTER();
            xattn_lds(WSP(bf16_t, WS_X + X_K), WSP(bf16_t, WS_KM) + l * 512, WSP(bf16_t, WS_VTM) + (size_t)l * 512 * TM, WSP(bf16_t, WS_X + X_V), bid, G, tid, wave, lane, lds);
            GRID_BAR();
        }
        if (PH(13)) for (int rep = 0; rep < NREP(13); ++rep) {
            PHASE_ENTER();
            pg8::Gemm g{WSP(bf16_t, WS_X + X_V), (const bf16_t*)(ws + WS_W + (size_t)l * W_LAYER + W_O), 512, 512, 512}; pg8::StaticOrder S; S.init(T, D, G, bid);
            pg8::EpiResidBf E{WSP(bf16_t, WS_HB), (rep + 1 < NREP(13)) ? WSP(bf16_t, WS_X + X_XT) : WSP(bf16_t, WS_HB), WSP(float, WS_SSQ + (size_t)((rep + 1 < NREP(13)) ? 13 : 3 * l + 1) * SSQ_BYTES), (LAS float*)(lds + 131072)};
            pg8::gemm_phase<pg8::EpiResidBf, pg8::StaticOrder, true, true>(lds, g, S, E, wave0);
            GRID_BAR();
        }
        if (moe && PH(14)) for (int rep = 0; rep < NREP(14); ++rep) {
            PHASE_ENTER();
            const bf16_t* HB = WSP(bf16_t, WS_HB); float* RS = WSP(float, WS_RS); const float* SSQ = WSP(float, WS_SSQ + (size_t)(3 * l + 1) * SSQ_BYTES);
            int* TE = WSP(int, WS_MOE + MO_TE); float* TW = WSP(float, WS_MOE + MO_TW); int* TP = WSP(int, WS_MOE + MO_TP); unsigned* CNT = WSP(unsigned, WS_CTL) + CW_CNT + jf * 16;
            LAS float* wsm = (LAS float*)lds;
            for (int i = tid; i < 8 * 1024; i += 512) { const int e = i >> 10, k = i & 1023; wsm[i] = p.in[I_MOE_R][(size_t)jf * D * NEXP + (size_t)k * NEXP + e] * p.in[I_NORM_FFN][l * D + k]; }
            __syncthreads();
            for (int m = gw; m < T; m += NGW) { float lg[8]; const float r = rstd4(SSQ + (size_t)m * 4);
                row_dots_bf16<8>(HB + (size_t)m * D, lane, wsm, r, lg);
                if (lane == 0 && rep + 1 == NREP(14)) { RS[m] = r;
                    int i0 = 0; float v0 = lg[0];
#pragma unroll
                    for (int e = 1; e < 8; ++e) if (lg[e] > v0) { v0 = lg[e]; i0 = e; }
                    int i1 = -1; float v1 = -3.0e38f;
#pragma unroll
                    for (int e = 0; e < 8; ++e) if (e != i0 && lg[e] > v1) { v1 = lg[e]; i1 = e; }
                    const float w0 = __builtin_amdgcn_rcpf(1.f + fexp(v1 - v0));
                    const unsigned p0 = atomicAdd(CNT + i0, 1u), p1 = atomicAdd(CNT + 8 + i1, 1u);
                    TE[m] = i0; TE[T + m] = i1; TW[m] = w0; TW[T + m] = 1.f - w0; TP[m] = (int)p0; TP[T + m] = (int)p1; }
            }
            GRID_BAR();
        }
        if (!moe) {
            if (PH(15)) for (int rep = 0; rep < NREP(15); ++rep) {
                PHASE_ENTER();
                pg8::Gemm g{WSP(bf16_t, WS_HB), (const bf16_t*)(ws + WS_WFF + (size_t)jf * W_FF + W_GU), D, D, D}; pg8::StaticOrder S; S.init(T, 2 * DFF, G, bid);
                pg8::EpiSwiglu E{WSP(bf16_t, WS_X + X_ACT), WSP(float, WS_SSQ + (size_t)(3 * l + 1) * SSQ_BYTES), 1};
                pg8::gemm_phase<pg8::EpiSwiglu, pg8::StaticOrder, true, true>(lds, g, S, E, wave0);
                GRID_BAR();
            }
            if (PH(16)) for (int rep = 0; rep < NREP(16); ++rep) {
                PHASE_ENTER();
                pg8::Gemm g{WSP(bf16_t, WS_X + X_ACT), (const bf16_t*)(ws + WS_WFF + (size_t)jf * W_FF + W_DN), DFF, DFF, DFF}; pg8::StaticOrder S; S.init(T, D, G, bid);
                pg8::EpiResidBf E{WSP(bf16_t, WS_HB), (rep + 1 < NREP(16)) ? WSP(bf16_t, WS_X + X_GS) : WSP(bf16_t, WS_HB), WSP(float, WS_SSQ + (size_t)((rep + 1 < NREP(16)) ? 13 : 3 * l + 2) * SSQ_BYTES), (LAS float*)(lds + 131072)};
                pg8::gemm_phase<pg8::EpiResidBf, pg8::StaticOrder, true, true>(lds, g, S, E, wave0);
                GRID_BAR();
            }
        } else {
            if (PH(15)) for (int rep = 0; rep < NREP(15); ++rep) {
                PHASE_ENTER();
                const bf16_t* HB = WSP(bf16_t, WS_HB); const float* RS = WSP(float, WS_RS); bf16_t* XG = WSP(bf16_t, WS_X + X_XG);
                const int* TE = WSP(int, WS_MOE + MO_TE); const float* TW = WSP(float, WS_MOE + MO_TW); const int* TP = WSP(int, WS_MOE + MO_TP); unsigned* CNT = WSP(unsigned, WS_CTL) + CW_CNT + jf * 16;
                int* ROWL = WSP(int, WS_MOE + MO_ROWL); float* WROW = WSP(float, WS_MOE + MO_WROW); float* RSG = WSP(float, WS_MOE + MO_RSG);
                unsigned* PEXP = WSP(unsigned, WS_MOE + MO_PEXP); unsigned* NPAN = WSP(unsigned, WS_MOE + MO_NPAN);
#pragma unroll
                for (int s = 0; s < 2; ++s) {
                    int off[9]; { int a = 0;
#pragma unroll
                        for (int e = 0; e < 8; ++e) { off[e] = a; a += ((int)__builtin_amdgcn_readfirstlane(ld_u32_agent(CNT + s * 8 + e)) + 255) & ~255; }
                        off[8] = a; }
                    if (bid == 0 && tid == 0) { NPAN[s] = (unsigned)(off[8] >> 8);
#pragma unroll
                        for (int e = 0; e < 8; ++e) for (int pnl = off[e] >> 8; pnl < (off[e + 1] >> 8); ++pnl) PEXP[s * 256 + pnl] = (unsigned)e; }
                    for (int m = gw; m < T; m += NGW) { const int e = TE[s * T + m]; int o = 0;
#pragma unroll
                        for (int k = 0; k < 8; ++k) o = (e == k) ? off[k] : o;
                        const int row = o + TP[s * T + m];
                        const u32x4* src = (const u32x4*)(HB + (size_t)m * D); u32x4* dst = (u32x4*)(XG + ((size_t)s * MOE_ROWS + row) * D);
                        dst[lane] = src[lane]; dst[lane + 64] = src[lane + 64];
                        if (lane == 0) { ROWL[s * MOE_ROWS + row] = m; WROW[s * MOE_ROWS + row] = TW[s * T + m]; RSG[s * MOE_ROWS + row] = RS[m]; } }
#pragma unroll
                    for (int e = 0; e < 8; ++e) { const int c = (int)__builtin_amdgcn_readfirstlane(ld_u32_agent(CNT + s * 8 + e)); const int lo = off[e] + c, hi = off[e + 1];
                        for (int row = lo + gw; row < hi; row += NGW) { u32x4* dst = (u32x4*)(XG + ((size_t)s * MOE_ROWS + row) * D); const u32x4 zz = {0u, 0u, 0u, 0u}; dst[lane] = zz; dst[lane + 64] = zz;
                            if (lane == 0) { ROWL[s * MOE_ROWS + row] = -1; WROW[s * MOE_ROWS + row] = 0.f; RSG[s * MOE_ROWS + row] = 0.f; } } }
                }
                GRID_BAR();
            }
#pragma unroll
            for (int s = 0; s < 2; ++s) {
                if (PH(16 + 2 * s)) for (int rep = 0; rep < NREP(16 + 2 * s); ++rep) {
                    PHASE_ENTER();
                    const int npan = (int)__builtin_amdgcn_readfirstlane(ld_u32_agent(WSP(unsigned, WS_MOE + MO_NPAN) + s));
                    pg8::Gemm g{WSP(bf16_t, WS_X + X_XG) + (size_t)s * MOE_ROWS * D, WSP(bf16_t, WS_WMOE + WM_GU), D, D, D}; pg8::MoeOrder S; S.init(npan, 2 * DFF / 256, G, bid, WSP(unsigned, WS_MOE + MO_PEXP) + s * 256);
                    pg8::EpiSwiglu E{WSP(bf16_t, WS_X + X_ACT), WSP(float, WS_MOE + MO_RSG) + s * MOE_ROWS, 0};
                    pg8::gemm_phase<pg8::EpiSwiglu, pg8::MoeOrder, true, true>(lds, g, S, E, wave0);
                    GRID_BAR();
                }
                if (PH(17 + 2 * s)) for (int rep = 0; rep < NREP(17 + 2 * s); ++rep) {
                    PHASE_ENTER();
                    const int npan = (int)__builtin_amdgcn_readfirstlane(ld_u32_agent(WSP(unsigned, WS_MOE + MO_NPAN) + s));
                    pg8::Gemm g{WSP(bf16_t, WS_X + X_ACT), WSP(bf16_t, WS_WMOE + WM_DN), DFF, DFF, DFF}; pg8::MoeOrder S; S.init(npan, D / 256, G, bid, WSP(unsigned, WS_MOE + MO_PEXP) + s * 256);
                    pg8::EpiMoeDown E{WSP(bf16_t, WS_HB), WSP(int, WS_MOE + MO_ROWL) + s * MOE_ROWS, WSP(float, WS_MOE + MO_WROW) + s * MOE_ROWS, (rep + 1 < NREP(17 + 2 * s)) ? WSP(bf16_t, WS_X + X_GS) : WSP(bf16_t, WS_HB), s == 1 ? WSP(float, WS_SSQ + (size_t)((rep + 1 < NREP(17 + 2 * s)) ? 13 : 3 * l + 2) * SSQ_BYTES) : nullptr, (LAS float*)(lds + 131072)};
                    pg8::gemm_phase<pg8::EpiMoeDown, pg8::MoeOrder, true, true>(lds, g, S, E, wave0);
                    GRID_BAR();
                }
            }
        }
    }
    if (p.l_hi == DEPTH && PH(20)) {
        PHASE_ENTER();
        const float* gf = p.in[I_FINAL]; float* O = p.out; const bf16_t* HB = WSP(bf16_t, WS_HB); const float* SSQ = WSP(float, WS_SSQ + (size_t)(3 * DEPTH - 1) * SSQ_BYTES);
        for (int m = gw; m < T; m += NGW) { const float rstd = rstd4(SSQ + (size_t)m * 4); const u32x2* xr = (const u32x2*)(HB + (size_t)m * D) + lane; f32x4* orow = (f32x4*)(O + (size_t)m * D) + lane;
#pragma unroll
            for (int j = 0; j < 4; ++j) { const u32x2 w = xr[64 * j]; const f32x4 g4 = *((const f32x4*)gf + lane + 64 * j); orow[64 * j] = (f32x4){bflo(w.x), bfhi(w.x), bflo(w.y), bfhi(w.y)} * rstd * g4; } }
    }
#undef PH
#undef GRID_BAR
}

extern "C" void kernel_launch(void* const* d_in, const int* in_sizes, int n_in, void* d_out, int out_size, void* d_ws, size_t ws_size, hipStream_t stream) {
    static int grid = 0;
    if (grid == 0) {
        if (n_in != 28 || out_size != T * D || ws_size < WS_END) { fprintf(stderr, "kernel_launch: unexpected problem (n_in %d, out %d, ws %zu < %zu)\n", n_in, out_size, ws_size, (size_t)WS_END); grid = -1; return; }
        int dev = 0, cus = 0;
        if (hipGetDevice(&dev) != hipSuccess || hipDeviceGetAttribute(&cus, hipDeviceAttributeMultiprocessorCount, dev) != hipSuccess) { grid = -1; return; }
        if (hipFuncSetAttribute((const void*)mk_fwd, hipFuncAttributeMaxDynamicSharedMemorySize, LDS_BYTES) != hipSuccess) { fprintf(stderr, "kernel_launch: hipFuncSetAttribute failed\n"); grid = -1; return; }
        int per_cu = 0;
        if (hipOccupancyMaxActiveBlocksPerMultiprocessor(&per_cu, (const void*)mk_fwd, 512, LDS_BYTES) != hipSuccess || per_cu < 1) { fprintf(stderr, "kernel_launch: occupancy query says %d\n", per_cu); (void)hipGetLastError(); }
        grid = cus;
    }
    if (grid < 0) return;
    (void)hipMemsetAsync((char*)d_ws + WS_CTL, 0, 1 * MiB, stream);
    Params p{};
    for (int i = 0; i < 28; ++i) p.in[i] = (const float*)d_in[i];
    p.out = (float*)d_out; p.ws = (unsigned char*)d_ws;
#if MK_ONE_LAUNCH
    p.l_lo = 0; p.l_hi = DEPTH; p.ph_lo = 0; p.ph_hi = 21;
    hipLaunchKernelGGL(mk_fwd, dim3(grid), dim3(512), LDS_BYTES, stream, p);
#else
    auto launch = [&](int l, int ph) { p.l_lo = l; p.l_hi = l + 1; p.ph_lo = ph; p.ph_hi = ph + 1; hipLaunchKernelGGL(mk_fwd, dim3(grid), dim3(512), LDS_BYTES, stream, p); };
    launch(0, 0); launch(0, 1);
    for (int l = 0; l < DEPTH; ++l) { const int last = (l & 1) ? 19 : 16; for (int ph = 2; ph <= last; ++ph) launch(l, ph); }
    launch(DEPTH - 1, 20);
#endif
}
```

```cpp
#include <hip/hip_runtime.h>
#include <cstdio>
#include <cstdint>

#define LAS __attribute__((address_space(3)))
#define GAS __attribute__((address_space(1)))
typedef unsigned short bf16_t;
typedef short bf16x8 __attribute__((ext_vector_type(8)));
typedef float f32x4 __attribute__((ext_vector_type(4)));
typedef float f32x2 __attribute__((ext_vector_type(2)));
typedef unsigned u32x4 __attribute__((ext_vector_type(4)));
typedef unsigned u32x2 __attribute__((ext_vector_type(2)));

#ifndef PROBE_MASK
#define PROBE_MASK 0u
#endif
#define NREP(k) ((int)((PROBE_MASK >> (k)) & 1u) + 1)
#ifndef PROBE_VAR
#define PROBE_VAR 0
#endif
#ifndef MK_ONE_LAUNCH
#define MK_ONE_LAUNCH 1
#endif

constexpr int T = 32768, D = 1024, SEQ = 2048, NBATCH = 16, DEPTH = 4, MEMLEN = 256, TM = NBATCH * MEMLEN;
constexpr int INW = 5904, NPROJ = 6144, NMAIN = 5632, DFF = 2816, NEXP = 8;
constexpr int MOE_ROWS = T + NEXP * 256;
constexpr int MOE_PAN = MOE_ROWS / 256;
constexpr float EPS = 1e-6f;

constexpr size_t MiB = 1u << 20;
constexpr size_t WS_CTL = 0;
constexpr size_t WS_RS = 1 * MiB;
constexpr size_t WS_RSMEM = WS_RS + 256 * 1024;
constexpr size_t WS_DT = 2 * MiB;
constexpr size_t WS_MOE = 4 * MiB;
constexpr size_t WS_SSQ_OLD_UNUSED = 6 * MiB;
constexpr size_t SSQ_BYTES = (size_t)T * 16;
constexpr size_t WS_KM = 8 * MiB;
constexpr size_t WS_VTM = 24 * MiB;
constexpr size_t WS_MEMB = 40 * MiB;
constexpr size_t WS_HB = 48 * MiB;
constexpr size_t WS_W = 112 * MiB;
constexpr size_t W_IN = 0, W_SSDO = W_IN + (size_t)NPROJ * 1024 * 2, W_SBO = W_SSDO + 2 * MiB, W_OUT = W_SBO + 1 * MiB, W_Q = W_OUT + 2 * MiB, W_O = W_Q + 1 * MiB, W_LAYER = W_O + 1 * MiB;
constexpr size_t WS_WKV = WS_W + 4 * W_LAYER;
constexpr size_t WS_WFF = WS_WKV + 8 * MiB;
constexpr size_t W_GU = 0, W_DN = (size_t)2 * DFF * 1024 * 2, W_FF = W_DN + (size_t)1024 * DFF * 2;
constexpr size_t WS_WMOE = WS_WFF + 2 * W_FF;
constexpr size_t WM_GU = 0, WM_DN = (size_t)NEXP * 2 * DFF * 1024 * 2;
constexpr size_t WS_X = WS_WMOE + NEXP * W_FF;
constexpr size_t X_Z = 0, X_XBC = X_Z + 64 * MiB, X_XT = X_XBC + 80 * MiB, X_BR = X_XT + 64 * MiB, X_BT = X_BR + 8 * MiB, X_CR = X_BT + 8 * MiB, X_Q = X_CR + 8 * MiB, X_K = X_Q + 32 * MiB, X_V = X_K + 32 * MiB,
                 X_GS = X_V + 32 * MiB, X_PREV = X_GS + 128 * MiB, X_END = X_PREV + 32 * MiB;
constexpr size_t X_ACT = 0;
constexpr size_t X_XG = 192 * MiB;
constexpr size_t WS_SSQ = WS_X + X_END;
constexpr size_t WS_END = WS_SSQ + 8 * MiB;
static_assert(X_XG + (size_t)2 * MOE_ROWS * 1024 * 2 <= X_END, "moe region");
static_assert((size_t)MOE_ROWS * DFF * 2 <= X_XG, "act region");
constexpr size_t MO_TE = 0, MO_TW = MO_TE + 2 * T * 4, MO_TP = MO_TW + 2 * T * 4, MO_ROWL = MO_TP + 2 * T * 4, MO_WROW = MO_ROWL + 2 * MOE_ROWS * 4, MO_RSG = MO_WROW + 2 * MOE_ROWS * 4,
                 MO_PEXP = MO_RSG + 2 * MOE_ROWS * 4, MO_NPAN = MO_PEXP + 2 * 256 * 4, MO_END = MO_NPAN + 256;
static_assert(MO_END <= 2 * MiB, "moe tables");
constexpr int CW_BAR = 4096;
constexpr int CW_CNT = 16384;

constexpr int RING_BYTES = 155648;
constexpr int LDSCTL_OFF = RING_BYTES;
constexpr int LDS_BYTES = 160 * 1024;

__device__ __forceinline__ float bf2f(unsigned b) { return __builtin_bit_cast(float, b << 16); }
__device__ __forceinline__ float bflo(unsigned w) { return __builtin_bit_cast(float, w << 16); }
__device__ __forceinline__ float bfhi(unsigned w) { return __builtin_bit_cast(float, w & 0xffff0000u); }
__device__ __forceinline__ unsigned cvt_pk_bf16(float lo, float hi) { unsigned r; asm volatile("v_cvt_pk_bf16_f32 %0, %1, %2" : "=v"(r) : "v"(lo), "v"(hi)); return r; }
__device__ __forceinline__ unsigned short f2bf(float f) { return (unsigned short)(cvt_pk_bf16(f, 0.f) & 0xffffu); }
__device__ __forceinline__ float wave_sum(float v) {
#pragma unroll
    for (int o = 1; o < 64; o <<= 1) v += __shfl_xor(v, o);
    return v;
}
__device__ __forceinline__ float wave_max(float v) {
#pragma unroll
    for (int o = 1; o < 64; o <<= 1) v = fmaxf(v, __shfl_xor(v, o));
    return v;
}
__device__ __forceinline__ float fexp(float x) { return __builtin_amdgcn_exp2f(1.4426950408889634f * x); }
__device__ __forceinline__ float softplusf_(float x) { return fmaxf(x, 0.f) + 0.6931471805599453f * __builtin_amdgcn_logf(1.f + __builtin_amdgcn_exp2f(-1.4426950408889634f * fabsf(x))); }
__device__ __forceinline__ float sigmoidf_(float x) { return __builtin_amdgcn_rcpf(1.f + __builtin_amdgcn_exp2f(-1.4426950408889634f * x)); }
__device__ __forceinline__ unsigned ld_u32_agent(const unsigned* p) { return __hip_atomic_load(p, __ATOMIC_RELAXED, __HIP_MEMORY_SCOPE_AGENT); }
__device__ __forceinline__ float ld_f32_agent(const float* p) { return __builtin_bit_cast(float, __hip_atomic_load((const unsigned*)p, __ATOMIC_RELAXED, __HIP_MEMORY_SCOPE_AGENT)); }
__device__ __forceinline__ float rstd_of(float sumsq) { return __builtin_amdgcn_rsqf(sumsq * (1.f / 1024.f) + 1e-6f); }
__device__ __forceinline__ float rstd4(const float* q4) { const f32x4 q = *(const f32x4*)q4; return rstd_of((q.x + q.y) + (q.z + q.w)); }
#define LDS_WAIT() asm volatile("s_waitcnt lgkmcnt(0)" ::: "memory")
__device__ __forceinline__ int lane_id_opaque() { int l; asm volatile("v_mbcnt_lo_u32_b32 %0, -1, 0\n\tv_mbcnt_hi_u32_b32 %0, -1, %0" : "=v"(l)); return l; }

namespace pg8 {
constexpr int BM = 256, BK = 64, HALF = 128, HTB = HALF * BK * 2, STAGE_BYTES = 8 * HTB, NXCD = 8, WGM = 8;
__host__ __device__ __forceinline__ int lds_byte(int r, int c) { const int st = (r >> 4) * 2 + (c >> 5), rr = r & 15, cc = c & 31, ob = rr * 64 + cc * 2; return st * 1024 + (ob ^ (((ob >> 9) & 1) << 5)); }
__host__ __device__ __forceinline__ void stage_rc(int b, int& R, int& C) { const unsigned ub = (unsigned)b, st = ub >> 10, sb = ub & 1023u, swz = sb ^ (((sb >> 9) & 1u) << 5); R = (int)((st >> 1) * 16u + (swz >> 6)); C = (int)((st & 1u) * 32u + ((swz & 63u) >> 1)); }
__host__ __device__ __forceinline__ int perm32(int rho) { const int n = rho >> 4, i = rho & 15; return 8 * (i >> 2) + 4 * n + (i & 3); }

struct Unit { int pm, pn, pb; };
struct Gemm { const bf16_t* A; const bf16_t* Bt; int lda, ldb, K; };

struct StaticOrder {
    int nM, nN, nwg, G, c;
    __device__ void init(int M, int N, int G_, int c_) { nM = M / BM; nN = N / BM; nwg = nM * nN; G = G_; c = c_; }
    __device__ bool next(int i, Unit& u) const {
        const long L = (long)i * G + c; if (L >= nwg) return false;
        int wgid = (int)L; { const int q = nwg / NXCD, r = nwg % NXCD, xcd = wgid % NXCD, off = wgid / NXCD; wgid = (xcd < r ? xcd * (q + 1) : r * (q + 1) + (xcd - r) * q) + off; }
        const int nig = WGM * nN, gid = wgid / nig, fm = gid * WGM, gsz = (nM - fm) < WGM ? (nM - fm) : WGM;
        u.pm = fm + ((wgid % nig) % gsz); u.pn = (wgid % nig) / gsz; u.pb = u.pn; return true;
    }
};
struct MoeOrder {
    int nM, nN, nwg, G, c; const unsigned* pexp;
    __device__ void init(int nM_, int nN_, int G_, int c_, const unsigned* pexp_) { nM = nM_; nN = nN_; nwg = nM * nN; G = G_; c = c_; pexp = pexp_; }
    __device__ bool next(int i, Unit& u) const {
        const long L = (long)i * G + c; if (L >= nwg) return false;
        int wgid = (int)L; { const int q = nwg / NXCD, r = nwg % NXCD, xcd = wgid % NXCD, off = wgid / NXCD; wgid = (xcd < r ? xcd * (q + 1) : r * (q + 1) + (xcd - r) * q) + off; }
        const int nig = WGM * nN, gid = wgid / nig, fm = gid * WGM, gsz = (nM - fm) < WGM ? (nM - fm) : WGM;
        u.pm = fm + ((wgid % nig) % gsz); u.pn = (wgid % nig) / gsz;
        const int e = (int)__builtin_amdgcn_readfirstlane(ld_u32_agent(pexp + u.pm)); u.pb = e * nN + u.pn; return true;
    }
};

template <class Epi, class Sched, bool ALIGN_EPI = false, bool SP2 = false>
__device__ __forceinline__ void gemm_phase(LAS unsigned char* lds, const Gemm g, const Sched& S, const Epi& E, const int wave0) {
    int tid_ = wave0 * 64 + lane_id_opaque();
    const int tid = tid_, wid = __builtin_amdgcn_readfirstlane(tid >> 6), lane = tid & 63, wr = wid >> 2, wc = wid & 3, fr = lane & 15, fq = lane >> 4;
    const int K = g.K, nt = K / BK;
    unsigned voffA[2], voffB[2];
    { int R, C; stage_rc(tid * 16, R, C); const int Rb = Epi::PERM ? ((R & ~31) + perm32(R & 31)) : R;
      voffA[0] = (unsigned)(R * g.lda + C) * 2u; voffB[0] = (unsigned)(Rb * g.ldb + C) * 2u; voffA[1] = voffA[0] + (unsigned)(64 * g.lda) * 2u; voffB[1] = voffB[0] + (unsigned)(64 * g.ldb) * 2u; }
    const size_t kstep = (size_t)(BK * 2);
    const size_t hsA = (size_t)HALF * g.lda * 2, hsB = (size_t)HALF * g.ldb * 2;
    const size_t tsA = 2 * hsA, tsB = 2 * hsB;
    const unsigned ldsw = (unsigned)wid * 1024u;
    const int swz_ = (fr * 64 + fq * 16) ^ ((fr & 8) << 2); const int aoff = wr * 8192 + swz_, boff = wc * 4096 + swz_;
#define PG8_SA(b, h) (((b) * 2 + (h)) * HTB)
#define PG8_SB(b, h) ((4 + (b) * 2 + (h)) * HTB)
#define PG8_STAGE(bufoff, gbase, voff) do { _Pragma("unroll") for (int _i = 0; _i < 2; ++_i) \
        __builtin_amdgcn_global_load_lds((const unsigned*)((const char*)(gbase) + (voff)[_i]), (LAS unsigned*)(lds + (bufoff) + ldsw + _i * 8192), 16, 0, 0); } while (0)
#define PG8_LDA(dst, b, h) do { _Pragma("unroll") for (int m = 0; m < 4; ++m) _Pragma("unroll") for (int k = 0; k < 2; ++k) dst[m][k] = *(const LAS bf16x8*)(lds + PG8_SA(b, h) + aoff + m * 2048 + k * 1024); } while (0)
#define PG8_LDB(dst, b, h) do { _Pragma("unroll") for (int n = 0; n < 2; ++n) _Pragma("unroll") for (int k = 0; k < 2; ++k) dst[n][k] = *(const LAS bf16x8*)(lds + PG8_SB(b, h) + boff + n * 2048 + k * 1024); } while (0)
#define PG8_MMA(ai, bj, At, Bt) do { __builtin_amdgcn_s_setprio(1); _Pragma("unroll") for (int m = 0; m < 4; ++m) _Pragma("unroll") for (int n = 0; n < 2; ++n) _Pragma("unroll") for (int k = 0; k < 2; ++k) \
        acc[ai][bj][m][n] = __builtin_amdgcn_mfma_f32_16x16x32_bf16(Bt[n][k], At[m][k], acc[ai][bj][m][n], 0, 0, 0); __builtin_amdgcn_s_setprio(0); } while (0)
#define PG8_WAIT_V(n) asm volatile("s_waitcnt vmcnt(" #n ")" ::: "memory")
#define PG8_WAIT_L(n) asm volatile("s_waitcnt lgkmcnt(" #n ")" ::: "memory")
#define PG8_BAR __builtin_amdgcn_s_barrier()
#define PG8_SCHED __builtin_amdgcn_sched_barrier(0)
    Unit cur, nxt; int ui = 0;
    if (!S.next(0, cur)) return;
    f32x4 acc[2][2][4][2];
#pragma unroll
    for (int a = 0; a < 2; ++a)
#pragma unroll
        for (int b = 0; b < 2; ++b)
#pragma unroll
            for (int m = 0; m < 4; ++m)
#pragma unroll
                for (int n = 0; n < 2; ++n) acc[a][b][m][n] = (f32x4){0.f, 0.f, 0.f, 0.f};
    bf16x8 At[4][2], B0[2][2], B1[2][2];
    const char* cA = (const char*)g.A + (size_t)cur.pm * tsA; const char* cB = (const char*)g.Bt + (size_t)cur.pb * tsB;
    if constexpr (SP2) {
        PG8_STAGE(PG8_SB(0, 0), cB, voffB); PG8_STAGE(PG8_SB(0, 1), cB + hsB, voffB); PG8_STAGE(PG8_SA(0, 0), cA, voffA); PG8_STAGE(PG8_SA(0, 1), cA + hsA, voffA);
        if (wr == 1) PG8_BAR;
        PG8_WAIT_V(2); PG8_BAR;
        PG8_STAGE(PG8_SB(1, 0), cB + kstep, voffB); PG8_STAGE(PG8_SA(1, 0), cA + kstep, voffA); PG8_STAGE(PG8_SB(1, 1), cB + hsB + kstep, voffB);
        PG8_WAIT_V(6); PG8_BAR;
    } else {
        PG8_STAGE(PG8_SB(0, 0), cB, voffB); PG8_STAGE(PG8_SA(0, 0), cA, voffA); PG8_STAGE(PG8_SB(0, 1), cB + hsB, voffB); PG8_STAGE(PG8_SA(0, 1), cA + hsA, voffA);
        if (wr == 1) PG8_BAR;
        PG8_WAIT_V(4); PG8_BAR;
        PG8_STAGE(PG8_SB(1, 0), cB + kstep, voffB); PG8_STAGE(PG8_SA(1, 0), cA + kstep, voffA); PG8_STAGE(PG8_SB(1, 1), cB + hsB + kstep, voffB);
        PG8_WAIT_V(6); PG8_BAR;
    }
    for (;;) {
        const bool has_next = S.next(ui + 1, nxt);
        const char* nA = has_next ? (const char*)g.A + (size_t)nxt.pm * tsA : cA; const char* nB = has_next ? (const char*)g.Bt + (size_t)nxt.pb * tsB : cB;
        for (int t = 0; t < nt; t += 2) {
            const bool last = (t == nt - 2);
            const char* a1 = cA + (size_t)(t + 1) * kstep;
            const char* a2 = last ? nA : cA + (size_t)(t + 2) * kstep; const char* b2 = last ? nB : cB + (size_t)(t + 2) * kstep;
            const char* a3 = a2 + kstep; const char* b3 = b2 + kstep;
            if constexpr (SP2) {
            PG8_LDB(B0, 0, 0); PG8_LDB(B1, 0, 1); PG8_SCHED; PG8_LDA(At, 0, 0); PG8_STAGE(PG8_SA(1, 1), a1 + hsA, voffA);
            PG8_WAIT_V(8); PG8_WAIT_L(0); PG8_BAR; PG8_MMA(0, 0, At, B0); PG8_MMA(0, 1, At, B1); PG8_BAR; PG8_SCHED;
            PG8_LDA(At, 0, 1); PG8_STAGE(PG8_SB(0, 0), b2, voffB); PG8_STAGE(PG8_SB(0, 1), b2 + hsB, voffB); PG8_STAGE(PG8_SA(0, 0), a2, voffA);
            PG8_WAIT_V(8); PG8_WAIT_L(0); PG8_BAR; PG8_MMA(1, 0, At, B0); PG8_MMA(1, 1, At, B1); PG8_BAR; PG8_SCHED;
            PG8_LDB(B0, 1, 0); PG8_LDB(B1, 1, 1); PG8_SCHED; PG8_LDA(At, 1, 0); PG8_STAGE(PG8_SA(0, 1), a2 + hsA, voffA);
            PG8_WAIT_V(8); PG8_WAIT_L(0); PG8_BAR; PG8_MMA(0, 0, At, B0); PG8_MMA(0, 1, At, B1); PG8_BAR; PG8_SCHED;
            PG8_LDA(At, 1, 1); PG8_STAGE(PG8_SB(1, 0), b3, voffB); PG8_STAGE(PG8_SB(1, 1), b3 + hsB, voffB); PG8_STAGE(PG8_SA(1, 0), a3, voffA);
            PG8_WAIT_V(8); PG8_WAIT_L(0); PG8_BAR; PG8_MMA(1, 0, At, B0); PG8_MMA(1, 1, At, B1); PG8_BAR; PG8_SCHED;
            } else {
            PG8_LDB(B0, 0, 0); PG8_SCHED; PG8_LDA(At, 0, 0); PG8_STAGE(PG8_SA(1, 1), a1 + hsA, voffA);
            PG8_WAIT_L(8); PG8_BAR; PG8_WAIT_L(0); PG8_MMA(0, 0, At, B0); PG8_BAR; PG8_SCHED;
            PG8_LDB(B1, 0, 1); PG8_STAGE(PG8_SB(0, 0), b2, voffB);
            PG8_BAR; PG8_WAIT_L(0); PG8_MMA(0, 1, At, B1); PG8_BAR;
            PG8_LDA(At, 0, 1); PG8_STAGE(PG8_SA(0, 0), a2, voffA);
            PG8_BAR; PG8_WAIT_L(0); PG8_MMA(1, 0, At, B0); PG8_BAR; PG8_SCHED;
            PG8_STAGE(PG8_SB(0, 1), b2 + hsB, voffB);
            PG8_WAIT_V(6); PG8_BAR; PG8_MMA(1, 1, At, B1); PG8_BAR;
            PG8_LDB(B0, 1, 0); PG8_SCHED; PG8_LDA(At, 1, 0); PG8_STAGE(PG8_SA(0, 1), a2 + hsA, voffA);
            PG8_WAIT_L(8); PG8_BAR; PG8_WAIT_L(0); PG8_MMA(0, 0, At, B0); PG8_BAR; PG8_SCHED;
            PG8_LDB(B1, 1, 1); PG8_STAGE(PG8_SB(1, 0), b3, voffB);
            PG8_BAR; PG8_WAIT_L(0); PG8_MMA(0, 1, At, B1); PG8_BAR;
            PG8_LDA(At, 1, 1); PG8_STAGE(PG8_SA(1, 0), a3, voffA);
            PG8_BAR; PG8_WAIT_L(0); PG8_MMA(1, 0, At, B0); PG8_BAR; PG8_SCHED;
            PG8_STAGE(PG8_SB(1, 1), b3 + hsB, voffB);
            PG8_WAIT_V(6); PG8_BAR; PG8_MMA(1, 1, At, B1); PG8_BAR;
            }
        }
        if constexpr (ALIGN_EPI) { if (wr == 0) PG8_BAR; }
        E(acc, cur, wr, wc, fr, fq);
        if (!has_next) break;
#pragma unroll
        for (int a = 0; a < 2; ++a)
#pragma unroll
            for (int b = 0; b < 2; ++b)
#pragma unroll
                for (int m = 0; m < 4; ++m)
#pragma unroll
                    for (int n = 0; n < 2; ++n) acc[a][b][m][n] = (f32x4){0.f, 0.f, 0.f, 0.f};
        cur = nxt; cA = nA; cB = nB; ++ui;
        if constexpr (ALIGN_EPI) { if (wr == 1) PG8_BAR; }
    }
    PG8_WAIT_V(0);
    if constexpr (!ALIGN_EPI) { if (wr == 0) PG8_BAR; }
    PG8_BAR;
#undef PG8_SA
#undef PG8_SB
#undef PG8_STAGE
#undef PG8_LDA
#undef PG8_LDB
#undef PG8_MMA
#undef PG8_WAIT_V
#undef PG8_WAIT_L
#undef PG8_BAR
#undef PG8_SCHED
}

typedef const f32x4 (&AccT)[2][2][4][2];
#define EPI_FENCE() asm volatile("" ::: "memory")

struct EpiInProj {
    static constexpr bool PERM = true;
    unsigned char* xbase; const float* ssq; float* rs_out; float* dtt; const float* dt_bias;
    __device__ __forceinline__ void operator()(AccT acc, const Unit& u, int wr, int wc, int fr_, int fq_) const {
        int fr = fr_, fq = fq_; asm volatile("" : "+v"(fr), "+v"(fq));
        const int pn = u.pn; int bmib = (int)(X_Z >> 20), ld = 1024, ct = pn; bool sig = false;
        float sc = 1.f;
        if (pn < 4) { }
        else if (pn < 9) { bmib = (int)(X_XBC >> 20); ld = 1280; ct = pn - 4; }
        else if (pn < 11) { bmib = (int)(X_Q >> 20); ld = 512; ct = pn - 9; sc = 0.18033688011112042f; }
        else if (pn < 13) { bmib = (int)(X_K >> 20); ld = 512; ct = pn - 11; }
        else { bmib = (int)(X_GS >> 20); ld = 2048; ct = pn - 13; sig = true; }
        const unsigned lo = (unsigned)(fr * ld + 8 * fq) * 2u;
        unsigned char* tb = xbase + ((size_t)(unsigned)bmib << 20) + ((size_t)(u.pm * BM + wr * 64) * ld + ct * BM + wc * 32) * 2;
        const int rowb = u.pm * BM + wr * 64 + fr;
        if (pn == 21) {
            if (wc == 0 && fq < 2) {
                int fqo = fq; asm volatile("" : "+v"(fqo));
                float* dbase = dtt + (size_t)(8 * fqo) * T;
                const f32x4 b0 = *(const f32x4*)(dt_bias + 8 * fqo), b1 = *(const f32x4*)(dt_bias + 8 * fqo + 4);
#pragma unroll
                for (int ai = 0; ai < 2; ++ai)
#pragma unroll
                    for (int m = 0; m < 4; ++m) { const int row = rowb + ai * HALF + m * 16; const float r = rstd4(ssq + (size_t)row * 4); const f32x4 v0 = acc[ai][0][m][0] * r + b0, v1 = acc[ai][0][m][1] * r + b1;
#pragma unroll
                        for (int j = 0; j < 4; ++j) { dbase[(size_t)j * T + row] = softplusf_(v0[j]); dbase[(size_t)(4 + j) * T + row] = softplusf_(v1[j]); } }
            }
            return;
        }
float rr[8];
#pragma unroll
        for (int gI = 0; gI < 8; ++gI) rr[gI] = rstd4(ssq + (size_t)(rowb + (gI >> 2) * HALF + (gI & 3) * 16) * 4);
#pragma unroll
        for (int ai = 0; ai < 2; ++ai)
#pragma unroll
            for (int m = 0; m < 4; ++m) { const int row = rowb + ai * HALF + m * 16; const float r0 = rr[ai * 4 + m]; const float r = r0 * sc; unsigned char* rowp = tb + (size_t)(ai * HALF + m * 16) * ld * 2;
                if (pn == 0 && wc == 0 && fq == 0) rs_out[row] = r0;
#pragma unroll
                for (int bj = 0; bj < 2; ++bj) { f32x4 v0 = acc[ai][bj][m][0] * r, v1 = acc[ai][bj][m][1] * r;
                    if (sig) {
#pragma unroll
                        for (int j = 0; j < 4; ++j) { v0[j] = sigmoidf_(v0[j]); v1[j] = sigmoidf_(v1[j]); } }
                    u32x4 w; w.x = cvt_pk_bf16(v0[0], v0[1]); w.y = cvt_pk_bf16(v0[2], v0[3]); w.z = cvt_pk_bf16(v1[0], v1[1]); w.w = cvt_pk_bf16(v1[2], v1[3]);
                    *(u32x4*)(rowp + lo + bj * HALF * 2) = w; }
                EPI_FENCE(); }
    }
};
struct EpiBf16Rs {
    static constexpr bool PERM = true;
    bf16_t* O; int ldc; const float* rs; float sc; int ssq16;
    __device__ __forceinline__ void operator()(AccT acc, const Unit& u, int wr, int wc, int fr_, int fq_) const {
        int fr = fr_, fq = fq_; asm volatile("" : "+v"(fr), "+v"(fq));
        const unsigned lo = (unsigned)(fr * ldc + 8 * fq) * 2u;
        unsigned char* tb = (unsigned char*)O + ((size_t)(u.pm * BM + wr * 64) * ldc + u.pn * BM + wc * 32) * 2;
        const float* rsb = rs + (size_t)(u.pm * BM + wr * 64 + fr) * (ssq16 ? 4 : 1);
        float rr[8];
#pragma unroll
        for (int gI = 0; gI < 8; ++gI) { const int ro = (gI >> 2) * HALF + (gI & 3) * 16; rr[gI] = (ssq16 ? rstd4(rsb + (size_t)ro * 4) : rsb[ro]) * sc; }
#pragma unroll
        for (int ai = 0; ai < 2; ++ai)
#pragma unroll
            for (int m = 0; m < 4; ++m) { const float r = rr[ai * 4 + m]; unsigned char* rowp = tb + (size_t)(ai * HALF + m * 16) * ldc * 2;
#pragma unroll
                for (int bj = 0; bj < 2; ++bj) { const f32x4 v0 = acc[ai][bj][m][0] * r, v1 = acc[ai][bj][m][1] * r;
                    u32x4 w; w.x = cvt_pk_bf16(v0[0], v0[1]); w.y = cvt_pk_bf16(v0[2], v0[3]); w.z = cvt_pk_bf16(v1[0], v1[1]); w.w = cvt_pk_bf16(v1[2], v1[3]);
                    *(u32x4*)(rowp + lo + bj * HALF * 2) = w; }
                EPI_FENCE(); }
    }
};
struct EpiBf16Cs {
    static constexpr bool PERM = true;
    bf16_t* O; int ldc; const float* cs; float sc; int chunk_rows;
    __device__ __forceinline__ void operator()(AccT acc, const Unit& u, int wr, int wc, int fr_, int fq_) const {
        int fr = fr_, fq = fq_; asm volatile("" : "+v"(fr), "+v"(fq));
        const int rstride = chunk_rows ? 128 : ldc;
        const size_t bjstride = chunk_rows ? (size_t)chunk_rows * 128 : (size_t)HALF;
        const unsigned lo = (unsigned)(fr * rstride + 8 * fq) * 2u;
        unsigned char* tb = (unsigned char*)O + (chunk_rows ? ((size_t)(u.pn * 2) * chunk_rows * 128 + (size_t)(u.pm * BM + wr * 64) * 128 + wc * 32) : ((size_t)(u.pm * BM + wr * 64) * ldc + u.pn * BM + wc * 32)) * 2;
        const float* csb = cs + u.pn * BM + wc * 32 + 8 * fq;
        f32x4 c0[2], c1[2];
#pragma unroll
        for (int bj = 0; bj < 2; ++bj) { c0[bj] = *(const f32x4*)(csb + bj * HALF) * sc; c1[bj] = *(const f32x4*)(csb + bj * HALF + 4) * sc; }
#pragma unroll
        for (int ai = 0; ai < 2; ++ai)
#pragma unroll
            for (int m = 0; m < 4; ++m) { unsigned char* rowp = tb + (size_t)(ai * HALF + m * 16) * rstride * 2;
#pragma unroll
                for (int bj = 0; bj < 2; ++bj) { const f32x4 v0 = acc[ai][bj][m][0] * c0[bj], v1 = acc[ai][bj][m][1] * c1[bj];
                    u32x4 w; w.x = cvt_pk_bf16(v0[0], v0[1]); w.y = cvt_pk_bf16(v0[2], v0[3]); w.z = cvt_pk_bf16(v1[0], v1[1]); w.w = cvt_pk_bf16(v1[2], v1[3]);
                    *(u32x4*)(rowp + lo + bj * bjstride * 2) = w; }
                EPI_FENCE(); }
    }
};
template <bool ADD> struct EpiGate {
    static constexpr bool PERM = true;
    bf16_t* O; const bf16_t* GS; int gcol0; const bf16_t* Oin;
    __device__ __forceinline__ void operator()(AccT acc, const Unit& u, int wr, int wc, int fr_, int fq_) const {
        int fr = fr_, fq = fq_; asm volatile("" : "+v"(fr), "+v"(fq));
        const unsigned lo = (unsigned)(fr * 1024 + 8 * fq) * 2u, lg = (unsigned)(fr * 2048 + 8 * fq) * 2u;
        unsigned char* tb = (unsigned char*)O + ((size_t)(u.pm * BM + wr * 64) * 1024 + u.pn * BM + wc * 32) * 2;
        const unsigned char* ib = (const unsigned char*)Oin + ((size_t)(u.pm * BM + wr * 64) * 1024 + u.pn * BM + wc * 32) * 2;
        const unsigned char* gb = (const unsigned char*)GS + ((size_t)(u.pm * BM + wr * 64) * 2048 + gcol0 + u.pn * BM + wc * 32) * 2;
        u32x4 gq[2][2], pq[2][2];
#pragma unroll
        for (int bj = 0; bj < 2; ++bj) { gq[0][bj] = *(const u32x4*)(gb + lg + bj * HALF * 2); if (ADD) pq[0][bj] = *(const u32x4*)(ib + lo + bj * HALF * 2); }
#pragma unroll
        for (int gI = 0; gI < 8; ++gI) { const int ai = gI >> 2, m = gI & 3, cur = gI & 1, nx = cur ^ 1;
            if (gI < 7) { const size_t ro = (size_t)(((gI + 1) >> 2) * HALF + ((gI + 1) & 3) * 16);
#pragma unroll
                for (int bj = 0; bj < 2; ++bj) { gq[nx][bj] = *(const u32x4*)(gb + ro * 2048 * 2 + lg + bj * HALF * 2); if (ADD) pq[nx][bj] = *(const u32x4*)(ib + ro * 1024 * 2 + lo + bj * HALF * 2); } }
            unsigned char* rowp = tb + (size_t)(ai * HALF + m * 16) * 1024 * 2;
#pragma unroll
            for (int bj = 0; bj < 2; ++bj) { const u32x4 gw = gq[cur][bj]; f32x4 v0 = acc[ai][bj][m][0], v1 = acc[ai][bj][m][1];
                v0[0] *= bflo(gw.x); v0[1] *= bfhi(gw.x); v0[2] *= bflo(gw.y); v0[3] *= bfhi(gw.y); v1[0] *= bflo(gw.z); v1[1] *= bfhi(gw.z); v1[2] *= bflo(gw.w); v1[3] *= bfhi(gw.w);
                if (ADD) { const u32x4 pw = pq[cur][bj];
                    v0[0] += bflo(pw.x); v0[1] += bfhi(pw.x); v0[2] += bflo(pw.y); v0[3] += bfhi(pw.y); v1[0] += bflo(pw.z); v1[1] += bfhi(pw.z); v1[2] += bflo(pw.w); v1[3] += bfhi(pw.w); }
                u32x4 w; w.x = cvt_pk_bf16(v0[0], v0[1]); w.y = cvt_pk_bf16(v0[2], v0[3]); w.z = cvt_pk_bf16(v1[0], v1[1]); w.w = cvt_pk_bf16(v1[2], v1[3]);
                *(u32x4*)(rowp + lo + bj * HALF * 2) = w; }
        }
    }
};
struct EpiResidBf {
    static constexpr bool PERM = true;
    const bf16_t* Hin; bf16_t* Hout; float* ssq; LAS float* sl;
    __device__ __forceinline__ void operator()(AccT acc, const Unit& u, int wr, int wc, int fr_, int fq_) const {
        int fr = fr_, fq = fq_; asm volatile("" : "+v"(fr), "+v"(fq));
        const unsigned lo = (unsigned)(fr * 1024 + 8 * fq) * 2u;
        const size_t ub = ((size_t)(u.pm * BM + wr * 64) * 1024 + u.pn * BM + wc * 32) * 2;
        const unsigned char* hi0 = (const unsigned char*)Hin + ub + lo; unsigned char* ho0 = (unsigned char*)Hout + ub + lo;
        u32x4 hq[2][2];
#pragma unroll
        for (int bj = 0; bj < 2; ++bj) hq[0][bj] = *(const u32x4*)(hi0 + bj * HALF * 2);
#pragma unroll
        for (int gI = 0; gI < 8; ++gI) { const int ai = gI >> 2, m = gI & 3, cur = gI & 1, nx = cur ^ 1;
            if (gI < 7) { const size_t ro = (size_t)(((gI + 1) >> 2) * HALF + ((gI + 1) & 3) * 16) * 1024 * 2;
#pragma unroll
                for (int bj = 0; bj < 2; ++bj) hq[nx][bj] = *(const u32x4*)(hi0 + ro + bj * HALF * 2); }
            unsigned char* ho = ho0 + (size_t)(ai * HALF + m * 16) * 1024 * 2;
            float ss = 0.f;
#pragma unroll
            for (int bj = 0; bj < 2; ++bj) { const f32x4 a0 = acc[ai][bj][m][0], a1 = acc[ai][bj][m][1]; const u32x4 hv = hq[cur][bj]; u32x4 w;
                w.x = cvt_pk_bf16(bflo(hv.x) + a0[0], bfhi(hv.x) + a0[1]); w.y = cvt_pk_bf16(bflo(hv.y) + a0[2], bfhi(hv.y) + a0[3]);
                w.z = cvt_pk_bf16(bflo(hv.z) + a1[0], bfhi(hv.z) + a1[1]); w.w = cvt_pk_bf16(bflo(hv.w) + a1[2], bfhi(hv.w) + a1[3]);
                *(u32x4*)(ho + bj * HALF * 2) = w;
                ss += (bflo(w.x) * bflo(w.x) + bfhi(w.x) * bfhi(w.x)) + (bflo(w.y) * bflo(w.y) + bfhi(w.y) * bfhi(w.y)) + (bflo(w.z) * bflo(w.z) + bfhi(w.z) * bfhi(w.z)) + (bflo(w.w) * bflo(w.w) + bfhi(w.w) * bfhi(w.w)); }
            ss += __shfl_xor(ss, 16); ss += __shfl_xor(ss, 32);
            if (fq == 0) sl[wc * 256 + ai * HALF + wr * 64 + m * 16 + fr] = ss;
        }
        asm volatile("s_waitcnt lgkmcnt(0)" ::: "memory"); __builtin_amdgcn_s_barrier(); asm volatile("" ::: "memory");
        const int t = (wr * 4 + wc) * 64 + fq * 16 + fr;
        if (t < 256) ssq[(size_t)(u.pm * BM + t) * 4 + u.pn] = (sl[t] + sl[256 + t]) + (sl[512 + t] + sl[768 + t]);
    }
};
struct EpiSwiglu {
    static constexpr bool PERM = true;
    bf16_t* ACT; const float* rs; int ssq16;
    __device__ __forceinline__ void operator()(AccT acc, const Unit& u, int wr, int wc, int fr_, int fq_) const {
        int fr = fr_, fq = fq_; asm volatile("" : "+v"(fr), "+v"(fq));
        const unsigned lo = (unsigned)(fr * DFF + 8 * fq) * 2u;
        unsigned char* tb = (unsigned char*)ACT + ((size_t)(u.pm * BM + wr * 64) * DFF + u.pn * HALF + wc * 32) * 2;
        const float* rsb = rs + (size_t)(u.pm * BM + wr * 64 + fr) * (ssq16 ? 4 : 1);
        float rr[8];
#pragma unroll
        for (int gI = 0; gI < 8; ++gI) { const int ro = (gI >> 2) * HALF + (gI & 3) * 16; rr[gI] = ssq16 ? rstd4(rsb + (size_t)ro * 4) : rsb[ro]; }
#pragma unroll
        for (int ai = 0; ai < 2; ++ai)
#pragma unroll
            for (int m = 0; m < 4; ++m) { const float r = rr[ai * 4 + m];
                float o[8];
#pragma unroll
                for (int n = 0; n < 2; ++n)
#pragma unroll
                    for (int j = 0; j < 4; ++j) { const float gt = acc[ai][0][m][n][j] * r, up = acc[ai][1][m][n][j] * r; o[n * 4 + j] = gt * sigmoidf_(gt) * up; }
                u32x4 w; w.x = cvt_pk_bf16(o[0], o[1]); w.y = cvt_pk_bf16(o[2], o[3]); w.z = cvt_pk_bf16(o[4], o[5]); w.w = cvt_pk_bf16(o[6], o[7]);
                *(u32x4*)(tb + (size_t)(ai * HALF + m * 16) * DFF * 2 + lo) = w;
                EPI_FENCE(); }
    }
};
struct EpiMoeDown {
    static constexpr bool PERM = true;
    const bf16_t* H; const int* rowl; const float* wrow; bf16_t* Hout; float* ssq; LAS float* sl;
    __device__ __forceinline__ void operator()(AccT acc, const Unit& u, int wr, int wc, int fr_, int fq_) const {
        int fr = fr_, fq = fq_; asm volatile("" : "+v"(fr), "+v"(fq));
        const int rb = u.pm * BM + wr * 64 + fr; const unsigned cb = (unsigned)(u.pn * BM + wc * 32 + 8 * fq) * 2u;
        int tk[8]; float wt[8];
#pragma unroll
        for (int gI = 0; gI < 8; ++gI) { const int row = rb + (gI >> 2) * HALF + (gI & 3) * 16; tk[gI] = rowl[row]; wt[gI] = wrow[row]; }
        u32x4 hq[2][2];
        { const size_t to = (size_t)(tk[0] < 0 ? 0 : tk[0]);
#pragma unroll
          for (int bj = 0; bj < 2; ++bj) hq[0][bj] = *(const u32x4*)((const unsigned char*)H + to * 2048 + cb + bj * HALF * 2); }
#pragma unroll
        for (int gI = 0; gI < 8; ++gI) { const int ai = gI >> 2, m = gI & 3, cur = gI & 1, nx = cur ^ 1;
            if (gI < 7) { const size_t tn = (size_t)(tk[gI + 1] < 0 ? 0 : tk[gI + 1]);
#pragma unroll
                for (int bj = 0; bj < 2; ++bj) hq[nx][bj] = *(const u32x4*)((const unsigned char*)H + tn * 2048 + cb + bj * HALF * 2); }
            const int tok = tk[gI]; const size_t to = (size_t)(tok < 0 ? 0 : tok);
            unsigned char* op = (unsigned char*)Hout + to * 2048 + cb;
            float ss = 0.f;
            if (tok >= 0) {
#pragma unroll
                for (int bj = 0; bj < 2; ++bj) { const f32x4 a0 = acc[ai][bj][m][0] * wt[gI], a1 = acc[ai][bj][m][1] * wt[gI]; const u32x4 hv = hq[cur][bj]; u32x4 w;
                    w.x = cvt_pk_bf16(bflo(hv.x) + a0[0], bfhi(hv.x) + a0[1]); w.y = cvt_pk_bf16(bflo(hv.y) + a0[2], bfhi(hv.y) + a0[3]);
                    w.z = cvt_pk_bf16(bflo(hv.z) + a1[0], bfhi(hv.z) + a1[1]); w.w = cvt_pk_bf16(bflo(hv.w) + a1[2], bfhi(hv.w) + a1[3]);
                    *(u32x4*)(op + bj * HALF * 2) = w;
                    ss += (bflo(w.x) * bflo(w.x) + bfhi(w.x) * bfhi(w.x)) + (bflo(w.y) * bflo(w.y) + bfhi(w.y) * bfhi(w.y)) + (bflo(w.z) * bflo(w.z) + bfhi(w.z) * bfhi(w.z)) + (bflo(w.w) * bflo(w.w) + bfhi(w.w) * bfhi(w.w)); } }
            ss += __shfl_xor(ss, 16); ss += __shfl_xor(ss, 32);
            if (ssq != nullptr && fq == 0) sl[wc * 256 + ai * HALF + wr * 64 + m * 16 + fr] = ss;
        }
        if (ssq != nullptr) {
            asm volatile("s_waitcnt lgkmcnt(0)" ::: "memory"); __builtin_amdgcn_s_barrier(); asm volatile("" ::: "memory");
            const int t = (wr * 4 + wc) * 64 + fq * 16 + fr;
            if (t < 256) { const int tok = rowl[u.pm * BM + t]; if (tok >= 0) ssq[(size_t)tok * 4 + u.pn] = (sl[t] + sl[256 + t]) + (sl[512 + t] + sl[768 + t]); }
        }
    }
};
}

#define XB_TMO      128
#define XB_XCNT(j)  (256  + 64 * (j))
#define XB_XSUB(j)  (1280 + 64 * (j))
#define XB_XGEN(j)  (2304 + 64 * (j))
#define XB_TOP      3328
#define XB_TOPGEN   3392
#define XCD_BAR_WORDS 3456
#define XB_SPIN_CAP (1u << 22)
__device__ __forceinline__ unsigned xb_ld(unsigned* p)              { return __hip_atomic_load(p, __ATOMIC_RELAXED, __HIP_MEMORY_SCOPE_AGENT); }
__device__ __forceinline__ unsigned xb_add(unsigned* p, unsigned v) { return __hip_atomic_fetch_add(p, v, __ATOMIC_RELAXED, __HIP_MEMORY_SCOPE_AGENT); }
__device__ __forceinline__ unsigned xb_xcc_id() { return (unsigned)__builtin_amdgcn_s_getreg((3 << 11) | 20) & 0xFu; }
#define XB_SPIN(cond, bar) do { unsigned _sp = 0; while (cond) { __builtin_amdgcn_s_sleep(1); \
    if ((++_sp & 255u) == 0u) { if (xb_ld(&(bar)[XB_TMO])) break; if (_sp > XB_SPIN_CAP) { atomicAdd(&(bar)[XB_TMO], 1u); break; } } } } while (0)
struct XcdBarrier { unsigned* bar; unsigned x; volatile LAS unsigned* st; };
__device__ __forceinline__ XcdBarrier xcd_barrier_post(unsigned* bar, volatile LAS unsigned* st) {
    XcdBarrier b; b.bar = bar; b.x = xb_xcc_id(); b.st = st;
    if (threadIdx.x == 0) (void)xb_add(&bar[XB_XCNT(b.x)], 1u);
    return b;
}
__device__ __forceinline__ void xcd_barrier_complete(unsigned* bar, unsigned x, unsigned& nloc, unsigned& nx) {
    const unsigned G = gridDim.x * gridDim.y * gridDim.z;
    unsigned sum, cnt, mine, sp = 0u;
    for (;;) {
        sum = 0u; cnt = 0u; mine = 0u;
#pragma unroll
        for (unsigned j = 0; j < 16; ++j) { const unsigned c = xb_ld(&bar[XB_XCNT(j)]); sum += c; cnt += (c > 0u) ? 1u : 0u; mine = (j == x) ? c : mine; }
        if (sum == G) break;
        __builtin_amdgcn_s_sleep(1);
        if ((++sp & 255u) == 0u) { if (xb_ld(&bar[XB_TMO])) break; if (sp > XB_SPIN_CAP) { atomicAdd(&bar[XB_TMO], 1u); break; } }
    }
    nloc = mine > 0u ? mine : 1u; nx = cnt > 0u ? cnt : 1u;
}
__device__ __forceinline__ void xcd_barrier(const XcdBarrier& b, const bool leader_thread) {
    asm volatile("s_waitcnt vmcnt(0)" ::: "memory");
    __syncthreads();
    if (leader_thread) {
        unsigned* bar = b.bar;
        __builtin_amdgcn_s_waitcnt(0);
        unsigned nloc = b.st[0], nx = b.st[1];
        if (nloc == 0u) { xcd_barrier_complete(bar, b.x, nloc, nx); b.st[0] = nloc; b.st[1] = nx; }
        const unsigned old = xb_add(&bar[XB_XSUB(b.x)], 1u);
        const unsigned gen = old / nloc;
        if (old + 1u == (gen + 1u) * nloc) {
            __builtin_amdgcn_fence(__ATOMIC_RELEASE, "agent");
            asm volatile("s_waitcnt vmcnt(0)" ::: "memory");
            const unsigned og = xb_add(&bar[XB_TOP], 1u);
            const unsigned tg = og / nx;
            if (og + 1u == (tg + 1u) * nx) xb_add(&bar[XB_TOPGEN], 1u);
            else XB_SPIN(xb_ld(&bar[XB_TOPGEN]) == tg, bar);
            __builtin_amdgcn_fence(__ATOMIC_ACQUIRE, "agent");
            xb_add(&bar[XB_XGEN(b.x)], 1u);
            asm volatile("s_waitcnt vmcnt(0)" ::: "memory");
        } else {
            XB_SPIN(xb_ld(&bar[XB_XGEN(b.x)]) == gen, bar);
            __builtin_amdgcn_fence(__ATOMIC_ACQUIRE, "agent");
            asm volatile("s_waitcnt vmcnt(0)" ::: "memory");
        }
    }
    __syncthreads();
}

struct Params {
    const float* in[28];
    float* out;
    unsigned char* ws;
    int l_lo, l_hi, ph_lo, ph_hi;
};
enum { I_X = 0, I_MEM, I_NORM_MIX, I_W_IN, I_CONV_W, I_CONV_B, I_DT_BIAS, I_A_LOG, I_D_SKIP, I_SSD_NORM, I_W_SSD_O, I_W_SB_O, I_W_OUT, I_NORM_XA, I_NORM_MEM,
       I_XA_WQ, I_XA_WK, I_XA_WV, I_XA_WO, I_NORM_FFN, I_FFN_G, I_FFN_U, I_FFN_D, I_MOE_R, I_MOE_G, I_MOE_U, I_MOE_D, I_FINAL };

__device__ __forceinline__ void tr_item(const float* W, int ldw, int k0, int n0, const float* gain, bf16_t* WT, int ldt, int drow0, LAS float* scr, int lane) {
    const int hl = lane >> 5, nl = lane & 31;
    const float* src = W + (size_t)(k0 + hl) * ldw + n0 + nl;
    float v[32];
#pragma unroll
    for (int i = 0; i < 32; ++i) v[i] = src[(size_t)(2 * i) * ldw];
#pragma unroll
    for (int i = 0; i < 32; ++i) scr[(2 * i + hl) * 33 + nl] = v[i];
    LDS_WAIT();
    const int c = lane & 7;
    f32x4 g0 = {1.f, 1.f, 1.f, 1.f}, g1 = {1.f, 1.f, 1.f, 1.f};
    if (gain) { g0 = *(const f32x4*)(gain + k0 + 8 * c); g1 = *(const f32x4*)(gain + k0 + 8 * c + 4); }
#pragma unroll
    for (int j = 0; j < 4; ++j) { const int n = (lane >> 3) + 8 * j; const LAS float* s = scr + (8 * c) * 33 + n;
        u32x4 o; o.x = cvt_pk_bf16(s[0 * 33] * g0.x, s[1 * 33] * g0.y); o.y = cvt_pk_bf16(s[2 * 33] * g0.z, s[3 * 33] * g0.w); o.z = cvt_pk_bf16(s[4 * 33] * g1.x, s[5 * 33] * g1.y); o.w = cvt_pk_bf16(s[6 * 33] * g1.z, s[7 * 33] * g1.w);
        *(u32x4*)(WT + (size_t)(drow0 + n) * ldt + k0 + 8 * c) = o; }
    LDS_WAIT();
}
struct TrJob { const float* W; int ldw, K, col0, ncols; const float* gain; bf16_t* WT; int dbase, dgroup; };
__device__ __forceinline__ void run_job(const TrJob& j, int& base, int gw, int NGW, LAS float* scr, int lane) {
    const int nblk = j.ncols / 32, nitems = (j.K / 64) * nblk;
    int start = (gw - base) % NGW; if (start < 0) start += NGW;
    for (int it = start; it < nitems; it += NGW) { const int kb = it / nblk, nb = it % nblk, c0 = nb * 32;
        tr_item(j.W, j.ldw, kb * 64, j.col0 + c0, j.gain, j.WT, j.K, j.dbase + (c0 / 128) * j.dgroup + (c0 % 128), scr, lane); }
    base = (base + nitems) % NGW;
}

__device__ __forceinline__ float row_to_bf16(const float* xrow, bf16_t* brow, int lane) {
    const f32x4* xr = (const f32x4*)xrow + lane; u32x2* o8 = (u32x2*)brow + lane; float s = 0.f;
#pragma unroll
    for (int j = 0; j < 4; ++j) { const f32x4 v = xr[64 * j]; u32x2 w; w.x = cvt_pk_bf16(v.x, v.y); w.y = cvt_pk_bf16(v.z, v.w); o8[64 * j] = w;
        s += (bflo(w.x) * bflo(w.x) + bfhi(w.x) * bfhi(w.x)) + (bflo(w.y) * bflo(w.y) + bfhi(w.y) * bfhi(w.y)); }
    return wave_sum(s);
}
template <int NE>
__device__ __forceinline__ void row_dots_bf16(const bf16_t* brow, int lane, const LAS float* wsm, float rstd, float (&ex)[NE]) {
    const u32x2* xr = (const u32x2*)brow + lane; f32x4 v[4];
#pragma unroll
    for (int j = 0; j < 4; ++j) { const u32x2 w = xr[64 * j]; v[j] = (f32x4){bflo(w.x), bfhi(w.x), bflo(w.y), bfhi(w.y)}; }
#pragma unroll
    for (int e = 0; e < NE; ++e) { float pp = 0.f;
#pragma unroll
        for (int j = 0; j < 4; ++j) { const f32x4 w4 = *(const LAS f32x4*)(wsm + e * 1024 + 256 * j + 4 * lane); pp += (v[j].x * w4.x + v[j].y * w4.y) + (v[j].z * w4.z + v[j].w * w4.w); }
        ex[e] = wave_sum(pp) * rstd; }
}

typedef float f32x16 __attribute__((ext_vector_type(16)));
#define MFMA32(a, b, c) __builtin_amdgcn_mfma_f32_32x32x16_bf16((a), (b), (c), 0, 0, 0)
__device__ __forceinline__ bf16x8 ldg8(const bf16_t* p) { return *(const bf16x8*)p; }
__device__ __forceinline__ bf16x8 pack8(const float* v) { u32x4 w; w.x = cvt_pk_bf16(v[0], v[1]); w.y = cvt_pk_bf16(v[2], v[3]); w.z = cvt_pk_bf16(v[4], v[5]); w.w = cvt_pk_bf16(v[6], v[7]); return __builtin_bit_cast(bf16x8, w); }
__device__ __forceinline__ int pi32(int r) { return 16 * ((r >> 2) & 1) + 4 * (r >> 3) + (r & 3); }

__device__ __forceinline__ void sb_attn_mfma(const bf16_t* Q, const bf16_t* Kb, const bf16_t* Vt, bf16_t* Yo, int bid, int G, int wave, int lane) {
    const int c = lane & 31, hh = lane >> 5, pr = pi32(c);
    bf16x8 U[2];
#pragma unroll
    for (int kk = 0; kk < 2; ++kk) { u32x4 uw;
#pragma unroll
        for (int q = 0; q < 4; ++q) uw[q] = ((16 * hh + 8 * kk + 2 * q > pr) ? 0x3F80u : 0u) | ((16 * hh + 8 * kk + 2 * q + 1 > pr) ? 0x3F800000u : 0u);
        U[kk] = __builtin_bit_cast(bf16x8, uw); }
    for (int vb = bid; vb < 256; vb += G)
    for (int iu = 0; iu < 4; ++iu) {
        const int k4 = iu, a = vb >> 4, bh = (vb & 15) * 8 + wave;
        const int qblk = k4 == 0 ? a : k4 == 1 ? 31 - a : k4 == 2 ? 32 + a : 63 - a;
        const int b = bh >> 3, h = bh & 7, t0 = qblk * 32;
        const bf16_t* qp = Q + (size_t)(b * SEQ + t0 + c) * 512 + h * 64; bf16_t* yp = Yo + (size_t)(b * SEQ + t0 + c) * 512 + h * 64;
        bf16x8 qf[4];
#pragma unroll
        for (int jj = 0; jj < 4; ++jj) qf[jj] = ldg8(qp + 16 * jj + 8 * hh);
        const bf16_t* kbase = Kb + (size_t)(b * SEQ + pr) * 512 + h * 64 + 8 * hh;
        const bf16_t* vbase = Vt + (size_t)(b * 16) * 512 * 128 + (size_t)(h * 64 + c) * 128 + 16 * hh;
        f32x16 o0, o1;
#pragma unroll
        for (int i = 0; i < 16; ++i) { o0[i] = 0.f; o1[i] = 0.f; }
        float R = 0.f;
        bf16x8 kf[4], vf[4], kn[4], vn[4];
#pragma unroll
        for (int jj = 0; jj < 4; ++jj) { kf[jj] = ldg8(kbase + (size_t)t0 * 512 + 16 * jj); vf[jj] = ldg8(vbase + (size_t)(t0 >> 7) * 512 * 128 + (t0 & 127) + (jj >> 1) * 32 * 128 + 8 * (jj & 1)); }
        for (int kb = qblk; kb >= 0; --kb) {
            const int s0 = kb * 32;
            if (kb > 0) {
#pragma unroll
                for (int jj = 0; jj < 4; ++jj) { kn[jj] = ldg8(kbase + (size_t)(s0 - 32) * 512 + 16 * jj); vn[jj] = ldg8(vbase + (size_t)((s0 - 32) >> 7) * 512 * 128 + ((s0 - 32) & 127) + (jj >> 1) * 32 * 128 + 8 * (jj & 1)); }
            }
            f32x16 s;
#pragma unroll
            for (int i = 0; i < 16; ++i) s[i] = 0.f;
#pragma unroll
            for (int jj = 0; jj < 4; ++jj) s = MFMA32(kf[jj], qf[jj], s);
            const bool diag = (kb == qblk);
            float sp[16]; float rsum = 0.f;
#pragma unroll
            for (int i = 0; i < 16; ++i) { const float x = s[i]; float v = fmaxf(x, 0.f) + __builtin_amdgcn_logf(1.f + __builtin_amdgcn_exp2f(-fabsf(x)));
                if (diag && !(16 * hh + i < c)) v = 0.f;
                sp[i] = v; rsum += v; }
            f32x16 E;
#pragma unroll
            for (int i = 0; i < 16; ++i) E[i] = 0.f;
            E = MFMA32(U[0], pack8(sp), E); E = MFMA32(U[1], pack8(sp + 8), E);
            float at[16];
#pragma unroll
            for (int i = 0; i < 16; ++i) { float av = __builtin_amdgcn_exp2f(s[i] - sp[i] - E[i] - R); if (diag && !(16 * hh + i < c)) av = 0.f; at[i] = av; }
            const bf16x8 a0 = pack8(at), a1 = pack8(at + 8);
            o0 = MFMA32(vf[0], a0, o0); o0 = MFMA32(vf[1], a1, o0);
            o1 = MFMA32(vf[2], a0, o1); o1 = MFMA32(vf[3], a1, o1);
            rsum += __shfl_xor(rsum, 32); R += rsum;
            if (__all(R > 48.f)) break;
#pragma unroll
            for (int jj = 0; jj < 4; ++jj) { kf[jj] = kn[jj]; vf[jj] = vn[jj]; }
        }
#pragma unroll
        for (int g = 0; g < 4; ++g) { u32x2 w0, w1; w0.x = cvt_pk_bf16(o0[4 * g], o0[4 * g + 1]); w0.y = cvt_pk_bf16(o0[4 * g + 2], o0[4 * g + 3]); w1.x = cvt_pk_bf16(o1[4 * g], o1[4 * g + 1]); w1.y = cvt_pk_bf16(o1[4 * g + 2], o1[4 * g + 3]);
            *(u32x2*)(yp + 8 * g + 4 * hh) = w0; *(u32x2*)(yp + 32 + 8 * g + 4 * hh) = w1; }
    }
}

__device__ __forceinline__ void xattn_lds(const bf16_t* XQ, const bf16_t* KMl, const bf16_t* VtMl, bf16_t* XO, int bid, int G, int tid, int wave, int lane, LAS unsigned char* lds) {
    constexpr int KP = 272, VP = 528;
    LAS unsigned char* Ks = lds; LAS unsigned char* Vs = lds + 256 * KP;
    const int c = lane & 31, hh = lane >> 5, pr = pi32(c);
    for (int u = bid; u < 256; u += G) { const int b = u >> 4, hd = (u >> 2) & 3, qz = u & 3;
        __syncthreads();
        { u32x4 kr[8], vr[8];
#pragma unroll
          for (int i = 0; i < 8; ++i) { const int idx = tid + 512 * i; kr[i] = *(const u32x4*)(KMl + (size_t)(b * MEMLEN + (idx >> 4)) * 2048 + hd * 128 + (idx & 15) * 8);
              vr[i] = *(const u32x4*)(VtMl + (size_t)(hd * 128 + (idx >> 5)) * TM + b * MEMLEN + (idx & 31) * 8); }
#pragma unroll
          for (int i = 0; i < 8; ++i) { const int idx = tid + 512 * i; *(LAS u32x4*)(Ks + (idx >> 4) * KP + (idx & 15) * 16) = kr[i]; *(LAS u32x4*)(Vs + (idx >> 5) * VP + (idx & 31) * 16) = vr[i]; } }
        __syncthreads();
        const LAS unsigned char* kl = Ks + pr * KP + 16 * hh;
        const LAS unsigned char* vl = Vs + c * VP + 32 * hh;
        for (int qi = 0; qi < 2; ++qi) { const int t0 = (qz * 16 + wave * 2 + qi) * 32;
            const bf16_t* qp = XQ + (size_t)(b * SEQ + t0 + c) * 512 + hd * 128 + 8 * hh;
            bf16x8 qf[8];
#pragma unroll
            for (int jj = 0; jj < 8; ++jj) qf[jj] = ldg8(qp + 16 * jj);
            float mx = -3.0e38f;
            for (int kb = 0; kb < 8; ++kb) { f32x16 sc;
#pragma unroll
                for (int i = 0; i < 16; ++i) sc[i] = 0.f;
#pragma unroll
                for (int jj = 0; jj < 8; ++jj) sc = MFMA32(*(const LAS bf16x8*)(kl + kb * 32 * KP + 32 * jj), qf[jj], sc);
#pragma unroll
                for (int i = 0; i < 16; ++i) mx = fmaxf(mx, sc[i]); }
            mx = fmaxf(mx, __shfl_xor(mx, 32));
            f32x16 o[4];
#pragma unroll
            for (int db = 0; db < 4; ++db)
#pragma unroll
                for (int i = 0; i < 16; ++i) o[db][i] = 0.f;
            float sum = 0.f;
            for (int kb = 0; kb < 8; ++kb) { f32x16 sc;
#pragma unroll
                for (int i = 0; i < 16; ++i) sc[i] = 0.f;
#pragma unroll
                for (int jj = 0; jj < 8; ++jj) sc = MFMA32(*(const LAS bf16x8*)(kl + kb * 32 * KP + 32 * jj), qf[jj], sc);
                float pv[16];
#pragma unroll
                for (int i = 0; i < 16; ++i) { pv[i] = __builtin_amdgcn_exp2f(sc[i] - mx); sum += pv[i]; }
                const bf16x8 p0 = pack8(pv), p1 = pack8(pv + 8);
#pragma unroll
                for (int db = 0; db < 4; ++db) { const LAS unsigned char* vp = vl + db * 32 * VP + kb * 64; o[db] = MFMA32(*(const LAS bf16x8*)vp, p0, o[db]); o[db] = MFMA32(*(const LAS bf16x8*)(vp + 16), p1, o[db]); } }
            sum += __shfl_xor(sum, 32);
            const float inv = 1.f / sum;
            bf16_t* op = XO + (size_t)(b * SEQ + t0 + c) * 512 + hd * 128 + 4 * hh;
#pragma unroll
            for (int db = 0; db < 4; ++db)
#pragma unroll
                for (int g = 0; g < 4; ++g) { u32x2 w0; w0.x = cvt_pk_bf16(o[db][4 * g] * inv, o[db][4 * g + 1] * inv); w0.y = cvt_pk_bf16(o[db][4 * g + 2] * inv, o[db][4 * g + 3] * inv);
                    *(u32x2*)(op + 32 * db + 8 * g) = w0; }
        }
    }
}

template <int CTRL, int ROWMASK> __device__ __forceinline__ float dpp_mov0(float v) { return __builtin_bit_cast(float, __builtin_amdgcn_update_dpp(0, __builtin_bit_cast(int, v), CTRL, ROWMASK, 0xF, false)); }
__device__ __forceinline__ float wave_incl_scan(float v, int) {
    v += dpp_mov0<0x111, 0xF>(v); v += dpp_mov0<0x112, 0xF>(v); v += dpp_mov0<0x114, 0xF>(v); v += dpp_mov0<0x118, 0xF>(v);
    v += dpp_mov0<0x142, 0xA>(v); v += dpp_mov0<0x143, 0xC>(v);
    return v;
}
__device__ __forceinline__ float lane63(float v) { return __builtin_bit_cast(float, __builtin_amdgcn_readlane(__builtin_bit_cast(int, v), 63)); }
__device__ __forceinline__ void conv_unit(const bf16_t* XBC, const float* cw, const float* cb, bf16_t* XT, bf16_t* BR, bf16_t* BT, bf16_t* CR, int u, int lane) {
    const int tb = u / 10, cbk = u - tb * 10, tok0 = tb * 64, ch0 = cbk * 128 + 2 * lane;
    float w[4][2], bs[2];
#pragma unroll
    for (int k = 0; k < 4; ++k) { w[k][0] = cw[k * 1280 + ch0]; w[k][1] = cw[k * 1280 + ch0 + 1]; }
    bs[0] = cb[ch0]; bs[1] = cb[ch0 + 1];
    const bf16_t* src = XBC + (size_t)tok0 * 1280 + ch0;
    float h0[2] = {0.f, 0.f}, h1[2] = {0.f, 0.f}, h2[2] = {0.f, 0.f};
    if ((tok0 & (SEQ - 1)) != 0) { const unsigned a = *(const unsigned*)(src - 3 * 1280), b = *(const unsigned*)(src - 2 * 1280), c = *(const unsigned*)(src - 1280);
        h0[0] = bflo(a); h0[1] = bfhi(a); h1[0] = bflo(b); h1[1] = bfhi(b); h2[0] = bflo(c); h2[1] = bfhi(c); }
    unsigned ylo[32], yhi[32]; float pe0 = 0.f, pe1 = 0.f;
    bf16_t* rdst = (cbk == 8) ? BR : CR;
#pragma unroll
    for (int tt = 0; tt < 64; ++tt) { const unsigned xw = *(const unsigned*)(src + (size_t)tt * 1280); const float x0 = bflo(xw), x1 = bfhi(xw);
        float v0 = bs[0] + w[0][0] * h0[0] + w[1][0] * h1[0] + w[2][0] * h2[0] + w[3][0] * x0, v1 = bs[1] + w[0][1] * h0[1] + w[1][1] * h1[1] + w[2][1] * h2[1] + w[3][1] * x1;
        v0 *= sigmoidf_(v0); v1 *= sigmoidf_(v1);
        h0[0] = h1[0]; h0[1] = h1[1]; h1[0] = h2[0]; h1[1] = h2[1]; h2[0] = x0; h2[1] = x1;
        if (cbk >= 8) *(unsigned*)(rdst + (size_t)(tok0 + tt) * 128 + 2 * lane) = cvt_pk_bf16(v0, v1);
        if (tt & 1) { ylo[tt >> 1] = cvt_pk_bf16(pe0, v0); yhi[tt >> 1] = cvt_pk_bf16(pe1, v1); } else { pe0 = v0; pe1 = v1; } }
    if (cbk <= 8) { bf16_t* tbase = (cbk < 8) ? XT + ((size_t)(tok0 >> 7) * 1024 + ch0) * 128 + (tok0 & 127) : BT + ((size_t)(tok0 >> 7) * 128 + 2 * lane) * 128 + (tok0 & 127);
#pragma unroll
        for (int q = 0; q < 8; ++q) { u32x4 a, b; a.x = ylo[4 * q]; a.y = ylo[4 * q + 1]; a.z = ylo[4 * q + 2]; a.w = ylo[4 * q + 3]; b.x = yhi[4 * q]; b.y = yhi[4 * q + 1]; b.z = yhi[4 * q + 2]; b.w = yhi[4 * q + 3];
            *(u32x4*)(tbase + 8 * q) = a; *(u32x4*)(tbase + 128 + 8 * q) = b; } }
}
__device__ __forceinline__ void ssd_scan_block(const bf16_t* XT, const bf16_t* BT, const float* DTT, bf16_t* PREV, float negA, int b, int h, int wave, int lane, LAS float* wl  , LAS float* xch  ) {
    const int c32 = lane & 31, hh = lane >> 5, g = h >> 3, q = wave & 3, pblk = q >> 1, nblk = q & 1, c0 = (wave >> 2) * 8;
    const bf16_t* xrow = XT + ((size_t)(b * 16) * 1024 + h * 64 + pblk * 32 + c32) * 128 + 8 * hh;
    const bf16_t* brow = BT + ((size_t)(b * 16) * 128 + g * 64 + nblk * 32 + c32) * 128 + 8 * hh;
    const float* dtp = DTT + (size_t)h * T + b * SEQ + lane;
    f32x16 S[8]; float dec[8];
#pragma unroll
    for (int ci = 0; ci < 8; ++ci) { const int c = c0 + ci;
        const float d0 = dtp[c * 128], d1 = dtp[c * 128 + 64];
        u32x4 xa[8]; bf16x8 ba[8];
#pragma unroll
        for (int ks = 0; ks < 8; ++ks) { xa[ks] = *(const u32x4*)(xrow + (size_t)c * 1024 * 128 + 16 * ks); ba[ks] = ldg8(brow + (size_t)c * 128 * 128 + 16 * ks); }
        const float s0 = wave_incl_scan(d0 * negA, lane); const float tot0 = lane63(s0);
        const float s1 = wave_incl_scan(d1 * negA, lane) + tot0; const float last = lane63(s1);
        wl[lane] = d0 * fexp(last - s0); wl[64 + lane] = d1 * fexp(last - s1);
        dec[ci] = fexp(last);
        f32x16 st;
#pragma unroll
        for (int i = 0; i < 16; ++i) st[i] = 0.f;
#pragma unroll
        for (int ks = 0; ks < 8; ++ks) { const u32x4 xw = xa[ks];
            const f32x4 wa = *(const LAS f32x4*)(wl + 16 * ks + 8 * hh), wb = *(const LAS f32x4*)(wl + 16 * ks + 8 * hh + 4);
            float xs[8]; xs[0] = bflo(xw.x) * wa.x; xs[1] = bfhi(xw.x) * wa.y; xs[2] = bflo(xw.y) * wa.z; xs[3] = bfhi(xw.y) * wa.w; xs[4] = bflo(xw.z) * wb.x; xs[5] = bfhi(xw.z) * wb.y; xs[6] = bflo(xw.w) * wb.z; xs[7] = bfhi(xw.w) * wb.w;
            st = MFMA32(pack8(xs), ba[ks], st); }
        S[ci] = st;
        asm volatile("" ::: "memory");
    }
    f32x16 carry;
#pragma unroll
    for (int i = 0; i < 16; ++i) carry[i] = 0.f;
    LAS float* xq = xch + q * 1024 + lane;
    bf16_t* pv = PREV + ((size_t)((b * 16) * 16 + h) * 64 + pblk * 32) * 64 + nblk * 32 + c32;
#pragma unroll
    for (int half = 0; half < 2; ++half) {
        if ((wave >> 2) == half) {
            if (half == 1) {
#pragma unroll
                for (int i = 0; i < 16; ++i) carry[i] = xq[i * 64]; }
#pragma unroll
            for (int ci = 0; ci < 8; ++ci) { bf16_t* pc = pv + (size_t)(c0 + ci) * 16 * 4096;
#pragma unroll
                for (int i = 0; i < 16; ++i) pc[(8 * (i >> 2) + 4 * hh + (i & 3)) * 64] = f2bf(carry[i]);
#pragma unroll
                for (int i = 0; i < 16; ++i) carry[i] = carry[i] * dec[ci] + S[ci][i]; }
            if (half == 0) {
#pragma unroll
                for (int i = 0; i < 16; ++i) xq[i * 64] = carry[i]; }
        }
        if (half == 0) { asm volatile("s_waitcnt lgkmcnt(0)" ::: "memory"); __builtin_amdgcn_s_barrier(); asm volatile("" ::: "memory"); }
    }
}
__device__ __forceinline__ void ssd_out_unit(const bf16_t* XT, const bf16_t* BR, const bf16_t* CR, const float* DTT, const bf16_t* PREV, const bf16_t* Zb, bf16_t* Y, float negA, float dsk,
                                             int b, int c, int g, int wave, int lane, LAS float* tab  , LAS float* red  , const int var) {
    const int c32 = lane & 31, hh = lane >> 5, pr = pi32(c32), h = g * 8 + wave;
    const int tokc = b * SEQ + c * 128;
    const float* dtp = DTT + (size_t)h * T + tokc + lane;
    const float d0 = dtp[0], d1 = dtp[64];
    const bf16_t* pv = PREV + ((size_t)((b * 16 + c) * 16 + h) * 64 + c32) * 64 + 8 * hh;
    const bf16_t* xrow = XT + ((size_t)(b * 16 + c) * 1024 + h * 64 + c32) * 128 + 16 * hh;
    const bf16_t* brow = BR + (size_t)(tokc + pr) * 128 + g * 64 + 8 * hh;
    const float s0 = wave_incl_scan(d0 * negA, lane); const float tot0 = lane63(s0);
    const float s1 = wave_incl_scan(d1 * negA, lane) + tot0;
    tab[lane] = s0; tab[64 + lane] = s1; tab[128 + lane] = d0; tab[192 + lane] = d1;
    for (int tq = 0; tq < ((var & 8) ? 0 : 4); ++tq) {
        const size_t tokg = (size_t)(tokc + tq * 32 + c32);
        bf16x8 cf[4], pf[8];
#pragma unroll
        for (int ks = 0; ks < 4; ++ks) cf[ks] = ldg8(CR + tokg * 128 + g * 64 + 16 * ks + 8 * hh);
#pragma unroll
        for (int ks = 0; ks < 4; ++ks) { pf[ks] = ldg8(pv + 16 * ks); pf[4 + ks] = ldg8(pv + 32 * 64 + 16 * ks); }
        bf16x8 bfr[4], xfr[4], bnx[4], xnx[4];
#pragma unroll
        for (int ks = 0; ks < 4; ++ks) bfr[ks] = ldg8(brow + 16 * ks);
        xfr[0] = ldg8(xrow); xfr[1] = ldg8(xrow + 8); xfr[2] = ldg8(xrow + 32 * 128); xfr[3] = ldg8(xrow + 32 * 128 + 8);
        const bf16_t* zp = Zb + tokg * 1024 + h * 64 + 4 * hh;
        u32x2 zr[8];
#pragma unroll
        for (int gq = 0; gq < 4; ++gq) { zr[gq] = *(const u32x2*)(zp + 8 * gq); zr[4 + gq] = *(const u32x2*)(zp + 32 + 8 * gq); }
        const float acum_t = tab[tq * 32 + c32];
        f32x16 y0, y1;
#pragma unroll
        for (int i = 0; i < 16; ++i) { y0[i] = 0.f; y1[i] = 0.f; }
        if (!(var & 2))
#pragma unroll
        for (int ks = 0; ks < 4; ++ks) { y0 = MFMA32(pf[ks], cf[ks], y0); y1 = MFMA32(pf[4 + ks], cf[ks], y1); }
        { const float ea = fexp(acum_t);
#pragma unroll
          for (int i = 0; i < 16; ++i) { y0[i] *= ea; y1[i] *= ea; } }
        for (int j = 0; j <= ((var & 1) ? -1 : tq); ++j) {
            if (j < tq) {
#pragma unroll
                for (int ks = 0; ks < 4; ++ks) bnx[ks] = ldg8(brow + (size_t)(32 * (j + 1)) * 128 + 16 * ks);
                xnx[0] = ldg8(xrow + 32 * (j + 1)); xnx[1] = ldg8(xrow + 32 * (j + 1) + 8); xnx[2] = ldg8(xrow + 32 * 128 + 32 * (j + 1)); xnx[3] = ldg8(xrow + 32 * 128 + 32 * (j + 1) + 8); }
            f32x16 cbt;
#pragma unroll
            for (int i = 0; i < 16; ++i) cbt[i] = 0.f;
#pragma unroll
            for (int ks = 0; ks < 4; ++ks) cbt = MFMA32(bfr[ks], cf[ks], cbt);
            float m[16];
#pragma unroll
            for (int q = 0; q < 4; ++q) { const f32x4 as = *(const LAS f32x4*)(tab + 32 * j + 16 * hh + 4 * q), ds = *(const LAS f32x4*)(tab + 128 + 32 * j + 16 * hh + 4 * q);
#pragma unroll
                for (int e = 0; e < 4; ++e) { const int i = 4 * q + e; float v = cbt[i] * ds[e] * fexp(acum_t - as[e]);
                    if (j == tq) { if (16 * hh + i > c32) v = 0.f; if (16 * hh + i == c32) v += dsk; }
                    m[i] = v; } }
            const bf16x8 m0 = pack8(m), m1 = pack8(m + 8);
            y0 = MFMA32(xfr[0], m0, y0); y0 = MFMA32(xfr[1], m1, y0);
            y1 = MFMA32(xfr[2], m0, y1); y1 = MFMA32(xfr[3], m1, y1);
#pragma unroll
            for (int ks = 0; ks < 4; ++ks) { bfr[ks] = bnx[ks]; xfr[ks] = xnx[ks]; }
        }
        float ss = 0.f;
#pragma unroll
        for (int gq = 0; gq < 4; ++gq) { const u32x2 za = zr[gq], zb2 = zr[4 + gq];
            const float z0[4] = {bflo(za.x), bfhi(za.x), bflo(za.y), bfhi(za.y)}, z1[4] = {bflo(zb2.x), bfhi(zb2.x), bflo(zb2.y), bfhi(zb2.y)};
#pragma unroll
            for (int e = 0; e < 4; ++e) { const int i = 4 * gq + e; y0[i] *= z0[e] * sigmoidf_(z0[e]); y1[i] *= z1[e] * sigmoidf_(z1[e]); ss += y0[i] * y0[i] + y1[i] * y1[i]; } }
        ss += __shfl_xor(ss, 32);
        LAS float* rd = red + (tq & 1) * 256;
        if (hh == 0) rd[wave * 32 + c32] = ss;
        asm volatile("s_waitcnt lgkmcnt(0)" ::: "memory"); __builtin_amdgcn_s_barrier(); asm volatile("" ::: "memory");
        float tot = 0.f;
#pragma unroll
        for (int w8 = 0; w8 < 8; ++w8) tot += rd[w8 * 32 + c32];
        const float rstd = __builtin_amdgcn_rsqf(tot * (1.f / 512.f) + EPS);
        bf16_t* yp = Y + tokg * 1024 + h * 64 + 4 * hh;
#pragma unroll
        for (int gq = 0; gq < 4; ++gq) { u32x2 o0, o1; o0.x = cvt_pk_bf16(y0[4 * gq] * rstd, y0[4 * gq + 1] * rstd); o0.y = cvt_pk_bf16(y0[4 * gq + 2] * rstd, y0[4 * gq + 3] * rstd);
            o1.x = cvt_pk_bf16(y1[4 * gq] * rstd, y1[4 * gq + 1] * rstd); o1.y = cvt_pk_bf16(y1[4 * gq + 2] * rstd, y1[4 * gq + 3] * rstd);
            if (!(var & 4)) { *(u32x2*)(yp + 8 * gq) = o0; *(u32x2*)(yp + 32 + 8 * gq) = o1; } }
    }
}

#define PHASE_ENTER() GAS unsigned char* ws_ = (GAS unsigned char*)p.ws; asm volatile("" : "+s"(ws_)); unsigned char* const ws = (unsigned char*)ws_;     \
    GAS float* out_ = (GAS float*)p.out; asm volatile("" : "+s"(out_)); float* const OUTP = (float*)out_; (void)OUTP; int tid_ = wave0 * 64 + lane_id_opaque(); int bid_ = blockIdx.x; asm volatile("" : "+s"(bid_)); \
    const int tid = tid_, lane = tid & 63, wave = __builtin_amdgcn_readfirstlane(tid >> 6); \
    const int G = gridDim.x, bid = bid_, gw = bid * 8 + wave, NGW = G * 8; (void)lane; (void)gw; (void)NGW; (void)wave; (void)bid; (void)G
#define WSP(type, off) ((type*)(ws + (off)))
__global__ void __launch_bounds__(512, 2) mk_fwd(Params p) {
    extern __shared__ __attribute__((aligned(16))) unsigned char lds_raw[];
    LAS unsigned char* lds = (LAS unsigned char*)lds_raw;
    volatile LAS unsigned* ldsctl = (volatile LAS unsigned*)(lds + LDSCTL_OFF);
    if (threadIdx.x < 64) ldsctl[threadIdx.x] = 0u;
    int wave0 = __builtin_amdgcn_readfirstlane((int)threadIdx.x >> 6); asm volatile("" : "+s"(wave0));
    __syncthreads();
    const int ph_lo = p.ph_lo, ph_hi = p.ph_hi;
    const bool use_bar = (ph_hi - ph_lo) > 1 || (p.l_hi - p.l_lo) > 1;
    XcdBarrier bar; bar.bar = (unsigned*)(p.ws + WS_CTL) + CW_BAR; bar.x = 0; bar.st = nullptr;
    if (use_bar) bar = xcd_barrier_post((unsigned*)(p.ws + WS_CTL) + CW_BAR, ldsctl + 8);
#define PH(k) (ph_lo <= (k) && (k) < ph_hi)
#define GRID_BAR() do { if (use_bar) xcd_barrier(bar, wave0 == 0 && lane_id_opaque() == 0); } while (0)

    if (p.l_lo == 0 && PH(0)) for (int rep = 0; rep < NREP(0); ++rep) {
        PHASE_ENTER();
        LAS float* scr = (LAS float*)(lds + wave * 16384);
        int base = 0;
        for (int jb = 0; jb < 4 * 12 + 2 * 3; ++jb) {
            TrJob j;
            if (jb < 48) { const int l = jb / 12, k = jb % 12; unsigned char* wl = ws + WS_W + (size_t)l * W_LAYER;
                switch (k) {
                case 0: j = TrJob{p.in[I_W_IN] + (size_t)l * D * INW, INW, D, 0, 2304, p.in[I_NORM_MIX] + l * D, (bf16_t*)(wl + W_IN), 0, 128}; break;
                case 1: j = TrJob{p.in[I_W_IN] + (size_t)l * D * INW, INW, D, 2320, 1024, p.in[I_NORM_MIX] + l * D, (bf16_t*)(wl + W_IN), 2304, 128}; break;
                case 9: j = TrJob{p.in[I_W_IN] + (size_t)l * D * INW, INW, D, 3344, 512, p.in[I_NORM_MIX] + l * D, (bf16_t*)(wl + W_IN), NMAIN, 128}; break;
                case 11: j = TrJob{p.in[I_W_IN] + (size_t)l * D * INW, INW, D, 2304, 32, p.in[I_NORM_MIX] + l * D, (bf16_t*)(wl + W_IN), 5376, 128}; break;
                case 10: j = TrJob{p.in[I_W_IN] + (size_t)l * D * INW, INW, D, 3856, 2048, p.in[I_NORM_MIX] + l * D, (bf16_t*)(wl + W_IN), 3328, 128}; break;
                case 2: j = TrJob{p.in[I_W_SSD_O] + (size_t)l * D * D, D, D, 0, D, p.in[I_SSD_NORM] + l * D, (bf16_t*)(wl + W_SSDO), 0, 128}; break;
                case 3: j = TrJob{p.in[I_W_SB_O] + (size_t)l * 512 * D, D, 512, 0, D, nullptr, (bf16_t*)(wl + W_SBO), 0, 128}; break;
                case 4: j = TrJob{p.in[I_W_OUT] + (size_t)l * D * D, D, D, 0, D, nullptr, (bf16_t*)(wl + W_OUT), 0, 128}; break;
                case 5: j = TrJob{p.in[I_XA_WQ] + (size_t)l * D * 512, 512, D, 0, 512, p.in[I_NORM_XA] + l * D, (bf16_t*)(wl + W_Q), 0, 128}; break;
                case 6: j = TrJob{p.in[I_XA_WK] + (size_t)l * D * 512, 512, D, 0, 512, p.in[I_NORM_MEM] + l * D, (bf16_t*)(ws + WS_WKV), l * 512, 128}; break;
                case 7: j = TrJob{p.in[I_XA_WV] + (size_t)l * D * 512, 512, D, 0, 512, p.in[I_NORM_MEM] + l * D, (bf16_t*)(ws + WS_WKV), 2048 + l * 512, 128}; break;
                case 8: j = TrJob{p.in[I_XA_WO] + (size_t)l * 512 * D, D, 512, 0, D, nullptr, (bf16_t*)(wl + W_O), 0, 128}; break;
                }
            } else { const int jj = (jb - 48) / 3, k = (jb - 48) % 3; unsigned char* wf = ws + WS_WFF + (size_t)jj * W_FF; const float* gn = p.in[I_NORM_FFN] + (2 * jj) * D;
                if (k == 0) j = TrJob{p.in[I_FFN_G] + (size_t)jj * D * DFF, DFF, D, 0, DFF, gn, (bf16_t*)(wf + W_GU), 0, 256};
                else if (k == 1) j = TrJob{p.in[I_FFN_U] + (size_t)jj * D * DFF, DFF, D, 0, DFF, gn, (bf16_t*)(wf + W_GU), 128, 256};
                else j = TrJob{p.in[I_FFN_D] + (size_t)jj * DFF * D, D, DFF, 0, D, nullptr, (bf16_t*)(wf + W_DN), 0, 128};
            }
            run_job(j, base, gw, NGW, scr, lane);
        }
        bf16_t* MEMB = WSP(bf16_t, WS_MEMB); float* RSMEM = WSP(float, WS_RSMEM);
        for (int m = gw; m < TM; m += NGW) { const float q = row_to_bf16(p.in[I_MEM] + (size_t)m * D, MEMB + (size_t)m * D, lane); if (lane == 0) RSMEM[m] = __builtin_amdgcn_rsqf(q * (1.f / D) + EPS); }
        { bf16_t* HB = WSP(bf16_t, WS_HB); float* SSQ = WSP(float, WS_SSQ + (size_t)(12) * SSQ_BYTES);
          for (int m = gw; m < T; m += NGW) { const float q = row_to_bf16(p.in[I_X] + (size_t)m * D, HB + (size_t)m * D, lane); if (lane < 4) SSQ[(size_t)m * 4 + lane] = lane == 0 ? q : 0.f; } }
        for (int it = gw; it < 4 * 224; it += NGW) { const int l = it / 224, r = 5408 + it % 224;
            u32x4* dst = (u32x4*)(WSP(bf16_t, WS_W + (size_t)l * W_LAYER + W_IN) + (size_t)r * 1024); const u32x4 zz = {0u, 0u, 0u, 0u}; dst[lane] = zz; dst[lane + 64] = zz; }
        GRID_BAR();
    }
    if (p.l_lo == 0 && PH(1)) for (int rep = 0; rep < NREP(1); ++rep) {
        PHASE_ENTER();
        { pg8::Gemm g{WSP(bf16_t, WS_MEMB), WSP(bf16_t, WS_WKV), D, D, D}; pg8::StaticOrder S; S.init(TM, 2048, G, bid);
          pg8::EpiBf16Rs E{WSP(bf16_t, WS_KM), 2048, WSP(float, WS_RSMEM), 1.f, 0};
          pg8::gemm_phase<pg8::EpiBf16Rs, pg8::StaticOrder, true, true>(lds, g, S, E, wave0); }
        { pg8::Gemm g{WSP(bf16_t, WS_WKV) + (size_t)2048 * 1024, WSP(bf16_t, WS_MEMB), D, D, D}; pg8::StaticOrder S; S.init(2048, TM, G, (bid + G / 2) % G);
          pg8::EpiBf16Cs E{WSP(bf16_t, WS_VTM), TM, WSP(float, WS_RSMEM), 1.f, 0};
          pg8::gemm_phase<pg8::EpiBf16Cs, pg8::StaticOrder, true, true>(lds, g, S, E, wave0); }
        GRID_BAR();
    }

    for (int l = p.l_lo; l < p.l_hi; ++l) {
        const bool moe = (l & 1) != 0; const int jf = l >> 1;

        if (PH(3)) for (int rep = 0; rep < NREP(3); ++rep) {
            PHASE_ENTER();
            pg8::Gemm g{WSP(bf16_t, WS_HB), (const bf16_t*)(ws + WS_W + (size_t)l * W_LAYER + W_IN), D, D, D}; pg8::StaticOrder S; S.init(T, NMAIN, G, bid);
            pg8::EpiInProj E{ws + WS_X, WSP(float, WS_SSQ + (size_t)(l == 0 ? 12 : 3 * l - 1) * SSQ_BYTES), WSP(float, WS_RS), WSP(float, WS_DT), p.in[I_DT_BIAS] + l * 16};
            pg8::gemm_phase<pg8::EpiInProj, pg8::StaticOrder, true, true>(lds, g, S, E, wave0);
            GRID_BAR();
        }
        if (PH(4)) for (int rep = 0; rep < NREP(4); ++rep) {
            PHASE_ENTER();
            const float* cw = p.in[I_CONV_W] + (size_t)l * 4 * 1280; const float* cb = p.in[I_CONV_B] + (size_t)l * 1280;
            for (int u = gw; u < (T / 64) * 10; u += NGW) conv_unit(WSP(bf16_t, WS_X + X_XBC), cw, cb, WSP(bf16_t, WS_X + X_XT), WSP(bf16_t, WS_X + X_BR), WSP(bf16_t, WS_X + X_BT), WSP(bf16_t, WS_X + X_CR), u, lane);
            { pg8::Gemm g{(const bf16_t*)(ws + WS_W + (size_t)l * W_LAYER + W_IN) + (size_t)NMAIN * 1024, WSP(bf16_t, WS_HB), D, D, D}; pg8::StaticOrder S; S.init(512, T, G, bid);
              pg8::EpiBf16Cs E{WSP(bf16_t, WS_X + X_V), T, WSP(float, WS_RS), 1.f, 512};
              pg8::gemm_phase<pg8::EpiBf16Cs, pg8::StaticOrder, true, true>(lds, g, S, E, wave0); }
            if (moe) {
                LAS float* scr = (LAS float*)(lds + wave * 16384);
                int base = 0; const float* gn = p.in[I_NORM_FFN] + l * D;
                for (int jb = 0; jb < NEXP * 3; ++jb) { const int e = jb / 3, k = jb % 3; TrJob j; const size_t eo = ((size_t)jf * NEXP + e) * D * DFF;
                    if (k == 0) j = TrJob{p.in[I_MOE_G] + eo, DFF, D, 0, DFF, gn, (bf16_t*)(ws + WS_WMOE + WM_GU) + (size_t)e * 2 * DFF * 1024, 0, 256};
                    else if (k == 1) j = TrJob{p.in[I_MOE_U] + eo, DFF, D, 0, DFF, gn, (bf16_t*)(ws + WS_WMOE + WM_GU) + (size_t)e * 2 * DFF * 1024, 128, 256};
                    else j = TrJob{p.in[I_MOE_D] + eo, D, DFF, 0, D, nullptr, (bf16_t*)(ws + WS_WMOE + WM_DN) + (size_t)e * 1024 * DFF, 0, 128};
                    run_job(j, base, gw, NGW, scr, lane); }
            }
            GRID_BAR();
        }
        if (PH(5)) for (int rep = 0; rep < NREP(5); ++rep) {
            PHASE_ENTER();
            const int pvar = (rep + 1 < NREP(5)) ? PROBE_VAR : 0;
            if (!(pvar & 1)) for (int u = bid; u < NBATCH * 16; u += G) { const int b = u >> 4, h = u & 15;
                __syncthreads();
                ssd_scan_block(WSP(bf16_t, WS_X + X_XT), WSP(bf16_t, WS_X + X_BT), WSP(float, WS_DT), WSP(bf16_t, WS_X + X_PREV), -fexp(p.in[I_A_LOG][l * 16 + h]), b, h, wave, lane, (LAS float*)(lds + wave * 1024), (LAS float*)(lds + 8192)); }
            if (!(pvar & 2)) sb_attn_mfma(WSP(bf16_t, WS_X + X_Q), WSP(bf16_t, WS_X + X_K), WSP(bf16_t, WS_X + X_V), (rep + 1 < NREP(5)) ? WSP(bf16_t, WS_X + X_XBC) : WSP(bf16_t, WS_X + X_Q), bid, G, wave, lane);
            GRID_BAR();
        }
        if (PH(6)) for (int rep = 0; rep < NREP(6); ++rep) {
            PHASE_ENTER();
            for (int u = bid; u < 512; u += G) { const int b = u >> 5, c = (u >> 1) & 15, g = u & 1; const int h = g * 8 + wave;
                ssd_out_unit(WSP(bf16_t, WS_X + X_XT), WSP(bf16_t, WS_X + X_BR), WSP(bf16_t, WS_X + X_CR), WSP(float, WS_DT), WSP(bf16_t, WS_X + X_PREV), WSP(bf16_t, WS_X + X_Z), WSP(bf16_t, WS_X + X_XBC),
                             -fexp(p.in[I_A_LOG][l * 16 + h]), p.in[I_D_SKIP][l * 16 + h], b, c, g, wave, lane, (LAS float*)(lds + wave * 1024), (LAS float*)(lds + 8192), (rep + 1 < NREP(6)) ? PROBE_VAR : 0); }
            GRID_BAR();
        }
        if (PH(7)) for (int rep = 0; rep < NREP(7); ++rep) {
            PHASE_ENTER();
            pg8::Gemm g{WSP(bf16_t, WS_X + X_XBC), (const bf16_t*)(ws + WS_W + (size_t)l * W_LAYER + W_SSDO), D, D, D}; pg8::StaticOrder S; S.init(T, D, G, bid);
            pg8::EpiGate<false> E{WSP(bf16_t, WS_X + X_Z), WSP(bf16_t, WS_X + X_GS), 0, WSP(bf16_t, WS_X + X_Z)};
            pg8::gemm_phase<pg8::EpiGate<false>, pg8::StaticOrder, true, true>(lds, g, S, E, wave0);
        }
        if (PH(8)) for (int rep = 0; rep < NREP(8); ++rep) {
            PHASE_ENTER();
            pg8::Gemm g{WSP(bf16_t, WS_X + X_Q), (const bf16_t*)(ws + WS_W + (size_t)l * W_LAYER + W_SBO), 512, 512, 512}; pg8::StaticOrder S; S.init(T, D, G, bid);
            pg8::EpiGate<true> E{(rep + 1 < NREP(8)) ? WSP(bf16_t, WS_X + X_XT) : WSP(bf16_t, WS_X + X_Z), WSP(bf16_t, WS_X + X_GS), 1024, WSP(bf16_t, WS_X + X_Z)};
            pg8::gemm_phase<pg8::EpiGate<true>, pg8::StaticOrder, true, true>(lds, g, S, E, wave0);
            GRID_BAR();
        }
        if (PH(9)) for (int rep = 0; rep < NREP(9); ++rep) {
            PHASE_ENTER();
            pg8::Gemm g{WSP(bf16_t, WS_X + X_Z), (const bf16_t*)(ws + WS_W + (size_t)l * W_LAYER + W_OUT), D, D, D}; pg8::StaticOrder S; S.init(T, D, G, bid);
            pg8::EpiResidBf E{WSP(bf16_t, WS_HB), (rep + 1 < NREP(9)) ? WSP(bf16_t, WS_X + X_XT) : WSP(bf16_t, WS_HB), WSP(float, WS_SSQ + (size_t)((rep + 1 < NREP(9)) ? 13 : 3 * l) * SSQ_BYTES), (LAS float*)(lds + 131072)};
            pg8::gemm_phase<pg8::EpiResidBf, pg8::StaticOrder, true, true>(lds, g, S, E, wave0);
            GRID_BAR();
        }
        if (PH(11)) for (int rep = 0; rep < NREP(11); ++rep) {
            PHASE_ENTER();
            pg8::Gemm g{WSP(bf16_t, WS_HB), (const bf16_t*)(ws + WS_W + (size_t)l * W_LAYER + W_Q), D, D, D}; pg8::StaticOrder S; S.init(T, 512, G, bid);
            pg8::EpiBf16Rs E{WSP(bf16_t, WS_X + X_K), 512, WSP(float, WS_SSQ + (size_t)(3 * l) * SSQ_BYTES), 0.12751743082459868f, 1};
            pg8::gemm_phase<pg8::EpiBf16Rs, pg8::StaticOrder, true, true>(lds, g, S, E, wave0);
            GRID_BAR();
        }
        if (PH(12)) for (int rep = 0; rep < NREP(12); ++rep) {
            PHASE_ENTER();
            xattn_lds(WSP(bf16_t, WS_X + X_K), WSP(bf16_t, WS_KM) + l * 512, WSP(bf16_t, WS_VTM) + (size_t)l * 512 * TM, WSP(bf16_t, WS_X + X_V), bid, G, tid, wave, lane, lds);
            GRID_BAR();
        }
        if (PH(13)) for (int rep = 0; rep < NREP(13); ++rep) {
            PHASE_ENTER();
            pg8::Gemm g{WSP(bf16_t, WS_X + X_V), (const bf16_t*)(ws + WS_W + (size_t)l * W_LAYER + W_O), 512, 512, 512}; pg8::StaticOrder S; S.init(T, D, G, bid);
            pg8::EpiResidBf E{WSP(bf16_t, WS_HB), (rep + 1 < NREP(13)) ? WSP(bf16_t, WS_X + X_XT) : WSP(bf16_t, WS_HB), WSP(float, WS_SSQ + (size_t)((rep + 1 < NREP(13)) ? 13 : 3 * l + 1) * SSQ_BYTES), (LAS float*)(lds + 131072)};
            pg8::gemm_phase<pg8::EpiResidBf, pg8::StaticOrder, true, true>(lds, g, S, E, wave0);
            GRID_BAR();
        }
        if (moe && PH(14)) for (int rep = 0; rep < NREP(14); ++rep) {
            PHASE_ENTER();
            const bf16_t* HB = WSP(bf16_t, WS_HB); float* RS = WSP(float, WS_RS); const float* SSQ = WSP(float, WS_SSQ + (size_t)(3 * l + 1) * SSQ_BYTES);
            int* TE = WSP(int, WS_MOE + MO_TE); float* TW = WSP(float, WS_MOE + MO_TW); int* TP = WSP(int, WS_MOE + MO_TP); unsigned* CNT = WSP(unsigned, WS_CTL) + CW_CNT + jf * 16;
            LAS float* wsm = (LAS float*)lds;
            for (int i = tid; i < 8 * 1024; i += 512) { const int e = i >> 10, k = i & 1023; wsm[i] = p.in[I_MOE_R][(size_t)jf * D * NEXP + (size_t)k * NEXP + e] * p.in[I_NORM_FFN][l * D + k]; }
            __syncthreads();
            for (int m = gw; m < T; m += NGW) { float lg[8]; const float r = rstd4(SSQ + (size_t)m * 4);
                row_dots_bf16<8>(HB + (size_t)m * D, lane, wsm, r, lg);
                if (lane == 0 && rep + 1 == NREP(14)) { RS[m] = r;
                    int i0 = 0; float v0 = lg[0];
#pragma unroll
                    for (int e = 1; e < 8; ++e) if (lg[e] > v0) { v0 = lg[e]; i0 = e; }
                    int i1 = -1; float v1 = -3.0e38f;
#pragma unroll
                    for (int e = 0; e < 8; ++e) if (e != i0 && lg[e] > v1) { v1 = lg[e]; i1 = e; }
                    const float w0 = __builtin_amdgcn_rcpf(1.f + fexp(v1 - v0));
                    const unsigned p0 = atomicAdd(CNT + i0, 1u), p1 = atomicAdd(CNT + 8 + i1, 1u);
                    TE[m] = i0; TE[T + m] = i1; TW[m] = w0; TW[T + m] = 1.f - w0; TP[m] = (int)p0; TP[T + m] = (int)p1; }
            }
            GRID_BAR();
        }
        if (!moe) {
            if (PH(15)) for (int rep = 0; rep < NREP(15); ++rep) {
                PHASE_ENTER();
                pg8::Gemm g{WSP(bf16_t, WS_HB), (const bf16_t*)(ws + WS_WFF + (size_t)jf * W_FF + W_GU), D, D, D}; pg8::StaticOrder S; S.init(T, 2 * DFF, G, bid);
                pg8::EpiSwiglu E{WSP(bf16_t, WS_X + X_ACT), WSP(float, WS_SSQ + (size_t)(3 * l + 1) * SSQ_BYTES), 1};
                pg8::gemm_phase<pg8::EpiSwiglu, pg8::StaticOrder, true, true>(lds, g, S, E, wave0);
                GRID_BAR();
            }
            if (PH(16)) for (int rep = 0; rep < NREP(16); ++rep) {
                PHASE_ENTER();
                pg8::Gemm g{WSP(bf16_t, WS_X + X_ACT), (const bf16_t*)(ws + WS_WFF + (size_t)jf * W_FF + W_DN), DFF, DFF, DFF}; pg8::StaticOrder S; S.init(T, D, G, bid);
                pg8::EpiResidBf E{WSP(bf16_t, WS_HB), (rep + 1 < NREP(16)) ? WSP(bf16_t, WS_X + X_GS) : WSP(bf16_t, WS_HB), WSP(float, WS_SSQ + (size_t)((rep + 1 < NREP(16)) ? 13 : 3 * l + 2) * SSQ_BYTES), (LAS float*)(lds + 131072)};
                pg8::gemm_phase<pg8::EpiResidBf, pg8::StaticOrder, true, true>(lds, g, S, E, wave0);
                GRID_BAR();
            }
        } else {
            if (PH(15)) for (int rep = 0; rep < NREP(15); ++rep) {
                PHASE_ENTER();
                const bf16_t* HB = WSP(bf16_t, WS_HB); const float* RS = WSP(float, WS_RS); bf16_t* XG = WSP(bf16_t, WS_X + X_XG);
                const int* TE = WSP(int, WS_MOE + MO_TE); const float* TW = WSP(float, WS_MOE + MO_TW); const int* TP = WSP(int, WS_MOE + MO_TP); unsigned* CNT = WSP(unsigned, WS_CTL) + CW_CNT + jf * 16;
                int* ROWL = WSP(int, WS_MOE + MO_ROWL); float* WROW = WSP(float, WS_MOE + MO_WROW); float* RSG = WSP(float, WS_MOE + MO_RSG);
                unsigned* PEXP = WSP(unsigned, WS_MOE + MO_PEXP); unsigned* NPAN = WSP(unsigned, WS_MOE + MO_NPAN);
#pragma unroll
                for (int s = 0; s < 2; ++s) {
                    int off[9]; { int a = 0;
#pragma unroll
                        for (int e = 0; e < 8; ++e) { off[e] = a; a += ((int)__builtin_amdgcn_readfirstlane(ld_u32_agent(CNT + s * 8 + e)) + 255) & ~255; }
                        off[8] = a; }
                    if (bid == 0 && tid == 0) { NPAN[s] = (unsigned)(off[8] >> 8);
#pragma unroll
                        for (int e = 0; e < 8; ++e) for (int pnl = off[e] >> 8; pnl < (off[e + 1] >> 8); ++pnl) PEXP[s * 256 + pnl] = (unsigned)e; }
                    for (int m = gw; m < T; m += NGW) { const int e = TE[s * T + m]; int o = 0;
#pragma unroll
                        for (int k = 0; k < 8; ++k) o = (e == k) ? off[k] : o;
                        const int row = o + TP[s * T + m];
                        const u32x4* src = (const u32x4*)(HB + (size_t)m * D); u32x4* dst = (u32x4*)(XG + ((size_t)s * MOE_ROWS + row) * D);
                        dst[lane] = src[lane]; dst[lane + 64] = src[lane + 64];
                        if (lane == 0) { ROWL[s * MOE_ROWS + row] = m; WROW[s * MOE_ROWS + row] = TW[s * T + m]; RSG[s * MOE_ROWS + row] = RS[m]; } }
#pragma unroll
                    for (int e = 0; e < 8; ++e) { const int c = (int)__builtin_amdgcn_readfirstlane(ld_u32_agent(CNT + s * 8 + e)); const int lo = off[e] + c, hi = off[e + 1];
                        for (int row = lo + gw; row < hi; row += NGW) { u32x4* dst = (u32x4*)(XG + ((size_t)s * MOE_ROWS + row) * D); const u32x4 zz = {0u, 0u, 0u, 0u}; dst[lane] = zz; dst[lane + 64] = zz;
                            if (lane == 0) { ROWL[s * MOE_ROWS + row] = -1; WROW[s * MOE_ROWS + row] = 0.f; RSG[s * MOE_ROWS + row] = 0.f; } } }
                }
                GRID_BAR();
            }
#pragma unroll
            for (int s = 0; s < 2; ++s) {
                if (PH(16 + 2 * s)) for (int rep = 0; rep < NREP(16 + 2 * s); ++rep) {
                    PHASE_ENTER();
                    const int npan = (int)__builtin_amdgcn_readfirstlane(ld_u32_agent(WSP(unsigned, WS_MOE + MO_NPAN) + s));
                    pg8::Gemm g{WSP(bf16_t, WS_X + X_XG) + (size_t)s * MOE_ROWS * D, WSP(bf16_t, WS_WMOE + WM_GU), D, D, D}; pg8::MoeOrder S; S.init(npan, 2 * DFF / 256, G, bid, WSP(unsigned, WS_MOE + MO_PEXP) + s * 256);
                    pg8::EpiSwiglu E{WSP(bf16_t, WS_X + X_ACT), WSP(float, WS_MOE + MO_RSG) + s * MOE_ROWS, 0};
                    pg8::gemm_phase<pg8::EpiSwiglu, pg8::MoeOrder, true, true>(lds, g, S, E, wave0);
                    GRID_BAR();
                }
                if (PH(17 + 2 * s)) for (int rep = 0; rep < NREP(17 + 2 * s); ++rep) {
                    PHASE_ENTER();
                    const int npan = (int)__builtin_amdgcn_readfirstlane(ld_u32_agent(WSP(unsigned, WS_MOE + MO_NPAN) + s));
                    pg8::Gemm g{WSP(bf16_t, WS_X + X_ACT), WSP(bf16_t, WS_WMOE + WM_DN), DFF, DFF, DFF}; pg8::MoeOrder S; S.init(npan, D / 256, G, bid, WSP(unsigned, WS_MOE + MO_PEXP) + s * 256);
                    pg8::EpiMoeDown E{WSP(bf16_t, WS_HB), WSP(int, WS_MOE + MO_ROWL) + s * MOE_ROWS, WSP(float, WS_MOE + MO_WROW) + s * MOE_ROWS, (rep + 1 < NREP(17 + 2 * s)) ? WSP(bf16_t, WS_X + X_GS) : WSP(bf16_t, WS_HB), s == 1 ? WSP(float, WS_SSQ + (size_t)((rep + 1 < NREP(17 + 2 * s)) ? 13 : 3 * l + 2) * SSQ_BYTES) : nullptr, (LAS float*)(lds + 131072)};
                    pg8::gemm_phase<pg8::EpiMoeDown, pg8::MoeOrder, true, true>(lds, g, S, E, wave0);
                    GRID_BAR();
                }
            }
        }
    }
    if (p.l_hi == DEPTH && PH(20)) {
        PHASE_ENTER();
        const float* gf = p.in[I_FINAL]; float* O = p.out; const bf16_t* HB = WSP(bf16_t, WS_HB); const float* SSQ = WSP(float, WS_SSQ + (size_t)(3 * DEPTH - 1) * SSQ_BYTES);
        for (int m = gw; m < T; m += NGW) { const float rstd = rstd4(SSQ + (size_t)m * 4); const u32x2* xr = (const u32x2*)(HB + (size_t)m * D) + lane; f32x4* orow = (f32x4*)(O + (size_t)m * D) + lane;
#pragma unroll
            for (int j = 0; j < 4; ++j) { const u32x2 w = xr[64 * j]; const f32x4 g4 = *((const f32x4*)gf + lane + 64 * j); orow[64 * j] = (f32x4){bflo(w.x), bfhi(w.x), bflo(w.y), bfhi(w.y)} * rstd * g4; } }
    }
#undef PH
#undef GRID_BAR
}

extern "C" void kernel_launch(void* const* d_in, const int* in_sizes, int n_in, void* d_out, int out_size, void* d_ws, size_t ws_size, hipStream_t stream) {
    static int grid = 0;
    if (grid == 0) {
        if (n_in != 28 || out_size != T * D || ws_size < WS_END) { fprintf(stderr, "kernel_launch: unexpected problem (n_in %d, out %d, ws %zu < %zu)\n", n_in, out_size, ws_size, (size_t)WS_END); grid = -1; return; }
        int dev = 0, cus = 0;
        if (hipGetDevice(&dev) != hipSuccess || hipDeviceGetAttribute(&cus, hipDeviceAttributeMultiprocessorCount, dev) != hipSuccess) { grid = -1; return; }
        if (hipFuncSetAttribute((const void*)mk_fwd, hipFuncAttributeMaxDynamicSharedMemorySize, LDS_BYTES) != hipSuccess) { fprintf(stderr, "kernel_launch: hipFuncSetAttribute failed\n"); grid = -1; return; }
        int per_cu = 0;
        if (hipOccupancyMaxActiveBlocksPerMultiprocessor(&per_cu, (const void*)mk_fwd, 512, LDS_BYTES) != hipSuccess || per_cu < 1) { fprintf(stderr, "kernel_launch: occupancy query says %d\n", per_cu); (void)hipGetLastError(); }
        grid = cus;
    }
    if (grid < 0) return;
    (void)hipMemsetAsync((char*)d_ws + WS_CTL, 0, 1 * MiB, stream);
    Params p{};
    for (int i = 0; i < 28; ++i) p.in[i] = (const float*)d_in[i];
    p.out = (float*)d_out; p.ws = (unsigned char*)d_ws;
#if MK_ONE_LAUNCH
    p.l_lo = 0; p.l_hi = DEPTH; p.ph_lo = 0; p.ph_hi = 21;
    hipLaunchKernelGGL(mk_fwd, dim3(grid), dim3(512), LDS_BYTES, stream, p);
#else
    auto launch = [&](int l, int ph) { p.l_lo = l; p.l_hi = l + 1; p.ph_lo = ph; p.ph_hi = ph + 1; hipLaunchKernelGGL(mk_fwd, dim3(grid), dim3(512), LDS_BYTES, stream, p); };
    launch(0, 0); launch(0, 1);
    for (int l = 0; l < DEPTH; ++l) { const int last = (l & 1) ? 19 : 16; for (int ph = 2; ph <= last; ++ph) launch(l, ph); }
    launch(DEPTH - 1, 20);
#endif
}
```

```cpp
#include <hip/hip_runtime.h>
#include <cstdio>
#include <cstdint>

#define LAS __attribute__((address_space(3)))
#define GAS __attribute__((address_space(1)))
typedef unsigned short bf16_t;
typedef short bf16x8 __attribute__((ext_vector_type(8)));
typedef float f32x4 __attribute__((ext_vector_type(4)));
typedef float f32x2 __attribute__((ext_vector_type(2)));
typedef unsigned u32x4 __attribute__((ext_vector_type(4)));
typedef unsigned u32x2 __attribute__((ext_vector_type(2)));

#ifndef PROBE_MASK
#define PROBE_MASK 0u
#endif
#define NREP(k) ((int)((PROBE_MASK >> (k)) & 1u) + 1)
#ifndef DELAY_MASK
#define DELAY_MASK 0u
#endif
#ifndef PROBE_VAR
#define PROBE_VAR 0
#endif
#ifndef MK_ONE_LAUNCH
#define MK_ONE_LAUNCH 1
#define DENSE_GU8_MASK 2
#define DENSE_DN8_MASK 2
#define INPROJ8_MASK 12
#define MIX8_MASK 0
static_assert((MIX8_MASK & ~INPROJ8_MASK) == 0, "fp8 v rows live in the fp8 layout of W_IN");
#define MOE_F8_GU 1
#define MOE_F8_DN 1
#endif

constexpr int T = 32768, D = 1024, SEQ = 2048, NBATCH = 16, DEPTH = 4, MEMLEN = 256, TM = NBATCH * MEMLEN;
constexpr int INW = 5904, NPROJ = 6144, NMAIN = 5632, DFF = 2816, NEXP = 8;
constexpr int MOE_ROWS = T + NEXP * 256;
constexpr int MOE_PAN = MOE_ROWS / 256;
constexpr float EPS = 1e-6f;

constexpr size_t MiB = 1u << 20;
constexpr size_t WS_CTL = 0;
constexpr size_t WS_RS = 1 * MiB;
constexpr size_t WS_RSMEM = WS_RS + 256 * 1024;
constexpr size_t WS_DT = 2 * MiB;
constexpr size_t WS_MOE = 4 * MiB;
constexpr size_t WS_SSQ_OLD_UNUSED = 6 * MiB;
constexpr size_t SSQ_BYTES = (size_t)T * 16;
constexpr size_t WS_KM = 8 * MiB;
constexpr size_t WS_VTM = 24 * MiB;
constexpr size_t WS_MEMB = 40 * MiB;
constexpr size_t WS_HB = 48 * MiB;
constexpr size_t WS_W = 112 * MiB;
constexpr size_t W_IN = 0, W_SSDO = W_IN + (size_t)NPROJ * 1024 * 2, W_SBO = W_SSDO + 2 * MiB, W_OUT = W_SBO + 1 * MiB, W_Q = W_OUT + 2 * MiB, W_O = W_Q + 1 * MiB, W_LAYER = W_O + 1 * MiB;
constexpr size_t WS_WKV = WS_W + 4 * W_LAYER;
constexpr size_t WS_WFF = WS_WKV + 8 * MiB;
constexpr size_t W_GU = 0, W_DN = (size_t)2 * DFF * 1024 * 2, W_FF = W_DN + (size_t)1024 * DFF * 2;
constexpr size_t WS_WMOE = WS_WFF + 2 * W_FF;
constexpr size_t WM_GU = 0, WM_DN = (size_t)NEXP * 2 * DFF * 1024 * 2;
constexpr size_t WS_X = WS_WMOE + NEXP * W_FF;
constexpr size_t X_Z = 0, X_XBC = X_Z + 64 * MiB, X_XT = X_XBC + 80 * MiB, X_BR = X_XT + 64 * MiB, X_BT = X_BR + 8 * MiB, X_CR = X_BT + 8 * MiB, X_Q = X_CR + 8 * MiB, X_K = X_Q + 32 * MiB, X_V = X_K + 32 * MiB,
                 X_GS = X_V + 32 * MiB, X_PREV = X_GS + 128 * MiB, X_END = 512 * MiB;
constexpr size_t X_HB8 = 456 * MiB;
static_assert(X_HB8 == X_PREV, "HB8 overlays PREV");
constexpr float F8_WGU = 32.f, F8_WDN = 64.f;
constexpr size_t X_ACT = 0;
constexpr size_t X_ACT2 = 188 * MiB;
constexpr size_t X_XG = 376 * MiB;
constexpr size_t WS_SSQ = WS_X + X_END;
constexpr size_t WS_END = WS_SSQ + 8 * MiB;
static_assert(X_XG + (size_t)2 * MOE_ROWS * 1024 * 2 <= X_END, "moe region");
static_assert((size_t)MOE_ROWS * DFF * 2 <= X_ACT2 && X_ACT2 + (size_t)MOE_ROWS * DFF * 2 <= X_XG && X_PREV + 32 * MiB <= X_END, "act regions");
constexpr size_t MO_TE = 0, MO_TW = MO_TE + 2 * T * 4, MO_TP = MO_TW + 2 * T * 4, MO_ROWL = MO_TP + 2 * T * 4, MO_WROW = MO_ROWL + 2 * MOE_ROWS * 4, MO_RSG = MO_WROW + 2 * MOE_ROWS * 4,
                 MO_PEXP = MO_RSG + 2 * MOE_ROWS * 4, MO_NPAN = MO_PEXP + 2 * 256 * 4, MO_END = MO_NPAN + 256;
static_assert(MO_END <= 2 * MiB, "moe tables");
constexpr int CW_BAR = 4096;
constexpr int CW_LBAR = 24576;
constexpr int CW_PLC = 28672;
constexpr int CW_CNT = 16384;

constexpr int RING_BYTES = 155648;
constexpr int LDSCTL_OFF = RING_BYTES;
constexpr int LDS_BYTES = 160 * 1024;

__device__ __forceinline__ float bf2f(unsigned b) { return __builtin_bit_cast(float, b << 16); }
__device__ __forceinline__ float bflo(unsigned w) { return __builtin_bit_cast(float, w << 16); }
__device__ __forceinline__ float bfhi(unsigned w) { return __builtin_bit_cast(float, w & 0xffff0000u); }
__device__ __forceinline__ unsigned cvt_pk_bf16(float lo, float hi) { unsigned r; asm volatile("v_cvt_pk_bf16_f32 %0, %1, %2" : "=v"(r) : "v"(lo), "v"(hi)); return r; }
__device__ __forceinline__ unsigned short f2bf(float f) { return (unsigned short)(cvt_pk_bf16(f, 0.f) & 0xffffu); }
__device__ __forceinline__ unsigned cvt_pk_fp8(float a, float b, float c, float d) { int w = __builtin_amdgcn_cvt_pk_fp8_f32(a, b, 0, false); w = __builtin_amdgcn_cvt_pk_fp8_f32(c, d, w, true); return (unsigned)w; }
__device__ __forceinline__ float wave_sum(float v) {
#pragma unroll
    for (int o = 1; o < 64; o <<= 1) v += __shfl_xor(v, o);
    return v;
}
__device__ __forceinline__ float wave_max(float v) {
#pragma unroll
    for (int o = 1; o < 64; o <<= 1) v = fmaxf(v, __shfl_xor(v, o));
    return v;
}
__device__ __forceinline__ float fexp(float x) { return __builtin_amdgcn_exp2f(1.4426950408889634f * x); }
__device__ __forceinline__ float softplusf_(float x) { return fmaxf(x, 0.f) + 0.6931471805599453f * __builtin_amdgcn_logf(1.f + __builtin_amdgcn_exp2f(-1.4426950408889634f * fabsf(x))); }
__device__ __forceinline__ float sigmoidf_(float x) { return __builtin_amdgcn_rcpf(1.f + __builtin_amdgcn_exp2f(-1.4426950408889634f * x)); }
__device__ __forceinline__ unsigned ld_u32_agent(const unsigned* p) { return __hip_atomic_load(p, __ATOMIC_RELAXED, __HIP_MEMORY_SCOPE_AGENT); }
__device__ __forceinline__ float ld_f32_agent(const float* p) { return __builtin_bit_cast(float, __hip_atomic_load((const unsigned*)p, __ATOMIC_RELAXED, __HIP_MEMORY_SCOPE_AGENT)); }
__device__ __forceinline__ float rstd_of(float sumsq) { return __builtin_amdgcn_rsqf(sumsq * (1.f / 1024.f) + 1e-6f); }
__device__ __forceinline__ void rstd4x8(const float* base, int stride_rows  , float (&rr)[8], float mul) {
    f32x4 q[8];
#pragma unroll
    for (int gI = 0; gI < 8; ++gI) q[gI] = *(const f32x4*)(base + (size_t)((gI >> 2) * stride_rows + (gI & 3) * 16) * 4);
    asm volatile("" ::: "memory");
#pragma unroll
    for (int gI = 0; gI < 8; ++gI) rr[gI] = __builtin_amdgcn_rsqf(((q[gI].x + q[gI].y) + (q[gI].z + q[gI].w)) * (1.f / 1024.f) + 1e-6f) * mul;
}
__device__ __forceinline__ float rstd4(const float* q4) { const f32x4 q = *(const f32x4*)q4; return rstd_of((q.x + q.y) + (q.z + q.w)); }
#define LDS_WAIT() asm volatile("s_waitcnt lgkmcnt(0)" ::: "memory")
__device__ __forceinline__ int lane_id_opaque() { int l; asm volatile("v_mbcnt_lo_u32_b32 %0, -1, 0\n\tv_mbcnt_hi_u32_b32 %0, -1, %0" : "=v"(l)); return l; }

namespace pg8 {
constexpr int BM = 256, BK = 64, HALF = 128, HTB = HALF * BK * 2, STAGE_BYTES = 8 * HTB, NXCD = 8, WGM = 8;
__host__ __device__ __forceinline__ int lds_byte(int r, int c) { const int st = (r >> 4) * 2 + (c >> 5), rr = r & 15, cc = c & 31, ob = rr * 64 + cc * 2; return st * 1024 + (ob ^ (((ob >> 9) & 1) << 5)); }
__host__ __device__ __forceinline__ void stage_rc(int b, int& R, int& C) { const unsigned ub = (unsigned)b, st = ub >> 10, sb = ub & 1023u, swz = sb ^ (((sb >> 9) & 1u) << 5); R = (int)((st >> 1) * 16u + (swz >> 6)); C = (int)((st & 1u) * 32u + ((swz & 63u) >> 1)); }
__host__ __device__ __forceinline__ int perm32(int rho) { const int n = rho >> 4, i = rho & 15; return 8 * (i >> 2) + 4 * n + (i & 3); }

struct Unit { int pm, pn, pb; };
struct Gemm { const bf16_t* A; const bf16_t* Bt; int lda, ldb, K; };

struct StaticOrder {
    int nM, nN, nwg, G, c; int pm0 = 0, pn0 = 0;
    __device__ void init(int M, int N, int G_, int c_) { nM = M / BM; nN = N / BM; nwg = nM * nN; G = G_; c = c_; }
    __device__ bool next(int i, Unit& u) const {
        const long L = (long)i * G + c; if (L >= nwg) return false;
        int wgid = (int)L; { const int q = nwg / NXCD, r = nwg % NXCD, xcd = wgid % NXCD, off = wgid / NXCD; wgid = (xcd < r ? xcd * (q + 1) : r * (q + 1) + (xcd - r) * q) + off; }
        const int nig = WGM * nN, gid = wgid / nig, fm = gid * WGM, gsz = (nM - fm) < WGM ? (nM - fm) : WGM;
        u.pm = fm + ((wgid % nig) % gsz) + pm0; u.pn = (wgid % nig) / gsz + pn0; u.pb = u.pn; return true;
    }
};
struct MoeOrder {
    int nM, nN, nwg, G, c; const LAS unsigned* pexp; int ne = 0, stride0 = 0, c0 = 0; long base0 = 0, base1 = 0;
    __device__ void init(int nM_, int nN_, int G_, int c_, const LAS unsigned* pexp_) { nM = nM_; nN = nN_; nwg = nM * nN; G = G_; c = c_; pexp = pexp_; }
    __device__ bool next(int i, Unit& u) const {
        const long L = i < ne ? base0 + (long)i * stride0 + c0 : base1 + (long)(i - ne) * G + c; if (L >= nwg) return false;
        int wgid = (int)L; { const int q = nwg / NXCD, r = nwg % NXCD, xcd = wgid % NXCD, off = wgid / NXCD; wgid = (xcd < r ? xcd * (q + 1) : r * (q + 1) + (xcd - r) * q) + off; }
        const int nig = WGM * nN, gid = wgid / nig, fm = gid * WGM, gsz = (nM - fm) < WGM ? (nM - fm) : WGM;
        u.pm = fm + ((wgid % nig) % gsz); u.pn = (wgid % nig) / gsz;
        const int e = (int)__builtin_amdgcn_readfirstlane(pexp[u.pm]); u.pb = e * nN + u.pn; return true;
    }
};

__device__ __forceinline__ void moe_pexp_to_lds(const unsigned* pexp_g, LAS unsigned* dst, int tid) {
    dst[tid] = ld_u32_agent(pexp_g + tid);
    __syncthreads();
}
typedef int i32x8 __attribute__((ext_vector_type(8)));
typedef int i32x4 __attribute__((ext_vector_type(4)));
template <class Epi, class Sched, bool ALIGN_EPI = false, bool SP2 = false, bool FP8 = false>
__device__ __forceinline__ void gemm_phase(LAS unsigned char* lds, const Gemm g, const Sched& S, const Epi& E, const int wave0) {
    int tid_ = wave0 * 64 + lane_id_opaque();
    const int tid = tid_, wid = __builtin_amdgcn_readfirstlane(tid >> 6), lane = tid & 63, wr = wid >> 2, wc = wid & 3, fr = lane & 15, fq = lane >> 4;
    constexpr int ESZ = FP8 ? 1 : 2;
    const int K = g.K, nt = K / (FP8 ? 2 * BK : BK);
    unsigned voffA[2], voffB[2];
    { int R, C; stage_rc(tid * 16, R, C); const int Rb = Epi::PERM ? ((R & ~31) + perm32(R & 31)) : R;
      voffA[0] = (unsigned)(R * g.lda) * ESZ + (unsigned)C * 2u; voffB[0] = (unsigned)(Rb * g.ldb) * ESZ + (unsigned)C * 2u; voffA[1] = voffA[0] + (unsigned)(64 * g.lda) * ESZ; voffB[1] = voffB[0] + (unsigned)(64 * g.ldb) * ESZ; }
    const size_t kstep = (size_t)(BK * 2);
    const size_t hsA = (size_t)HALF * g.lda * ESZ, hsB = (size_t)HALF * g.ldb * ESZ;
    const size_t tsA = 2 * hsA, tsB = 2 * hsB;
    const unsigned ldsw = (unsigned)wid * 1024u;
    const int swz_ = (fr * 64 + fq * 16) ^ ((fr & 8) << 2);
    const int aoff = wr * 8192 + swz_, boff = wc * 4096 + swz_;
    int sc1 = 0x7F7F7F7F; asm volatile("" : "+v"(sc1)); (void)sc1;
    constexpr int KD = 1024;
#define PG8_SA(b, h) (((b) * 2 + (h)) * HTB)
#define PG8_SB(b, h) ((4 + (b) * 2 + (h)) * HTB)
#define PG8_STAGE(bufoff, gbase, voff) do { _Pragma("unroll") for (int _i = 0; _i < 2; ++_i) \
        __builtin_amdgcn_global_load_lds((const unsigned*)((const char*)(gbase) + (voff)[_i]), (LAS unsigned*)(lds + (bufoff) + ldsw + _i * 8192), 16, 0, 0); } while (0)
#define PG8_LDA(dst, b, h) do { _Pragma("unroll") for (int m = 0; m < 4; ++m) _Pragma("unroll") for (int k = 0; k < 2; ++k) dst[m][k] = *(const LAS bf16x8*)(lds + PG8_SA(b, h) + aoff + m * 2048 + k * KD); } while (0)
#define PG8_LDB(dst, b, h) do { _Pragma("unroll") for (int n = 0; n < 2; ++n) _Pragma("unroll") for (int k = 0; k < 2; ++k) dst[n][k] = *(const LAS bf16x8*)(lds + PG8_SB(b, h) + boff + n * 2048 + k * KD); } while (0)
#define PG8_CAT8(x) __builtin_shufflevector(__builtin_bit_cast(i32x4, (x)[0]), __builtin_bit_cast(i32x4, (x)[1]), 0, 1, 2, 3, 4, 5, 6, 7)
#define PG8_MMA(ai, bj, At, Bt) do { __builtin_amdgcn_s_setprio(1); _Pragma("unroll") for (int m = 0; m < 4; ++m) _Pragma("unroll") for (int n = 0; n < 2; ++n) { \
        if constexpr (FP8) asm volatile("v_mfma_scale_f32_16x16x128_f8f6f4 %0, %1, %2, %0, %3, %3 op_sel_hi:[0,0,0]" : "+v"(acc[ai][bj][m][n]) : "v"(PG8_CAT8(Bt[n])), "v"(PG8_CAT8(At[m])), "v"(sc1)); \
        else { _Pragma("unroll") for (int k = 0; k < 2; ++k) acc[ai][bj][m][n] = __builtin_amdgcn_mfma_f32_16x16x32_bf16(Bt[n][k], At[m][k], acc[ai][bj][m][n], 0, 0, 0); } } __builtin_amdgcn_s_setprio(0); } while (0)
#define PG8_WAIT_V(n) asm volatile("s_waitcnt vmcnt(" #n ")" ::: "memory")
#define PG8_WAIT_L(n) asm volatile("s_waitcnt lgkmcnt(" #n ")" ::: "memory")
#define PG8_BAR __builtin_amdgcn_s_barrier()
#define PG8_SCHED __builtin_amdgcn_sched_barrier(0)
    Unit cur, nxt; int ui = 0;
    if (!S.next(0, cur)) return;
    f32x4 acc[2][2][4][2];
#pragma unroll
    for (int a = 0; a < 2; ++a)
#pragma unroll
        for (int b = 0; b < 2; ++b)
#pragma unroll
            for (int m = 0; m < 4; ++m)
#pragma unroll
                for (int n = 0; n < 2; ++n) acc[a][b][m][n] = (f32x4){0.f, 0.f, 0.f, 0.f};
    bf16x8 At[4][2], B0[2][2], B1[2][2];
    const char* cA = (const char*)g.A + (size_t)cur.pm * tsA; const char* cB = (const char*)g.Bt + (size_t)cur.pb * tsB;
    if constexpr (SP2) {
        PG8_STAGE(PG8_SB(0, 0), cB, voffB); PG8_STAGE(PG8_SB(0, 1), cB + hsB, voffB); PG8_STAGE(PG8_SA(0, 0), cA, voffA); PG8_STAGE(PG8_SA(0, 1), cA + hsA, voffA);
        if (wr == 1) PG8_BAR;
        PG8_WAIT_V(2); PG8_BAR;
        PG8_STAGE(PG8_SB(1, 0), cB + kstep, voffB); PG8_STAGE(PG8_SA(1, 0), cA + kstep, voffA); PG8_STAGE(PG8_SB(1, 1), cB + hsB + kstep, voffB);
        PG8_WAIT_V(6); PG8_BAR;
    } else {
        PG8_STAGE(PG8_SB(0, 0), cB, voffB); PG8_STAGE(PG8_SA(0, 0), cA, voffA); PG8_STAGE(PG8_SB(0, 1), cB + hsB, voffB); PG8_STAGE(PG8_SA(0, 1), cA + hsA, voffA);
        if (wr == 1) PG8_BAR;
        PG8_WAIT_V(4); PG8_BAR;
        PG8_STAGE(PG8_SB(1, 0), cB + kstep, voffB); PG8_STAGE(PG8_SA(1, 0), cA + kstep, voffA); PG8_STAGE(PG8_SB(1, 1), cB + hsB + kstep, voffB);
        PG8_WAIT_V(6); PG8_BAR;
    }
    for (;;) {
        const bool has_next = S.next(ui + 1, nxt);
        const char* nA = has_next ? (const char*)g.A + (size_t)nxt.pm * tsA : cA; const char* nB = has_next ? (const char*)g.Bt + (size_t)nxt.pb * tsB : cB;
#pragma nounroll
        for (int t = 0; t < nt; t += 2) {
            const bool last = (t == nt - 2);
            const char* a1 = cA + (size_t)(t + 1) * kstep;
            const char* a2 = last ? nA : cA + (size_t)(t + 2) * kstep; const char* b2 = last ? nB : cB + (size_t)(t + 2) * kstep;
            const char* a3 = a2 + kstep; const char* b3 = b2 + kstep;
            if constexpr (SP2) {
            PG8_LDB(B0, 0, 0); PG8_LDB(B1, 0, 1); PG8_SCHED; PG8_LDA(At, 0, 0); PG8_STAGE(PG8_SA(1, 1), a1 + hsA, voffA);
            PG8_WAIT_V(8); PG8_WAIT_L(0); PG8_BAR; PG8_MMA(0, 0, At, B0); PG8_MMA(0, 1, At, B1); PG8_BAR; PG8_SCHED;
            PG8_LDA(At, 0, 1); PG8_STAGE(PG8_SB(0, 0), b2, voffB); PG8_STAGE(PG8_SB(0, 1), b2 + hsB, voffB); PG8_STAGE(PG8_SA(0, 0), a2, voffA);
            PG8_WAIT_V(8); PG8_WAIT_L(0); PG8_BAR; PG8_MMA(1, 0, At, B0); PG8_MMA(1, 1, At, B1); PG8_BAR; PG8_SCHED;
            PG8_LDB(B0, 1, 0); PG8_LDB(B1, 1, 1); PG8_SCHED; PG8_LDA(At, 1, 0); PG8_STAGE(PG8_SA(0, 1), a2 + hsA, voffA);
            PG8_WAIT_V(8); PG8_WAIT_L(0); PG8_BAR; PG8_MMA(0, 0, At, B0); PG8_MMA(0, 1, At, B1); PG8_BAR; PG8_SCHED;
            PG8_LDA(At, 1, 1); PG8_STAGE(PG8_SB(1, 0), b3, voffB); PG8_STAGE(PG8_SB(1, 1), b3 + hsB, voffB); PG8_STAGE(PG8_SA(1, 0), a3, voffA);
            PG8_WAIT_V(8); PG8_WAIT_L(0); PG8_BAR; PG8_MMA(1, 0, At, B0); PG8_MMA(1, 1, At, B1); PG8_BAR; PG8_SCHED;
            } else {
            PG8_LDB(B0, 0, 0); PG8_SCHED; PG8_LDA(At, 0, 0); PG8_STAGE(PG8_SA(1, 1), a1 + hsA, voffA);
            PG8_WAIT_L(8); PG8_BAR; PG8_WAIT_L(0); PG8_MMA(0, 0, At, B0); PG8_BAR; PG8_SCHED;
            PG8_LDB(B1, 0, 1); PG8_STAGE(PG8_SB(0, 0), b2, voffB);
            PG8_BAR; PG8_WAIT_L(0); PG8_MMA(0, 1, At, B1); PG8_BAR;
            PG8_LDA(At, 0, 1); PG8_STAGE(PG8_SA(0, 0), a2, voffA);
            PG8_BAR; PG8_WAIT_L(0); PG8_MMA(1, 0, At, B0); PG8_BAR; PG8_SCHED;
            PG8_STAGE(PG8_SB(0, 1), b2 + hsB, voffB);
            PG8_WAIT_V(6); PG8_BAR; PG8_MMA(1, 1, At, B1); PG8_BAR;
            PG8_LDB(B0, 1, 0); PG8_SCHED; PG8_LDA(At, 1, 0); PG8_STAGE(PG8_SA(0, 1), a2 + hsA, voffA);
            PG8_WAIT_L(8); PG8_BAR; PG8_WAIT_L(0); PG8_MMA(0, 0, At, B0); PG8_BAR; PG8_SCHED;
            PG8_LDB(B1, 1, 1); PG8_STAGE(PG8_SB(1, 0), b3, voffB);
            PG8_BAR; PG8_WAIT_L(0); PG8_MMA(0, 1, At, B1); PG8_BAR;
            PG8_LDA(At, 1, 1); PG8_STAGE(PG8_SA(1, 0), a3, voffA);
            PG8_BAR; PG8_WAIT_L(0); PG8_MMA(1, 0, At, B0); PG8_BAR; PG8_SCHED;
            PG8_STAGE(PG8_SB(1, 1), b3 + hsB, voffB);
            PG8_WAIT_V(6); PG8_BAR; PG8_MMA(1, 1, At, B1); PG8_BAR;
            }
        }
        if constexpr (ALIGN_EPI) { if (wr == 0) PG8_BAR; }
        if constexpr (FP8) asm volatile("s_nop 15\n\ts_nop 15\n\ts_nop 15\n\ts_nop 15\n\ts_nop 15\n\ts_nop 15" ::: "memory");
        E(acc, cur, wr, wc, fr, fq);
        if (!has_next) break;
#pragma unroll
        for (int a = 0; a < 2; ++a)
#pragma unroll
            for (int b = 0; b < 2; ++b)
#pragma unroll
                for (int m = 0; m < 4; ++m)
#pragma unroll
                    for (int n = 0; n < 2; ++n) acc[a][b][m][n] = (f32x4){0.f, 0.f, 0.f, 0.f};
        cur = nxt; cA = nA; cB = nB; ++ui;
        if constexpr (ALIGN_EPI) { if (wr == 1) PG8_BAR; }
    }
    PG8_WAIT_V(0);
    if constexpr (!ALIGN_EPI) { if (wr == 0) PG8_BAR; }
    PG8_BAR;
#undef PG8_SA
#undef PG8_SB
#undef PG8_STAGE
#undef PG8_LDA
#undef PG8_LDB
#undef PG8_MMA
#undef PG8_WAIT_V
#undef PG8_WAIT_L
#undef PG8_BAR
#undef PG8_SCHED
}

typedef const f32x4 (&AccT)[2][2][4][2];
#define EPI_FENCE() asm volatile("" ::: "memory")

struct EpiInProj {
    static constexpr bool PERM = true;
    unsigned char* xbase; const float* ssq; float* rs_out; float* dtt; const float* dt_bias; float asc = 1.f;
    __device__ __forceinline__ void operator()(AccT acc, const Unit& u, int wr, int wc, int fr_, int fq_) const {
        int fr = fr_, fq = fq_; asm volatile("" : "+v"(fr), "+v"(fq));
        const int pn = u.pn; int bmib = (int)(X_Z >> 20), ld = 1024, ct = pn; bool sig = false;
        float sc = 1.f;
        if (pn < 4) { }
        else if (pn < 9) { bmib = (int)(X_XBC >> 20); ld = 1280; ct = pn - 4; }
        else if (pn < 11) { bmib = (int)(X_Q >> 20); ld = 512; ct = pn - 9; sc = 0.18033688011112042f; }
        else if (pn < 13) { bmib = (int)(X_K >> 20); ld = 512; ct = pn - 11; }
        else { bmib = (int)(X_GS >> 20); ld = 2048; ct = pn - 13; sig = true; }
        const unsigned lo = (unsigned)(fr * ld + 8 * fq) * 2u;
        unsigned char* tb = xbase + ((size_t)(unsigned)bmib << 20) + ((size_t)(u.pm * BM + wr * 64) * ld + ct * BM + wc * 32) * 2;
        const int rowb = u.pm * BM + wr * 64 + fr;
        float rr[8];
        rstd4x8(ssq + (size_t)rowb * 4, HALF, rr, 1.f);
        if (pn == 21) {
            if (wc == 0 && fq < 2) {
                int fqo = fq; asm volatile("" : "+v"(fqo));
                float* dbase = dtt + (size_t)(8 * fqo) * T;
                const f32x4 b0 = *(const f32x4*)(dt_bias + 8 * fqo), b1 = *(const f32x4*)(dt_bias + 8 * fqo + 4);
#pragma unroll
                for (int ai = 0; ai < 2; ++ai)
#pragma unroll
                    for (int m = 0; m < 4; ++m) { const int row = rowb + ai * HALF + m * 16; const float r = rr[ai * 4 + m] * asc; const f32x4 v0 = acc[ai][0][m][0] * r + b0, v1 = acc[ai][0][m][1] * r + b1;
#pragma unroll
                        for (int j = 0; j < 4; ++j) { dbase[(size_t)j * T + row] = softplusf_(v0[j]); dbase[(size_t)(4 + j) * T + row] = softplusf_(v1[j]); } }
            }
            return;
        }
#pragma unroll
        for (int ai = 0; ai < 2; ++ai)
#pragma unroll
            for (int m = 0; m < 4; ++m) { const int row = rowb + ai * HALF + m * 16; const float r0 = rr[ai * 4 + m]; const float r = r0 * (sc * asc); unsigned char* rowp = tb + (size_t)(ai * HALF + m * 16) * ld * 2;
                if (pn == 0 && wc == 0 && fq == 0) rs_out[row] = r0;
#pragma unroll
                for (int bj = 0; bj < 2; ++bj) { f32x4 v0 = acc[ai][bj][m][0] * r, v1 = acc[ai][bj][m][1] * r;
                    if (sig) {
#pragma unroll
                        for (int j = 0; j < 4; ++j) { v0[j] = sigmoidf_(v0[j]); v1[j] = sigmoidf_(v1[j]); } }
                    u32x4 w; w.x = cvt_pk_bf16(v0[0], v0[1]); w.y = cvt_pk_bf16(v0[2], v0[3]); w.z = cvt_pk_bf16(v1[0], v1[1]); w.w = cvt_pk_bf16(v1[2], v1[3]);
                    *(u32x4*)(rowp + lo + bj * HALF * 2) = w; }
                EPI_FENCE(); }
    }
};
struct EpiBf16Rs {
    static constexpr bool PERM = true;
    bf16_t* O; int ldc; const float* rs; float sc; int ssq16;
    __device__ __forceinline__ void operator()(AccT acc, const Unit& u, int wr, int wc, int fr_, int fq_) const {
        int fr = fr_, fq = fq_; asm volatile("" : "+v"(fr), "+v"(fq));
        const unsigned lo = (unsigned)(fr * ldc + 8 * fq) * 2u;
        unsigned char* tb = (unsigned char*)O + ((size_t)(u.pm * BM + wr * 64) * ldc + u.pn * BM + wc * 32) * 2;
        const float* rsb = rs + (size_t)(u.pm * BM + wr * 64 + fr) * (ssq16 ? 4 : 1);
        float rr[8];
#pragma unroll
        for (int gI = 0; gI < 8; ++gI) { const int ro = (gI >> 2) * HALF + (gI & 3) * 16; rr[gI] = ssq16 ? 0.f : rsb[ro] * sc; }
        if (ssq16) rstd4x8(rsb, HALF, rr, sc);
#pragma unroll
        for (int ai = 0; ai < 2; ++ai)
#pragma unroll
            for (int m = 0; m < 4; ++m) { const float r = rr[ai * 4 + m]; unsigned char* rowp = tb + (size_t)(ai * HALF + m * 16) * ldc * 2;
#pragma unroll
                for (int bj = 0; bj < 2; ++bj) { const f32x4 v0 = acc[ai][bj][m][0] * r, v1 = acc[ai][bj][m][1] * r;
                    u32x4 w; w.x = cvt_pk_bf16(v0[0], v0[1]); w.y = cvt_pk_bf16(v0[2], v0[3]); w.z = cvt_pk_bf16(v1[0], v1[1]); w.w = cvt_pk_bf16(v1[2], v1[3]);
                    *(u32x4*)(rowp + lo + bj * HALF * 2) = w; }
                EPI_FENCE(); }
    }
};
struct EpiBf16Cs {
    static constexpr bool PERM = true;
    bf16_t* O; int ldc; const float* cs; float sc; int chunk_rows;
    __device__ __forceinline__ void operator()(AccT acc, const Unit& u, int wr, int wc, int fr_, int fq_) const {
        int fr = fr_, fq = fq_; asm volatile("" : "+v"(fr), "+v"(fq));
        const int rstride = chunk_rows ? 128 : ldc;
        const size_t bjstride = chunk_rows ? (size_t)chunk_rows * 128 : (size_t)HALF;
        const unsigned lo = (unsigned)(fr * rstride + 8 * fq) * 2u;
        unsigned char* tb = (unsigned char*)O + (chunk_rows ? ((size_t)(u.pn * 2) * chunk_rows * 128 + (size_t)(u.pm * BM + wr * 64) * 128 + wc * 32) : ((size_t)(u.pm * BM + wr * 64) * ldc + u.pn * BM + wc * 32)) * 2;
        const float* csb = cs + u.pn * BM + wc * 32 + 8 * fq;
        f32x4 c0[2], c1[2];
#pragma unroll
        for (int bj = 0; bj < 2; ++bj) { c0[bj] = *(const f32x4*)(csb + bj * HALF) * sc; c1[bj] = *(const f32x4*)(csb + bj * HALF + 4) * sc; }
#pragma unroll
        for (int ai = 0; ai < 2; ++ai)
#pragma unroll
            for (int m = 0; m < 4; ++m) { unsigned char* rowp = tb + (size_t)(ai * HALF + m * 16) * rstride * 2;
#pragma unroll
                for (int bj = 0; bj < 2; ++bj) { const f32x4 v0 = acc[ai][bj][m][0] * c0[bj], v1 = acc[ai][bj][m][1] * c1[bj];
                    u32x4 w; w.x = cvt_pk_bf16(v0[0], v0[1]); w.y = cvt_pk_bf16(v0[2], v0[3]); w.z = cvt_pk_bf16(v1[0], v1[1]); w.w = cvt_pk_bf16(v1[2], v1[3]);
                    *(u32x4*)(rowp + lo + bj * bjstride * 2) = w; }
                EPI_FENCE(); }
    }
};
template <bool ADD, bool W8 = false> struct EpiGate {
    static constexpr bool PERM = true;
    bf16_t* O; const bf16_t* GS; int gcol0; const bf16_t* Oin;
    unsigned char* o8 = nullptr;
    __device__ __forceinline__ void operator()(AccT acc, const Unit& u, int wr, int wc, int fr_, int fq_) const {
        int fr = fr_, fq = fq_; asm volatile("" : "+v"(fr), "+v"(fq));
        const unsigned lo = (unsigned)(fr * 1024 + 8 * fq) * 2u, lg = (unsigned)(fr * 2048 + 8 * fq) * 2u;
        unsigned char* tb = (unsigned char*)O + ((size_t)(u.pm * BM + wr * 64) * 1024 + u.pn * BM + wc * 32) * 2;
        const unsigned char* ib = (const unsigned char*)Oin + ((size_t)(u.pm * BM + wr * 64) * 1024 + u.pn * BM + wc * 32) * 2;
        const unsigned char* gb = (const unsigned char*)GS + ((size_t)(u.pm * BM + wr * 64) * 2048 + gcol0 + u.pn * BM + wc * 32) * 2;
        u32x4 gq[2][2], pq[2][2];
#pragma unroll
        for (int bj = 0; bj < 2; ++bj) { gq[0][bj] = *(const u32x4*)(gb + lg + bj * HALF * 2); if (ADD) pq[0][bj] = *(const u32x4*)(ib + lo + bj * HALF * 2); }
#pragma unroll
        for (int gI = 0; gI < 8; ++gI) { const int ai = gI >> 2, m = gI & 3, cur = gI & 1, nx = cur ^ 1;
            if (gI < 7) { const size_t ro = (size_t)(((gI + 1) >> 2) * HALF + ((gI + 1) & 3) * 16);
#pragma unroll
                for (int bj = 0; bj < 2; ++bj) { gq[nx][bj] = *(const u32x4*)(gb + ro * 2048 * 2 + lg + bj * HALF * 2); if (ADD) pq[nx][bj] = *(const u32x4*)(ib + ro * 1024 * 2 + lo + bj * HALF * 2); } }
            unsigned char* rowp = tb + (size_t)(ai * HALF + m * 16) * 1024 * 2;
#pragma unroll
            for (int bj = 0; bj < 2; ++bj) { const u32x4 gw = gq[cur][bj]; f32x4 v0 = acc[ai][bj][m][0], v1 = acc[ai][bj][m][1];
                v0[0] *= bflo(gw.x); v0[1] *= bfhi(gw.x); v0[2] *= bflo(gw.y); v0[3] *= bfhi(gw.y); v1[0] *= bflo(gw.z); v1[1] *= bfhi(gw.z); v1[2] *= bflo(gw.w); v1[3] *= bfhi(gw.w);
                if (ADD) { const u32x4 pw = pq[cur][bj];
                    v0[0] += bflo(pw.x); v0[1] += bfhi(pw.x); v0[2] += bflo(pw.y); v0[3] += bfhi(pw.y); v1[0] += bflo(pw.z); v1[1] += bfhi(pw.z); v1[2] += bflo(pw.w); v1[3] += bfhi(pw.w); }
                if constexpr (W8) { u32x2 q8; q8.x = cvt_pk_fp8(v0[0], v0[1], v0[2], v0[3]); q8.y = cvt_pk_fp8(v1[0], v1[1], v1[2], v1[3]);
                    *(u32x2*)(o8 + (size_t)(u.pm * BM + wr * 64 + ai * HALF + m * 16 + fr) * 2048 + u.pn * BM + wc * 32 + 8 * fq + bj * HALF) = q8; }
                else { u32x4 w; w.x = cvt_pk_bf16(v0[0], v0[1]); w.y = cvt_pk_bf16(v0[2], v0[3]); w.z = cvt_pk_bf16(v1[0], v1[1]); w.w = cvt_pk_bf16(v1[2], v1[3]);
                       *(u32x4*)(rowp + lo + bj * HALF * 2) = w; } }
        }
    }
};
template <bool W8 = false, bool SC = false>
struct EpiResidBfT {
    static constexpr bool PERM = true;
    const bf16_t* Hin; bf16_t* Hout; float* ssq; LAS float* sl;
    unsigned char* h8 = nullptr; float asc = 1.f;
    __device__ __forceinline__ void operator()(AccT acc, const Unit& u, int wr, int wc, int fr_, int fq_) const {
        int fr = fr_, fq = fq_; asm volatile("" : "+v"(fr), "+v"(fq));
        const unsigned lo = (unsigned)(fr * 1024 + 8 * fq) * 2u;
        const size_t ub = ((size_t)(u.pm * BM + wr * 64) * 1024 + u.pn * BM + wc * 32) * 2;
        const unsigned char* hi0 = (const unsigned char*)Hin + ub + lo; unsigned char* ho0 = (unsigned char*)Hout + ub + lo;
        unsigned char* h80 = W8 ? h8 + (ub >> 1) + (lo >> 1) : nullptr; (void)h80;
        u32x4 hq[2][2];
#pragma unroll
        for (int bj = 0; bj < 2; ++bj) hq[0][bj] = *(const u32x4*)(hi0 + bj * HALF * 2);
#pragma unroll
        for (int gI = 0; gI < 8; ++gI) { const int ai = gI >> 2, m = gI & 3, cur = gI & 1, nx = cur ^ 1;
            if (gI < 7) { const size_t ro = (size_t)(((gI + 1) >> 2) * HALF + ((gI + 1) & 3) * 16) * 1024 * 2;
#pragma unroll
                for (int bj = 0; bj < 2; ++bj) hq[nx][bj] = *(const u32x4*)(hi0 + ro + bj * HALF * 2); }
            unsigned char* ho = ho0 + (size_t)(ai * HALF + m * 16) * 1024 * 2;
            float ss = 0.f;
#pragma unroll
            for (int bj = 0; bj < 2; ++bj) { f32x4 a0 = acc[ai][bj][m][0], a1 = acc[ai][bj][m][1]; const u32x4 hv = hq[cur][bj]; u32x4 w;
                if constexpr (SC) { a0 *= asc; a1 *= asc; }
                a0[0] += bflo(hv.x); a0[1] += bfhi(hv.x); a0[2] += bflo(hv.y); a0[3] += bfhi(hv.y); a1[0] += bflo(hv.z); a1[1] += bfhi(hv.z); a1[2] += bflo(hv.w); a1[3] += bfhi(hv.w);
                w.x = cvt_pk_bf16(a0[0], a0[1]); w.y = cvt_pk_bf16(a0[2], a0[3]); w.z = cvt_pk_bf16(a1[0], a1[1]); w.w = cvt_pk_bf16(a1[2], a1[3]);
                *(u32x4*)(ho + bj * HALF * 2) = w;
                if constexpr (W8) { u32x2 q8; q8.x = cvt_pk_fp8(a0[0], a0[1], a0[2], a0[3]); q8.y = cvt_pk_fp8(a1[0], a1[1], a1[2], a1[3]); *(u32x2*)(h80 + (size_t)(ai * HALF + m * 16) * 1024 + bj * HALF) = q8; }
                ss += (bflo(w.x) * bflo(w.x) + bfhi(w.x) * bfhi(w.x)) + (bflo(w.y) * bflo(w.y) + bfhi(w.y) * bfhi(w.y)) + (bflo(w.z) * bflo(w.z) + bfhi(w.z) * bfhi(w.z)) + (bflo(w.w) * bflo(w.w) + bfhi(w.w) * bfhi(w.w)); }
            ss += __shfl_xor(ss, 16); ss += __shfl_xor(ss, 32);
            if (fq == 0) sl[wc * 256 + ai * HALF + wr * 64 + m * 16 + fr] = ss;
        }
        asm volatile("s_waitcnt lgkmcnt(0)" ::: "memory"); __builtin_amdgcn_s_barrier(); asm volatile("" ::: "memory");
        const int t = (wr * 4 + wc) * 64 + fq * 16 + fr;
        if (t < 256) ssq[(size_t)(u.pm * BM + t) * 4 + u.pn] = (sl[t] + sl[256 + t]) + (sl[512 + t] + sl[768 + t]);
    }
};
typedef EpiResidBfT<false, false> EpiResidBf;
template <bool F8 = false>
struct EpiSwigluT {
    static constexpr bool PERM = true;
    bf16_t* ACT; const float* rs; int ssq16; float asc = 1.f;
    __device__ __forceinline__ void operator()(AccT acc, const Unit& u, int wr, int wc, int fr_, int fq_) const {
        int fr = fr_, fq = fq_; asm volatile("" : "+v"(fr), "+v"(fq));
        constexpr unsigned ES = F8 ? 1u : 2u;
        const unsigned lo = (unsigned)(fr * DFF + 8 * fq) * ES;
        unsigned char* tb = (unsigned char*)ACT + ((size_t)(u.pm * BM + wr * 64) * DFF + u.pn * HALF + wc * 32) * ES;
        const float* rsb = rs + (size_t)(u.pm * BM + wr * 64 + fr) * (ssq16 ? 4 : 1);
        float rr[8];
#pragma unroll
        for (int gI = 0; gI < 8; ++gI) { const int ro = (gI >> 2) * HALF + (gI & 3) * 16; rr[gI] = ssq16 ? 0.f : rsb[ro] * asc; }
        if (ssq16) rstd4x8(rsb, HALF, rr, asc);
#pragma unroll
        for (int ai = 0; ai < 2; ++ai)
#pragma unroll
            for (int m = 0; m < 4; ++m) { const float r = rr[ai * 4 + m];
                float o[8];
#pragma unroll
                for (int n = 0; n < 2; ++n)
#pragma unroll
                    for (int j = 0; j < 4; ++j) { const float gt = acc[ai][0][m][n][j] * r, up = acc[ai][1][m][n][j] * r; o[n * 4 + j] = gt * sigmoidf_(gt) * up; }
                if constexpr (F8) { u32x2 w; w.x = cvt_pk_fp8(o[0], o[1], o[2], o[3]); w.y = cvt_pk_fp8(o[4], o[5], o[6], o[7]); *(u32x2*)(tb + (size_t)(ai * HALF + m * 16) * DFF + lo) = w; }
                else { u32x4 w; w.x = cvt_pk_bf16(o[0], o[1]); w.y = cvt_pk_bf16(o[2], o[3]); w.z = cvt_pk_bf16(o[4], o[5]); w.w = cvt_pk_bf16(o[6], o[7]);
                       *(u32x4*)(tb + (size_t)(ai * HALF + m * 16) * DFF * 2 + lo) = w; }
                EPI_FENCE(); }
    }
};
typedef EpiSwigluT<false> EpiSwiglu;
struct EpiMoeDown {
    static constexpr bool PERM = true;
    const bf16_t* H; const int* rowl; const float* wrow; bf16_t* Hout; float* ssq; LAS float* sl;
    float asc = 1.f; unsigned char* h8 = nullptr;
    __device__ __forceinline__ void operator()(AccT acc, const Unit& u, int wr, int wc, int fr_, int fq_) const {
        int fr = fr_, fq = fq_; asm volatile("" : "+v"(fr), "+v"(fq));
        const int rb = u.pm * BM + wr * 64 + fr; const unsigned cb = (unsigned)(u.pn * BM + wc * 32 + 8 * fq) * 2u;
        int tk[8]; float wt[8];
#pragma unroll
        for (int gI = 0; gI < 8; ++gI) { const int row = rb + (gI >> 2) * HALF + (gI & 3) * 16; tk[gI] = rowl[row]; wt[gI] = wrow[row] * asc; }
        u32x4 hq[2][2];
        { const size_t to = (size_t)(tk[0] < 0 ? 0 : tk[0]);
#pragma unroll
          for (int bj = 0; bj < 2; ++bj) hq[0][bj] = *(const u32x4*)((const unsigned char*)H + to * 2048 + cb + bj * HALF * 2); }
#pragma unroll
        for (int gI = 0; gI < 8; ++gI) { const int ai = gI >> 2, m = gI & 3, cur = gI & 1, nx = cur ^ 1;
            if (gI < 7) { const size_t tn = (size_t)(tk[gI + 1] < 0 ? 0 : tk[gI + 1]);
#pragma unroll
                for (int bj = 0; bj < 2; ++bj) hq[nx][bj] = *(const u32x4*)((const unsigned char*)H + tn * 2048 + cb + bj * HALF * 2); }
            const int tok = tk[gI]; const size_t to = (size_t)(tok < 0 ? 0 : tok);
            unsigned char* op = (unsigned char*)Hout + to * 2048 + cb;
            float ss = 0.f;
            if (tok >= 0) {
#pragma unroll
                for (int bj = 0; bj < 2; ++bj) { f32x4 a0 = acc[ai][bj][m][0] * wt[gI], a1 = acc[ai][bj][m][1] * wt[gI]; const u32x4 hv = hq[cur][bj]; u32x4 w;
                    a0[0] += bflo(hv.x); a0[1] += bfhi(hv.x); a0[2] += bflo(hv.y); a0[3] += bfhi(hv.y); a1[0] += bflo(hv.z); a1[1] += bfhi(hv.z); a1[2] += bflo(hv.w); a1[3] += bfhi(hv.w);
                    w.x = cvt_pk_bf16(a0[0], a0[1]); w.y = cvt_pk_bf16(a0[2], a0[3]); w.z = cvt_pk_bf16(a1[0], a1[1]); w.w = cvt_pk_bf16(a1[2], a1[3]);
                    *(u32x4*)(op + bj * HALF * 2) = w;
                    if (h8 != nullptr) { u32x2 q8; q8.x = cvt_pk_fp8(a0[0], a0[1], a0[2], a0[3]); q8.y = cvt_pk_fp8(a1[0], a1[1], a1[2], a1[3]); *(u32x2*)(h8 + to * 1024 + (cb >> 1) + bj * HALF) = q8; }
                    ss += (bflo(w.x) * bflo(w.x) + bfhi(w.x) * bfhi(w.x)) + (bflo(w.y) * bflo(w.y) + bfhi(w.y) * bfhi(w.y)) + (bflo(w.z) * bflo(w.z) + bfhi(w.z) * bfhi(w.z)) + (bflo(w.w) * bflo(w.w) + bfhi(w.w) * bfhi(w.w)); } }
            ss += __shfl_xor(ss, 16); ss += __shfl_xor(ss, 32);
            if (ssq != nullptr && fq == 0) sl[wc * 256 + ai * HALF + wr * 64 + m * 16 + fr] = ss;
        }
        if (ssq != nullptr) {
            asm volatile("s_waitcnt lgkmcnt(0)" ::: "memory"); __builtin_amdgcn_s_barrier(); asm volatile("" ::: "memory");
            const int t = (wr * 4 + wc) * 64 + fq * 16 + fr;
            if (t < 256) { const int tok = rowl[u.pm * BM + t]; if (tok >= 0) ssq[(size_t)tok * 4 + u.pn] = (sl[t] + sl[256 + t]) + (sl[512 + t] + sl[768 + t]); }
        }
    }
};
}

#define XB_TMO      128
#define XB_XCNT(j)  (256  + 64 * (j))
#define XB_XSUB(j)  (1280 + 64 * (j))
#define XB_XGEN(j)  (2304 + 64 * (j))
#define XB_TOP      3328
#define XB_TOPGEN   3392
#define XCD_BAR_WORDS 3456
#define XB_SPIN_CAP (1u << 22)
__device__ __forceinline__ unsigned xb_ld(unsigned* p)              { return __hip_atomic_load(p, __ATOMIC_RELAXED, __HIP_MEMORY_SCOPE_AGENT); }
__device__ __forceinline__ unsigned xb_add(unsigned* p, unsigned v) { return __hip_atomic_fetch_add(p, v, __ATOMIC_RELAXED, __HIP_MEMORY_SCOPE_AGENT); }
__device__ __forceinline__ unsigned xb_xcc_id() { return (unsigned)__builtin_amdgcn_s_getreg((3 << 11) | 20) & 0xFu; }
#define XB_SPIN(cond, bar) do { unsigned _sp = 0; while (cond) { __builtin_amdgcn_s_sleep(1); \
    if ((++_sp & 255u) == 0u) { if (xb_ld(&(bar)[XB_TMO])) break; if (_sp > XB_SPIN_CAP) { atomicAdd(&(bar)[XB_TMO], 1u); break; } } } } while (0)
struct XcdBarrier { unsigned* bar; unsigned x; volatile LAS unsigned* st; };
__device__ __forceinline__ XcdBarrier xcd_barrier_post(unsigned* bar, volatile LAS unsigned* st) {
    XcdBarrier b; b.bar = bar; b.x = xb_xcc_id(); b.st = st;
    if (threadIdx.x == 0) (void)xb_add(&bar[XB_XCNT(b.x)], 1u);
    return b;
}
__device__ __forceinline__ void xcd_barrier_complete(unsigned* bar, unsigned x, unsigned& nloc, unsigned& nx) {
    const unsigned G = gridDim.x * gridDim.y * gridDim.z;
    unsigned sum, cnt, mine, sp = 0u;
    for (;;) {
        sum = 0u; cnt = 0u; mine = 0u;
#pragma unroll
        for (unsigned j = 0; j < 16; ++j) { const unsigned c = xb_ld(&bar[XB_XCNT(j)]); sum += c; cnt += (c > 0u) ? 1u : 0u; mine = (j == x) ? c : mine; }
        if (sum == G) break;
        __builtin_amdgcn_s_sleep(1);
        if ((++sp & 255u) == 0u) { if (xb_ld(&bar[XB_TMO])) break; if (sp > XB_SPIN_CAP) { atomicAdd(&bar[XB_TMO], 1u); break; } }
    }
    nloc = mine > 0u ? mine : 1u; nx = cnt > 0u ? cnt : 1u;
}
__device__ __forceinline__ void xcd_barrier(const XcdBarrier& b, const bool leader_thread) {
    asm volatile("s_waitcnt vmcnt(0)" ::: "memory");
    __syncthreads();
    if (leader_thread) {
        unsigned* bar = b.bar;
        __builtin_amdgcn_s_waitcnt(0);
        unsigned nloc = b.st[0], nx = b.st[1];
        if (nloc == 0u) { xcd_barrier_complete(bar, b.x, nloc, nx); b.st[0] = nloc; b.st[1] = nx; }
        const unsigned old = xb_add(&bar[XB_XSUB(b.x)], 1u);
        const unsigned gen = old / nloc;
        if (old + 1u == (gen + 1u) * nloc) {
            __builtin_amdgcn_fence(__ATOMIC_RELEASE, "agent");
            asm volatile("s_waitcnt vmcnt(0)" ::: "memory");
            const unsigned og = xb_add(&bar[XB_TOP], 1u);
            const unsigned tg = og / nx;
            if (og + 1u == (tg + 1u) * nx) xb_add(&bar[XB_TOPGEN], 1u);
            else XB_SPIN(xb_ld(&bar[XB_TOPGEN]) == tg, bar);
            __builtin_amdgcn_fence(__ATOMIC_ACQUIRE, "agent");
            xb_add(&bar[XB_XGEN(b.x)], 1u);
            asm volatile("s_waitcnt vmcnt(0)" ::: "memory");
        } else {
            XB_SPIN(xb_ld(&bar[XB_XGEN(b.x)]) == gen, bar);
            __builtin_amdgcn_fence(__ATOMIC_ACQUIRE, "agent");
            asm volatile("s_waitcnt vmcnt(0)" ::: "memory");
        }
    }
    __syncthreads();
}

__device__ __forceinline__ void grp_barrier(unsigned* lb, unsigned RG, unsigned* tmo_bar, const bool leader_thread) {
    asm volatile("s_waitcnt vmcnt(0)" ::: "memory");
    __syncthreads();
    if (leader_thread) {
        __builtin_amdgcn_s_waitcnt(0);
        const unsigned old = xb_add(lb, 1u);
        const unsigned gen = old / RG;
        if (old + 1u == (gen + 1u) * RG) xb_add(lb + 64, 1u);
        else XB_SPIN(xb_ld(lb + 64) == gen, tmo_bar);
        __builtin_amdgcn_fence(__ATOMIC_ACQUIRE, "agent");
        asm volatile("s_waitcnt vmcnt(0)" ::: "memory");
    }
    __syncthreads();
}

struct Params {
    const float* in[28];
    float* out;
    unsigned char* ws;
    int l_lo, l_hi, ph_lo, ph_hi;
};
enum { I_X = 0, I_MEM, I_NORM_MIX, I_W_IN, I_CONV_W, I_CONV_B, I_DT_BIAS, I_A_LOG, I_D_SKIP, I_SSD_NORM, I_W_SSD_O, I_W_SB_O, I_W_OUT, I_NORM_XA, I_NORM_MEM,
       I_XA_WQ, I_XA_WK, I_XA_WV, I_XA_WO, I_NORM_FFN, I_FFN_G, I_FFN_U, I_FFN_D, I_MOE_R, I_MOE_G, I_MOE_U, I_MOE_D, I_FINAL };

struct TrStream { float v[32]; f32x4 g0, g1; bool pending; unsigned char* dst; int ldt, k0, drow0; float f8; };
__device__ __forceinline__ void tr_scatter(const TrStream& S, LAS float* scr, int lane) {
    const int hl = lane >> 5, nl = lane & 31;
#pragma unroll
    for (int i = 0; i < 32; ++i) scr[(2 * i + hl) * 33 + nl] = S.v[i];
}
__device__ __forceinline__ void tr_store(unsigned char* dst, int ldt, int k0, int drow0, float f8, f32x4 g0, f32x4 g1, LAS float* scr, int lane) {
    const int c = lane & 7;
    if (f8 != 0.f) {
        g0 *= f8; g1 *= f8;
#pragma unroll
        for (int j = 0; j < 4; ++j) { const int n = (lane >> 3) + 8 * j; const LAS float* s = scr + (8 * c) * 33 + n;
            u32x2 o; o.x = cvt_pk_fp8(s[0 * 33] * g0.x, s[1 * 33] * g0.y, s[2 * 33] * g0.z, s[3 * 33] * g0.w); o.y = cvt_pk_fp8(s[4 * 33] * g1.x, s[5 * 33] * g1.y, s[6 * 33] * g1.z, s[7 * 33] * g1.w);
            *(u32x2*)(dst + (size_t)(drow0 + n) * ldt + k0 + 8 * c) = o; }
    } else {
#pragma unroll
        for (int j = 0; j < 4; ++j) { const int n = (lane >> 3) + 8 * j; const LAS float* s = scr + (8 * c) * 33 + n;
            u32x4 o; o.x = cvt_pk_bf16(s[0 * 33] * g0.x, s[1 * 33] * g0.y); o.y = cvt_pk_bf16(s[2 * 33] * g0.z, s[3 * 33] * g0.w); o.z = cvt_pk_bf16(s[4 * 33] * g1.x, s[5 * 33] * g1.y); o.w = cvt_pk_bf16(s[6 * 33] * g1.z, s[7 * 33] * g1.w);
            *(u32x4*)((bf16_t*)dst + (size_t)(drow0 + n) * ldt + k0 + 8 * c) = o; }
    }
}
__device__ __forceinline__ void tr_finish(TrStream& S, LAS float* scr, int lane) {
    if (S.pending) { tr_scatter(S, scr, lane); LDS_WAIT(); tr_store(S.dst, S.ldt, S.k0, S.drow0, S.f8, S.g0, S.g1, scr, lane); LDS_WAIT(); S.pending = false; }
}
__device__ __forceinline__ void tr_push(TrStream& S, const float* W, int ldw, int k0, int n0, const float* gain, bf16_t* WT, int ldt, int drow0, float f8, LAS float* scr, int lane) {
    const bool had = S.pending; unsigned char* odst = S.dst; const int oldt = S.ldt, ok0 = S.k0, odrow0 = S.drow0; const float of8 = S.f8; const f32x4 og0 = S.g0, og1 = S.g1;
    if (had) tr_scatter(S, scr, lane);
    { const int hl = lane >> 5, nl = lane & 31, c = lane & 7;
      const float* src = W + (size_t)(k0 + hl) * ldw + n0 + nl;
#pragma unroll
      for (int i = 0; i < 32; ++i) S.v[i] = src[(size_t)(2 * i) * ldw];
      S.g0 = (f32x4){1.f, 1.f, 1.f, 1.f}; S.g1 = S.g0;
      if (gain) { S.g0 = *(const f32x4*)(gain + k0 + 8 * c); S.g1 = *(const f32x4*)(gain + k0 + 8 * c + 4); }
      S.dst = (unsigned char*)WT; S.ldt = ldt; S.k0 = k0; S.drow0 = drow0; S.f8 = f8; S.pending = true; }
    if (had) { LDS_WAIT(); tr_store(odst, oldt, ok0, odrow0, of8, og0, og1, scr, lane); LDS_WAIT(); }
}
struct TrJob { const float* W; int ldw, K, col0, ncols; const float* gain; bf16_t* WT; int dbase, dgroup; float f8 = 0.f; };
__device__ __forceinline__ void run_job(TrStream& S, const TrJob& j, int& base, int gw, int NGW, LAS float* scr, int lane) {
    const int nblk = j.ncols / 32, nitems = (j.K / 64) * nblk;
    int start = (gw - base) % NGW; if (start < 0) start += NGW;
    for (int it = start; it < nitems; it += NGW) { const int kb = it / nblk, nb = it % nblk, c0 = nb * 32;
        tr_push(S, j.W, j.ldw, kb * 64, j.col0 + c0, j.gain, j.WT, j.K, j.dbase + (c0 / 128) * j.dgroup + (c0 % 128), j.f8, scr, lane); }
    base = (base + nitems) % NGW;
}

__device__ __forceinline__ float row_to_bf16(const float* xrow, bf16_t* brow, int lane) {
    const f32x4* xr = (const f32x4*)xrow + lane; u32x2* o8 = (u32x2*)brow + lane; float s = 0.f;
    f32x4 vin[4];
#pragma unroll
    for (int j = 0; j < 4; ++j) vin[j] = xr[64 * j];
#pragma unroll
    for (int j = 0; j < 4; ++j) { const f32x4 v = vin[j]; u32x2 w; w.x = cvt_pk_bf16(v.x, v.y); w.y = cvt_pk_bf16(v.z, v.w); o8[64 * j] = w;
        s += (bflo(w.x) * bflo(w.x) + bfhi(w.x) * bfhi(w.x)) + (bflo(w.y) * bflo(w.y) + bfhi(w.y) * bfhi(w.y)); }
    return wave_sum(s);
}
template <int NE>
__device__ __forceinline__ void row_dots_raw(const u32x2 (&xw)[4], int lane, const LAS float* wsm, float rstd, float (&ex)[NE]) {
    f32x4 v[4];
#pragma unroll
    for (int j = 0; j < 4; ++j) { const u32x2 w = xw[j]; v[j] = (f32x4){bflo(w.x), bfhi(w.x), bflo(w.y), bfhi(w.y)}; }
#pragma unroll
    for (int e = 0; e < NE; ++e) { float pp = 0.f;
#pragma unroll
        for (int j = 0; j < 4; ++j) { const f32x4 w4 = *(const LAS f32x4*)(wsm + e * 1024 + 256 * j + 4 * lane); pp += (v[j].x * w4.x + v[j].y * w4.y) + (v[j].z * w4.z + v[j].w * w4.w); }
        ex[e] = wave_sum(pp) * rstd; }
}
template <int NE>
__device__ __forceinline__ void row_dots_bf16(const bf16_t* brow, int lane, const LAS float* wsm, float rstd, float (&ex)[NE]) {
    const u32x2* xr = (const u32x2*)brow + lane; f32x4 v[4];
#pragma unroll
    for (int j = 0; j < 4; ++j) { const u32x2 w = xr[64 * j]; v[j] = (f32x4){bflo(w.x), bfhi(w.x), bflo(w.y), bfhi(w.y)}; }
#pragma unroll
    for (int e = 0; e < NE; ++e) { float pp = 0.f;
#pragma unroll
        for (int j = 0; j < 4; ++j) { const f32x4 w4 = *(const LAS f32x4*)(wsm + e * 1024 + 256 * j + 4 * lane); pp += (v[j].x * w4.x + v[j].y * w4.y) + (v[j].z * w4.z + v[j].w * w4.w); }
        ex[e] = wave_sum(pp) * rstd; }
}

typedef float f32x16 __attribute__((ext_vector_type(16)));
#define MFMA32(a, b, c) __builtin_amdgcn_mfma_f32_32x32x16_bf16((a), (b), (c), 0, 0, 0)
__device__ __forceinline__ bf16x8 ldg8(const bf16_t* p) { return *(const bf16x8*)p; }
__device__ __forceinline__ bf16x8 pack8(const float* v) { u32x4 w; w.x = cvt_pk_bf16(v[0], v[1]); w.y = cvt_pk_bf16(v[2], v[3]); w.z = cvt_pk_bf16(v[4], v[5]); w.w = cvt_pk_bf16(v[6], v[7]); return __builtin_bit_cast(bf16x8, w); }
__device__ __forceinline__ int pi32(int r) { return 16 * ((r >> 2) & 1) + 4 * (r >> 3) + (r & 3); }

__device__ __forceinline__ void sb_attn_mfma(const bf16_t* Q, const bf16_t* Kb, const bf16_t* Vt, bf16_t* Yo, int vg, int rg, int RG, int wave, int lane) {
    const int c = lane & 31, hh = lane >> 5, pr = pi32(c);
    bf16x8 U[2];
#pragma unroll
    for (int kk = 0; kk < 2; ++kk) { u32x4 uw;
#pragma unroll
        for (int q = 0; q < 4; ++q) uw[q] = ((16 * hh + 8 * kk + 2 * q > pr) ? 0x3F80u : 0u) | ((16 * hh + 8 * kk + 2 * q + 1 > pr) ? 0x3F800000u : 0u);
        U[kk] = __builtin_bit_cast(bf16x8, uw); }
    for (int vb = rg; vb < 32; vb += RG)
    for (int iu = 0; iu < 4; ++iu) {
        const int k4 = iu, a = vb >> 1, bh = (2 * vg + (vb & 1)) * 8 + wave;
        const int qblk = k4 == 0 ? a : k4 == 1 ? 31 - a : k4 == 2 ? 32 + a : 63 - a;
        const int b = bh >> 3, h = bh & 7, t0 = qblk * 32;
        const bf16_t* qp = Q + (size_t)(b * SEQ + t0 + c) * 512 + h * 64; bf16_t* yp = Yo + (size_t)(b * SEQ + t0 + c) * 512 + h * 64;
        bf16x8 qf[4];
#pragma unroll
        for (int jj = 0; jj < 4; ++jj) qf[jj] = ldg8(qp + 16 * jj + 8 * hh);
        const bf16_t* kbase = Kb + (size_t)(b * SEQ + pr) * 512 + h * 64 + 8 * hh;
        const bf16_t* vbase = Vt + (size_t)(b * 16) * 512 * 128 + (size_t)(h * 64 + c) * 128 + 16 * hh;
        f32x16 o0, o1;
#pragma unroll
        for (int i = 0; i < 16; ++i) { o0[i] = 0.f; o1[i] = 0.f; }
        float R = 0.f;
        bf16x8 kf[4], vf[4], kn[4], vn[4];
#pragma unroll
        for (int jj = 0; jj < 4; ++jj) { kf[jj] = ldg8(kbase + (size_t)t0 * 512 + 16 * jj); vf[jj] = ldg8(vbase + (size_t)(t0 >> 7) * 512 * 128 + (t0 & 127) + (jj >> 1) * 32 * 128 + 8 * (jj & 1)); }
        for (int kb = qblk; kb >= 0; --kb) {
            const int s0 = kb * 32;
            if (kb > 0) {
#pragma unroll
                for (int jj = 0; jj < 4; ++jj) { kn[jj] = ldg8(kbase + (size_t)(s0 - 32) * 512 + 16 * jj); vn[jj] = ldg8(vbase + (size_t)((s0 - 32) >> 7) * 512 * 128 + ((s0 - 32) & 127) + (jj >> 1) * 32 * 128 + 8 * (jj & 1)); }
            }
            f32x16 s;
#pragma unroll
            for (int i = 0; i < 16; ++i) s[i] = 0.f;
#pragma unroll
            for (int jj = 0; jj < 4; ++jj) s = MFMA32(kf[jj], qf[jj], s);
            const bool diag = (kb == qblk);
            float sp[16]; float rsum = 0.f;
#pragma unroll
            for (int i = 0; i < 16; ++i) { const float x = s[i]; float v = fmaxf(x, 0.f) + __builtin_amdgcn_logf(1.f + __builtin_amdgcn_exp2f(-fabsf(x)));
                if (diag && !(16 * hh + i < c)) v = 0.f;
                sp[i] = v; rsum += v; }
            f32x16 E;
#pragma unroll
            for (int i = 0; i < 16; ++i) E[i] = 0.f;
            E = MFMA32(U[0], pack8(sp), E); E = MFMA32(U[1], pack8(sp + 8), E);
            float at[16];
#pragma unroll
            for (int i = 0; i < 16; ++i) { float av = __builtin_amdgcn_exp2f(s[i] - sp[i] - E[i] - R); if (diag && !(16 * hh + i < c)) av = 0.f; at[i] = av; }
            const bf16x8 a0 = pack8(at), a1 = pack8(at + 8);
            o0 = MFMA32(vf[0], a0, o0); o0 = MFMA32(vf[1], a1, o0);
            o1 = MFMA32(vf[2], a0, o1); o1 = MFMA32(vf[3], a1, o1);
            rsum += __shfl_xor(rsum, 32); R += rsum;
            if (__all(R > 48.f)) break;
#pragma unroll
            for (int jj = 0; jj < 4; ++jj) { kf[jj] = kn[jj]; vf[jj] = vn[jj]; }
        }
#pragma unroll
        for (int g = 0; g < 4; ++g) { u32x2 w0, w1; w0.x = cvt_pk_bf16(o0[4 * g], o0[4 * g + 1]); w0.y = cvt_pk_bf16(o0[4 * g + 2], o0[4 * g + 3]); w1.x = cvt_pk_bf16(o1[4 * g], o1[4 * g + 1]); w1.y = cvt_pk_bf16(o1[4 * g + 2], o1[4 * g + 3]);
            *(u32x2*)(yp + 8 * g + 4 * hh) = w0; *(u32x2*)(yp + 32 + 8 * g + 4 * hh) = w1; }
    }
}

__device__ __forceinline__ void xattn_lds(const bf16_t* XQ, const bf16_t* KMl, const bf16_t* VtMl, bf16_t* XO, int vg, int rg, int RG, int tid, int wave, int lane, LAS unsigned char* lds) {
    constexpr int KP = 272, VP = 528;
    LAS unsigned char* Ks = lds; LAS unsigned char* Vs = lds + 256 * KP;
    const int c = lane & 31, hh = lane >> 5, pr = pi32(c);
    for (int u = rg; u < 32; u += RG) { const int b = 2 * vg + (u >> 4), hd = (u >> 2) & 3, qz = u & 3;
        __syncthreads();
        { u32x4 kr[8], vr[8];
#pragma unroll
          for (int i = 0; i < 8; ++i) { const int idx = tid + 512 * i; kr[i] = *(const u32x4*)(KMl + (size_t)(b * MEMLEN + (idx >> 4)) * 2048 + hd * 128 + (idx & 15) * 8);
              vr[i] = *(const u32x4*)(VtMl + (size_t)(hd * 128 + (idx >> 5)) * TM + b * MEMLEN + (idx & 31) * 8); }
#pragma unroll
          for (int i = 0; i < 8; ++i) { const int idx = tid + 512 * i; *(LAS u32x4*)(Ks + (idx >> 4) * KP + (idx & 15) * 16) = kr[i]; *(LAS u32x4*)(Vs + (idx >> 5) * VP + (idx & 31) * 16) = vr[i]; } }
        __syncthreads();
        const LAS unsigned char* kl = Ks + pr * KP + 16 * hh;
        const LAS unsigned char* vl = Vs + c * VP + 32 * hh;
        for (int qi = 0; qi < 2; ++qi) { const int t0 = (qz * 16 + wave * 2 + qi) * 32;
            const bf16_t* qp = XQ + (size_t)(b * SEQ + t0 + c) * 512 + hd * 128 + 8 * hh;
            bf16x8 qf[8];
#pragma unroll
            for (int jj = 0; jj < 8; ++jj) qf[jj] = ldg8(qp + 16 * jj);
            float mx = -3.0e38f;
            for (int kb = 0; kb < 8; ++kb) { f32x16 sc;
#pragma unroll
                for (int i = 0; i < 16; ++i) sc[i] = 0.f;
#pragma unroll
                for (int jj = 0; jj < 8; ++jj) sc = MFMA32(*(const LAS bf16x8*)(kl + kb * 32 * KP + 32 * jj), qf[jj], sc);
#pragma unroll
                for (int i = 0; i < 16; ++i) mx = fmaxf(mx, sc[i]); }
            mx = fmaxf(mx, __shfl_xor(mx, 32));
            f32x16 o[4];
#pragma unroll
            for (int db = 0; db < 4; ++db)
#pragma unroll
                for (int i = 0; i < 16; ++i) o[db][i] = 0.f;
            float sum = 0.f;
            for (int kb = 0; kb < 8; ++kb) { f32x16 sc;
#pragma unroll
                for (int i = 0; i < 16; ++i) sc[i] = 0.f;
#pragma unroll
                for (int jj = 0; jj < 8; ++jj) sc = MFMA32(*(const LAS bf16x8*)(kl + kb * 32 * KP + 32 * jj), qf[jj], sc);
                float pv[16];
#pragma unroll
                for (int i = 0; i < 16; ++i) { pv[i] = __builtin_amdgcn_exp2f(sc[i] - mx); sum += pv[i]; }
                const bf16x8 p0 = pack8(pv), p1 = pack8(pv + 8);
#pragma unroll
                for (int db = 0; db < 4; ++db) { const LAS unsigned char* vp = vl + db * 32 * VP + kb * 64; o[db] = MFMA32(*(const LAS bf16x8*)vp, p0, o[db]); o[db] = MFMA32(*(const LAS bf16x8*)(vp + 16), p1, o[db]); } }
            sum += __shfl_xor(sum, 32);
            const float inv = 1.f / sum;
            bf16_t* op = XO + (size_t)(b * SEQ + t0 + c) * 512 + hd * 128 + 4 * hh;
#pragma unroll
            for (int db = 0; db < 4; ++db)
#pragma unroll
                for (int g = 0; g < 4; ++g) { u32x2 w0; w0.x = cvt_pk_bf16(o[db][4 * g] * inv, o[db][4 * g + 1] * inv); w0.y = cvt_pk_bf16(o[db][4 * g + 2] * inv, o[db][4 * g + 3] * inv);
                    *(u32x2*)(op + 32 * db + 8 * g) = w0; }
        }
    }
}

template <int CTRL, int ROWMASK> __device__ __forceinline__ float dpp_mov0(float v) { return __builtin_bit_cast(float, __builtin_amdgcn_update_dpp(0, __builtin_bit_cast(int, v), CTRL, ROWMASK, 0xF, false)); }
__device__ __forceinline__ float wave_incl_scan(float v, int) {
    v += dpp_mov0<0x111, 0xF>(v); v += dpp_mov0<0x112, 0xF>(v); v += dpp_mov0<0x114, 0xF>(v); v += dpp_mov0<0x118, 0xF>(v);
    v += dpp_mov0<0x142, 0xA>(v); v += dpp_mov0<0x143, 0xC>(v);
    return v;
}
__device__ __forceinline__ float lane63(float v) { return __builtin_bit_cast(float, __builtin_amdgcn_readlane(__builtin_bit_cast(int, v), 63)); }
__device__ __forceinline__ void conv_unit(const bf16_t* XBC, const float* cw, const float* cb, bf16_t* XT, bf16_t* BR, bf16_t* BT, bf16_t* CR, int u, int lane) {
    const int tb = u / 10, cbk = u - tb * 10, tok0 = tb * 64, ch0 = cbk * 128 + 2 * lane;
    float w[4][2], bs[2];
#pragma unroll
    for (int k = 0; k < 4; ++k) { w[k][0] = cw[k * 1280 + ch0]; w[k][1] = cw[k * 1280 + ch0 + 1]; }
    bs[0] = cb[ch0]; bs[1] = cb[ch0 + 1];
    const bf16_t* src = XBC + (size_t)tok0 * 1280 + ch0;
    float h0[2] = {0.f, 0.f}, h1[2] = {0.f, 0.f}, h2[2] = {0.f, 0.f};
    if ((tok0 & (SEQ - 1)) != 0) { const unsigned a = *(const unsigned*)(src - 3 * 1280), b = *(const unsigned*)(src - 2 * 1280), c = *(const unsigned*)(src - 1280);
        h0[0] = bflo(a); h0[1] = bfhi(a); h1[0] = bflo(b); h1[1] = bfhi(b); h2[0] = bflo(c); h2[1] = bfhi(c); }
    unsigned ylo[32], yhi[32]; float pe0 = 0.f, pe1 = 0.f;
    bf16_t* rdst = (cbk == 8) ? BR : CR;
    unsigned xin[64];
#pragma unroll
    for (int tt = 0; tt < 64; ++tt) xin[tt] = *(const unsigned*)(src + (size_t)tt * 1280);
#pragma unroll
    for (int tt = 0; tt < 64; ++tt) { const unsigned xw = xin[tt]; const float x0 = bflo(xw), x1 = bfhi(xw);
        float v0 = bs[0] + w[0][0] * h0[0] + w[1][0] * h1[0] + w[2][0] * h2[0] + w[3][0] * x0, v1 = bs[1] + w[0][1] * h0[1] + w[1][1] * h1[1] + w[2][1] * h2[1] + w[3][1] * x1;
        v0 *= sigmoidf_(v0); v1 *= sigmoidf_(v1);
        h0[0] = h1[0]; h0[1] = h1[1]; h1[0] = h2[0]; h1[1] = h2[1]; h2[0] = x0; h2[1] = x1;
        xin[tt] = cvt_pk_bf16(v0, v1);
        if (tt & 1) { ylo[tt >> 1] = cvt_pk_bf16(pe0, v0); yhi[tt >> 1] = cvt_pk_bf16(pe1, v1); } else { pe0 = v0; pe1 = v1; } }
    if (cbk >= 8) {
#pragma unroll
        for (int tt = 0; tt < 64; ++tt) *(unsigned*)(rdst + (size_t)(tok0 + tt) * 128 + 2 * lane) = xin[tt]; }
    if (cbk <= 8) { bf16_t* tbase = (cbk < 8) ? XT + ((size_t)(tok0 >> 7) * 1024 + ch0) * 128 + (tok0 & 127) : BT + ((size_t)(tok0 >> 7) * 128 + 2 * lane) * 128 + (tok0 & 127);
#pragma unroll
        for (int q = 0; q < 8; ++q) { u32x4 a, b; a.x = ylo[4 * q]; a.y = ylo[4 * q + 1]; a.z = ylo[4 * q + 2]; a.w = ylo[4 * q + 3]; b.x = yhi[4 * q]; b.y = yhi[4 * q + 1]; b.z = yhi[4 * q + 2]; b.w = yhi[4 * q + 3];
            *(u32x4*)(tbase + 8 * q) = a; *(u32x4*)(tbase + 128 + 8 * q) = b; } }
}
__device__ __forceinline__ void ssd_scan_block(const bf16_t* XT, const bf16_t* BT, const float* DTT, bf16_t* PREV, float negA, int b, int h, int wave, int lane, LAS float* wl  , LAS float* xch  ) {
    const int c32 = lane & 31, hh = lane >> 5, g = h >> 3, q = wave & 3, pblk = q >> 1, nblk = q & 1, c0 = (wave >> 2) * 8;
    const bf16_t* xrow = XT + ((size_t)(b * 16) * 1024 + h * 64 + pblk * 32 + c32) * 128 + 8 * hh;
    const bf16_t* brow = BT + ((size_t)(b * 16) * 128 + g * 64 + nblk * 32 + c32) * 128 + 8 * hh;
    const float* dtp = DTT + (size_t)h * T + b * SEQ + lane;
    f32x16 S[8]; float dec[8];
#pragma unroll
    for (int ci = 0; ci < 8; ++ci) { const int c = c0 + ci;
        const float d0 = dtp[c * 128], d1 = dtp[c * 128 + 64];
        u32x4 xa[8]; bf16x8 ba[8];
#pragma unroll
        for (int ks = 0; ks < 8; ++ks) { xa[ks] = *(const u32x4*)(xrow + (size_t)c * 1024 * 128 + 16 * ks); ba[ks] = ldg8(brow + (size_t)c * 128 * 128 + 16 * ks); }
        const float s0 = wave_incl_scan(d0 * negA, lane); const float tot0 = lane63(s0);
        const float s1 = wave_incl_scan(d1 * negA, lane) + tot0; const float last = lane63(s1);
        wl[lane] = d0 * fexp(last - s0); wl[64 + lane] = d1 * fexp(last - s1);
        dec[ci] = fexp(last);
        f32x16 st;
#pragma unroll
        for (int i = 0; i < 16; ++i) st[i] = 0.f;
#pragma unroll
        for (int ks = 0; ks < 8; ++ks) { const u32x4 xw = xa[ks];
            const f32x4 wa = *(const LAS f32x4*)(wl + 16 * ks + 8 * hh), wb = *(const LAS f32x4*)(wl + 16 * ks + 8 * hh + 4);
            float xs[8]; xs[0] = bflo(xw.x) * wa.x; xs[1] = bfhi(xw.x) * wa.y; xs[2] = bflo(xw.y) * wa.z; xs[3] = bfhi(xw.y) * wa.w; xs[4] = bflo(xw.z) * wb.x; xs[5] = bfhi(xw.z) * wb.y; xs[6] = bflo(xw.w) * wb.z; xs[7] = bfhi(xw.w) * wb.w;
            st = MFMA32(pack8(xs), ba[ks], st); }
        S[ci] = st;
        asm volatile("" ::: "memory");
    }
    f32x16 carry;
#pragma unroll
    for (int i = 0; i < 16; ++i) carry[i] = 0.f;
    LAS float* xq = xch + q * 1024 + lane;
    bf16_t* pv = PREV + ((size_t)((b * 16) * 16 + h) * 64 + pblk * 32) * 64 + nblk * 32 + c32;
#pragma unroll
    for (int half = 0; half < 2; ++half) {
        if ((wave >> 2) == half) {
            if (half == 1) {
#pragma unroll
                for (int i = 0; i < 16; ++i) carry[i] = xq[i * 64]; }
#pragma unroll
            for (int ci = 0; ci < 8; ++ci) { bf16_t* pc = pv + (size_t)(c0 + ci) * 16 * 4096;
#pragma unroll
                for (int i = 0; i < 16; ++i) pc[(8 * (i >> 2) + 4 * hh + (i & 3)) * 64] = f2bf(carry[i]);
#pragma unroll
                for (int i = 0; i < 16; ++i) carry[i] = carry[i] * dec[ci] + S[ci][i]; }
            if (half == 0) {
#pragma unroll
                for (int i = 0; i < 16; ++i) xq[i * 64] = carry[i]; }
        }
        if (half == 0) { asm volatile("s_waitcnt lgkmcnt(0)" ::: "memory"); __builtin_amdgcn_s_barrier(); asm volatile("" ::: "memory"); }
    }
}
__device__ __forceinline__ void ssd_out_unit(const bf16_t* XT, const bf16_t* BR, const bf16_t* CR, const float* DTT, const bf16_t* PREV, const bf16_t* Zb, bf16_t* Y, float negA, float dsk,
                                             int b, int c, int g, int wave, int lane, LAS float* tab  , LAS float* red  , const int var) {
    const int c32 = lane & 31, hh = lane >> 5, pr = pi32(c32), h = g * 8 + wave;
    const int tokc = b * SEQ + c * 128;
    const float* dtp = DTT + (size_t)h * T + tokc + lane;
    const float d0 = dtp[0], d1 = dtp[64];
    const bf16_t* pv = PREV + ((size_t)((b * 16 + c) * 16 + h) * 64 + c32) * 64 + 8 * hh;
    const bf16_t* xrow = XT + ((size_t)(b * 16 + c) * 1024 + h * 64 + c32) * 128 + 16 * hh;
    const bf16_t* brow = BR + (size_t)(tokc + pr) * 128 + g * 64 + 8 * hh;
    const float s0 = wave_incl_scan(d0 * negA, lane); const float tot0 = lane63(s0);
    const float s1 = wave_incl_scan(d1 * negA, lane) + tot0;
    tab[lane] = s0; tab[64 + lane] = s1; tab[128 + lane] = d0; tab[192 + lane] = d1;
    tab[256 + lane] = d0 * fexp(tab[lane | 31] - s0); tab[320 + lane] = d1 * fexp(tab[64 + (lane | 31)] - s1);
#pragma unroll
    for (int tq = 0; tq < ((var & 8) ? 0 : 4); ++tq) {
        const size_t tokg = (size_t)(tokc + tq * 32 + c32);
        bf16x8 cf[4], pf[8];
#pragma unroll
        for (int ks = 0; ks < 4; ++ks) cf[ks] = ldg8(CR + tokg * 128 + g * 64 + 16 * ks + 8 * hh);
#pragma unroll
        for (int ks = 0; ks < 4; ++ks) { pf[ks] = ldg8(pv + 16 * ks); pf[4 + ks] = ldg8(pv + 32 * 64 + 16 * ks); }
        bf16x8 bfr[4], xfr[4], bnx[4], xnx[4];
#pragma unroll
        for (int ks = 0; ks < 4; ++ks) bfr[ks] = ldg8(brow + 16 * ks);
        xfr[0] = ldg8(xrow); xfr[1] = ldg8(xrow + 8); xfr[2] = ldg8(xrow + 32 * 128); xfr[3] = ldg8(xrow + 32 * 128 + 8);
        const bf16_t* zp = Zb + tokg * 1024 + h * 64 + 4 * hh;
        u32x2 zr[8];
#pragma unroll
        for (int gq = 0; gq < 4; ++gq) { zr[gq] = *(const u32x2*)(zp + 8 * gq); zr[4 + gq] = *(const u32x2*)(zp + 32 + 8 * gq); }
        const float acum_t = tab[tq * 32 + c32];
        f32x16 y0, y1;
#pragma unroll
        for (int i = 0; i < 16; ++i) { y0[i] = 0.f; y1[i] = 0.f; }
        if (!(var & 2))
#pragma unroll
        for (int ks = 0; ks < 4; ++ks) { y0 = MFMA32(pf[ks], cf[ks], y0); y1 = MFMA32(pf[4 + ks], cf[ks], y1); }
        { const float ea = fexp(acum_t);
#pragma unroll
          for (int i = 0; i < 16; ++i) { y0[i] *= ea; y1[i] *= ea; } }
#pragma unroll
        for (int j = 0; j <= ((var & 1) ? -1 : tq); ++j) {
            if (j < tq) {
#pragma unroll
                for (int ks = 0; ks < 4; ++ks) bnx[ks] = ldg8(brow + (size_t)(32 * (j + 1)) * 128 + 16 * ks);
                xnx[0] = ldg8(xrow + 32 * (j + 1)); xnx[1] = ldg8(xrow + 32 * (j + 1) + 8); xnx[2] = ldg8(xrow + 32 * 128 + 32 * (j + 1)); xnx[3] = ldg8(xrow + 32 * 128 + 32 * (j + 1) + 8); }
            f32x16 cbt;
#pragma unroll
            for (int i = 0; i < 16; ++i) cbt[i] = 0.f;
#pragma unroll
            for (int ks = 0; ks < 4; ++ks) cbt = MFMA32(bfr[ks], cf[ks], cbt);
            float m[16];
            if (j < tq) { const float et = fexp(acum_t - tab[32 * j + 31]);
#pragma unroll
                for (int q = 0; q < 4; ++q) { const f32x4 ks = *(const LAS f32x4*)(tab + 256 + 32 * j + 16 * hh + 4 * q);
#pragma unroll
                    for (int e = 0; e < 4; ++e) m[4 * q + e] = cbt[4 * q + e] * ks[e] * et; }
            } else {
#pragma unroll
                for (int q = 0; q < 4; ++q) { const f32x4 as = *(const LAS f32x4*)(tab + 32 * j + 16 * hh + 4 * q), ds = *(const LAS f32x4*)(tab + 128 + 32 * j + 16 * hh + 4 * q);
#pragma unroll
                    for (int e = 0; e < 4; ++e) { const int i = 4 * q + e; float v = cbt[i] * ds[e] * fexp(acum_t - as[e]);
                        if (16 * hh + i > c32) v = 0.f; if (16 * hh + i == c32) v += dsk;
                        m[i] = v; } }
            }
            const bf16x8 m0 = pack8(m), m1 = pack8(m + 8);
            y0 = MFMA32(xfr[0], m0, y0); y0 = MFMA32(xfr[1], m1, y0);
            y1 = MFMA32(xfr[2], m0, y1); y1 = MFMA32(xfr[3], m1, y1);
#pragma unroll
            for (int ks = 0; ks < 4; ++ks) { bfr[ks] = bnx[ks]; xfr[ks] = xnx[ks]; }
        }
        float ss = 0.f;
#pragma unroll
        for (int gq = 0; gq < 4; ++gq) { const u32x2 za = zr[gq], zb2 = zr[4 + gq];
            const float z0[4] = {bflo(za.x), bfhi(za.x), bflo(za.y), bfhi(za.y)}, z1[4] = {bflo(zb2.x), bfhi(zb2.x), bflo(zb2.y), bfhi(zb2.y)};
#pragma unroll
            for (int e = 0; e < 4; ++e) { const int i = 4 * gq + e; y0[i] *= z0[e] * sigmoidf_(z0[e]); y1[i] *= z1[e] * sigmoidf_(z1[e]); ss += y0[i] * y0[i] + y1[i] * y1[i]; } }
        ss += __shfl_xor(ss, 32);
        LAS float* rd = red + (tq & 1) * 256;
        if (hh == 0) rd[wave * 32 + c32] = ss;
        asm volatile("s_waitcnt lgkmcnt(0)" ::: "memory"); __builtin_amdgcn_s_barrier(); asm volatile("" ::: "memory");
        float tot = 0.f;
#pragma unroll
        for (int w8 = 0; w8 < 8; ++w8) tot += rd[w8 * 32 + c32];
        const float rstd = __builtin_amdgcn_rsqf(tot * (1.f / 512.f) + EPS);
        bf16_t* yp = Y + tokg * 1280 + h * 64 + 4 * hh;
#pragma unroll
        for (int gq = 0; gq < 4; ++gq) { u32x2 o0, o1; o0.x = cvt_pk_bf16(y0[4 * gq] * rstd, y0[4 * gq + 1] * rstd); o0.y = cvt_pk_bf16(y0[4 * gq + 2] * rstd, y0[4 * gq + 3] * rstd);
            o1.x = cvt_pk_bf16(y1[4 * gq] * rstd, y1[4 * gq + 1] * rstd); o1.y = cvt_pk_bf16(y1[4 * gq + 2] * rstd, y1[4 * gq + 3] * rstd);
            if (!(var & 4)) { *(u32x2*)(yp + 8 * gq) = o0; *(u32x2*)(yp + 32 + 8 * gq) = o1; } }
    }
}

__device__ __forceinline__ void moe_convert(const Params& p, unsigned char* ws, int lm, int jfm, int kinds, int gwc, int NGWc, LAS float* scr, int lane) {
    int base = 0; const float* gn = p.in[I_NORM_FFN] + lm * D; TrStream S{};
    for (int jb = 0; jb < NEXP * 3; ++jb) { const int e = jb / 3, k = jb % 3; if (!((kinds >> k) & 1)) continue;
        TrJob j; const size_t eo = ((size_t)jfm * NEXP + e) * D * DFF;
        if (k == 0) j = TrJob{p.in[I_MOE_G] + eo, DFF, D, 0, DFF, gn, (bf16_t*)(ws + WS_WMOE + WM_GU + (size_t)e * 2 * DFF * 1024 * (MOE_F8_GU ? 1 : 2)), 0, 256, MOE_F8_GU ? F8_WGU : 0.f};
        else if (k == 1) j = TrJob{p.in[I_MOE_U] + eo, DFF, D, 0, DFF, gn, (bf16_t*)(ws + WS_WMOE + WM_GU + (size_t)e * 2 * DFF * 1024 * (MOE_F8_GU ? 1 : 2)), 128, 256, MOE_F8_GU ? F8_WGU : 0.f};
        else j = TrJob{p.in[I_MOE_D] + eo, D, DFF, 0, D, nullptr, (bf16_t*)(ws + WS_WMOE + WM_DN + (size_t)e * 1024 * DFF * (MOE_F8_DN ? 1 : 2)), 0, 128, MOE_F8_DN ? F8_WDN : 0.f};
        run_job(S, j, base, gwc, NGWc, scr, lane); }
    tr_finish(S, scr, lane);
}

#define PHASE_DELAY() do { if ((DELAY_MASK >> site_) & 1u) { const unsigned long long t1_ = __builtin_amdgcn_s_memrealtime(); while (__builtin_amdgcn_s_memrealtime() - t1_ < t1_ - t0_) __builtin_amdgcn_s_sleep(8); } } while (0)
#define PHASE_ENTER() constexpr int site_ = __COUNTER__; const unsigned long long t0_ = (DELAY_MASK >> site_) & 1u ? __builtin_amdgcn_s_memrealtime() : 0ull; (void)t0_; GAS unsigned char* ws_ = (GAS unsigned char*)p.ws; asm volatile("" : "+s"(ws_)); unsigned char* const ws = (unsigned char*)ws_;     \
    GAS float* out_ = (GAS float*)p.out; asm volatile("" : "+s"(out_)); float* const OUTP = (float*)out_; (void)OUTP; int tid_ = wave0 * 64 + lane_id_opaque(); int bid_ = blockIdx.x; asm volatile("" : "+s"(bid_)); \
    const int tid = tid_, lane = tid & 63, wave = __builtin_amdgcn_readfirstlane(tid >> 6); \
    const int G = gridDim.x, bid = bid_, gw = bid * 8 + wave, NGW = G * 8, vg = bid & 7, rg = bid >> 3, RG = G >> 3; (void)lane; (void)gw; (void)NGW; (void)wave; (void)bid; (void)G; (void)vg; (void)rg; (void)RG
#define WSP(type, off) ((type*)(ws + (off)))
__global__ void __launch_bounds__(512, 2) mk_fwd(Params p) {
    extern __shared__ __attribute__((aligned(16))) unsigned char lds_raw[];
    LAS unsigned char* lds = (LAS unsigned char*)lds_raw;
    volatile LAS unsigned* ldsctl = (volatile LAS unsigned*)(lds + LDSCTL_OFF);
    if (threadIdx.x < 64) ldsctl[threadIdx.x] = 0u;
    int wave0 = __builtin_amdgcn_readfirstlane((int)threadIdx.x >> 6); asm volatile("" : "+s"(wave0));
    __syncthreads();
    const int ph_lo = p.ph_lo, ph_hi = p.ph_hi;
    const bool use_bar = (ph_hi - ph_lo) > 1 || (p.l_hi - p.l_lo) > 1;
    XcdBarrier bar; bar.bar = (unsigned*)(p.ws + WS_CTL) + CW_BAR; bar.x = 0; bar.st = nullptr;
    if (use_bar) bar = xcd_barrier_post((unsigned*)(p.ws + WS_CTL) + CW_BAR, ldsctl + 8);
    int local_ok = 0;
    if (use_bar && threadIdx.x == 0) { const unsigned xcc = xb_xcc_id(); unsigned* plc = (unsigned*)(p.ws + WS_CTL) + CW_PLC + 64 * (blockIdx.x & 7);
        (void)__hip_atomic_fetch_max(plc, xcc + 1u, __ATOMIC_RELAXED, __HIP_MEMORY_SCOPE_AGENT); (void)__hip_atomic_fetch_max(plc + 1, 16u - xcc, __ATOMIC_RELAXED, __HIP_MEMORY_SCOPE_AGENT); }
#define LOCAL_BAR() do { PHASE_DELAY(); if (use_bar) { if (local_ok) grp_barrier((unsigned*)(p.ws + WS_CTL) + CW_LBAR + 128 * (blockIdx.x & 7), gridDim.x >> 3, bar.bar, wave0 == 0 && lane_id_opaque() == 0); \
                                                       else xcd_barrier(bar, wave0 == 0 && lane_id_opaque() == 0); } } while (0)
#define PH(k) (ph_lo <= (k) && (k) < ph_hi)
#define GRID_BAR() do { PHASE_DELAY(); if (use_bar) xcd_barrier(bar, wave0 == 0 && lane_id_opaque() == 0); } while (0)

    if (p.l_lo == 0 && PH(0)) for (int rep = 0; rep < NREP(0); ++rep) {
        PHASE_ENTER();
        LAS float* scr = (LAS float*)(lds + wave * 16384);
        int base = 0; TrStream S{};
        for (int jb = 0; jb < 4 * 12 + 2 * 3; ++jb) {
            TrJob j;
            if (jb < 48) { const int l = jb / 12, k = jb % 12; unsigned char* wl = ws + WS_W + (size_t)l * W_LAYER;
                switch (k) {
                case 0: j = TrJob{p.in[I_W_IN] + (size_t)l * D * INW, INW, D, 0, 2304, p.in[I_NORM_MIX] + l * D, (bf16_t*)(wl + W_IN), 0, 128, ((INPROJ8_MASK >> l) & 1) ? F8_WGU : 0.f}; break;
                case 1: j = TrJob{p.in[I_W_IN] + (size_t)l * D * INW, INW, D, 2320, 1024, p.in[I_NORM_MIX] + l * D, (bf16_t*)(wl + W_IN), 2304, 128, ((INPROJ8_MASK >> l) & 1) ? F8_WGU : 0.f}; break;
                case 9: j = TrJob{p.in[I_W_IN] + (size_t)l * D * INW, INW, D, 3344, 512, p.in[I_NORM_MIX] + l * D, (bf16_t*)(wl + W_IN), NMAIN, 128, ((MIX8_MASK >> l) & 1) ? F8_WGU : 0.f}; break;
                case 11: j = TrJob{p.in[I_W_IN] + (size_t)l * D * INW, INW, D, 2304, 32, p.in[I_NORM_MIX] + l * D, (bf16_t*)(wl + W_IN), 5376, 128, ((INPROJ8_MASK >> l) & 1) ? F8_WGU : 0.f}; break;
                case 10: j = TrJob{p.in[I_W_IN] + (size_t)l * D * INW, INW, D, 3856, 2048, p.in[I_NORM_MIX] + l * D, (bf16_t*)(wl + W_IN), 3328, 128, ((INPROJ8_MASK >> l) & 1) ? F8_WGU : 0.f}; break;
                case 2: j = TrJob{p.in[I_W_SSD_O] + (size_t)l * D * D, D, D, 0, D, p.in[I_SSD_NORM] + l * D, (bf16_t*)(wl + W_SSDO), 0, 128}; break;
                case 3: j = TrJob{p.in[I_W_SB_O] + (size_t)l * 512 * D, D, 512, 0, D, nullptr, (bf16_t*)(wl + W_SBO), 0, 128}; break;
                case 4: j = TrJob{p.in[I_W_OUT] + (size_t)l * D * D, D, D, 0, D, nullptr, (bf16_t*)(wl + W_OUT), 0, 128, ((MIX8_MASK >> l) & 1) ? F8_WGU : 0.f}; break;
                case 5: j = TrJob{p.in[I_XA_WQ] + (size_t)l * D * 512, 512, D, 0, 512, p.in[I_NORM_XA] + l * D, (bf16_t*)(wl + W_Q), 0, 128, ((MIX8_MASK >> l) & 1) ? F8_WGU : 0.f}; break;
                case 6: j = TrJob{p.in[I_XA_WK] + (size_t)l * D * 512, 512, D, 0, 512, p.in[I_NORM_MEM] + l * D, (bf16_t*)(ws + WS_WKV), l * 512, 128}; break;
                case 7: j = TrJob{p.in[I_XA_WV] + (size_t)l * D * 512, 512, D, 0, 512, p.in[I_NORM_MEM] + l * D, (bf16_t*)(ws + WS_WKV), 2048 + l * 512, 128}; break;
                case 8: j = TrJob{p.in[I_XA_WO] + (size_t)l * 512 * D, D, 512, 0, D, nullptr, (bf16_t*)(wl + W_O), 0, 128}; break;
                }
            } else { const int jj = (jb - 48) / 3, k = (jb - 48) % 3; unsigned char* wf = ws + WS_WFF + (size_t)jj * W_FF; const float* gn = p.in[I_NORM_FFN] + (2 * jj) * D;
                if (k == 0) j = TrJob{p.in[I_FFN_G] + (size_t)jj * D * DFF, DFF, D, 0, DFF, gn, (bf16_t*)(wf + W_GU), 0, 256, ((DENSE_GU8_MASK >> jj) & 1) ? F8_WGU : 0.f};
                else if (k == 1) j = TrJob{p.in[I_FFN_U] + (size_t)jj * D * DFF, DFF, D, 0, DFF, gn, (bf16_t*)(wf + W_GU), 128, 256, ((DENSE_GU8_MASK >> jj) & 1) ? F8_WGU : 0.f};
                else j = TrJob{p.in[I_FFN_D] + (size_t)jj * DFF * D, D, DFF, 0, D, nullptr, (bf16_t*)(wf + W_DN), 0, 128, ((DENSE_DN8_MASK >> jj) & 1) ? F8_WDN : 0.f};
            }
            run_job(S, j, base, gw, NGW, scr, lane);
        }
        tr_finish(S, scr, lane);
        bf16_t* MEMB = WSP(bf16_t, WS_MEMB); float* RSMEM = WSP(float, WS_RSMEM);
        for (int m = gw; m < TM; m += NGW) { const float q = row_to_bf16(p.in[I_MEM] + (size_t)m * D, MEMB + (size_t)m * D, lane); if (lane == 0) RSMEM[m] = __builtin_amdgcn_rsqf(q * (1.f / D) + EPS); }
        { bf16_t* HB = WSP(bf16_t, WS_HB); float* SSQ = WSP(float, WS_SSQ + (size_t)(12) * SSQ_BYTES);
          for (int m = gw; m < T; m += NGW) { const float q = row_to_bf16(p.in[I_X] + (size_t)m * D, HB + (size_t)m * D, lane); if (lane < 4) SSQ[(size_t)m * 4 + lane] = lane == 0 ? q : 0.f; } }
        for (int it = gw; it < 4 * 224; it += NGW) { const int l = it / 224, r = 5408 + it % 224;
            const u32x4 zz = {0u, 0u, 0u, 0u};
            if ((INPROJ8_MASK >> l) & 1) { u32x4* dst = (u32x4*)(WSP(unsigned char, WS_W + (size_t)l * W_LAYER + W_IN) + (size_t)r * 1024); dst[lane] = zz; }
            else { u32x4* dst = (u32x4*)(WSP(bf16_t, WS_W + (size_t)l * W_LAYER + W_IN) + (size_t)r * 1024); dst[lane] = zz; dst[lane + 64] = zz; } }
        GRID_BAR();
        if (use_bar && (G & 7) == 0) {
            if (tid == 0) { unsigned okv = 1u; const unsigned* plc = WSP(unsigned, WS_CTL) + CW_PLC;
                for (int v = 0; v < 8; ++v) okv &= (ld_u32_agent(plc + 64 * v) + ld_u32_agent(plc + 64 * v + 1) == 17u) ? 1u : 0u;
                ldsctl[12] = okv; }
            __syncthreads();
            local_ok = (int)__builtin_amdgcn_readfirstlane(ldsctl[12]);
        }
    }
    if (p.l_lo == 0 && PH(1)) for (int rep = 0; rep < NREP(1); ++rep) {
        PHASE_ENTER();
        { pg8::Gemm g{WSP(bf16_t, WS_MEMB), WSP(bf16_t, WS_WKV), D, D, D}; pg8::StaticOrder S; S.init(TM, 2048, G, bid);
          pg8::EpiBf16Rs E{WSP(bf16_t, WS_KM), 2048, WSP(float, WS_RSMEM), 1.f, 0};
          pg8::gemm_phase<pg8::EpiBf16Rs, pg8::StaticOrder, true, true>(lds, g, S, E, wave0); }
        { pg8::Gemm g{WSP(bf16_t, WS_WKV) + (size_t)2048 * 1024, WSP(bf16_t, WS_MEMB), D, D, D}; pg8::StaticOrder S; S.init(2048, TM, G, (bid + G / 2) % G);
          pg8::EpiBf16Cs E{WSP(bf16_t, WS_VTM), TM, WSP(float, WS_RSMEM), 1.f, 0};
          pg8::gemm_phase<pg8::EpiBf16Cs, pg8::StaticOrder, true, true>(lds, g, S, E, wave0); }
        GRID_BAR();
    }

    for (int l = p.l_lo; l < p.l_hi; ++l) {
        const bool moe = (l & 1) != 0; const int jf = l >> 1;

        if (PH(3)) for (int rep = 0; rep < NREP(3); ++rep) {
            PHASE_ENTER();
            const bool in8 = (INPROJ8_MASK >> l) & 1;
            pg8::Gemm g{in8 ? WSP(bf16_t, WS_X + X_HB8) : WSP(bf16_t, WS_HB), (const bf16_t*)(ws + WS_W + (size_t)l * W_LAYER + W_IN), D, D, D}; pg8::StaticOrder S; S.init(T / 8, NMAIN, RG, rg); S.pm0 = 16 * vg;
            pg8::EpiInProj E{ws + WS_X, WSP(float, WS_SSQ + (size_t)(l == 0 ? 12 : 3 * l - 1) * SSQ_BYTES), WSP(float, WS_RS), WSP(float, WS_DT), p.in[I_DT_BIAS] + l * 16, in8 ? 1.f / F8_WGU : 1.f};
            if (in8) pg8::gemm_phase<pg8::EpiInProj, pg8::StaticOrder, true, true, true>(lds, g, S, E, wave0);
            else pg8::gemm_phase<pg8::EpiInProj, pg8::StaticOrder, true, true, false>(lds, g, S, E, wave0);
            LOCAL_BAR();
        }
        if (PH(4)) for (int rep = 0; rep < NREP(4); ++rep) {
            PHASE_ENTER();
            const float* cw = p.in[I_CONV_W] + (size_t)l * 4 * 1280; const float* cb = p.in[I_CONV_B] + (size_t)l * 1280;
            for (int u = rg * 8 + wave; u < (T / 8 / 64) * 10; u += RG * 8) conv_unit(WSP(bf16_t, WS_X + X_XBC), cw, cb, WSP(bf16_t, WS_X + X_XT), WSP(bf16_t, WS_X + X_BR), WSP(bf16_t, WS_X + X_BT), WSP(bf16_t, WS_X + X_CR), vg * ((T / 8 / 64) * 10) + u, lane);
            { const bool v8 = (MIX8_MASK >> l) & 1;
              pg8::Gemm g{(const bf16_t*)(ws + WS_W + (size_t)l * W_LAYER + W_IN + (size_t)NMAIN * 1024 * (v8 ? 1 : 2)), v8 ? WSP(bf16_t, WS_X + X_HB8) : WSP(bf16_t, WS_HB), D, D, D}; pg8::StaticOrder S; S.init(512, T / 8, RG, rg); S.pn0 = 16 * vg;
              pg8::EpiBf16Cs E{WSP(bf16_t, WS_X + X_V), T, WSP(float, WS_RS), v8 ? 1.f / F8_WGU : 1.f, 512};
              if (v8) pg8::gemm_phase<pg8::EpiBf16Cs, pg8::StaticOrder, true, true, true>(lds, g, S, E, wave0);
              else pg8::gemm_phase<pg8::EpiBf16Cs, pg8::StaticOrder, true, true, false>(lds, g, S, E, wave0); }
            if (moe)
                moe_convert(p, ws, l, jf, l == 1 ? 7 : 4, gw, NGW, (LAS float*)(lds + wave * 16384), lane);
            LOCAL_BAR();
        }
        if (PH(5)) for (int rep = 0; rep < NREP(5); ++rep) {
            PHASE_ENTER();
            const int pvar = (rep + 1 < NREP(5)) ? PROBE_VAR : 0;
            if (!(pvar & 1)) for (int u = rg; u < 32; u += RG) { const int b = 2 * vg + (u >> 4), h = u & 15;
                __syncthreads();
                ssd_scan_block(WSP(bf16_t, WS_X + X_XT), WSP(bf16_t, WS_X + X_BT), WSP(float, WS_DT), WSP(bf16_t, WS_X + X_PREV), -fexp(p.in[I_A_LOG][l * 16 + h]), b, h, wave, lane, (LAS float*)(lds + wave * 1024), (LAS float*)(lds + 8192)); }
            if (!(pvar & 2)) sb_attn_mfma(WSP(bf16_t, WS_X + X_Q), WSP(bf16_t, WS_X + X_K), WSP(bf16_t, WS_X + X_V), (rep + 1 < NREP(5)) ? WSP(bf16_t, WS_X + X_XBC) : WSP(bf16_t, WS_X + X_Q), vg, rg, RG, wave, lane);
            LOCAL_BAR();
        }
        if (PH(6)) for (int rep = 0; rep < NREP(6); ++rep) {
            PHASE_ENTER();
            for (int u = rg; u < 64; u += RG) { const int b = 2 * vg + (u >> 5), c = (u >> 1) & 15, g = u & 1; const int h = g * 8 + wave;
                ssd_out_unit(WSP(bf16_t, WS_X + X_XT), WSP(bf16_t, WS_X + X_BR), WSP(bf16_t, WS_X + X_CR), WSP(float, WS_DT), WSP(bf16_t, WS_X + X_PREV), WSP(bf16_t, WS_X + X_Z), WSP(bf16_t, WS_X + X_XBC),
                             -fexp(p.in[I_A_LOG][l * 16 + h]), p.in[I_D_SKIP][l * 16 + h], b, c, g, wave, lane, (LAS float*)(lds + wave * 2048), (LAS float*)(lds + 16384), (rep + 1 < NREP(6)) ? PROBE_VAR : 0); }
            LOCAL_BAR();
        }
        if (PH(7)) for (int rep = 0; rep < NREP(7); ++rep) {
            PHASE_ENTER();
            pg8::Gemm g{WSP(bf16_t, WS_X + X_XBC), (const bf16_t*)(ws + WS_W + (size_t)l * W_LAYER + W_SSDO), 1280, D, D};   pg8::StaticOrder S; S.init(T / 8, D, RG, rg); S.pm0 = 16 * vg;
            pg8::EpiGate<false> E{WSP(bf16_t, WS_X + X_Z), WSP(bf16_t, WS_X + X_GS), 0, WSP(bf16_t, WS_X + X_Z)};
            pg8::gemm_phase<pg8::EpiGate<false>, pg8::StaticOrder, true, true>(lds, g, S, E, wave0);
            PHASE_DELAY();
        }
        if (PH(8)) for (int rep = 0; rep < NREP(8); ++rep) {
            PHASE_ENTER();
            pg8::Gemm g{WSP(bf16_t, WS_X + X_Q), (const bf16_t*)(ws + WS_W + (size_t)l * W_LAYER + W_SBO), 512, 512, 512}; pg8::StaticOrder S; S.init(T / 8, D, RG, rg); S.pm0 = 16 * vg;
            if ((MIX8_MASK >> l) & 1) {
                pg8::EpiGate<true, true> E{WSP(bf16_t, WS_X + X_Z), WSP(bf16_t, WS_X + X_GS), 1024, WSP(bf16_t, WS_X + X_Z), WSP(unsigned char, WS_X + X_XT)};
                pg8::gemm_phase<pg8::EpiGate<true, true>, pg8::StaticOrder, true, true>(lds, g, S, E, wave0);
            } else {
            pg8::EpiGate<true> E{(rep + 1 < NREP(8)) ? WSP(bf16_t, WS_X + X_XT) : WSP(bf16_t, WS_X + X_Z), WSP(bf16_t, WS_X + X_GS), 1024, WSP(bf16_t, WS_X + X_Z)};
            pg8::gemm_phase<pg8::EpiGate<true>, pg8::StaticOrder, true, true>(lds, g, S, E, wave0); }
            LOCAL_BAR();
        }
        if (PH(9)) for (int rep = 0; rep < NREP(9); ++rep) {
            PHASE_ENTER();
            if ((MIX8_MASK >> l) & 1) {
                pg8::Gemm g{WSP(bf16_t, WS_X + X_XT), (const bf16_t*)(ws + WS_W + (size_t)l * W_LAYER + W_OUT), 2048, D, D}; pg8::StaticOrder S; S.init(T / 8, D, RG, rg); S.pm0 = 16 * vg;
                pg8::EpiResidBfT<true, true> E{WSP(bf16_t, WS_HB), WSP(bf16_t, WS_HB), WSP(float, WS_SSQ + (size_t)(3 * l) * SSQ_BYTES), (LAS float*)(lds + 131072), WSP(unsigned char, WS_X + X_HB8), 1.f / F8_WGU};
                pg8::gemm_phase<pg8::EpiResidBfT<true, true>, pg8::StaticOrder, true, true, true>(lds, g, S, E, wave0);
            } else {
            pg8::Gemm g{WSP(bf16_t, WS_X + X_Z), (const bf16_t*)(ws + WS_W + (size_t)l * W_LAYER + W_OUT), D, D, D}; pg8::StaticOrder S; S.init(T / 8, D, RG, rg); S.pm0 = 16 * vg;
            pg8::EpiResidBf E{WSP(bf16_t, WS_HB), (rep + 1 < NREP(9)) ? WSP(bf16_t, WS_X + X_XT) : WSP(bf16_t, WS_HB), WSP(float, WS_SSQ + (size_t)((rep + 1 < NREP(9)) ? 13 : 3 * l) * SSQ_BYTES), (LAS float*)(lds + 131072)};
            pg8::gemm_phase<pg8::EpiResidBf, pg8::StaticOrder, true, true>(lds, g, S, E, wave0); }
            LOCAL_BAR();
        }
        if (PH(11)) for (int rep = 0; rep < NREP(11); ++rep) {
            PHASE_ENTER();
            const bool q8 = (MIX8_MASK >> l) & 1;
            pg8::Gemm g{q8 ? WSP(bf16_t, WS_X + X_HB8) : WSP(bf16_t, WS_HB), (const bf16_t*)(ws + WS_W + (size_t)l * W_LAYER + W_Q), D, D, D}; pg8::StaticOrder S; S.init(T / 8, 512, RG, rg); S.pm0 = 16 * vg;
            pg8::EpiBf16Rs E{WSP(bf16_t, WS_X + X_K), 512, WSP(float, WS_SSQ + (size_t)(3 * l) * SSQ_BYTES), 0.12751743082459868f * (q8 ? 1.f / F8_WGU : 1.f), 1};
            if (q8) pg8::gemm_phase<pg8::EpiBf16Rs, pg8::StaticOrder, true, true, true>(lds, g, S, E, wave0);
            else pg8::gemm_phase<pg8::EpiBf16Rs, pg8::StaticOrder, true, true, false>(lds, g, S, E, wave0);
            LOCAL_BAR();
        }
        if (PH(12)) for (int rep = 0; rep < NREP(12); ++rep) {
            PHASE_ENTER();
            xattn_lds(WSP(bf16_t, WS_X + X_K), WSP(bf16_t, WS_KM) + l * 512, WSP(bf16_t, WS_VTM) + (size_t)l * 512 * TM, WSP(bf16_t, WS_X + X_V), vg, rg, RG, tid, wave, lane, lds);
            LOCAL_BAR();
        }
        if (PH(13)) for (int rep = 0; rep < NREP(13); ++rep) {
            PHASE_ENTER();
            pg8::Gemm g{WSP(bf16_t, WS_X + X_V), (const bf16_t*)(ws + WS_W + (size_t)l * W_LAYER + W_O), 512, 512, 512}; pg8::StaticOrder S; S.init(T / 8, D, RG, rg); S.pm0 = 16 * vg;
            pg8::EpiResidBfT<true, false> E{WSP(bf16_t, WS_HB), (rep + 1 < NREP(13)) ? WSP(bf16_t, WS_X + X_XT) : WSP(bf16_t, WS_HB), WSP(float, WS_SSQ + (size_t)((rep + 1 < NREP(13)) ? 13 : 3 * l + 1) * SSQ_BYTES), (LAS float*)(lds + 131072),
                                            WSP(unsigned char, WS_X + X_HB8), 1.f};
            pg8::gemm_phase<pg8::EpiResidBfT<true, false>, pg8::StaticOrder, true, true>(lds, g, S, E, wave0);
            if (moe) LOCAL_BAR(); else GRID_BAR();
        }
        if (moe && PH(14)) for (int rep = 0; rep < NREP(14); ++rep) {
            PHASE_ENTER();
            const bf16_t* HB = WSP(bf16_t, WS_HB); float* RS = WSP(float, WS_RS); const float* SSQ = WSP(float, WS_SSQ + (size_t)(3 * l + 1) * SSQ_BYTES);
            int* TE = WSP(int, WS_MOE + MO_TE); float* TW = WSP(float, WS_MOE + MO_TW); int* TP = WSP(int, WS_MOE + MO_TP); unsigned* CNT = WSP(unsigned, WS_CTL) + CW_CNT + jf * 1024;
            LAS float* wsm = (LAS float*)lds;
            LAS unsigned* lcnt = (LAS unsigned*)(lds + 32768); LAS unsigned* lbase = lcnt + 16;
            LAS int* le = (LAS int*)(lds + 32768 + 128); LAS int* lp = le + 256;
#pragma unroll
            for (int q = 0; q < 16; ++q) { const int i = tid + 512 * q; const int e = i >> 10, k = i & 1023; wsm[i] = p.in[I_MOE_R][(size_t)jf * D * NEXP + (size_t)k * NEXP + e] * p.in[I_NORM_FFN][l * D + k]; }
            const int gwl = rg * 8 + wave, NGL = RG * 8, tok0 = vg * (T / 8);
            for (int k0 = 0; gwl + k0 * NGL < T / 8; k0 += 16) {
                __syncthreads();
                if (tid < 16) lcnt[tid] = 0u;
                __syncthreads();
                u32x2 xn[4]; f32x4 qn = {0.f, 0.f, 0.f, 0.f};
                { const int ml0 = gwl + k0 * NGL; const int m0 = tok0 + (ml0 < T / 8 ? ml0 : 0);
#pragma unroll
                  for (int j = 0; j < 4; ++j) xn[j] = ((const u32x2*)(HB + (size_t)m0 * D) + lane)[64 * j];
                  qn = *(const f32x4*)(SSQ + (size_t)m0 * 4); }
                for (int k = 0; k < 16; ++k) { const int ml = gwl + (k0 + k) * NGL; if (ml >= T / 8) break; const int m = tok0 + ml;
                    u32x2 xc[4];
#pragma unroll
                    for (int j = 0; j < 4; ++j) xc[j] = xn[j];
                    float lg[8]; const float r = rstd_of((qn.x + qn.y) + (qn.z + qn.w));
                    { const int mln = gwl + (k0 + k + 1) * NGL; const int mn = tok0 + ((k + 1 < 16 && mln < T / 8) ? mln : ml);
#pragma unroll
                      for (int j = 0; j < 4; ++j) xn[j] = ((const u32x2*)(HB + (size_t)mn * D) + lane)[64 * j];
                      qn = *(const f32x4*)(SSQ + (size_t)mn * 4); }
                    row_dots_raw<8>(xc, lane, wsm, r, lg);
                    if (lane == 0) { RS[m] = r;
                        int i0 = 0; float v0 = lg[0];
#pragma unroll
                        for (int e = 1; e < 8; ++e) if (lg[e] > v0) { v0 = lg[e]; i0 = e; }
                        int i1 = -1; float v1 = -3.0e38f;
#pragma unroll
                        for (int e = 0; e < 8; ++e) if (e != i0 && lg[e] > v1) { v1 = lg[e]; i1 = e; }
                        const float w0 = __builtin_amdgcn_rcpf(1.f + fexp(v1 - v0));
                        const int li = k * 8 + wave;
                        le[li] = i0; le[128 + li] = i1;
                        lp[li] = (int)__hip_atomic_fetch_add(lcnt + i0, 1u, __ATOMIC_RELAXED, __HIP_MEMORY_SCOPE_WORKGROUP);
                        lp[128 + li] = (int)__hip_atomic_fetch_add(lcnt + 8 + i1, 1u, __ATOMIC_RELAXED, __HIP_MEMORY_SCOPE_WORKGROUP);
                        TE[m] = i0; TE[T + m] = i1; TW[m] = w0; TW[T + m] = 1.f - w0; }
                }
                __syncthreads();
                if (tid < 16 && rep + 1 == NREP(14)) lbase[tid] = atomicAdd(CNT + tid * 64, lcnt[tid]);
                __syncthreads();
                if (rep + 1 == NREP(14))
                for (int li = tid; li < 256; li += 512) { const int sl = li >> 7, idx = li & 127, ml = (rg * 8 + (idx & 7)) + (k0 + (idx >> 3)) * NGL;
                    if (ml < T / 8) TP[sl * T + tok0 + ml] = (int)lbase[sl * 8 + le[li]] + lp[li]; }
            }
            GRID_BAR();
        }
        if (!moe) {
            if (PH(15)) for (int rep = 0; rep < NREP(15); ++rep) {
                PHASE_ENTER();
#define DENSE_GU(GU8, DN8) do { pg8::Gemm g{GU8 ? WSP(bf16_t, WS_X + X_HB8) : WSP(bf16_t, WS_HB), (const bf16_t*)(ws + WS_WFF + (size_t)jf * W_FF + W_GU), D, D, D}; pg8::StaticOrder S; S.init(T / 8, 2 * DFF, RG, rg); S.pm0 = 16 * vg; \
                pg8::EpiSwigluT<DN8> E{WSP(bf16_t, WS_X + X_ACT), WSP(float, WS_SSQ + (size_t)(3 * l + 1) * SSQ_BYTES), 1, GU8 ? 1.f / F8_WGU : 1.f}; \
                pg8::gemm_phase<pg8::EpiSwigluT<DN8>, pg8::StaticOrder, true, true, GU8>(lds, g, S, E, wave0); } while (0)
                const bool gu8 = (DENSE_GU8_MASK >> jf) & 1, dn8 = (DENSE_DN8_MASK >> jf) & 1;
                if (gu8 && dn8) DENSE_GU(true, true); else if (gu8) DENSE_GU(true, false); else if (dn8) DENSE_GU(false, true); else DENSE_GU(false, false);
                LOCAL_BAR();
            }
            if (PH(16)) for (int rep = 0; rep < NREP(16); ++rep) {
                PHASE_ENTER();
                pg8::Gemm g{WSP(bf16_t, WS_X + X_ACT), (const bf16_t*)(ws + WS_WFF + (size_t)jf * W_FF + W_DN), DFF, DFF, DFF}; pg8::StaticOrder S; S.init(T / 8, D, RG, rg); S.pm0 = 16 * vg;
                pg8::EpiResidBfT<true, true> E{WSP(bf16_t, WS_HB), (rep + 1 < NREP(16)) ? WSP(bf16_t, WS_X + X_GS) : WSP(bf16_t, WS_HB), WSP(float, WS_SSQ + (size_t)((rep + 1 < NREP(16)) ? 13 : 3 * l + 2) * SSQ_BYTES), (LAS float*)(lds + 131072),
                                               WSP(unsigned char, WS_X + X_HB8), ((DENSE_DN8_MASK >> jf) & 1) ? 1.f / F8_WDN : 1.f};
                if ((DENSE_DN8_MASK >> jf) & 1) pg8::gemm_phase<pg8::EpiResidBfT<true, true>, pg8::StaticOrder, true, true, true>(lds, g, S, E, wave0);
                else pg8::gemm_phase<pg8::EpiResidBfT<true, true>, pg8::StaticOrder, true, true, false>(lds, g, S, E, wave0);
                GRID_BAR();
            }
        } else {
            if (PH(15)) for (int rep = 0; rep < NREP(15); ++rep) {
                PHASE_ENTER();
                const bf16_t* HB = WSP(bf16_t, WS_HB); const float* RS = WSP(float, WS_RS); bf16_t* XG = WSP(bf16_t, WS_X + X_XG);
                const int* TE = WSP(int, WS_MOE + MO_TE); const float* TW = WSP(float, WS_MOE + MO_TW); const int* TP = WSP(int, WS_MOE + MO_TP); unsigned* CNT = WSP(unsigned, WS_CTL) + CW_CNT + jf * 1024;
                int* ROWL = WSP(int, WS_MOE + MO_ROWL); float* WROW = WSP(float, WS_MOE + MO_WROW); float* RSG = WSP(float, WS_MOE + MO_RSG);
                unsigned* PEXP = WSP(unsigned, WS_MOE + MO_PEXP); unsigned* NPAN = WSP(unsigned, WS_MOE + MO_NPAN);
                const unsigned cntv = ld_u32_agent(CNT + (lane & 15) * 64);
#pragma unroll
                for (int s = 0; s < 2; ++s) {
                    int off[9]; { int a = 0;
#pragma unroll
                        for (int e = 0; e < 8; ++e) { off[e] = a; a += ((int)__builtin_amdgcn_readlane(cntv, s * 8 + e) + 255) & ~255; }
                        off[8] = a; }
                    if (bid == 0 && tid == 0) { NPAN[s] = (unsigned)(off[8] >> 8);
#pragma unroll
                        for (int e = 0; e < 8; ++e) for (int pnl = off[e] >> 8; pnl < (off[e + 1] >> 8); ++pnl) PEXP[s * 256 + pnl] = (unsigned)e; }
                    for (int m0 = gw; m0 < T; m0 += 4 * NGW) {
                        int rowq[4]; float twq[4], rsq[4];
#pragma unroll
                        for (int q = 0; q < 4; ++q) { const int m = m0 + q * NGW < T ? m0 + q * NGW : m0; const int e = TE[s * T + m]; int o = 0;
#pragma unroll
                            for (int k = 0; k < 8; ++k) o = (e == k) ? off[k] : o;
                            rowq[q] = o + TP[s * T + m]; twq[q] = TW[s * T + m]; rsq[q] = RS[m]; }
                        u32x4 r0[4], r1[4];
#pragma unroll
                        for (int q = 0; q < 4; ++q) { const int m = m0 + q * NGW < T ? m0 + q * NGW : m0;
                            if (MOE_F8_GU) { r0[q] = ((const u32x4*)(WSP(unsigned char, WS_X + X_HB8) + (size_t)m * D))[lane]; r1[q] = r0[q]; }
                            else { const u32x4* src = (const u32x4*)(HB + (size_t)m * D); r0[q] = src[lane]; r1[q] = src[lane + 64]; } }
#pragma unroll
                        for (int q = 0; q < 4; ++q) { const int m = m0 + q * NGW; if (m < T) { const int row = rowq[q];
                            if (MOE_F8_GU) { u32x4* dst = (u32x4*)((unsigned char*)XG + ((size_t)s * MOE_ROWS + row) * D); dst[lane] = r0[q]; }
                            else { u32x4* dst = (u32x4*)(XG + ((size_t)s * MOE_ROWS + row) * D); dst[lane] = r0[q]; dst[lane + 64] = r1[q]; }
                            if (lane == 0) { ROWL[s * MOE_ROWS + row] = m; WROW[s * MOE_ROWS + row] = twq[q]; RSG[s * MOE_ROWS + row] = rsq[q]; } } } }
#pragma unroll
                    for (int e = 0; e < 8; ++e) { const int c = (int)__builtin_amdgcn_readlane(cntv, s * 8 + e); const int lo = off[e] + c, hi = off[e + 1];
                        for (int row = lo + gw; row < hi; row += NGW) { unsigned z0 = 0u; asm volatile("" : "+v"(z0)); const u32x4 zz = {z0, z0, z0, z0};
                            if (MOE_F8_GU) { u32x4* dst = (u32x4*)((unsigned char*)XG + ((size_t)s * MOE_ROWS + row) * D); dst[lane] = zz; }
                            else { u32x4* dst = (u32x4*)(XG + ((size_t)s * MOE_ROWS + row) * D); dst[lane] = zz; dst[lane + 64] = zz; }
                            if (lane == 0) { ROWL[s * MOE_ROWS + row] = -1; WROW[s * MOE_ROWS + row] = 0.f; RSG[s * MOE_ROWS + row] = 0.f; } } }
                }
                GRID_BAR();
            }
            if (PH(16)) for (int rep = 0; rep < NREP(16); ++rep) {
                PHASE_ENTER();
                const int npan = (int)__builtin_amdgcn_readfirstlane(ld_u32_agent(WSP(unsigned, WS_MOE + MO_NPAN)));
                LAS unsigned* PXL = (LAS unsigned*)(lds + 131072 + 8192); pg8::moe_pexp_to_lds(WSP(unsigned, WS_MOE + MO_PEXP), PXL, tid);
                pg8::Gemm g{WSP(bf16_t, WS_X + X_XG), WSP(bf16_t, WS_WMOE + WM_GU), D, D, D}; pg8::MoeOrder S; S.init(npan, 2 * DFF / 256, G, bid, PXL);
                pg8::EpiSwigluT<(bool)MOE_F8_DN> E{WSP(bf16_t, WS_X + X_ACT), WSP(float, WS_MOE + MO_RSG), 0, MOE_F8_GU ? 1.f / F8_WGU : 1.f};
                pg8::gemm_phase<pg8::EpiSwigluT<(bool)MOE_F8_DN>, pg8::MoeOrder, true, true, (bool)MOE_F8_GU>(lds, g, S, E, wave0);
                {
                  const int n0 = npan * (2 * DFF / 256), f0 = n0 % G;
                  const int npan1 = (int)__builtin_amdgcn_readfirstlane(ld_u32_agent(WSP(unsigned, WS_MOE + MO_NPAN) + 1));
                  pg8::Gemm g1{(const bf16_t*)(ws + WS_X + X_XG + (size_t)MOE_ROWS * D * (MOE_F8_GU ? 1 : 2)), WSP(bf16_t, WS_WMOE + WM_GU), D, D, D};
                  pg8::MoeOrder S1; S1.init(npan1, 2 * DFF / 256, 1 << 28, (f0 > 0 && bid >= f0) ? bid - f0 : (1 << 28), PXL + 256);
                  pg8::EpiSwigluT<(bool)MOE_F8_DN> E1{WSP(bf16_t, WS_X + X_ACT2), WSP(float, WS_MOE + MO_RSG) + MOE_ROWS, 0, MOE_F8_GU ? 1.f / F8_WGU : 1.f};
                  pg8::gemm_phase<pg8::EpiSwigluT<(bool)MOE_F8_DN>, pg8::MoeOrder, true, true, (bool)MOE_F8_GU>(lds, g1, S1, E1, wave0); }
                GRID_BAR();
            }
            if (PH(17)) {
                PHASE_ENTER();
                LAS unsigned* PXL = (LAS unsigned*)(lds + 131072 + 8192); pg8::moe_pexp_to_lds(WSP(unsigned, WS_MOE + MO_PEXP), PXL, tid);
                { const int npan = (int)__builtin_amdgcn_readfirstlane(ld_u32_agent(WSP(unsigned, WS_MOE + MO_NPAN)));
                  pg8::Gemm g{WSP(bf16_t, WS_X + X_ACT), WSP(bf16_t, WS_WMOE + WM_DN), DFF, DFF, DFF}; pg8::MoeOrder S; S.init(npan, D / 256, G, bid, PXL);
                  pg8::EpiMoeDown E{WSP(bf16_t, WS_HB), WSP(int, WS_MOE + MO_ROWL), WSP(float, WS_MOE + MO_WROW), WSP(bf16_t, WS_HB), nullptr, (LAS float*)(lds + 131072), MOE_F8_DN ? 1.f / F8_WDN : 1.f};
                  pg8::gemm_phase<pg8::EpiMoeDown, pg8::MoeOrder, true, true, (bool)MOE_F8_DN>(lds, g, S, E, wave0); }
                { const int npan = (int)__builtin_amdgcn_readfirstlane(ld_u32_agent(WSP(unsigned, WS_MOE + MO_NPAN) + 1));
                  pg8::Gemm g{(const bf16_t*)(ws + WS_X + X_XG + (size_t)MOE_ROWS * D * (MOE_F8_GU ? 1 : 2)), WSP(bf16_t, WS_WMOE + WM_GU), D, D, D}; pg8::MoeOrder S; S.init(npan, 2 * DFF / 256, G, bid, PXL + 256);
                  {
                    const int npan0 = (int)__builtin_amdgcn_readfirstlane(ld_u32_agent(WSP(unsigned, WS_MOE + MO_NPAN)));
                    const int n0 = npan0 * (2 * DFF / 256), f0 = n0 % G, n1 = npan * (2 * DFF / 256); int F = f0 > 0 ? G - f0 : 0; F = F < n1 ? F : n1;
                    const int h9 = (npan0 * (D / 256)) % G, heavy = bid < h9;
                    S.ne = heavy ? 0 : 2; S.stride0 = G - h9; S.c0 = bid - h9; S.base0 = F; S.base1 = (long)F + 2 * (G - h9); S.c = heavy ? G - h9 + bid : bid - h9; }
                  pg8::EpiSwigluT<(bool)MOE_F8_DN> E{WSP(bf16_t, WS_X + X_ACT2), WSP(float, WS_MOE + MO_RSG) + MOE_ROWS, 0, MOE_F8_GU ? 1.f / F8_WGU : 1.f};
                  pg8::gemm_phase<pg8::EpiSwigluT<(bool)MOE_F8_DN>, pg8::MoeOrder, true, true, (bool)MOE_F8_GU>(lds, g, S, E, wave0); }
                GRID_BAR();
            }
            if (PH(19)) for (int rep = 0; rep < NREP(19); ++rep) {
                PHASE_ENTER();
                LAS unsigned* PXL = (LAS unsigned*)(lds + 131072 + 8192); pg8::moe_pexp_to_lds(WSP(unsigned, WS_MOE + MO_PEXP), PXL, tid);
                const int npan = (int)__builtin_amdgcn_readfirstlane(ld_u32_agent(WSP(unsigned, WS_MOE + MO_NPAN) + 1));
                pg8::Gemm g{WSP(bf16_t, WS_X + X_ACT2), WSP(bf16_t, WS_WMOE + WM_DN), DFF, DFF, DFF}; pg8::MoeOrder S; S.init(npan, D / 256, G, bid, PXL + 256);
                pg8::EpiMoeDown E{WSP(bf16_t, WS_HB), WSP(int, WS_MOE + MO_ROWL) + MOE_ROWS, WSP(float, WS_MOE + MO_WROW) + MOE_ROWS, (rep + 1 < NREP(19)) ? WSP(bf16_t, WS_X + X_GS) : WSP(bf16_t, WS_HB),
                                  WSP(float, WS_SSQ + (size_t)((rep + 1 < NREP(19)) ? 13 : 3 * l + 2) * SSQ_BYTES), (LAS float*)(lds + 131072), MOE_F8_DN ? 1.f / F8_WDN : 1.f, WSP(unsigned char, WS_X + X_HB8)};
                pg8::gemm_phase<pg8::EpiMoeDown, pg8::MoeOrder, true, true, (bool)MOE_F8_DN>(lds, g, S, E, wave0);
                if (l + 2 < DEPTH && rep + 1 == NREP(19)) {
                    const int nx = npan * (D / 256) - 2 * G > 0 ? npan * (D / 256) - 2 * G : 0;
                    if (bid >= nx) moe_convert(p, ws, l + 2, jf + 1, 3, (bid - nx) * 8 + wave, (G - nx) * 8, (LAS float*)(lds + wave * 16384), lane);
                }
                GRID_BAR();
            }
        }
    }
    if (p.l_hi == DEPTH && PH(20)) {
        PHASE_ENTER();
        const float* gf = p.in[I_FINAL]; float* O = p.out; const bf16_t* HB = WSP(bf16_t, WS_HB); const float* SSQ = WSP(float, WS_SSQ + (size_t)(3 * DEPTH - 1) * SSQ_BYTES);
        for (int m = gw; m < T; m += NGW) { const float rstd = rstd4(SSQ + (size_t)m * 4); const u32x2* xr = (const u32x2*)(HB + (size_t)m * D) + lane; f32x4* orow = (f32x4*)(O + (size_t)m * D) + lane;
#pragma unroll
            for (int j = 0; j < 4; ++j) { const u32x2 w = xr[64 * j]; const f32x4 g4 = *((const f32x4*)gf + lane + 64 * j); orow[64 * j] = (f32x4){bflo(w.x), bfhi(w.x), bflo(w.y), bfhi(w.y)} * rstd * g4; } }
        PHASE_DELAY();
    }
#undef PH
#undef GRID_BAR
}

extern "C" void kernel_launch(void* const* d_in, const int* in_sizes, int n_in, void* d_out, int out_size, void* d_ws, size_t ws_size, hipStream_t stream) {
    static int grid = 0;
    if (grid == 0) {
        if (n_in != 28 || out_size != T * D || ws_size < WS_END) { fprintf(stderr, "kernel_launch: unexpected problem (n_in %d, out %d, ws %zu < %zu)\n", n_in, out_size, ws_size, (size_t)WS_END); grid = -1; return; }
        int dev = 0, cus = 0;
        if (hipGetDevice(&dev) != hipSuccess || hipDeviceGetAttribute(&cus, hipDeviceAttributeMultiprocessorCount, dev) != hipSuccess) { grid = -1; return; }
        if (hipFuncSetAttribute((const void*)mk_fwd, hipFuncAttributeMaxDynamicSharedMemorySize, LDS_BYTES) != hipSuccess) { fprintf(stderr, "kernel_launch: hipFuncSetAttribute failed\n"); grid = -1; return; }
        int per_cu = 0;
        if (hipOccupancyMaxActiveBlocksPerMultiprocessor(&per_cu, (const void*)mk_fwd, 512, LDS_BYTES) != hipSuccess || per_cu < 1) { fprintf(stderr, "kernel_launch: occupancy query says %d\n", per_cu); (void)hipGetLastError(); }
        grid = cus;
    }
    if (grid < 0) return;
    (void)hipMemsetAsync((char*)d_ws + WS_CTL, 0, 1 * MiB, stream);
    Params p{};
    for (int i = 0; i < 28; ++i) p.in[i] = (const float*)d_in[i];
    p.out = (float*)d_out; p.ws = (unsigned char*)d_ws;
#if MK_ONE_LAUNCH
    p.l_lo = 0; p.l_hi = DEPTH; p.ph_lo = 0; p.ph_hi = 21;
    hipLaunchKernelGGL(mk_fwd, dim3(grid), dim3(512), LDS_BYTES, stream, p);
#else
    auto launch = [&](int l, int ph) { p.l_lo = l; p.l_hi = l + 1; p.ph_lo = ph; p.ph_hi = ph + 1; hipLaunchKernelGGL(mk_fwd, dim3(grid), dim3(512), LDS_BYTES, stream, p); };
    launch(0, 0); launch(0, 1);
    for (int l = 0; l < DEPTH; ++l) { const int last = (l & 1) ? 19 : 16; for (int ph = 2; ph <= last; ++ph) launch(l, ph); }
    launch(DEPTH - 1, 20);
#endif
}
```

```cpp
#include <hip/hip_runtime.h>
#include <cstdio>
#include <cstdint>

#define LAS __attribute__((address_space(3)))
#define GAS __attribute__((address_space(1)))
typedef unsigned short bf16_t;
typedef short bf16x8 __attribute__((ext_vector_type(8)));
typedef float f32x4 __attribute__((ext_vector_type(4)));
typedef float f32x2 __attribute__((ext_vector_type(2)));
typedef unsigned u32x4 __attribute__((ext_vector_type(4)));
typedef unsigned u32x2 __attribute__((ext_vector_type(2)));

#ifndef PROBE_MASK
#define PROBE_MASK 0u
#endif
#define NREP(k) ((int)((PROBE_MASK >> (k)) & 1u) + 1)
#ifndef DELAY_MASK
#define DELAY_MASK 0u
#endif
#ifndef PROBE_VAR
#define PROBE_VAR 0
#endif
#ifndef MK_ONE_LAUNCH
#define MK_ONE_LAUNCH 1
#define DENSE_GU8_MASK 2
#define DENSE_DN8_MASK 2
#define INPROJ8_MASK 12
#define MIX8_MASK 0
static_assert((MIX8_MASK & ~INPROJ8_MASK) == 0, "fp8 v rows live in the fp8 layout of W_IN");
#define MOE_F8_GU 1
#define MOE_F8_DN 1
#endif

constexpr int T = 32768, D = 1024, SEQ = 2048, NBATCH = 16, DEPTH = 4, MEMLEN = 256, TM = NBATCH * MEMLEN;
constexpr int INW = 5904, NPROJ = 6144, NMAIN = 5632, DFF = 2816, NEXP = 8;
constexpr int MOE_ROWS = T + NEXP * 256;
constexpr int MOE_PAN = MOE_ROWS / 256;
constexpr float EPS = 1e-6f;

constexpr size_t MiB = 1u << 20;
constexpr size_t WS_CTL = 0;
constexpr size_t WS_RS = 1 * MiB;
constexpr size_t WS_RSMEM = WS_RS + 256 * 1024;
constexpr size_t WS_DT = 2 * MiB;
constexpr size_t WS_MOE = 4 * MiB;
constexpr size_t WS_SSQ_OLD_UNUSED = 6 * MiB;
constexpr size_t SSQ_BYTES = (size_t)T * 16;
constexpr size_t WS_KM = 8 * MiB;
constexpr size_t WS_VTM = 24 * MiB;
constexpr size_t WS_MEMB = 40 * MiB;
constexpr size_t WS_HB = 48 * MiB;
constexpr size_t WS_W = 112 * MiB;
constexpr size_t W_IN = 0, W_SSDO = W_IN + (size_t)NPROJ * 1024 * 2, W_SBO = W_SSDO + 2 * MiB, W_OUT = W_SBO + 1 * MiB, W_Q = W_OUT + 2 * MiB, W_O = W_Q + 1 * MiB, W_LAYER = W_O + 1 * MiB;
constexpr size_t WS_WKV = WS_W + 4 * W_LAYER;
constexpr size_t WS_WFF = WS_WKV + 8 * MiB;
constexpr size_t W_GU = 0, W_DN = (size_t)2 * DFF * 1024 * 2, W_FF = W_DN + (size_t)1024 * DFF * 2;
constexpr size_t WS_WMOE = WS_WFF + 2 * W_FF;
constexpr size_t WM_GU = 0, WM_DN = (size_t)NEXP * 2 * DFF * 1024 * 2;
constexpr size_t WS_X = WS_WMOE + NEXP * W_FF;
constexpr size_t X_Z = 0, X_XBC = X_Z + 64 * MiB, X_XT = X_XBC + 80 * MiB, X_BR = X_XT + 64 * MiB, X_BT = X_BR + 8 * MiB, X_CR = X_BT + 8 * MiB, X_Q = X_CR + 8 * MiB, X_K = X_Q + 32 * MiB, X_V = X_K + 32 * MiB,
                 X_GS = X_V + 32 * MiB, X_PREV = X_GS + 128 * MiB, X_END = 512 * MiB;
constexpr size_t X_HB8 = 456 * MiB;
static_assert(X_HB8 == X_PREV, "HB8 overlays PREV");
constexpr float F8_WGU = 32.f, F8_WDN = 64.f;
constexpr size_t X_ACT = 0;
constexpr size_t X_ACT2 = 188 * MiB;
constexpr size_t X_XG = 376 * MiB;
constexpr size_t WS_SSQ = WS_X + X_END;
constexpr size_t WS_END = WS_SSQ + 8 * MiB;
static_assert(X_XG + (size_t)2 * MOE_ROWS * 1024 * 2 <= X_END, "moe region");
static_assert((size_t)MOE_ROWS * DFF * 2 <= X_ACT2 && X_ACT2 + (size_t)MOE_ROWS * DFF * 2 <= X_XG && X_PREV + 32 * MiB <= X_END, "act regions");
constexpr size_t MO_TE = 0, MO_TW = MO_TE + 2 * T * 4, MO_TP = MO_TW + 2 * T * 4, MO_ROWL = MO_TP + 2 * T * 4, MO_WROW = MO_ROWL + 2 * MOE_ROWS * 4, MO_RSG = MO_WROW + 2 * MOE_ROWS * 4,
                 MO_PEXP = MO_RSG + 2 * MOE_ROWS * 4, MO_NPAN = MO_PEXP + 2 * 256 * 4, MO_END = MO_NPAN + 256;
static_assert(MO_END <= 2 * MiB, "moe tables");
constexpr int CW_BAR = 4096;
constexpr int CW_LBAR = 24576;
constexpr int CW_PLC = 28672;
constexpr int CW_CNT = 16384;

constexpr int RING_BYTES = 155648;
constexpr int LDSCTL_OFF = RING_BYTES;
constexpr int LDS_BYTES = 160 * 1024;

__device__ __forceinline__ float bf2f(unsigned b) { return __builtin_bit_cast(float, b << 16); }
__device__ __forceinline__ float bflo(unsigned w) { return __builtin_bit_cast(float, w << 16); }
__device__ __forceinline__ float bfhi(unsigned w) { return __builtin_bit_cast(float, w & 0xffff0000u); }
__device__ __forceinline__ unsigned cvt_pk_bf16(float lo, float hi) { unsigned r; asm volatile("v_cvt_pk_bf16_f32 %0, %1, %2" : "=v"(r) : "v"(lo), "v"(hi)); return r; }
__device__ __forceinline__ unsigned short f2bf(float f) { return (unsigned short)(cvt_pk_bf16(f, 0.f) & 0xffffu); }
__device__ __forceinline__ unsigned cvt_pk_fp8(float a, float b, float c, float d) { int w = __builtin_amdgcn_cvt_pk_fp8_f32(a, b, 0, false); w = __builtin_amdgcn_cvt_pk_fp8_f32(c, d, w, true); return (unsigned)w; }
__device__ __forceinline__ float wave_sum(float v) {
#pragma unroll
    for (int o = 1; o < 64; o <<= 1) v += __shfl_xor(v, o);
    return v;
}
__device__ __forceinline__ float wave_max(float v) {
#pragma unroll
    for (int o = 1; o < 64; o <<= 1) v = fmaxf(v, __shfl_xor(v, o));
    return v;
}
__device__ __forceinline__ float fexp(float x) { return __builtin_amdgcn_exp2f(1.4426950408889634f * x); }
__device__ __forceinline__ float softplusf_(float x) { return fmaxf(x, 0.f) + 0.6931471805599453f * __builtin_amdgcn_logf(1.f + __builtin_amdgcn_exp2f(-1.4426950408889634f * fabsf(x))); }
__device__ __forceinline__ float sigmoidf_(float x) { return __builtin_amdgcn_rcpf(1.f + __builtin_amdgcn_exp2f(-1.4426950408889634f * x)); }
__device__ __forceinline__ unsigned ld_u32_agent(const unsigned* p) { return __hip_atomic_load(p, __ATOMIC_RELAXED, __HIP_MEMORY_SCOPE_AGENT); }
__device__ __forceinline__ float ld_f32_agent(const float* p) { return __builtin_bit_cast(float, __hip_atomic_load((const unsigned*)p, __ATOMIC_RELAXED, __HIP_MEMORY_SCOPE_AGENT)); }
__device__ __forceinline__ float rstd_of(float sumsq) { return __builtin_amdgcn_rsqf(sumsq * (1.f / 1024.f) + 1e-6f); }
__device__ __forceinline__ void rstd4x8(const float* base, int stride_rows  , float (&rr)[8], float mul) {
    f32x4 q[8];
#pragma unroll
    for (int gI = 0; gI < 8; ++gI) q[gI] = *(const f32x4*)(base + (size_t)((gI >> 2) * stride_rows + (gI & 3) * 16) * 4);
    asm volatile("" ::: "memory");
#pragma unroll
    for (int gI = 0; gI < 8; ++gI) rr[gI] = __builtin_amdgcn_rsqf(((q[gI].x + q[gI].y) + (q[gI].z + q[gI].w)) * (1.f / 1024.f) + 1e-6f) * mul;
}
__device__ __forceinline__ float rstd4(const float* q4) { const f32x4 q = *(const f32x4*)q4; return rstd_of((q.x + q.y) + (q.z + q.w)); }
#define LDS_WAIT() asm volatile("s_waitcnt lgkmcnt(0)" ::: "memory")
__device__ __forceinline__ int lane_id_opaque() { int l; asm volatile("v_mbcnt_lo_u32_b32 %0, -1, 0\n\tv_mbcnt_hi_u32_b32 %0, -1, %0" : "=v"(l)); return l; }

namespace pg8 {
constexpr int BM = 256, BK = 64, HALF = 128, HTB = HALF * BK * 2, STAGE_BYTES = 8 * HTB, NXCD = 8, WGM = 8;
__host__ __device__ __forceinline__ int lds_byte(int r, int c) { const int st = (r >> 4) * 2 + (c >> 5), rr = r & 15, cc = c & 31, ob = rr * 64 + cc * 2; return st * 1024 + (ob ^ (((ob >> 9) & 1) << 5)); }
__host__ __device__ __forceinline__ void stage_rc(int b, int& R, int& C) { const unsigned ub = (unsigned)b, st = ub >> 10, sb = ub & 1023u, swz = sb ^ (((sb >> 9) & 1u) << 5); R = (int)((st >> 1) * 16u + (swz >> 6)); C = (int)((st & 1u) * 32u + ((swz & 63u) >> 1)); }
__host__ __device__ __forceinline__ int perm32(int rho) { const int n = rho >> 4, i = rho & 15; return 8 * (i >> 2) + 4 * n + (i & 3); }

struct Unit { int pm, pn, pb; };
struct Gemm { const bf16_t* A; const bf16_t* Bt; int lda, ldb, K; };

struct StaticOrder {
    int nM, nN, nwg, G, c; int pm0 = 0, pn0 = 0;
    __device__ void init(int M, int N, int G_, int c_) { nM = M / BM; nN = N / BM; nwg = nM * nN; G = G_; c = c_; }
    __device__ bool next(int i, Unit& u) const {
        const long L = (long)i * G + c; if (L >= nwg) return false;
        int wgid = (int)L; { const int q = nwg / NXCD, r = nwg % NXCD, xcd = wgid % NXCD, off = wgid / NXCD; wgid = (xcd < r ? xcd * (q + 1) : r * (q + 1) + (xcd - r) * q) + off; }
        const int nig = WGM * nN, gid = wgid / nig, fm = gid * WGM, gsz = (nM - fm) < WGM ? (nM - fm) : WGM;
        u.pm = fm + ((wgid % nig) % gsz) + pm0; u.pn = (wgid % nig) / gsz + pn0; u.pb = u.pn; return true;
    }
};
struct MoeOrder {
    int nM, nN, nwg, G, c; const LAS unsigned* pexp; int ne = 0, stride0 = 0, c0 = 0; long base0 = 0, base1 = 0;
    __device__ void init(int nM_, int nN_, int G_, int c_, const LAS unsigned* pexp_) { nM = nM_; nN = nN_; nwg = nM * nN; G = G_; c = c_; pexp = pexp_; }
    __device__ bool next(int i, Unit& u) const {
        const long L = i < ne ? base0 + (long)i * stride0 + c0 : base1 + (long)(i - ne) * G + c; if (L >= nwg) return false;
        int wgid = (int)L; { const int q = nwg / NXCD, r = nwg % NXCD, xcd = wgid % NXCD, off = wgid / NXCD; wgid = (xcd < r ? xcd * (q + 1) : r * (q + 1) + (xcd - r) * q) + off; }
        const int nig = WGM * nN, gid = wgid / nig, fm = gid * WGM, gsz = (nM - fm) < WGM ? (nM - fm) : WGM;
        u.pm = fm + ((wgid % nig) % gsz); u.pn = (wgid % nig) / gsz;
        const int e = (int)__builtin_amdgcn_readfirstlane(pexp[u.pm]); u.pb = e * nN + u.pn; return true;
    }
};

__device__ __forceinline__ void moe_pexp_to_lds(const unsigned* pexp_g, LAS unsigned* dst, int tid) {
    dst[tid] = ld_u32_agent(pexp_g + tid);
    __syncthreads();
}
typedef int i32x8 __attribute__((ext_vector_type(8)));
typedef int i32x4 __attribute__((ext_vector_type(4)));
template <class Epi, class Sched, bool ALIGN_EPI = false, bool SP2 = false, bool FP8 = false>
__device__ __forceinline__ void gemm_phase(LAS unsigned char* lds, const Gemm g, const Sched& S, const Epi& E, const int wave0) {
    int tid_ = wave0 * 64 + lane_id_opaque();
    const int tid = tid_, wid = __builtin_amdgcn_readfirstlane(tid >> 6), lane = tid & 63, wr = wid >> 2, wc = wid & 3, fr = lane & 15, fq = lane >> 4;
    constexpr int ESZ = FP8 ? 1 : 2;
    const int K = g.K, nt = K / (FP8 ? 2 * BK : BK);
    unsigned voffA[2], voffB[2];
    { int R, C; stage_rc(tid * 16, R, C); const int Rb = Epi::PERM ? ((R & ~31) + perm32(R & 31)) : R;
      voffA[0] = (unsigned)(R * g.lda) * ESZ + (unsigned)C * 2u; voffB[0] = (unsigned)(Rb * g.ldb) * ESZ + (unsigned)C * 2u; voffA[1] = voffA[0] + (unsigned)(64 * g.lda) * ESZ; voffB[1] = voffB[0] + (unsigned)(64 * g.ldb) * ESZ; }
    const size_t kstep = (size_t)(BK * 2);
    const size_t hsA = (size_t)HALF * g.lda * ESZ, hsB = (size_t)HALF * g.ldb * ESZ;
    const size_t tsA = 2 * hsA, tsB = 2 * hsB;
    const unsigned ldsw = (unsigned)wid * 1024u;
    const int swz_ = (fr * 64 + fq * 16) ^ ((fr & 8) << 2);
    const int aoff = wr * 8192 + swz_, boff = wc * 4096 + swz_;
    int sc1 = 0x7F7F7F7F; asm volatile("" : "+v"(sc1)); (void)sc1;
    constexpr int KD = 1024;
#define PG8_SA(b, h) (((b) * 2 + (h)) * HTB)
#define PG8_SB(b, h) ((4 + (b) * 2 + (h)) * HTB)
#define PG8_STAGE(bufoff, gbase, voff) do { _Pragma("unroll") for (int _i = 0; _i < 2; ++_i) \
        __builtin_amdgcn_global_load_lds((const unsigned*)((const char*)(gbase) + (voff)[_i]), (LAS unsigned*)(lds + (bufoff) + ldsw + _i * 8192), 16, 0, 0); } while (0)
#define PG8_LDA(dst, b, h) do { _Pragma("unroll") for (int m = 0; m < 4; ++m) _Pragma("unroll") for (int k = 0; k < 2; ++k) dst[m][k] = *(const LAS bf16x8*)(lds + PG8_SA(b, h) + aoff + m * 2048 + k * KD); } while (0)
#define PG8_LDB(dst, b, h) do { _Pragma("unroll") for (int n = 0; n < 2; ++n) _Pragma("unroll") for (int k = 0; k < 2; ++k) dst[n][k] = *(const LAS bf16x8*)(lds + PG8_SB(b, h) + boff + n * 2048 + k * KD); } while (0)
#define PG8_CAT8(x) __builtin_shufflevector(__builtin_bit_cast(i32x4, (x)[0]), __builtin_bit_cast(i32x4, (x)[1]), 0, 1, 2, 3, 4, 5, 6, 7)
#define PG8_MMA(ai, bj, At, Bt) do { __builtin_amdgcn_s_setprio(1); _Pragma("unroll") for (int m = 0; m < 4; ++m) _Pragma("unroll") for (int n = 0; n < 2; ++n) { \
        if constexpr (FP8) asm volatile("v_mfma_scale_f32_16x16x128_f8f6f4 %0, %1, %2, %0, %3, %3 op_sel_hi:[0,0,0]" : "+v"(acc[ai][bj][m][n]) : "v"(PG8_CAT8(Bt[n])), "v"(PG8_CAT8(At[m])), "v"(sc1)); \
        else { _Pragma("unroll") for (int k = 0; k < 2; ++k) acc[ai][bj][m][n] = __builtin_amdgcn_mfma_f32_16x16x32_bf16(Bt[n][k], At[m][k], acc[ai][bj][m][n], 0, 0, 0); } } __builtin_amdgcn_s_setprio(0); } while (0)
#define PG8_WAIT_V(n) asm volatile("s_waitcnt vmcnt(" #n ")" ::: "memory")
#define PG8_WAIT_L(n) asm volatile("s_waitcnt lgkmcnt(" #n ")" ::: "memory")
#define PG8_BAR __builtin_amdgcn_s_barrier()
#define PG8_SCHED __builtin_amdgcn_sched_barrier(0)
    Unit cur, nxt; int ui = 0;
    if (!S.next(0, cur)) return;
    f32x4 acc[2][2][4][2];
#pragma unroll
    for (int a = 0; a < 2; ++a)
#pragma unroll
        for (int b = 0; b < 2; ++b)
#pragma unroll
            for (int m = 0; m < 4; ++m)
#pragma unroll
                for (int n = 0; n < 2; ++n) acc[a][b][m][n] = (f32x4){0.f, 0.f, 0.f, 0.f};
    bf16x8 At[4][2], B0[2][2], B1[2][2];
    const char* cA = (const char*)g.A + (size_t)cur.pm * tsA; const char* cB = (const char*)g.Bt + (size_t)cur.pb * tsB;
    if constexpr (SP2) {
        PG8_STAGE(PG8_SB(0, 0), cB, voffB); PG8_STAGE(PG8_SB(0, 1), cB + hsB, voffB); PG8_STAGE(PG8_SA(0, 0), cA, voffA); PG8_STAGE(PG8_SA(0, 1), cA + hsA, voffA);
        if (wr == 1) PG8_BAR;
        PG8_WAIT_V(2); PG8_BAR;
        PG8_STAGE(PG8_SB(1, 0), cB + kstep, voffB); PG8_STAGE(PG8_SA(1, 0), cA + kstep, voffA); PG8_STAGE(PG8_SB(1, 1), cB + hsB + kstep, voffB);
        PG8_WAIT_V(6); PG8_BAR;
    } else {
        PG8_STAGE(PG8_SB(0, 0), cB, voffB); PG8_STAGE(PG8_SA(0, 0), cA, voffA); PG8_STAGE(PG8_SB(0, 1), cB + hsB, voffB); PG8_STAGE(PG8_SA(0, 1), cA + hsA, voffA);
        if (wr == 1) PG8_BAR;
        PG8_WAIT_V(4); PG8_BAR;
        PG8_STAGE(PG8_SB(1, 0), cB + kstep, voffB); PG8_STAGE(PG8_SA(1, 0), cA + kstep, voffA); PG8_STAGE(PG8_SB(1, 1), cB + hsB + kstep, voffB);
        PG8_WAIT_V(6); PG8_BAR;
    }
    for (;;) {
        const bool has_next = S.next(ui + 1, nxt);
        const char* nA = has_next ? (const char*)g.A + (size_t)nxt.pm * tsA : cA; const char* nB = has_next ? (const char*)g.Bt + (size_t)nxt.pb * tsB : cB;
#pragma nounroll
        for (int t = 0; t < nt; t += 2) {
            const bool last = (t == nt - 2);
            const char* a1 = cA + (size_t)(t + 1) * kstep;
            const char* a2 = last ? nA : cA + (size_t)(t + 2) * kstep; const char* b2 = last ? nB : cB + (size_t)(t + 2) * kstep;
            const char* a3 = a2 + kstep; const char* b3 = b2 + kstep;
            if constexpr (SP2) {
            PG8_LDB(B0, 0, 0); PG8_LDB(B1, 0, 1); PG8_SCHED; PG8_LDA(At, 0, 0); PG8_STAGE(PG8_SA(1, 1), a1 + hsA, voffA);
            PG8_WAIT_V(8); PG8_WAIT_L(0); PG8_BAR; PG8_MMA(0, 0, At, B0); PG8_MMA(0, 1, At, B1); PG8_BAR; PG8_SCHED;
            PG8_LDA(At, 0, 1); PG8_STAGE(PG8_SB(0, 0), b2, voffB); PG8_STAGE(PG8_SB(0, 1), b2 + hsB, voffB); PG8_STAGE(PG8_SA(0, 0), a2, voffA);
            PG8_WAIT_V(8); PG8_WAIT_L(0); PG8_BAR; PG8_MMA(1, 0, At, B0); PG8_MMA(1, 1, At, B1); PG8_BAR; PG8_SCHED;
            PG8_LDB(B0, 1, 0); PG8_LDB(B1, 1, 1); PG8_SCHED; PG8_LDA(At, 1, 0); PG8_STAGE(PG8_SA(0, 1), a2 + hsA, voffA);
            PG8_WAIT_V(8); PG8_WAIT_L(0); PG8_BAR; PG8_MMA(0, 0, At, B0); PG8_MMA(0, 1, At, B1); PG8_BAR; PG8_SCHED;
            PG8_LDA(At, 1, 1); PG8_STAGE(PG8_SB(1, 0), b3, voffB); PG8_STAGE(PG8_SB(1, 1), b3 + hsB, voffB); PG8_STAGE(PG8_SA(1, 0), a3, voffA);
            PG8_WAIT_V(8); PG8_WAIT_L(0); PG8_BAR; PG8_MMA(1, 0, At, B0); PG8_MMA(1, 1, At, B1); PG8_BAR; PG8_SCHED;
            } else {
            PG8_LDB(B0, 0, 0); PG8_SCHED; PG8_LDA(At, 0, 0); PG8_STAGE(PG8_SA(1, 1), a1 + hsA, voffA);
            PG8_WAIT_L(8); PG8_BAR; PG8_WAIT_L(0); PG8_MMA(0, 0, At, B0); PG8_BAR; PG8_SCHED;
            PG8_LDB(B1, 0, 1); PG8_STAGE(PG8_SB(0, 0), b2, voffB);
            PG8_BAR; PG8_WAIT_L(0); PG8_MMA(0, 1, At, B1); PG8_BAR;
            PG8_LDA(At, 0, 1); PG8_STAGE(PG8_SA(0, 0), a2, voffA);
            PG8_BAR; PG8_WAIT_L(0); PG8_MMA(1, 0, At, B0); PG8_BAR; PG8_SCHED;
            PG8_STAGE(PG8_SB(0, 1), b2 + hsB, voffB);
            PG8_WAIT_V(6); PG8_BAR; PG8_MMA(1, 1, At, B1); PG8_BAR;
            PG8_LDB(B0, 1, 0); PG8_SCHED; PG8_LDA(At, 1, 0); PG8_STAGE(PG8_SA(0, 1), a2 + hsA, voffA);
            PG8_WAIT_L(8); PG8_BAR; PG8_WAIT_L(0); PG8_MMA(0, 0, At, B0); PG8_BAR; PG8_SCHED;
            PG8_LDB(B1, 1, 1); PG8_STAGE(PG8_SB(1, 0), b3, voffB);
            PG8_BAR; PG8_WAIT_L(0); PG8_MMA(0, 1, At, B1); PG8_BAR;
            PG8_LDA(At, 1, 1); PG8_STAGE(PG8_SA(1, 0), a3, voffA);
            PG8_BAR; PG8_WAIT_L(0); PG8_MMA(1, 0, At, B0); PG8_BAR; PG8_SCHED;
            PG8_STAGE(PG8_SB(1, 1), b3 + hsB, voffB);
            PG8_WAIT_V(6); PG8_BAR; PG8_MMA(1, 1, At, B1); PG8_BAR;
            }
        }
        if constexpr (ALIGN_EPI) { if (wr == 0) PG8_BAR; }
        if constexpr (FP8) asm volatile("s_nop 15\n\ts_nop 15\n\ts_nop 15\n\ts_nop 15\n\ts_nop 15\n\ts_nop 15" ::: "memory");
        E(acc, cur, wr, wc, fr, fq);
        if (!has_next) break;
#pragma unroll
        for (int a = 0; a < 2; ++a)
#pragma unroll
            for (int b = 0; b < 2; ++b)
#pragma unroll
                for (int m = 0; m < 4; ++m)
#pragma unroll
                    for (int n = 0; n < 2; ++n) acc[a][b][m][n] = (f32x4){0.f, 0.f, 0.f, 0.f};
        cur = nxt; cA = nA; cB = nB; ++ui;
        if constexpr (ALIGN_EPI) { if (wr == 1) PG8_BAR; }
    }
    PG8_WAIT_V(0);
    if constexpr (!ALIGN_EPI) { if (wr == 0) PG8_BAR; }
    PG8_BAR;
#undef PG8_SA
#undef PG8_SB
#undef PG8_STAGE
#undef PG8_LDA
#undef PG8_LDB
#undef PG8_MMA
#undef PG8_WAIT_V
#undef PG8_WAIT_L
#undef PG8_BAR
#undef PG8_SCHED
}

typedef const f32x4 (&AccT)[2][2][4][2];
#define EPI_FENCE() asm volatile("" ::: "memory")

struct EpiInProj {
    static constexpr bool PERM = true;
    unsigned char* xbase; const float* ssq; float* rs_out; float* dtt; const float* dt_bias; float asc = 1.f;
    __device__ __forceinline__ void operator()(AccT acc, const Unit& u, int wr, int wc, int fr_, int fq_) const {
        int fr = fr_, fq = fq_; asm volatile("" : "+v"(fr), "+v"(fq));
        const int pn = u.pn; int bmib = (int)(X_Z >> 20), ld = 1024, ct = pn; bool sig = false;
        float sc = 1.f;
        if (pn < 4) { }
        else if (pn < 9) { bmib = (int)(X_XBC >> 20); ld = 1280; ct = pn - 4; }
        else if (pn < 11) { bmib = (int)(X_Q >> 20); ld = 512; ct = pn - 9; sc = 0.18033688011112042f; }
        else if (pn < 13) { bmib = (int)(X_K >> 20); ld = 512; ct = pn - 11; }
        else { bmib = (int)(X_GS >> 20); ld = 2048; ct = pn - 13; sig = true; }
        const unsigned lo = (unsigned)(fr * ld + 8 * fq) * 2u;
        unsigned char* tb = xbase + ((size_t)(unsigned)bmib << 20) + ((size_t)(u.pm * BM + wr * 64) * ld + ct * BM + wc * 32) * 2;
        const int rowb = u.pm * BM + wr * 64 + fr;
        float rr[8];
        rstd4x8(ssq + (size_t)rowb * 4, HALF, rr, 1.f);
        if (pn == 21) {
            if (wc == 0 && fq < 2) {
                int fqo = fq; asm volatile("" : "+v"(fqo));
                float* dbase = dtt + (size_t)(8 * fqo) * T;
                const f32x4 b0 = *(const f32x4*)(dt_bias + 8 * fqo), b1 = *(const f32x4*)(dt_bias + 8 * fqo + 4);
#pragma unroll
                for (int ai = 0; ai < 2; ++ai)
#pragma unroll
                    for (int m = 0; m < 4; ++m) { const int row = rowb + ai * HALF + m * 16; const float r = rr[ai * 4 + m] * asc; const f32x4 v0 = acc[ai][0][m][0] * r + b0, v1 = acc[ai][0][m][1] * r + b1;
#pragma unroll
                        for (int j = 0; j < 4; ++j) { dbase[(size_t)j * T + row] = softplusf_(v0[j]); dbase[(size_t)(4 + j) * T + row] = softplusf_(v1[j]); } }
            }
            return;
        }
#pragma unroll
        for (int ai = 0; ai < 2; ++ai)
#pragma unroll
            for (int m = 0; m < 4; ++m) { const int row = rowb + ai * HALF + m * 16; const float r0 = rr[ai * 4 + m]; const float r = r0 * (sc * asc); unsigned char* rowp = tb + (size_t)(ai * HALF + m * 16) * ld * 2;
                if (pn == 0 && wc == 0 && fq == 0) rs_out[row] = r0;
#pragma unroll
                for (int bj = 0; bj < 2; ++bj) { f32x4 v0 = acc[ai][bj][m][0] * r, v1 = acc[ai][bj][m][1] * r;
                    if (sig) {
#pragma unroll
                        for (int j = 0; j < 4; ++j) { v0[j] = sigmoidf_(v0[j]); v1[j] = sigmoidf_(v1[j]); } }
                    u32x4 w; w.x = cvt_pk_bf16(v0[0], v0[1]); w.y = cvt_pk_bf16(v0[2], v0[3]); w.z = cvt_pk_bf16(v1[0], v1[1]); w.w = cvt_pk_bf16(v1[2], v1[3]);
                    *(u32x4*)(rowp + lo + bj * HALF * 2) = w; }
                EPI_FENCE(); }
    }
};
struct EpiBf16Rs {
    static constexpr bool PERM = true;
    bf16_t* O; int ldc; const float* rs; float sc; int ssq16;
    __device__ __forceinline__ void operator()(AccT acc, const Unit& u, int wr, int wc, int fr_, int fq_) const {
        int fr = fr_, fq = fq_; asm volatile("" : "+v"(fr), "+v"(fq));
        const unsigned lo = (unsigned)(fr * ldc + 8 * fq) * 2u;
        unsigned char* tb = (unsigned char*)O + ((size_t)(u.pm * BM + wr * 64) * ldc + u.pn * BM + wc * 32) * 2;
        const float* rsb = rs + (size_t)(u.pm * BM + wr * 64 + fr) * (ssq16 ? 4 : 1);
        float rr[8];
#pragma unroll
        for (int gI = 0; gI < 8; ++gI) { const int ro = (gI >> 2) * HALF + (gI & 3) * 16; rr[gI] = ssq16 ? 0.f : rsb[ro] * sc; }
        if (ssq16) rstd4x8(rsb, HALF, rr, sc);
#pragma unroll
        for (int ai = 0; ai < 2; ++ai)
#pragma unroll
            for (int m = 0; m < 4; ++m) { const float r = rr[ai * 4 + m]; unsigned char* rowp = tb + (size_t)(ai * HALF + m * 16) * ldc * 2;
#pragma unroll
                for (int bj = 0; bj < 2; ++bj) { const f32x4 v0 = acc[ai][bj][m][0] * r, v1 = acc[ai][bj][m][1] * r;
                    u32x4 w; w.x = cvt_pk_bf16(v0[0], v0[1]); w.y = cvt_pk_bf16(v0[2], v0[3]); w.z = cvt_pk_bf16(v1[0], v1[1]); w.w = cvt_pk_bf16(v1[2], v1[3]);
                    *(u32x4*)(rowp + lo + bj * HALF * 2) = w; }
                EPI_FENCE(); }
    }
};
struct EpiBf16Cs {
    static constexpr bool PERM = true;
    bf16_t* O; int ldc; const float* cs; float sc; int chunk_rows;
    __device__ __forceinline__ void operator()(AccT acc, const Unit& u, int wr, int wc, int fr_, int fq_) const {
        int fr = fr_, fq = fq_; asm volatile("" : "+v"(fr), "+v"(fq));
        const int rstride = chunk_rows ? 128 : ldc;
        const size_t bjstride = chunk_rows ? (size_t)chunk_rows * 128 : (size_t)HALF;
        const unsigned lo = (unsigned)(fr * rstride + 8 * fq) * 2u;
        unsigned char* tb = (unsigned char*)O + (chunk_rows ? ((size_t)(u.pn * 2) * chunk_rows * 128 + (size_t)(u.pm * BM + wr * 64) * 128 + wc * 32) : ((size_t)(u.pm * BM + wr * 64) * ldc + u.pn * BM + wc * 32)) * 2;
        const float* csb = cs + u.pn * BM + wc * 32 + 8 * fq;
        f32x4 c0[2], c1[2];
#pragma unroll
        for (int bj = 0; bj < 2; ++bj) { c0[bj] = *(const f32x4*)(csb + bj * HALF) * sc; c1[bj] = *(const f32x4*)(csb + bj * HALF + 4) * sc; }
#pragma unroll
        for (int ai = 0; ai < 2; ++ai)
#pragma unroll
            for (int m = 0; m < 4; ++m) { unsigned char* rowp = tb + (size_t)(ai * HALF + m * 16) * rstride * 2;
#pragma unroll
                for (int bj = 0; bj < 2; ++bj) { const f32x4 v0 = acc[ai][bj][m][0] * c0[bj], v1 = acc[ai][bj][m][1] * c1[bj];
                    u32x4 w; w.x = cvt_pk_bf16(v0[0], v0[1]); w.y = cvt_pk_bf16(v0[2], v0[3]); w.z = cvt_pk_bf16(v1[0], v1[1]); w.w = cvt_pk_bf16(v1[2], v1[3]);
                    *(u32x4*)(rowp + lo + bj * bjstride * 2) = w; }
                EPI_FENCE(); }
    }
};
template <bool ADD, bool W8 = false> struct EpiGate {
    static constexpr bool PERM = true;
    bf16_t* O; const bf16_t* GS; int gcol0; const bf16_t* Oin;
    unsigned char* o8 = nullptr;
    __device__ __forceinline__ void operator()(AccT acc, const Unit& u, int wr, int wc, int fr_, int fq_) const {
        int fr = fr_, fq = fq_; asm volatile("" : "+v"(fr), "+v"(fq));
        const unsigned lo = (unsigned)(fr * 1024 + 8 * fq) * 2u, lg = (unsigned)(fr * 2048 + 8 * fq) * 2u;
        unsigned char* tb = (unsigned char*)O + ((size_t)(u.pm * BM + wr * 64) * 1024 + u.pn * BM + wc * 32) * 2;
        const unsigned char* ib = (const unsigned char*)Oin + ((size_t)(u.pm * BM + wr * 64) * 1024 + u.pn * BM + wc * 32) * 2;
        const unsigned char* gb = (const unsigned char*)GS + ((size_t)(u.pm * BM + wr * 64) * 2048 + gcol0 + u.pn * BM + wc * 32) * 2;
        u32x4 gq[2][2], pq[2][2];
#pragma unroll
        for (int bj = 0; bj < 2; ++bj) { gq[0][bj] = *(const u32x4*)(gb + lg + bj * HALF * 2); if (ADD) pq[0][bj] = *(const u32x4*)(ib + lo + bj * HALF * 2); }
#pragma unroll
        for (int gI = 0; gI < 8; ++gI) { const int ai = gI >> 2, m = gI & 3, cur = gI & 1, nx = cur ^ 1;
            if (gI < 7) { const size_t ro = (size_t)(((gI + 1) >> 2) * HALF + ((gI + 1) & 3) * 16);
#pragma unroll
                for (int bj = 0; bj < 2; ++bj) { gq[nx][bj] = *(const u32x4*)(gb + ro * 2048 * 2 + lg + bj * HALF * 2); if (ADD) pq[nx][bj] = *(const u32x4*)(ib + ro * 1024 * 2 + lo + bj * HALF * 2); } }
            unsigned char* rowp = tb + (size_t)(ai * HALF + m * 16) * 1024 * 2;
#pragma unroll
            for (int bj = 0; bj < 2; ++bj) { const u32x4 gw = gq[cur][bj]; f32x4 v0 = acc[ai][bj][m][0], v1 = acc[ai][bj][m][1];
                v0[0] *= bflo(gw.x); v0[1] *= bfhi(gw.x); v0[2] *= bflo(gw.y); v0[3] *= bfhi(gw.y); v1[0] *= bflo(gw.z); v1[1] *= bfhi(gw.z); v1[2] *= bflo(gw.w); v1[3] *= bfhi(gw.w);
                if (ADD) { const u32x4 pw = pq[cur][bj];
                    v0[0] += bflo(pw.x); v0[1] += bfhi(pw.x); v0[2] += bflo(pw.y); v0[3] += bfhi(pw.y); v1[0] += bflo(pw.z); v1[1] += bfhi(pw.z); v1[2] += bflo(pw.w); v1[3] += bfhi(pw.w); }
                if constexpr (W8) { u32x2 q8; q8.x = cvt_pk_fp8(v0[0], v0[1], v0[2], v0[3]); q8.y = cvt_pk_fp8(v1[0], v1[1], v1[2], v1[3]);
                    *(u32x2*)(o8 + (size_t)(u.pm * BM + wr * 64 + ai * HALF + m * 16 + fr) * 2048 + u.pn * BM + wc * 32 + 8 * fq + bj * HALF) = q8; }
                else { u32x4 w; w.x = cvt_pk_bf16(v0[0], v0[1]); w.y = cvt_pk_bf16(v0[2], v0[3]); w.z = cvt_pk_bf16(v1[0], v1[1]); w.w = cvt_pk_bf16(v1[2], v1[3]);
                       *(u32x4*)(rowp + lo + bj * HALF * 2) = w; } }
        }
    }
};
template <bool W8 = false, bool SC = false>
struct EpiResidBfT {
    static constexpr bool PERM = true;
    const bf16_t* Hin; bf16_t* Hout; float* ssq; LAS float* sl;
    unsigned char* h8 = nullptr; float asc = 1.f;
    __device__ __forceinline__ void operator()(AccT acc, const Unit& u, int wr, int wc, int fr_, int fq_) const {
        int fr = fr_, fq = fq_; asm volatile("" : "+v"(fr), "+v"(fq));
        const unsigned lo = (unsigned)(fr * 1024 + 8 * fq) * 2u;
        const size_t ub = ((size_t)(u.pm * BM + wr * 64) * 1024 + u.pn * BM + wc * 32) * 2;
        const unsigned char* hi0 = (const unsigned char*)Hin + ub + lo; unsigned char* ho0 = (unsigned char*)Hout + ub + lo;
        unsigned char* h80 = W8 ? h8 + (ub >> 1) + (lo >> 1) : nullptr; (void)h80;
        u32x4 hq[2][2];
#pragma unroll
        for (int bj = 0; bj < 2; ++bj) hq[0][bj] = *(const u32x4*)(hi0 + bj * HALF * 2);
#pragma unroll
        for (int gI = 0; gI < 8; ++gI) { const int ai = gI >> 2, m = gI & 3, cur = gI & 1, nx = cur ^ 1;
            if (gI < 7) { const size_t ro = (size_t)(((gI + 1) >> 2) * HALF + ((gI + 1) & 3) * 16) * 1024 * 2;
#pragma unroll
                for (int bj = 0; bj < 2; ++bj) hq[nx][bj] = *(const u32x4*)(hi0 + ro + bj * HALF * 2); }
            unsigned char* ho = ho0 + (size_t)(ai * HALF + m * 16) * 1024 * 2;
            float ss = 0.f;
#pragma unroll
            for (int bj = 0; bj < 2; ++bj) { f32x4 a0 = acc[ai][bj][m][0], a1 = acc[ai][bj][m][1]; const u32x4 hv = hq[cur][bj]; u32x4 w;
                if constexpr (SC) { a0 *= asc; a1 *= asc; }
                a0[0] += bflo(hv.x); a0[1] += bfhi(hv.x); a0[2] += bflo(hv.y); a0[3] += bfhi(hv.y); a1[0] += bflo(hv.z); a1[1] += bfhi(hv.z); a1[2] += bflo(hv.w); a1[3] += bfhi(hv.w);
                w.x = cvt_pk_bf16(a0[0], a0[1]); w.y = cvt_pk_bf16(a0[2], a0[3]); w.z = cvt_pk_bf16(a1[0], a1[1]); w.w = cvt_pk_bf16(a1[2], a1[3]);
                *(u32x4*)(ho + bj * HALF * 2) = w;
                if constexpr (W8) { u32x2 q8; q8.x = cvt_pk_fp8(a0[0], a0[1], a0[2], a0[3]); q8.y = cvt_pk_fp8(a1[0], a1[1], a1[2], a1[3]); *(u32x2*)(h80 + (size_t)(ai * HALF + m * 16) * 1024 + bj * HALF) = q8; }
                ss += (bflo(w.x) * bflo(w.x) + bfhi(w.x) * bfhi(w.x)) + (bflo(w.y) * bflo(w.y) + bfhi(w.y) * bfhi(w.y)) + (bflo(w.z) * bflo(w.z) + bfhi(w.z) * bfhi(w.z)) + (bflo(w.w) * bflo(w.w) + bfhi(w.w) * bfhi(w.w)); }
            ss += __shfl_xor(ss, 16); ss += __shfl_xor(ss, 32);
            if (fq == 0) sl[wc * 256 + ai * HALF + wr * 64 + m * 16 + fr] = ss;
        }
        asm volatile("s_waitcnt lgkmcnt(0)" ::: "memory"); __builtin_amdgcn_s_barrier(); asm volatile("" ::: "memory");
        const int t = (wr * 4 + wc) * 64 + fq * 16 + fr;
        if (t < 256) ssq[(size_t)(u.pm * BM + t) * 4 + u.pn] = (sl[t] + sl[256 + t]) + (sl[512 + t] + sl[768 + t]);
    }
};
typedef EpiResidBfT<false, false> EpiResidBf;
template <bool F8 = false>
struct EpiSwigluT {
    static constexpr bool PERM = true;
    bf16_t* ACT; const float* rs; int ssq16; float asc = 1.f;
    __device__ __forceinline__ void operator()(AccT acc, const Unit& u, int wr, int wc, int fr_, int fq_) const {
        int fr = fr_, fq = fq_; asm volatile("" : "+v"(fr), "+v"(fq));
        constexpr unsigned ES = F8 ? 1u : 2u;
        const unsigned lo = (unsigned)(fr * DFF + 8 * fq) * ES;
        unsigned char* tb = (unsigned char*)ACT + ((size_t)(u.pm * BM + wr * 64) * DFF + u.pn * HALF + wc * 32) * ES;
        const float* rsb = rs + (size_t)(u.pm * BM + wr * 64 + fr) * (ssq16 ? 4 : 1);
        float rr[8];
#pragma unroll
        for (int gI = 0; gI < 8; ++gI) { const int ro = (gI >> 2) * HALF + (gI & 3) * 16; rr[gI] = ssq16 ? 0.f : rsb[ro] * asc; }
        if (ssq16) rstd4x8(rsb, HALF, rr, asc);
#pragma unroll
        for (int ai = 0; ai < 2; ++ai)
#pragma unroll
            for (int m = 0; m < 4; ++m) { const float r = rr[ai * 4 + m];
                float o[8];
#pragma unroll
                for (int n = 0; n < 2; ++n)
#pragma unroll
                    for (int j = 0; j < 4; ++j) { const float gt = acc[ai][0][m][n][j] * r, up = acc[ai][1][m][n][j] * r; o[n * 4 + j] = gt * sigmoidf_(gt) * up; }
                if constexpr (F8) { u32x2 w; w.x = cvt_pk_fp8(o[0], o[1], o[2], o[3]); w.y = cvt_pk_fp8(o[4], o[5], o[6], o[7]); *(u32x2*)(tb + (size_t)(ai * HALF + m * 16) * DFF + lo) = w; }
                else { u32x4 w; w.x = cvt_pk_bf16(o[0], o[1]); w.y = cvt_pk_bf16(o[2], o[3]); w.z = cvt_pk_bf16(o[4], o[5]); w.w = cvt_pk_bf16(o[6], o[7]);
                       *(u32x4*)(tb + (size_t)(ai * HALF + m * 16) * DFF * 2 + lo) = w; }
                EPI_FENCE(); }
    }
};
typedef EpiSwigluT<false> EpiSwiglu;
struct EpiMoeDown {
    static constexpr bool PERM = true;
    const bf16_t* H; const int* rowl; const float* wrow; bf16_t* Hout; float* ssq; LAS float* sl;
    float asc = 1.f; unsigned char* h8 = nullptr;
    __device__ __forceinline__ void operator()(AccT acc, const Unit& u, int wr, int wc, int fr_, int fq_) const {
        int fr = fr_, fq = fq_; asm volatile("" : "+v"(fr), "+v"(fq));
        const int rb = u.pm * BM + wr * 64 + fr; const unsigned cb = (unsigned)(u.pn * BM + wc * 32 + 8 * fq) * 2u;
        int tk[8]; float wt[8];
#pragma unroll
        for (int gI = 0; gI < 8; ++gI) { const int row = rb + (gI >> 2) * HALF + (gI & 3) * 16; tk[gI] = rowl[row]; wt[gI] = wrow[row] * asc; }
        u32x4 hq[2][2];
        { const size_t to = (size_t)(tk[0] < 0 ? 0 : tk[0]);
#pragma unroll
          for (int bj = 0; bj < 2; ++bj) hq[0][bj] = *(const u32x4*)((const unsigned char*)H + to * 2048 + cb + bj * HALF * 2); }
#pragma unroll
        for (int gI = 0; gI < 8; ++gI) { const int ai = gI >> 2, m = gI & 3, cur = gI & 1, nx = cur ^ 1;
            if (gI < 7) { const size_t tn = (size_t)(tk[gI + 1] < 0 ? 0 : tk[gI + 1]);
#pragma unroll
                for (int bj = 0; bj < 2; ++bj) hq[nx][bj] = *(const u32x4*)((const unsigned char*)H + tn * 2048 + cb + bj * HALF * 2); }
            const int tok = tk[gI]; const size_t to = (size_t)(tok < 0 ? 0 : tok);
            unsigned char* op = (unsigned char*)Hout + to * 2048 + cb;
            float ss = 0.f;
            if (tok >= 0) {
#pragma unroll
                for (int bj = 0; bj < 2; ++bj) { f32x4 a0 = acc[ai][bj][m][0] * wt[gI], a1 = acc[ai][bj][m][1] * wt[gI]; const u32x4 hv = hq[cur][bj]; u32x4 w;
                    a0[0] += bflo(hv.x); a0[1] += bfhi(hv.x); a0[2] += bflo(hv.y); a0[3] += bfhi(hv.y); a1[0] += bflo(hv.z); a1[1] += bfhi(hv.z); a1[2] += bflo(hv.w); a1[3] += bfhi(hv.w);
                    w.x = cvt_pk_bf16(a0[0], a0[1]); w.y = cvt_pk_bf16(a0[2], a0[3]); w.z = cvt_pk_bf16(a1[0], a1[1]); w.w = cvt_pk_bf16(a1[2], a1[3]);
                    *(u32x4*)(op + bj * HALF * 2) = w;
                    if (h8 != nullptr) { u32x2 q8; q8.x = cvt_pk_fp8(a0[0], a0[1], a0[2], a0[3]); q8.y = cvt_pk_fp8(a1[0], a1[1], a1[2], a1[3]); *(u32x2*)(h8 + to * 1024 + (cb >> 1) + bj * HALF) = q8; }
                    ss += (bflo(w.x) * bflo(w.x) + bfhi(w.x) * bfhi(w.x)) + (bflo(w.y) * bflo(w.y) + bfhi(w.y) * bfhi(w.y)) + (bflo(w.z) * bflo(w.z) + bfhi(w.z) * bfhi(w.z)) + (bflo(w.w) * bflo(w.w) + bfhi(w.w) * bfhi(w.w)); } }
            ss += __shfl_xor(ss, 16); ss += __shfl_xor(ss, 32);
            if (ssq != nullptr && fq == 0) sl[wc * 256 + ai * HALF + wr * 64 + m * 16 + fr] = ss;
        }
        if (ssq != nullptr) {
            asm volatile("s_waitcnt lgkmcnt(0)" ::: "memory"); __builtin_amdgcn_s_barrier(); asm volatile("" ::: "memory");
            const int t = (wr * 4 + wc) * 64 + fq * 16 + fr;
            if (t < 256) { const int tok = rowl[u.pm * BM + t]; if (tok >= 0) ssq[(size_t)tok * 4 + u.pn] = (sl[t] + sl[256 + t]) + (sl[512 + t] + sl[768 + t]); }
        }
    }
};
}

#define XB_TMO      128
#define XB_XCNT(j)  (256  + 64 * (j))
#define XB_XSUB(j)  (1280 + 64 * (j))
#define XB_XGEN(j)  (2304 + 64 * (j))
#define XB_TOP      3328
#define XB_TOPGEN   3392
#define XCD_BAR_WORDS 3456
#define XB_SPIN_CAP (1u << 22)
__device__ __forceinline__ unsigned xb_ld(unsigned* p)              { return __hip_atomic_load(p, __ATOMIC_RELAXED, __HIP_MEMORY_SCOPE_AGENT); }
__device__ __forceinline__ unsigned xb_add(unsigned* p, unsigned v) { return __hip_atomic_fetch_add(p, v, __ATOMIC_RELAXED, __HIP_MEMORY_SCOPE_AGENT); }
__device__ __forceinline__ unsigned xb_xcc_id() { return (unsigned)__builtin_amdgcn_s_getreg((3 << 11) | 20) & 0xFu; }
#define XB_SPIN(cond, bar) do { unsigned _sp = 0; while (cond) { __builtin_amdgcn_s_sleep(1); \
    if ((++_sp & 255u) == 0u) { if (xb_ld(&(bar)[XB_TMO])) break; if (_sp > XB_SPIN_CAP) { atomicAdd(&(bar)[XB_TMO], 1u); break; } } } } while (0)
struct XcdBarrier { unsigned* bar; unsigned x; volatile LAS unsigned* st; };
__device__ __forceinline__ XcdBarrier xcd_barrier_post(unsigned* bar, volatile LAS unsigned* st) {
    XcdBarrier b; b.bar = bar; b.x = xb_xcc_id(); b.st = st;
    if (threadIdx.x == 0) (void)xb_add(&bar[XB_XCNT(b.x)], 1u);
    return b;
}
__device__ __forceinline__ void xcd_barrier_complete(unsigned* bar, unsigned x, unsigned& nloc, unsigned& nx) {
    const unsigned G = gridDim.x * gridDim.y * gridDim.z;
    unsigned sum, cnt, mine, sp = 0u;
    for (;;) {
        sum = 0u; cnt = 0u; mine = 0u;
#pragma unroll
        for (unsigned j = 0; j < 16; ++j) { const unsigned c = xb_ld(&bar[XB_XCNT(j)]); sum += c; cnt += (c > 0u) ? 1u : 0u; mine = (j == x) ? c : mine; }
        if (sum == G) break;
        __builtin_amdgcn_s_sleep(1);
        if ((++sp & 255u) == 0u) { if (xb_ld(&bar[XB_TMO])) break; if (sp > XB_SPIN_CAP) { atomicAdd(&bar[XB_TMO], 1u); break; } }
    }
    nloc = mine > 0u ? mine : 1u; nx = cnt > 0u ? cnt : 1u;
}
__device__ __forceinline__ void xcd_barrier(const XcdBarrier& b, const bool leader_thread) {
    asm volatile("s_waitcnt vmcnt(0)" ::: "memory");
    __syncthreads();
    if (leader_thread) {
        unsigned* bar = b.bar;
        __builtin_amdgcn_s_waitcnt(0);
        unsigned nloc = b.st[0], nx = b.st[1];
        if (nloc == 0u) { xcd_barrier_complete(bar, b.x, nloc, nx); b.st[0] = nloc; b.st[1] = nx; }
        const unsigned old = xb_add(&bar[XB_XSUB(b.x)], 1u);
        const unsigned gen = old / nloc;
        if (old + 1u == (gen + 1u) * nloc) {
            __builtin_amdgcn_fence(__ATOMIC_RELEASE, "agent");
            asm volatile("s_waitcnt vmcnt(0)" ::: "memory");
            const unsigned og = xb_add(&bar[XB_TOP], 1u);
            const unsigned tg = og / nx;
            if (og + 1u == (tg + 1u) * nx) xb_add(&bar[XB_TOPGEN], 1u);
            else XB_SPIN(xb_ld(&bar[XB_TOPGEN]) == tg, bar);
            __builtin_amdgcn_fence(__ATOMIC_ACQUIRE, "agent");
            xb_add(&bar[XB_XGEN(b.x)], 1u);
            asm volatile("s_waitcnt vmcnt(0)" ::: "memory");
        } else {
            XB_SPIN(xb_ld(&bar[XB_XGEN(b.x)]) == gen, bar);
            __builtin_amdgcn_fence(__ATOMIC_ACQUIRE, "agent");
            asm volatile("s_waitcnt vmcnt(0)" ::: "memory");
        }
    }
    __syncthreads();
}

__device__ __forceinline__ void grp_barrier(unsigned* lb, unsigned RG, unsigned* tmo_bar, const bool leader_thread) {
    asm volatile("s_waitcnt vmcnt(0)" ::: "memory");
    __syncthreads();
    if (leader_thread) {
        __builtin_amdgcn_s_waitcnt(0);
        const unsigned old = xb_add(lb, 1u);
        const unsigned gen = old / RG;
        if (old + 1u == (gen + 1u) * RG) xb_add(lb + 64, 1u);
        else XB_SPIN(xb_ld(lb + 64) == gen, tmo_bar);
        __builtin_amdgcn_fence(__ATOMIC_ACQUIRE, "agent");
        asm volatile("s_waitcnt vmcnt(0)" ::: "memory");
    }
    __syncthreads();
}

struct Params {
    const float* in[28];
    float* out;
    unsigned char* ws;
    int l_lo, l_hi, ph_lo, ph_hi;
};
enum { I_X = 0, I_MEM, I_NORM_MIX, I_W_IN, I_CONV_W, I_CONV_B, I_DT_BIAS, I_A_LOG, I_D_SKIP, I_SSD_NORM, I_W_SSD_O, I_W_SB_O, I_W_OUT, I_NORM_XA, I_NORM_MEM,
       I_XA_WQ, I_XA_WK, I_XA_WV, I_XA_WO, I_NORM_FFN, I_FFN_G, I_FFN_U, I_FFN_D, I_MOE_R, I_MOE_G, I_MOE_U, I_MOE_D, I_FINAL };

struct TrStream { float v[32]; f32x4 g0, g1; bool pending; unsigned char* dst; int ldt, k0, drow0; float f8; };
__device__ __forceinline__ void tr_scatter(const TrStream& S, LAS float* scr, int lane) {
    const int hl = lane >> 5, nl = lane & 31;
#pragma unroll
    for (int i = 0; i < 32; ++i) scr[(2 * i + hl) * 33 + nl] = S.v[i];
}
__device__ __forceinline__ void tr_store(unsigned char* dst, int ldt, int k0, int drow0, float f8, f32x4 g0, f32x4 g1, LAS float* scr, int lane) {
    const int c = lane & 7;
    if (f8 != 0.f) {
        g0 *= f8; g1 *= f8;
#pragma unroll
        for (int j = 0; j < 4; ++j) { const int n = (lane >> 3) + 8 * j; const LAS float* s = scr + (8 * c) * 33 + n;
            u32x2 o; o.x = cvt_pk_fp8(s[0 * 33] * g0.x, s[1 * 33] * g0.y, s[2 * 33] * g0.z, s[3 * 33] * g0.w); o.y = cvt_pk_fp8(s[4 * 33] * g1.x, s[5 * 33] * g1.y, s[6 * 33] * g1.z, s[7 * 33] * g1.w);
            *(u32x2*)(dst + (size_t)(drow0 + n) * ldt + k0 + 8 * c) = o; }
    } else {
#pragma unroll
        for (int j = 0; j < 4; ++j) { const int n = (lane >> 3) + 8 * j; const LAS float* s = scr + (8 * c) * 33 + n;
            u32x4 o; o.x = cvt_pk_bf16(s[0 * 33] * g0.x, s[1 * 33] * g0.y); o.y = cvt_pk_bf16(s[2 * 33] * g0.z, s[3 * 33] * g0.w); o.z = cvt_pk_bf16(s[4 * 33] * g1.x, s[5 * 33] * g1.y); o.w = cvt_pk_bf16(s[6 * 33] * g1.z, s[7 * 33] * g1.w);
            *(u32x4*)((bf16_t*)dst + (size_t)(drow0 + n) * ldt + k0 + 8 * c) = o; }
    }
}
__device__ __forceinline__ void tr_finish(TrStream& S, LAS float* scr, int lane) {
    if (S.pending) { tr_scatter(S, scr, lane); LDS_WAIT(); tr_store(S.dst, S.ldt, S.k0, S.drow0, S.f8, S.g0, S.g1, scr, lane); LDS_WAIT(); S.pending = false; }
}
__device__ __forceinline__ void tr_push(TrStream& S, const float* W, int ldw, int k0, int n0, const float* gain, bf16_t* WT, int ldt, int drow0, float f8, LAS float* scr, int lane) {
    const bool had = S.pending; unsigned char* odst = S.dst; const int oldt = S.ldt, ok0 = S.k0, odrow0 = S.drow0; const float of8 = S.f8; const f32x4 og0 = S.g0, og1 = S.g1;
    if (had) tr_scatter(S, scr, lane);
    { const int hl = lane >> 5, nl = lane & 31, c = lane & 7;
      const float* src = W + (size_t)(k0 + hl) * ldw + n0 + nl;
#pragma unroll
      for (int i = 0; i < 32; ++i) S.v[i] = src[(size_t)(2 * i) * ldw];
      S.g0 = (f32x4){1.f, 1.f, 1.f, 1.f}; S.g1 = S.g0;
      if (gain) { S.g0 = *(const f32x4*)(gain + k0 + 8 * c); S.g1 = *(const f32x4*)(gain + k0 + 8 * c + 4); }
      S.dst = (unsigned char*)WT; S.ldt = ldt; S.k0 = k0; S.drow0 = drow0; S.f8 = f8; S.pending = true; }
    if (had) { LDS_WAIT(); tr_store(odst, oldt, ok0, odrow0, of8, og0, og1, scr, lane); LDS_WAIT(); }
}
struct TrJob { const float* W; int ldw, K, col0, ncols; const float* gain; bf16_t* WT; int dbase, dgroup; float f8 = 0.f; };
__device__ __forceinline__ void run_job(TrStream& S, const TrJob& j, int& base, int gw, int NGW, LAS float* scr, int lane) {
    const int nblk = j.ncols / 32, nitems = (j.K / 64) * nblk;
    int start = (gw - base) % NGW; if (start < 0) start += NGW;
    for (int it = start; it < nitems; it += NGW) { const int kb = it / nblk, nb = it % nblk, c0 = nb * 32;
        tr_push(S, j.W, j.ldw, kb * 64, j.col0 + c0, j.gain, j.WT, j.K, j.dbase + (c0 / 128) * j.dgroup + (c0 % 128), j.f8, scr, lane); }
    base = (base + nitems) % NGW;
}

__device__ __forceinline__ float row_to_bf16(const float* xrow, bf16_t* brow, int lane) {
    const f32x4* xr = (const f32x4*)xrow + lane; u32x2* o8 = (u32x2*)brow + lane; float s = 0.f;
    f32x4 vin[4];
#pragma unroll
    for (int j = 0; j < 4; ++j) vin[j] = xr[64 * j];
#pragma unroll
    for (int j = 0; j < 4; ++j) { const f32x4 v = vin[j]; u32x2 w; w.x = cvt_pk_bf16(v.x, v.y); w.y = cvt_pk_bf16(v.z, v.w); o8[64 * j] = w;
        s += (bflo(w.x) * bflo(w.x) + bfhi(w.x) * bfhi(w.x)) + (bflo(w.y) * bflo(w.y) + bfhi(w.y) * bfhi(w.y)); }
    return wave_sum(s);
}
template <int NE>
__device__ __forceinline__ void row_dots_raw(const u32x2 (&xw)[4], int lane, const LAS float* wsm, float rstd, float (&ex)[NE]) {
    f32x4 v[4];
#pragma unroll
    for (int j = 0; j < 4; ++j) { const u32x2 w = xw[j]; v[j] = (f32x4){bflo(w.x), bfhi(w.x), bflo(w.y), bfhi(w.y)}; }
#pragma unroll
    for (int e = 0; e < NE; ++e) { float pp = 0.f;
#pragma unroll
        for (int j = 0; j < 4; ++j) { const f32x4 w4 = *(const LAS f32x4*)(wsm + e * 1024 + 256 * j + 4 * lane); pp += (v[j].x * w4.x + v[j].y * w4.y) + (v[j].z * w4.z + v[j].w * w4.w); }
        ex[e] = wave_sum(pp) * rstd; }
}
template <int NE>
__device__ __forceinline__ void row_dots_bf16(const bf16_t* brow, int lane, const LAS float* wsm, float rstd, float (&ex)[NE]) {
    const u32x2* xr = (const u32x2*)brow + lane; f32x4 v[4];
#pragma unroll
    for (int j = 0; j < 4; ++j) { const u32x2 w = xr[64 * j]; v[j] = (f32x4){bflo(w.x), bfhi(w.x), bflo(w.y), bfhi(w.y)}; }
#pragma unroll
    for (int e = 0; e < NE; ++e) { float pp = 0.f;
#pragma unroll
        for (int j = 0; j < 4; ++j) { const f32x4 w4 = *(const LAS f32x4*)(wsm + e * 1024 + 256 * j + 4 * lane); pp += (v[j].x * w4.x + v[j].y * w4.y) + (v[j].z * w4.z + v[j].w * w4.w); }
        ex[e] = wave_sum(pp) * rstd; }
}

typedef float f32x16 __attribute__((ext_vector_type(16)));
#define MFMA32(a, b, c) __builtin_amdgcn_mfma_f32_32x32x16_bf16((a), (b), (c), 0, 0, 0)
__device__ __forceinline__ bf16x8 ldg8(const bf16_t* p) { return *(const bf16x8*)p; }
__device__ __forceinline__ bf16x8 pack8(const float* v) { u32x4 w; w.x = cvt_pk_bf16(v[0], v[1]); w.y = cvt_pk_bf16(v[2], v[3]); w.z = cvt_pk_bf16(v[4], v[5]); w.w = cvt_pk_bf16(v[6], v[7]); return __builtin_bit_cast(bf16x8, w); }
__device__ __forceinline__ int pi32(int r) { return 16 * ((r >> 2) & 1) + 4 * (r >> 3) + (r & 3); }

__device__ __forceinline__ void sb_attn_mfma(const bf16_t* Q, const bf16_t* Kb, const bf16_t* Vt, bf16_t* Yo, int vg, int rg, int RG, int wave, int lane) {
    const int c = lane & 31, hh = lane >> 5, pr = pi32(c);
    bf16x8 U[2];
#pragma unroll
    for (int kk = 0; kk < 2; ++kk) { u32x4 uw;
#pragma unroll
        for (int q = 0; q < 4; ++q) uw[q] = ((16 * hh + 8 * kk + 2 * q > pr) ? 0x3F80u : 0u) | ((16 * hh + 8 * kk + 2 * q + 1 > pr) ? 0x3F800000u : 0u);
        U[kk] = __builtin_bit_cast(bf16x8, uw); }
    for (int vb = rg; vb < 32; vb += RG)
    for (int iu = 0; iu < 4; ++iu) {
        const int k4 = iu, a = vb >> 1, bh = (2 * vg + (vb & 1)) * 8 + wave;
        const int qblk = k4 == 0 ? a : k4 == 1 ? 31 - a : k4 == 2 ? 32 + a : 63 - a;
        const int b = bh >> 3, h = bh & 7, t0 = qblk * 32;
        const bf16_t* qp = Q + (size_t)(b * SEQ + t0 + c) * 512 + h * 64; bf16_t* yp = Yo + (size_t)(b * SEQ + t0 + c) * 512 + h * 64;
        bf16x8 qf[4];
#pragma unroll
        for (int jj = 0; jj < 4; ++jj) qf[jj] = ldg8(qp + 16 * jj + 8 * hh);
        const bf16_t* kbase = Kb + (size_t)(b * SEQ + pr) * 512 + h * 64 + 8 * hh;
        const bf16_t* vbase = Vt + (size_t)(b * 16) * 512 * 128 + (size_t)(h * 64 + c) * 128 + 16 * hh;
        f32x16 o0, o1;
#pragma unroll
        for (int i = 0; i < 16; ++i) { o0[i] = 0.f; o1[i] = 0.f; }
        float R = 0.f;
        bf16x8 kf[4], vf[4], kn[4], vn[4];
#pragma unroll
        for (int jj = 0; jj < 4; ++jj) { kf[jj] = ldg8(kbase + (size_t)t0 * 512 + 16 * jj); vf[jj] = ldg8(vbase + (size_t)(t0 >> 7) * 512 * 128 + (t0 & 127) + (jj >> 1) * 32 * 128 + 8 * (jj & 1)); }
        for (int kb = qblk; kb >= 0; --kb) {
            const int s0 = kb * 32;
            if (kb > 0) {
#pragma unroll
                for (int jj = 0; jj < 4; ++jj) { kn[jj] = ldg8(kbase + (size_t)(s0 - 32) * 512 + 16 * jj); vn[jj] = ldg8(vbase + (size_t)((s0 - 32) >> 7) * 512 * 128 + ((s0 - 32) & 127) + (jj >> 1) * 32 * 128 + 8 * (jj & 1)); }
            }
            f32x16 s;
#pragma unroll
            for (int i = 0; i < 16; ++i) s[i] = 0.f;
#pragma unroll
            for (int jj = 0; jj < 4; ++jj) s = MFMA32(kf[jj], qf[jj], s);
            const bool diag = (kb == qblk);
            float sp[16]; float rsum = 0.f;
#pragma unroll
            for (int i = 0; i < 16; ++i) { const float x = s[i]; float v = fmaxf(x, 0.f) + __builtin_amdgcn_logf(1.f + __builtin_amdgcn_exp2f(-fabsf(x)));
                if (diag && !(16 * hh + i < c)) v = 0.f;
                sp[i] = v; rsum += v; }
            f32x16 E;
#pragma unroll
            for (int i = 0; i < 16; ++i) E[i] = 0.f;
            E = MFMA32(U[0], pack8(sp), E); E = MFMA32(U[1], pack8(sp + 8), E);
            float at[16];
#pragma unroll
            for (int i = 0; i < 16; ++i) { float av = __builtin_amdgcn_exp2f(s[i] - sp[i] - E[i] - R); if (diag && !(16 * hh + i < c)) av = 0.f; at[i] = av; }
            const bf16x8 a0 = pack8(at), a1 = pack8(at + 8);
            o0 = MFMA32(vf[0], a0, o0); o0 = MFMA32(vf[1], a1, o0);
            o1 = MFMA32(vf[2], a0, o1); o1 = MFMA32(vf[3], a1, o1);
            rsum += __shfl_xor(rsum, 32); R += rsum;
            if (__all(R > 48.f)) break;
#pragma unroll
            for (int jj = 0; jj < 4; ++jj) { kf[jj] = kn[jj]; vf[jj] = vn[jj]; }
        }
#pragma unroll
        for (int g = 0; g < 4; ++g) { u32x2 w0, w1; w0.x = cvt_pk_bf16(o0[4 * g], o0[4 * g + 1]); w0.y = cvt_pk_bf16(o0[4 * g + 2], o0[4 * g + 3]); w1.x = cvt_pk_bf16(o1[4 * g], o1[4 * g + 1]); w1.y = cvt_pk_bf16(o1[4 * g + 2], o1[4 * g + 3]);
            *(u32x2*)(yp + 8 * g + 4 * hh) = w0; *(u32x2*)(yp + 32 + 8 * g + 4 * hh) = w1; }
    }
}

__device__ __forceinline__ void xattn_lds(const bf16_t* XQ, const bf16_t* KMl, const bf16_t* VtMl, bf16_t* XO, int vg, int rg, int RG, int tid, int wave, int lane, LAS unsigned char* lds) {
    constexpr int KP = 272, VP = 528;
    LAS unsigned char* Ks = lds; LAS unsigned char* Vs = lds + 256 * KP;
    const int c = lane & 31, hh = lane >> 5, pr = pi32(c);
    for (int u = rg; u < 32; u += RG) { const int b = 2 * vg + (u >> 4), hd = (u >> 2) & 3, qz = u & 3;
        __syncthreads();
        { u32x4 kr[8], vr[8];
#pragma unroll
          for (int i = 0; i < 8; ++i) { const int idx = tid + 512 * i; kr[i] = *(const u32x4*)(KMl + (size_t)(b * MEMLEN + (idx >> 4)) * 2048 + hd * 128 + (idx & 15) * 8);
              vr[i] = *(const u32x4*)(VtMl + (size_t)(hd * 128 + (idx >> 5)) * TM + b * MEMLEN + (idx & 31) * 8); }
#pragma unroll
          for (int i = 0; i < 8; ++i) { const int idx = tid + 512 * i; *(LAS u32x4*)(Ks + (idx >> 4) * KP + (idx & 15) * 16) = kr[i]; *(LAS u32x4*)(Vs + (idx >> 5) * VP + (idx & 31) * 16) = vr[i]; } }
        __syncthreads();
        const LAS unsigned char* kl = Ks + pr * KP + 16 * hh;
        const LAS unsigned char* vl = Vs + c * VP + 32 * hh;
        for (int qi = 0; qi < 2; ++qi) { const int t0 = (qz * 16 + wave * 2 + qi) * 32;
            const bf16_t* qp = XQ + (size_t)(b * SEQ + t0 + c) * 512 + hd * 128 + 8 * hh;
            bf16x8 qf[8];
#pragma unroll
            for (int jj = 0; jj < 8; ++jj) qf[jj] = ldg8(qp + 16 * jj);
            float mx = -3.0e38f;
            for (int kb = 0; kb < 8; ++kb) { f32x16 sc;
#pragma unroll
                for (int i = 0; i < 16; ++i) sc[i] = 0.f;
#pragma unroll
                for (int jj = 0; jj < 8; ++jj) sc = MFMA32(*(const LAS bf16x8*)(kl + kb * 32 * KP + 32 * jj), qf[jj], sc);
#pragma unroll
                for (int i = 0; i < 16; ++i) mx = fmaxf(mx, sc[i]); }
            mx = fmaxf(mx, __shfl_xor(mx, 32));
            f32x16 o[4];
#pragma unroll
            for (int db = 0; db < 4; ++db)
#pragma unroll
                for (int i = 0; i < 16; ++i) o[db][i] = 0.f;
            float sum = 0.f;
            for (int kb = 0; kb < 8; ++kb) { f32x16 sc;
#pragma unroll
                for (int i = 0; i < 16; ++i) sc[i] = 0.f;
#pragma unroll
                for (int jj = 0; jj < 8; ++jj) sc = MFMA32(*(const LAS bf16x8*)(kl + kb * 32 * KP + 32 * jj), qf[jj], sc);
                float pv[16];
#pragma unroll
                for (int i = 0; i < 16; ++i) { pv[i] = __builtin_amdgcn_exp2f(sc[i] - mx); sum += pv[i]; }
                const bf16x8 p0 = pack8(pv), p1 = pack8(pv + 8);
#pragma unroll
                for (int db = 0; db < 4; ++db) { const LAS unsigned char* vp = vl + db * 32 * VP + kb * 64; o[db] = MFMA32(*(const LAS bf16x8*)vp, p0, o[db]); o[db] = MFMA32(*(const LAS bf16x8*)(vp + 16), p1, o[db]); } }
            sum += __shfl_xor(sum, 32);
            const float inv = 1.f / sum;
            bf16_t* op = XO + (size_t)(b * SEQ + t0 + c) * 512 + hd * 128 + 4 * hh;
#pragma unroll
            for (int db = 0; db < 4; ++db)
#pragma unroll
                for (int g = 0; g < 4; ++g) { u32x2 w0; w0.x = cvt_pk_bf16(o[db][4 * g] * inv, o[db][4 * g + 1] * inv); w0.y = cvt_pk_bf16(o[db][4 * g + 2] * inv, o[db][4 * g + 3] * inv);
                    *(u32x2*)(op + 32 * db + 8 * g) = w0; }
        }
    }
}

template <int CTRL, int ROWMASK> __device__ __forceinline__ float dpp_mov0(float v) { return __builtin_bit_cast(float, __builtin_amdgcn_update_dpp(0, __builtin_bit_cast(int, v), CTRL, ROWMASK, 0xF, false)); }
__device__ __forceinline__ float wave_incl_scan(float v, int) {
    v += dpp_mov0<0x111, 0xF>(v); v += dpp_mov0<0x112, 0xF>(v); v += dpp_mov0<0x114, 0xF>(v); v += dpp_mov0<0x118, 0xF>(v);
    v += dpp_mov0<0x142, 0xA>(v); v += dpp_mov0<0x143, 0xC>(v);
    return v;
}
__device__ __forceinline__ float lane63(float v) { return __builtin_bit_cast(float, __builtin_amdgcn_readlane(__builtin_bit_cast(int, v), 63)); }
__device__ __forceinline__ void conv_unit(const bf16_t* XBC, const float* cw, const float* cb, bf16_t* XT, bf16_t* BR, bf16_t* BT, bf16_t* CR, int u, int lane) {
    const int tb = u / 10, cbk = u - tb * 10, tok0 = tb * 64, ch0 = cbk * 128 + 2 * lane;
    float w[4][2], bs[2];
#pragma unroll
    for (int k = 0; k < 4; ++k) { w[k][0] = cw[k * 1280 + ch0]; w[k][1] = cw[k * 1280 + ch0 + 1]; }
    bs[0] = cb[ch0]; bs[1] = cb[ch0 + 1];
    const bf16_t* src = XBC + (size_t)tok0 * 1280 + ch0;
    float h0[2] = {0.f, 0.f}, h1[2] = {0.f, 0.f}, h2[2] = {0.f, 0.f};
    if ((tok0 & (SEQ - 1)) != 0) { const unsigned a = *(const unsigned*)(src - 3 * 1280), b = *(const unsigned*)(src - 2 * 1280), c = *(const unsigned*)(src - 1280);
        h0[0] = bflo(a); h0[1] = bfhi(a); h1[0] = bflo(b); h1[1] = bfhi(b); h2[0] = bflo(c); h2[1] = bfhi(c); }
    unsigned ylo[32], yhi[32]; float pe0 = 0.f, pe1 = 0.f;
    bf16_t* rdst = (cbk == 8) ? BR : CR;
    unsigned xin[64];
#pragma unroll
    for (int tt = 0; tt < 64; ++tt) xin[tt] = *(const unsigned*)(src + (size_t)tt * 1280);
#pragma unroll
    for (int tt = 0; tt < 64; ++tt) { const unsigned xw = xin[tt]; const float x0 = bflo(xw), x1 = bfhi(xw);
        float v0 = bs[0] + w[0][0] * h0[0] + w[1][0] * h1[0] + w[2][0] * h2[0] + w[3][0] * x0, v1 = bs[1] + w[0][1] * h0[1] + w[1][1] * h1[1] + w[2][1] * h2[1] + w[3][1] * x1;
        v0 *= sigmoidf_(v0); v1 *= sigmoidf_(v1);
        h0[0] = h1[0]; h0[1] = h1[1]; h1[0] = h2[0]; h1[1] = h2[1]; h2[0] = x0; h2[1] = x1;
        xin[tt] = cvt_pk_bf16(v0, v1);
        if (tt & 1) { ylo[tt >> 1] = cvt_pk_bf16(pe0, v0); yhi[tt >> 1] = cvt_pk_bf16(pe1, v1); } else { pe0 = v0; pe1 = v1; } }
    if (cbk >= 8) {
#pragma unroll
        for (int tt = 0; tt < 64; ++tt) *(unsigned*)(rdst + (size_t)(tok0 + tt) * 128 + 2 * lane) = xin[tt]; }
    if (cbk <= 8) { bf16_t* tbase = (cbk < 8) ? XT + ((size_t)(tok0 >> 7) * 1024 + ch0) * 128 + (tok0 & 127) : BT + ((size_t)(tok0 >> 7) * 128 + 2 * lane) * 128 + (tok0 & 127);
#pragma unroll
        for (int q = 0; q < 8; ++q) { u32x4 a, b; a.x = ylo[4 * q]; a.y = ylo[4 * q + 1]; a.z = ylo[4 * q + 2]; a.w = ylo[4 * q + 3]; b.x = yhi[4 * q]; b.y = yhi[4 * q + 1]; b.z = yhi[4 * q + 2]; b.w = yhi[4 * q + 3];
            *(u32x4*)(tbase + 8 * q) = a; *(u32x4*)(tbase + 128 + 8 * q) = b; } }
}
__device__ __forceinline__ void ssd_scan_block(const bf16_t* XT, const bf16_t* BT, const float* DTT, bf16_t* PREV, float negA, int b, int h, int wave, int lane, LAS float* wl  , LAS float* xch  ) {
    const int c32 = lane & 31, hh = lane >> 5, g = h >> 3, q = wave & 3, pblk = q >> 1, nblk = q & 1, c0 = (wave >> 2) * 8;
    const bf16_t* xrow = XT + ((size_t)(b * 16) * 1024 + h * 64 + pblk * 32 + c32) * 128 + 8 * hh;
    const bf16_t* brow = BT + ((size_t)(b * 16) * 128 + g * 64 + nblk * 32 + c32) * 128 + 8 * hh;
    const float* dtp = DTT + (size_t)h * T + b * SEQ + lane;
    f32x16 S[8]; float dec[8];
#pragma unroll
    for (int ci = 0; ci < 8; ++ci) { const int c = c0 + ci;
        const float d0 = dtp[c * 128], d1 = dtp[c * 128 + 64];
        u32x4 xa[8]; bf16x8 ba[8];
#pragma unroll
        for (int ks = 0; ks < 8; ++ks) { xa[ks] = *(const u32x4*)(xrow + (size_t)c * 1024 * 128 + 16 * ks); ba[ks] = ldg8(brow + (size_t)c * 128 * 128 + 16 * ks); }
        const float s0 = wave_incl_scan(d0 * negA, lane); const float tot0 = lane63(s0);
        const float s1 = wave_incl_scan(d1 * negA, lane) + tot0; const float last = lane63(s1);
        wl[lane] = d0 * fexp(last - s0); wl[64 + lane] = d1 * fexp(last - s1);
        dec[ci] = fexp(last);
        f32x16 st;
#pragma unroll
        for (int i = 0; i < 16; ++i) st[i] = 0.f;
#pragma unroll
        for (int ks = 0; ks < 8; ++ks) { const u32x4 xw = xa[ks];
            const f32x4 wa = *(const LAS f32x4*)(wl + 16 * ks + 8 * hh), wb = *(const LAS f32x4*)(wl + 16 * ks + 8 * hh + 4);
            float xs[8]; xs[0] = bflo(xw.x) * wa.x; xs[1] = bfhi(xw.x) * wa.y; xs[2] = bflo(xw.y) * wa.z; xs[3] = bfhi(xw.y) * wa.w; xs[4] = bflo(xw.z) * wb.x; xs[5] = bfhi(xw.z) * wb.y; xs[6] = bflo(xw.w) * wb.z; xs[7] = bfhi(xw.w) * wb.w;
            st = MFMA32(pack8(xs), ba[ks], st); }
        S[ci] = st;
        asm volatile("" ::: "memory");
    }
    f32x16 carry;
#pragma unroll
    for (int i = 0; i < 16; ++i) carry[i] = 0.f;
    LAS float* xq = xch + q * 1024 + lane;
    bf16_t* pv = PREV + ((size_t)((b * 16) * 16 + h) * 64 + pblk * 32) * 64 + nblk * 32 + c32;
#pragma unroll
    for (int half = 0; half < 2; ++half) {
        if ((wave >> 2) == half) {
            if (half == 1) {
#pragma unroll
                for (int i = 0; i < 16; ++i) carry[i] = xq[i * 64]; }
#pragma unroll
            for (int ci = 0; ci < 8; ++ci) { bf16_t* pc = pv + (size_t)(c0 + ci) * 16 * 4096;
#pragma unroll
                for (int i = 0; i < 16; ++i) pc[(8 * (i >> 2) + 4 * hh + (i & 3)) * 64] = f2bf(carry[i]);
#pragma unroll
                for (int i = 0; i < 16; ++i) carry[i] = carry[i] * dec[ci] + S[ci][i]; }
            if (half == 0) {
#pragma unroll
                for (int i = 0; i < 16; ++i) xq[i * 64] = carry[i]; }
        }
        if (half == 0) { asm volatile("s_waitcnt lgkmcnt(0)" ::: "memory"); __builtin_amdgcn_s_barrier(); asm volatile("" ::: "memory"); }
    }
}
__device__ __forceinline__ void ssd_out_unit(const bf16_t* XT, const bf16_t* BR, const bf16_t* CR, const float* DTT, const bf16_t* PREV, const bf16_t* Zb, bf16_t* Y, float negA, float dsk,
                                             int b, int c, int g, int wave, int lane, LAS float* tab  , LAS float* red  , LAS float* cbl  , const int var) {
    const int c32 = lane & 31, hh = lane >> 5, pr = pi32(c32), h = g * 8 + wave;
    const int tokc = b * SEQ + c * 128;
    const float* dtp = DTT + (size_t)h * T + tokc + lane;
    { bf16x8 bb[2][4], cc[2][4];
#pragma unroll
      for (int r = 0; r < 2; ++r) { const int kk = wave + 8 * r; if (kk < 10) { const int tqk = kk < 1 ? 0 : kk < 3 ? 1 : kk < 6 ? 2 : 3, jk = kk - tqk * (tqk + 1) / 2;
#pragma unroll
          for (int ks = 0; ks < 4; ++ks) { bb[r][ks] = ldg8(BR + (size_t)(tokc + 32 * jk + pr) * 128 + g * 64 + 8 * hh + 16 * ks); cc[r][ks] = ldg8(CR + (size_t)(tokc + 32 * tqk + c32) * 128 + g * 64 + 16 * ks + 8 * hh); } } }
#pragma unroll
      for (int r = 0; r < 2; ++r) { const int kk = wave + 8 * r; if (kk < 10) { f32x16 t;
#pragma unroll
          for (int i = 0; i < 16; ++i) t[i] = 0.f;
#pragma unroll
          for (int ks = 0; ks < 4; ++ks) t = MFMA32(bb[r][ks], cc[r][ks], t);
#pragma unroll
          for (int q = 0; q < 4; ++q) *(LAS f32x4*)(cbl + ((kk * 4 + q) * 64 + lane) * 4) = (f32x4){t[4 * q], t[4 * q + 1], t[4 * q + 2], t[4 * q + 3]}; } } }
    const float d0 = dtp[0], d1 = dtp[64];
    const bf16_t* pv = PREV + ((size_t)((b * 16 + c) * 16 + h) * 64 + c32) * 64 + 8 * hh;
    const bf16_t* xrow = XT + ((size_t)(b * 16 + c) * 1024 + h * 64 + c32) * 128 + 16 * hh;
    const float s0 = wave_incl_scan(d0 * negA, lane); const float tot0 = lane63(s0);
    const float s1 = wave_incl_scan(d1 * negA, lane) + tot0;
    tab[lane] = s0; tab[64 + lane] = s1; tab[128 + lane] = d0; tab[192 + lane] = d1;
    tab[256 + lane] = d0 * fexp(tab[lane | 31] - s0); tab[320 + lane] = d1 * fexp(tab[64 + (lane | 31)] - s1);
    asm volatile("s_waitcnt lgkmcnt(0)" ::: "memory"); __builtin_amdgcn_s_barrier(); asm volatile("" ::: "memory");
    for (int tq = 0; tq < ((var & 8) ? 0 : 4); ++tq) {
        const size_t tokg = (size_t)(tokc + tq * 32 + c32);
        bf16x8 cf[4], pf[8];
#pragma unroll
        for (int ks = 0; ks < 4; ++ks) cf[ks] = ldg8(CR + tokg * 128 + g * 64 + 16 * ks + 8 * hh);
#pragma unroll
        for (int ks = 0; ks < 4; ++ks) { pf[ks] = ldg8(pv + 16 * ks); pf[4 + ks] = ldg8(pv + 32 * 64 + 16 * ks); }
        bf16x8 xfr[4], xnx[4];
        xfr[0] = ldg8(xrow); xfr[1] = ldg8(xrow + 8); xfr[2] = ldg8(xrow + 32 * 128); xfr[3] = ldg8(xrow + 32 * 128 + 8);
        const bf16_t* zp = Zb + tokg * 1024 + h * 64 + 4 * hh;
        u32x2 zr[8];
#pragma unroll
        for (int gq = 0; gq < 4; ++gq) { zr[gq] = *(const u32x2*)(zp + 8 * gq); zr[4 + gq] = *(const u32x2*)(zp + 32 + 8 * gq); }
        const float acum_t = tab[tq * 32 + c32];
        f32x16 y0, y1;
#pragma unroll
        for (int i = 0; i < 16; ++i) { y0[i] = 0.f; y1[i] = 0.f; }
        if (!(var & 2))
#pragma unroll
        for (int ks = 0; ks < 4; ++ks) { y0 = MFMA32(pf[ks], cf[ks], y0); y1 = MFMA32(pf[4 + ks], cf[ks], y1); }
        { const float ea = fexp(acum_t);
#pragma unroll
          for (int i = 0; i < 16; ++i) { y0[i] *= ea; y1[i] *= ea; } }
        for (int j = 0; j <= ((var & 1) ? -1 : tq); ++j) {
            if (j < tq) {
                xnx[0] = ldg8(xrow + 32 * (j + 1)); xnx[1] = ldg8(xrow + 32 * (j + 1) + 8); xnx[2] = ldg8(xrow + 32 * 128 + 32 * (j + 1)); xnx[3] = ldg8(xrow + 32 * 128 + 32 * (j + 1) + 8); }
            f32x16 cbt;
            { const LAS float* cb = cbl + (((tq * (tq + 1) / 2 + j) * 4) * 64 + lane) * 4;
#pragma unroll
              for (int q = 0; q < 4; ++q) { const f32x4 t4 = *(const LAS f32x4*)(cb + q * 256); cbt[4 * q] = t4.x; cbt[4 * q + 1] = t4.y; cbt[4 * q + 2] = t4.z; cbt[4 * q + 3] = t4.w; } }
            float m[16];
            if (j < tq) { const float et = fexp(acum_t - tab[32 * j + 31]);
#pragma unroll
                for (int q = 0; q < 4; ++q) { const f32x4 ks = *(const LAS f32x4*)(tab + 256 + 32 * j + 16 * hh + 4 * q);
#pragma unroll
                    for (int e = 0; e < 4; ++e) m[4 * q + e] = cbt[4 * q + e] * ks[e] * et; }
            } else {
#pragma unroll
                for (int q = 0; q < 4; ++q) { const f32x4 as = *(const LAS f32x4*)(tab + 32 * j + 16 * hh + 4 * q), ds = *(const LAS f32x4*)(tab + 128 + 32 * j + 16 * hh + 4 * q);
#pragma unroll
                    for (int e = 0; e < 4; ++e) { const int i = 4 * q + e; float v = cbt[i] * ds[e] * fexp(acum_t - as[e]);
                        if (16 * hh + i > c32) v = 0.f; if (16 * hh + i == c32) v += dsk;
                        m[i] = v; } }
            }
            const bf16x8 m0 = pack8(m), m1 = pack8(m + 8);
            y0 = MFMA32(xfr[0], m0, y0); y0 = MFMA32(xfr[1], m1, y0);
            y1 = MFMA32(xfr[2], m0, y1); y1 = MFMA32(xfr[3], m1, y1);
#pragma unroll
            for (int ks = 0; ks < 4; ++ks) xfr[ks] = xnx[ks];
        }
        float ss = 0.f;
#pragma unroll
        for (int gq = 0; gq < 4; ++gq) { const u32x2 za = zr[gq], zb2 = zr[4 + gq];
            const float z0[4] = {bflo(za.x), bfhi(za.x), bflo(za.y), bfhi(za.y)}, z1[4] = {bflo(zb2.x), bfhi(zb2.x), bflo(zb2.y), bfhi(zb2.y)};
#pragma unroll
            for (int e = 0; e < 4; ++e) { const int i = 4 * gq + e; y0[i] *= z0[e] * sigmoidf_(z0[e]); y1[i] *= z1[e] * sigmoidf_(z1[e]); ss += y0[i] * y0[i] + y1[i] * y1[i]; } }
        ss += __shfl_xor(ss, 32);
        LAS float* rd = red + (tq & 1) * 256;
        if (hh == 0) rd[wave * 32 + c32] = ss;
        asm volatile("s_waitcnt lgkmcnt(0)" ::: "memory"); __builtin_amdgcn_s_barrier(); asm volatile("" ::: "memory");
        float tot = 0.f;
#pragma unroll
        for (int w8 = 0; w8 < 8; ++w8) tot += rd[w8 * 32 + c32];
        const float rstd = __builtin_amdgcn_rsqf(tot * (1.f / 512.f) + EPS);
        bf16_t* yp = Y + tokg * 1280 + h * 64 + 4 * hh;
#pragma unroll
        for (int gq = 0; gq < 4; ++gq) { u32x2 o0, o1; o0.x = cvt_pk_bf16(y0[4 * gq] * rstd, y0[4 * gq + 1] * rstd); o0.y = cvt_pk_bf16(y0[4 * gq + 2] * rstd, y0[4 * gq + 3] * rstd);
            o1.x = cvt_pk_bf16(y1[4 * gq] * rstd, y1[4 * gq + 1] * rstd); o1.y = cvt_pk_bf16(y1[4 * gq + 2] * rstd, y1[4 * gq + 3] * rstd);
            if (!(var & 4)) { *(u32x2*)(yp + 8 * gq) = o0; *(u32x2*)(yp + 32 + 8 * gq) = o1; } }
    }
}

__device__ __forceinline__ void moe_convert(const Params& p, unsigned char* ws, int lm, int jfm, int kinds, int gwc, int NGWc, LAS float* scr, int lane) {
    int base = 0; const float* gn = p.in[I_NORM_FFN] + lm * D; TrStream S{};
    for (int jb = 0; jb < NEXP * 3; ++jb) { const int e = jb / 3, k = jb % 3; if (!((kinds >> k) & 1)) continue;
        TrJob j; const size_t eo = ((size_t)jfm * NEXP + e) * D * DFF;
        if (k == 0) j = TrJob{p.in[I_MOE_G] + eo, DFF, D, 0, DFF, gn, (bf16_t*)(ws + WS_WMOE + WM_GU + (size_t)e * 2 * DFF * 1024 * (MOE_F8_GU ? 1 : 2)), 0, 256, MOE_F8_GU ? F8_WGU : 0.f};
        else if (k == 1) j = TrJob{p.in[I_MOE_U] + eo, DFF, D, 0, DFF, gn, (bf16_t*)(ws + WS_WMOE + WM_GU + (size_t)e * 2 * DFF * 1024 * (MOE_F8_GU ? 1 : 2)), 128, 256, MOE_F8_GU ? F8_WGU : 0.f};
        else j = TrJob{p.in[I_MOE_D] + eo, D, DFF, 0, D, nullptr, (bf16_t*)(ws + WS_WMOE + WM_DN + (size_t)e * 1024 * DFF * (MOE_F8_DN ? 1 : 2)), 0, 128, MOE_F8_DN ? F8_WDN : 0.f};
        run_job(S, j, base, gwc, NGWc, scr, lane); }
    tr_finish(S, scr, lane);
}

#define PHASE_DELAY() do { if ((DELAY_MASK >> site_) & 1u) { const unsigned long long t1_ = __builtin_amdgcn_s_memrealtime(); while (__builtin_amdgcn_s_memrealtime() - t1_ < t1_ - t0_) __builtin_amdgcn_s_sleep(8); } } while (0)
#define PHASE_ENTER() constexpr int site_ = __COUNTER__; const unsigned long long t0_ = (DELAY_MASK >> site_) & 1u ? __builtin_amdgcn_s_memrealtime() : 0ull; (void)t0_; GAS unsigned char* ws_ = (GAS unsigned char*)p.ws; asm volatile("" : "+s"(ws_)); unsigned char* const ws = (unsigned char*)ws_;     \
    GAS float* out_ = (GAS float*)p.out; asm volatile("" : "+s"(out_)); float* const OUTP = (float*)out_; (void)OUTP; int tid_ = wave0 * 64 + lane_id_opaque(); int bid_ = blockIdx.x; asm volatile("" : "+s"(bid_)); \
    const int tid = tid_, lane = tid & 63, wave = __builtin_amdgcn_readfirstlane(tid >> 6); \
    const int G = gridDim.x, bid = bid_, gw = bid * 8 + wave, NGW = G * 8, vg = bid & 7, rg = bid >> 3, RG = G >> 3; (void)lane; (void)gw; (void)NGW; (void)wave; (void)bid; (void)G; (void)vg; (void)rg; (void)RG
#define WSP(type, off) ((type*)(ws + (off)))
__global__ void __launch_bounds__(512, 2) mk_fwd(Params p) {
    extern __shared__ __attribute__((aligned(16))) unsigned char lds_raw[];
    LAS unsigned char* lds = (LAS unsigned char*)lds_raw;
    volatile LAS unsigned* ldsctl = (volatile LAS unsigned*)(lds + LDSCTL_OFF);
    if (threadIdx.x < 64) ldsctl[threadIdx.x] = 0u;
    int wave0 = __builtin_amdgcn_readfirstlane((int)threadIdx.x >> 6); asm volatile("" : "+s"(wave0));
    __syncthreads();
    const int ph_lo = p.ph_lo, ph_hi = p.ph_hi;
    const bool use_bar = (ph_hi - ph_lo) > 1 || (p.l_hi - p.l_lo) > 1;
    XcdBarrier bar; bar.bar = (unsigned*)(p.ws + WS_CTL) + CW_BAR; bar.x = 0; bar.st = nullptr;
    if (use_bar) bar = xcd_barrier_post((unsigned*)(p.ws + WS_CTL) + CW_BAR, ldsctl + 8);
    int local_ok = 0;
    if (use_bar && threadIdx.x == 0) { const unsigned xcc = xb_xcc_id(); unsigned* plc = (unsigned*)(p.ws + WS_CTL) + CW_PLC + 64 * (blockIdx.x & 7);
        (void)__hip_atomic_fetch_max(plc, xcc + 1u, __ATOMIC_RELAXED, __HIP_MEMORY_SCOPE_AGENT); (void)__hip_atomic_fetch_max(plc + 1, 16u - xcc, __ATOMIC_RELAXED, __HIP_MEMORY_SCOPE_AGENT); }
#define LOCAL_BAR() do { PHASE_DELAY(); if (use_bar) { if (local_ok) grp_barrier((unsigned*)(p.ws + WS_CTL) + CW_LBAR + 128 * (blockIdx.x & 7), gridDim.x >> 3, bar.bar, wave0 == 0 && lane_id_opaque() == 0); \
                                                       else xcd_barrier(bar, wave0 == 0 && lane_id_opaque() == 0); } } while (0)
#define PH(k) (ph_lo <= (k) && (k) < ph_hi)
#define GRID_BAR() do { PHASE_DELAY(); if (use_bar) xcd_barrier(bar, wave0 == 0 && lane_id_opaque() == 0); } while (0)

    if (p.l_lo == 0 && PH(0)) for (int rep = 0; rep < NREP(0); ++rep) {
        PHASE_ENTER();
        LAS float* scr = (LAS float*)(lds + wave * 16384);
        int base = 0; TrStream S{};
        for (int jb = 0; jb < 4 * 12 + 2 * 3; ++jb) {
            TrJob j;
            if (jb < 48) { const int l = jb / 12, k = jb % 12; unsigned char* wl = ws + WS_W + (size_t)l * W_LAYER;
                switch (k) {
                case 0: j = TrJob{p.in[I_W_IN] + (size_t)l * D * INW, INW, D, 0, 2304, p.in[I_NORM_MIX] + l * D, (bf16_t*)(wl + W_IN), 0, 128, ((INPROJ8_MASK >> l) & 1) ? F8_WGU : 0.f}; break;
                case 1: j = TrJob{p.in[I_W_IN] + (size_t)l * D * INW, INW, D, 2320, 1024, p.in[I_NORM_MIX] + l * D, (bf16_t*)(wl + W_IN), 2304, 128, ((INPROJ8_MASK >> l) & 1) ? F8_WGU : 0.f}; break;
                case 9: j = TrJob{p.in[I_W_IN] + (size_t)l * D * INW, INW, D, 3344, 512, p.in[I_NORM_MIX] + l * D, (bf16_t*)(wl + W_IN), NMAIN, 128, ((MIX8_MASK >> l) & 1) ? F8_WGU : 0.f}; break;
                case 11: j = TrJob{p.in[I_W_IN] + (size_t)l * D * INW, INW, D, 2304, 32, p.in[I_NORM_MIX] + l * D, (bf16_t*)(wl + W_IN), 5376, 128, ((INPROJ8_MASK >> l) & 1) ? F8_WGU : 0.f}; break;
                case 10: j = TrJob{p.in[I_W_IN] + (size_t)l * D * INW, INW, D, 3856, 2048, p.in[I_NORM_MIX] + l * D, (bf16_t*)(wl + W_IN), 3328, 128, ((INPROJ8_MASK >> l) & 1) ? F8_WGU : 0.f}; break;
                case 2: j = TrJob{p.in[I_W_SSD_O] + (size_t)l * D * D, D, D, 0, D, p.in[I_SSD_NORM] + l * D, (bf16_t*)(wl + W_SSDO), 0, 128}; break;
                case 3: j = TrJob{p.in[I_W_SB_O] + (size_t)l * 512 * D, D, 512, 0, D, nullptr, (bf16_t*)(wl + W_SBO), 0, 128}; break;
                case 4: j = TrJob{p.in[I_W_OUT] + (size_t)l * D * D, D, D, 0, D, nullptr, (bf16_t*)(wl + W_OUT), 0, 128, ((MIX8_MASK >> l) & 1) ? F8_WGU : 0.f}; break;
                case 5: j = TrJob{p.in[I_XA_WQ] + (size_t)l * D * 512, 512, D, 0, 512, p.in[I_NORM_XA] + l * D, (bf16_t*)(wl + W_Q), 0, 128, ((MIX8_MASK >> l) & 1) ? F8_WGU : 0.f}; break;
                case 6: j = TrJob{p.in[I_XA_WK] + (size_t)l * D * 512, 512, D, 0, 512, p.in[I_NORM_MEM] + l * D, (bf16_t*)(ws + WS_WKV), l * 512, 128}; break;
                case 7: j = TrJob{p.in[I_XA_WV] + (size_t)l * D * 512, 512, D, 0, 512, p.in[I_NORM_MEM] + l * D, (bf16_t*)(ws + WS_WKV), 2048 + l * 512, 128}; break;
                case 8: j = TrJob{p.in[I_XA_WO] + (size_t)l * 512 * D, D, 512, 0, D, nullptr, (bf16_t*)(wl + W_O), 0, 128}; break;
                }
            } else { const int jj = (jb - 48) / 3, k = (jb - 48) % 3; unsigned char* wf = ws + WS_WFF + (size_t)jj * W_FF; const float* gn = p.in[I_NORM_FFN] + (2 * jj) * D;
                if (k == 0) j = TrJob{p.in[I_FFN_G] + (size_t)jj * D * DFF, DFF, D, 0, DFF, gn, (bf16_t*)(wf + W_GU), 0, 256, ((DENSE_GU8_MASK >> jj) & 1) ? F8_WGU : 0.f};
                else if (k == 1) j = TrJob{p.in[I_FFN_U] + (size_t)jj * D * DFF, DFF, D, 0, DFF, gn, (bf16_t*)(wf + W_GU), 128, 256, ((DENSE_GU8_MASK >> jj) & 1) ? F8_WGU : 0.f};
                else j = TrJob{p.in[I_FFN_D] + (size_t)jj * DFF * D, D, DFF, 0, D, nullptr, (bf16_t*)(wf + W_DN), 0, 128, ((DENSE_DN8_MASK >> jj) & 1) ? F8_WDN : 0.f};
            }
            run_job(S, j, base, gw, NGW, scr, lane);
        }
        tr_finish(S, scr, lane);
        bf16_t* MEMB = WSP(bf16_t, WS_MEMB); float* RSMEM = WSP(float, WS_RSMEM);
        for (int m = gw; m < TM; m += NGW) { const float q = row_to_bf16(p.in[I_MEM] + (size_t)m * D, MEMB + (size_t)m * D, lane); if (lane == 0) RSMEM[m] = __builtin_amdgcn_rsqf(q * (1.f / D) + EPS); }
        { bf16_t* HB = WSP(bf16_t, WS_HB); float* SSQ = WSP(float, WS_SSQ + (size_t)(12) * SSQ_BYTES);
          for (int m = gw; m < T; m += NGW) { const float q = row_to_bf16(p.in[I_X] + (size_t)m * D, HB + (size_t)m * D, lane); if (lane < 4) SSQ[(size_t)m * 4 + lane] = lane == 0 ? q : 0.f; } }
        for (int it = gw; it < 4 * 224; it += NGW) { const int l = it / 224, r = 5408 + it % 224;
            const u32x4 zz = {0u, 0u, 0u, 0u};
            if ((INPROJ8_MASK >> l) & 1) { u32x4* dst = (u32x4*)(WSP(unsigned char, WS_W + (size_t)l * W_LAYER + W_IN) + (size_t)r * 1024); dst[lane] = zz; }
            else { u32x4* dst = (u32x4*)(WSP(bf16_t, WS_W + (size_t)l * W_LAYER + W_IN) + (size_t)r * 1024); dst[lane] = zz; dst[lane + 64] = zz; } }
        GRID_BAR();
        if (use_bar && (G & 7) == 0) {
            if (tid == 0) { unsigned okv = 1u; const unsigned* plc = WSP(unsigned, WS_CTL) + CW_PLC;
                for (int v = 0; v < 8; ++v) okv &= (ld_u32_agent(plc + 64 * v) + ld_u32_agent(plc + 64 * v + 1) == 17u) ? 1u : 0u;
                ldsctl[12] = okv; }
            __syncthreads();
            local_ok = (int)__builtin_amdgcn_readfirstlane(ldsctl[12]);
        }
    }
    if (p.l_lo == 0 && PH(1)) for (int rep = 0; rep < NREP(1); ++rep) {
        PHASE_ENTER();
        { pg8::Gemm g{WSP(bf16_t, WS_MEMB), WSP(bf16_t, WS_WKV), D, D, D}; pg8::StaticOrder S; S.init(TM, 2048, G, bid);
          pg8::EpiBf16Rs E{WSP(bf16_t, WS_KM), 2048, WSP(float, WS_RSMEM), 1.f, 0};
          pg8::gemm_phase<pg8::EpiBf16Rs, pg8::StaticOrder, true, true>(lds, g, S, E, wave0); }
        { pg8::Gemm g{WSP(bf16_t, WS_WKV) + (size_t)2048 * 1024, WSP(bf16_t, WS_MEMB), D, D, D}; pg8::StaticOrder S; S.init(2048, TM, G, (bid + G / 2) % G);
          pg8::EpiBf16Cs E{WSP(bf16_t, WS_VTM), TM, WSP(float, WS_RSMEM), 1.f, 0};
          pg8::gemm_phase<pg8::EpiBf16Cs, pg8::StaticOrder, true, true>(lds, g, S, E, wave0); }
        GRID_BAR();
    }

    for (int l = p.l_lo; l < p.l_hi; ++l) {
        const bool moe = (l & 1) != 0; const int jf = l >> 1;

        if (PH(3)) for (int rep = 0; rep < NREP(3); ++rep) {
            PHASE_ENTER();
            const bool in8 = (INPROJ8_MASK >> l) & 1;
            pg8::Gemm g{in8 ? WSP(bf16_t, WS_X + X_HB8) : WSP(bf16_t, WS_HB), (const bf16_t*)(ws + WS_W + (size_t)l * W_LAYER + W_IN), D, D, D}; pg8::StaticOrder S; S.init(T / 8, NMAIN, RG, rg); S.pm0 = 16 * vg;
            pg8::EpiInProj E{ws + WS_X, WSP(float, WS_SSQ + (size_t)(l == 0 ? 12 : 3 * l - 1) * SSQ_BYTES), WSP(float, WS_RS), WSP(float, WS_DT), p.in[I_DT_BIAS] + l * 16, in8 ? 1.f / F8_WGU : 1.f};
            if (in8) pg8::gemm_phase<pg8::EpiInProj, pg8::StaticOrder, true, true, true>(lds, g, S, E, wave0);
            else pg8::gemm_phase<pg8::EpiInProj, pg8::StaticOrder, true, true, false>(lds, g, S, E, wave0);
            LOCAL_BAR();
        }
        if (PH(4)) for (int rep = 0; rep < NREP(4); ++rep) {
            PHASE_ENTER();
            const float* cw = p.in[I_CONV_W] + (size_t)l * 4 * 1280; const float* cb = p.in[I_CONV_B] + (size_t)l * 1280;
            for (int u = rg * 8 + wave; u < (T / 8 / 64) * 10; u += RG * 8) conv_unit(WSP(bf16_t, WS_X + X_XBC), cw, cb, WSP(bf16_t, WS_X + X_XT), WSP(bf16_t, WS_X + X_BR), WSP(bf16_t, WS_X + X_BT), WSP(bf16_t, WS_X + X_CR), vg * ((T / 8 / 64) * 10) + u, lane);
            { const bool v8 = (MIX8_MASK >> l) & 1;
              pg8::Gemm g{(const bf16_t*)(ws + WS_W + (size_t)l * W_LAYER + W_IN + (size_t)NMAIN * 1024 * (v8 ? 1 : 2)), v8 ? WSP(bf16_t, WS_X + X_HB8) : WSP(bf16_t, WS_HB), D, D, D}; pg8::StaticOrder S; S.init(512, T / 8, RG, rg); S.pn0 = 16 * vg;
              pg8::EpiBf16Cs E{WSP(bf16_t, WS_X + X_V), T, WSP(float, WS_RS), v8 ? 1.f / F8_WGU : 1.f, 512};
              if (v8) pg8::gemm_phase<pg8::EpiBf16Cs, pg8::StaticOrder, true, true, true>(lds, g, S, E, wave0);
              else pg8::gemm_phase<pg8::EpiBf16Cs, pg8::StaticOrder, true, true, false>(lds, g, S, E, wave0); }
            if (moe)
                moe_convert(p, ws, l, jf, l == 1 ? 7 : 4, gw, NGW, (LAS float*)(lds + wave * 16384), lane);
            LOCAL_BAR();
        }
        if (PH(5)) for (int rep = 0; rep < NREP(5); ++rep) {
            PHASE_ENTER();
            const int pvar = (rep + 1 < NREP(5)) ? PROBE_VAR : 0;
            if (!(pvar & 1)) for (int u = rg; u < 32; u += RG) { const int b = 2 * vg + (u >> 4), h = u & 15;
                __syncthreads();
                ssd_scan_block(WSP(bf16_t, WS_X + X_XT), WSP(bf16_t, WS_X + X_BT), WSP(float, WS_DT), WSP(bf16_t, WS_X + X_PREV), -fexp(p.in[I_A_LOG][l * 16 + h]), b, h, wave, lane, (LAS float*)(lds + wave * 1024), (LAS float*)(lds + 8192)); }
            if (!(pvar & 2)) sb_attn_mfma(WSP(bf16_t, WS_X + X_Q), WSP(bf16_t, WS_X + X_K), WSP(bf16_t, WS_X + X_V), (rep + 1 < NREP(5)) ? WSP(bf16_t, WS_X + X_XBC) : WSP(bf16_t, WS_X + X_Q), vg, rg, RG, wave, lane);
            LOCAL_BAR();
        }
        if (PH(6)) for (int rep = 0; rep < NREP(6); ++rep) {
            PHASE_ENTER();
            for (int u = rg; u < 64; u += RG) { const int b = 2 * vg + (u >> 5), c = (u >> 1) & 15, g = u & 1; const int h = g * 8 + wave;
                ssd_out_unit(WSP(bf16_t, WS_X + X_XT), WSP(bf16_t, WS_X + X_BR), WSP(bf16_t, WS_X + X_CR), WSP(float, WS_DT), WSP(bf16_t, WS_X + X_PREV), WSP(bf16_t, WS_X + X_Z), WSP(bf16_t, WS_X + X_XBC),
                             -fexp(p.in[I_A_LOG][l * 16 + h]), p.in[I_D_SKIP][l * 16 + h], b, c, g, wave, lane, (LAS float*)(lds + wave * 2048), (LAS float*)(lds + 16384), (LAS float*)(lds + 32768), (rep + 1 < NREP(6)) ? PROBE_VAR : 0); }
            LOCAL_BAR();
        }
        if (PH(7)) for (int rep = 0; rep < NREP(7); ++rep) {
            PHASE_ENTER();
            pg8::Gemm g{WSP(bf16_t, WS_X + X_XBC), (const bf16_t*)(ws + WS_W + (size_t)l * W_LAYER + W_SSDO), 1280, D, D};   pg8::StaticOrder S; S.init(T / 8, D, RG, rg); S.pm0 = 16 * vg;
            pg8::EpiGate<false> E{WSP(bf16_t, WS_X + X_Z), WSP(bf16_t, WS_X + X_GS), 0, WSP(bf16_t, WS_X + X_Z)};
            pg8::gemm_phase<pg8::EpiGate<false>, pg8::StaticOrder, true, true>(lds, g, S, E, wave0);
            PHASE_DELAY();
        }
        if (PH(8)) for (int rep = 0; rep < NREP(8); ++rep) {
            PHASE_ENTER();
            pg8::Gemm g{WSP(bf16_t, WS_X + X_Q), (const bf16_t*)(ws + WS_W + (size_t)l * W_LAYER + W_SBO), 512, 512, 512}; pg8::StaticOrder S; S.init(T / 8, D, RG, rg); S.pm0 = 16 * vg;
            if ((MIX8_MASK >> l) & 1) {
                pg8::EpiGate<true, true> E{WSP(bf16_t, WS_X + X_Z), WSP(bf16_t, WS_X + X_GS), 1024, WSP(bf16_t, WS_X + X_Z), WSP(unsigned char, WS_X + X_XT)};
                pg8::gemm_phase<pg8::EpiGate<true, true>, pg8::StaticOrder, true, true>(lds, g, S, E, wave0);
            } else {
            pg8::EpiGate<true> E{(rep + 1 < NREP(8)) ? WSP(bf16_t, WS_X + X_XT) : WSP(bf16_t, WS_X + X_Z), WSP(bf16_t, WS_X + X_GS), 1024, WSP(bf16_t, WS_X + X_Z)};
            pg8::gemm_phase<pg8::EpiGate<true>, pg8::StaticOrder, true, true>(lds, g, S, E, wave0); }
            LOCAL_BAR();
        }
        if (PH(9)) for (int rep = 0; rep < NREP(9); ++rep) {
            PHASE_ENTER();
            if ((MIX8_MASK >> l) & 1) {
                pg8::Gemm g{WSP(bf16_t, WS_X + X_XT), (const bf16_t*)(ws + WS_W + (size_t)l * W_LAYER + W_OUT), 2048, D, D}; pg8::StaticOrder S; S.init(T / 8, D, RG, rg); S.pm0 = 16 * vg;
                pg8::EpiResidBfT<true, true> E{WSP(bf16_t, WS_HB), WSP(bf16_t, WS_HB), WSP(float, WS_SSQ + (size_t)(3 * l) * SSQ_BYTES), (LAS float*)(lds + 131072), WSP(unsigned char, WS_X + X_HB8), 1.f / F8_WGU};
                pg8::gemm_phase<pg8::EpiResidBfT<true, true>, pg8::StaticOrder, true, true, true>(lds, g, S, E, wave0);
            } else {
            pg8::Gemm g{WSP(bf16_t, WS_X + X_Z), (const bf16_t*)(ws + WS_W + (size_t)l * W_LAYER + W_OUT), D, D, D}; pg8::StaticOrder S; S.init(T / 8, D, RG, rg); S.pm0 = 16 * vg;
            pg8::EpiResidBf E{WSP(bf16_t, WS_HB), (rep + 1 < NREP(9)) ? WSP(bf16_t, WS_X + X_XT) : WSP(bf16_t, WS_HB), WSP(float, WS_SSQ + (size_t)((rep + 1 < NREP(9)) ? 13 : 3 * l) * SSQ_BYTES), (LAS float*)(lds + 131072)};
            pg8::gemm_phase<pg8::EpiResidBf, pg8::StaticOrder, true, true>(lds, g, S, E, wave0); }
            LOCAL_BAR();
        }
        if (PH(11)) for (int rep = 0; rep < NREP(11); ++rep) {
            PHASE_ENTER();
            const bool q8 = (MIX8_MASK >> l) & 1;
            pg8::Gemm g{q8 ? WSP(bf16_t, WS_X + X_HB8) : WSP(bf16_t, WS_HB), (const bf16_t*)(ws + WS_W + (size_t)l * W_LAYER + W_Q), D, D, D}; pg8::StaticOrder S; S.init(T / 8, 512, RG, rg); S.pm0 = 16 * vg;
            pg8::EpiBf16Rs E{WSP(bf16_t, WS_X + X_K), 512, WSP(float, WS_SSQ + (size_t)(3 * l) * SSQ_BYTES), 0.12751743082459868f * (q8 ? 1.f / F8_WGU : 1.f), 1};
            if (q8) pg8::gemm_phase<pg8::EpiBf16Rs, pg8::StaticOrder, true, true, true>(lds, g, S, E, wave0);
            else pg8::gemm_phase<pg8::EpiBf16Rs, pg8::StaticOrder, true, true, false>(lds, g, S, E, wave0);
            LOCAL_BAR();
        }
        if (PH(12)) for (int rep = 0; rep < NREP(12); ++rep) {
            PHASE_ENTER();
            xattn_lds(WSP(bf16_t, WS_X + X_K), WSP(bf16_t, WS_KM) + l * 512, WSP(bf16_t, WS_VTM) + (size_t)l * 512 * TM, WSP(bf16_t, WS_X + X_V), vg, rg, RG, tid, wave, lane, lds);
            LOCAL_BAR();
        }
        if (PH(13)) for (int rep = 0; rep < NREP(13); ++rep) {
            PHASE_ENTER();
            pg8::Gemm g{WSP(bf16_t, WS_X + X_V), (const bf16_t*)(ws + WS_W + (size_t)l * W_LAYER + W_O), 512, 512, 512}; pg8::StaticOrder S; S.init(T / 8, D, RG, rg); S.pm0 = 16 * vg;
            pg8::EpiResidBfT<true, false> E{WSP(bf16_t, WS_HB), (rep + 1 < NREP(13)) ? WSP(bf16_t, WS_X + X_XT) : WSP(bf16_t, WS_HB), WSP(float, WS_SSQ + (size_t)((rep + 1 < NREP(13)) ? 13 : 3 * l + 1) * SSQ_BYTES), (LAS float*)(lds + 131072),
                                            WSP(unsigned char, WS_X + X_HB8), 1.f};
            pg8::gemm_phase<pg8::EpiResidBfT<true, false>, pg8::StaticOrder, true, true>(lds, g, S, E, wave0);
            if (moe) LOCAL_BAR(); else GRID_BAR();
        }
        if (moe && PH(14)) for (int rep = 0; rep < NREP(14); ++rep) {
            PHASE_ENTER();
            const bf16_t* HB = WSP(bf16_t, WS_HB); float* RS = WSP(float, WS_RS); const float* SSQ = WSP(float, WS_SSQ + (size_t)(3 * l + 1) * SSQ_BYTES);
            int* TE = WSP(int, WS_MOE + MO_TE); float* TW = WSP(float, WS_MOE + MO_TW); int* TP = WSP(int, WS_MOE + MO_TP); unsigned* CNT = WSP(unsigned, WS_CTL) + CW_CNT + jf * 1024;
            LAS float* wsm = (LAS float*)lds;
            LAS unsigned* lcnt = (LAS unsigned*)(lds + 32768); LAS unsigned* lbase = lcnt + 16;
            LAS int* le = (LAS int*)(lds + 32768 + 128); LAS int* lp = le + 256;
#pragma unroll
            for (int q = 0; q < 16; ++q) { const int i = tid + 512 * q; const int e = i >> 10, k = i & 1023; wsm[i] = p.in[I_MOE_R][(size_t)jf * D * NEXP + (size_t)k * NEXP + e] * p.in[I_NORM_FFN][l * D + k]; }
            const int gwl = rg * 8 + wave, NGL = RG * 8, tok0 = vg * (T / 8);
            for (int k0 = 0; gwl + k0 * NGL < T / 8; k0 += 16) {
                __syncthreads();
                if (tid < 16) lcnt[tid] = 0u;
                __syncthreads();
                u32x2 xn[4]; f32x4 qn = {0.f, 0.f, 0.f, 0.f};
                { const int ml0 = gwl + k0 * NGL; const int m0 = tok0 + (ml0 < T / 8 ? ml0 : 0);
#pragma unroll
                  for (int j = 0; j < 4; ++j) xn[j] = ((const u32x2*)(HB + (size_t)m0 * D) + lane)[64 * j];
                  qn = *(const f32x4*)(SSQ + (size_t)m0 * 4); }
                for (int k = 0; k < 16; ++k) { const int ml = gwl + (k0 + k) * NGL; if (ml >= T / 8) break; const int m = tok0 + ml;
                    u32x2 xc[4];
#pragma unroll
                    for (int j = 0; j < 4; ++j) xc[j] = xn[j];
                    float lg[8]; const float r = rstd_of((qn.x + qn.y) + (qn.z + qn.w));
                    { const int mln = gwl + (k0 + k + 1) * NGL; const int mn = tok0 + ((k + 1 < 16 && mln < T / 8) ? mln : ml);
#pragma unroll
                      for (int j = 0; j < 4; ++j) xn[j] = ((const u32x2*)(HB + (size_t)mn * D) + lane)[64 * j];
                      qn = *(const f32x4*)(SSQ + (size_t)mn * 4); }
                    row_dots_raw<8>(xc, lane, wsm, r, lg);
                    if (lane == 0) { RS[m] = r;
                        int i0 = 0; float v0 = lg[0];
#pragma unroll
                        for (int e = 1; e < 8; ++e) if (lg[e] > v0) { v0 = lg[e]; i0 = e; }
                        int i1 = -1; float v1 = -3.0e38f;
#pragma unroll
                        for (int e = 0; e < 8; ++e) if (e != i0 && lg[e] > v1) { v1 = lg[e]; i1 = e; }
                        const float w0 = __builtin_amdgcn_rcpf(1.f + fexp(v1 - v0));
                        const int li = k * 8 + wave;
                        le[li] = i0; le[128 + li] = i1;
                        lp[li] = (int)__hip_atomic_fetch_add(lcnt + i0, 1u, __ATOMIC_RELAXED, __HIP_MEMORY_SCOPE_WORKGROUP);
                        lp[128 + li] = (int)__hip_atomic_fetch_add(lcnt + 8 + i1, 1u, __ATOMIC_RELAXED, __HIP_MEMORY_SCOPE_WORKGROUP);
                        TE[m] = i0; TE[T + m] = i1; TW[m] = w0; TW[T + m] = 1.f - w0; }
                }
                __syncthreads();
                if (tid < 16 && rep + 1 == NREP(14)) lbase[tid] = atomicAdd(CNT + tid * 64, lcnt[tid]);
                __syncthreads();
                if (rep + 1 == NREP(14))
                for (int li = tid; li < 256; li += 512) { const int sl = li >> 7, idx = li & 127, ml = (rg * 8 + (idx & 7)) + (k0 + (idx >> 3)) * NGL;
                    if (ml < T / 8) TP[sl * T + tok0 + ml] = (int)lbase[sl * 8 + le[li]] + lp[li]; }
            }
            GRID_BAR();
        }
        if (!moe) {
            if (PH(15)) for (int rep = 0; rep < NREP(15); ++rep) {
                PHASE_ENTER();
#define DENSE_GU(GU8, DN8) do { pg8::Gemm g{GU8 ? WSP(bf16_t, WS_X + X_HB8) : WSP(bf16_t, WS_HB), (const bf16_t*)(ws + WS_WFF + (size_t)jf * W_FF + W_GU), D, D, D}; pg8::StaticOrder S; S.init(T / 8, 2 * DFF, RG, rg); S.pm0 = 16 * vg; \
                pg8::EpiSwigluT<DN8> E{WSP(bf16_t, WS_X + X_ACT), WSP(float, WS_SSQ + (size_t)(3 * l + 1) * SSQ_BYTES), 1, GU8 ? 1.f / F8_WGU : 1.f}; \
                pg8::gemm_phase<pg8::EpiSwigluT<DN8>, pg8::StaticOrder, true, true, GU8>(lds, g, S, E, wave0); } while (0)
                const bool gu8 = (DENSE_GU8_MASK >> jf) & 1, dn8 = (DENSE_DN8_MASK >> jf) & 1;
                if (gu8 && dn8) DENSE_GU(true, true); else if (gu8) DENSE_GU(true, false); else if (dn8) DENSE_GU(false, true); else DENSE_GU(false, false);
                LOCAL_BAR();
            }
            if (PH(16)) for (int rep = 0; rep < NREP(16); ++rep) {
                PHASE_ENTER();
                pg8::Gemm g{WSP(bf16_t, WS_X + X_ACT), (const bf16_t*)(ws + WS_WFF + (size_t)jf * W_FF + W_DN), DFF, DFF, DFF}; pg8::StaticOrder S; S.init(T / 8, D, RG, rg); S.pm0 = 16 * vg;
                pg8::EpiResidBfT<true, true> E{WSP(bf16_t, WS_HB), (rep + 1 < NREP(16)) ? WSP(bf16_t, WS_X + X_GS) : WSP(bf16_t, WS_HB), WSP(float, WS_SSQ + (size_t)((rep + 1 < NREP(16)) ? 13 : 3 * l + 2) * SSQ_BYTES), (LAS float*)(lds + 131072),
                                               WSP(unsigned char, WS_X + X_HB8), ((DENSE_DN8_MASK >> jf) & 1) ? 1.f / F8_WDN : 1.f};
                if ((DENSE_DN8_MASK >> jf) & 1) pg8::gemm_phase<pg8::EpiResidBfT<true, true>, pg8::StaticOrder, true, true, true>(lds, g, S, E, wave0);
                else pg8::gemm_phase<pg8::EpiResidBfT<true, true>, pg8::StaticOrder, true, true, false>(lds, g, S, E, wave0);
                GRID_BAR();
            }
        } else {
            if (PH(15)) for (int rep = 0; rep < NREP(15); ++rep) {
                PHASE_ENTER();
                const bf16_t* HB = WSP(bf16_t, WS_HB); const float* RS = WSP(float, WS_RS); bf16_t* XG = WSP(bf16_t, WS_X + X_XG);
                const int* TE = WSP(int, WS_MOE + MO_TE); const float* TW = WSP(float, WS_MOE + MO_TW); const int* TP = WSP(int, WS_MOE + MO_TP); unsigned* CNT = WSP(unsigned, WS_CTL) + CW_CNT + jf * 1024;
                int* ROWL = WSP(int, WS_MOE + MO_ROWL); float* WROW = WSP(float, WS_MOE + MO_WROW); float* RSG = WSP(float, WS_MOE + MO_RSG);
                unsigned* PEXP = WSP(unsigned, WS_MOE + MO_PEXP); unsigned* NPAN = WSP(unsigned, WS_MOE + MO_NPAN);
                const unsigned cntv = ld_u32_agent(CNT + (lane & 15) * 64);
#pragma unroll
                for (int s = 0; s < 2; ++s) {
                    int off[9]; { int a = 0;
#pragma unroll
                        for (int e = 0; e < 8; ++e) { off[e] = a; a += ((int)__builtin_amdgcn_readlane(cntv, s * 8 + e) + 255) & ~255; }
                        off[8] = a; }
                    if (bid == 0 && tid == 0) { NPAN[s] = (unsigned)(off[8] >> 8);
#pragma unroll
                        for (int e = 0; e < 8; ++e) for (int pnl = off[e] >> 8; pnl < (off[e + 1] >> 8); ++pnl) PEXP[s * 256 + pnl] = (unsigned)e; }
                    for (int m0 = gw; m0 < T; m0 += 4 * NGW) {
                        int rowq[4]; float twq[4], rsq[4];
#pragma unroll
                        for (int q = 0; q < 4; ++q) { const int m = m0 + q * NGW < T ? m0 + q * NGW : m0; const int e = TE[s * T + m]; int o = 0;
#pragma unroll
                            for (int k = 0; k < 8; ++k) o = (e == k) ? off[k] : o;
                            rowq[q] = o + TP[s * T + m]; twq[q] = TW[s * T + m]; rsq[q] = RS[m]; }
                        u32x4 r0[4], r1[4];
#pragma unroll
                        for (int q = 0; q < 4; ++q) { const int m = m0 + q * NGW < T ? m0 + q * NGW : m0;
                            if (MOE_F8_GU) { r0[q] = ((const u32x4*)(WSP(unsigned char, WS_X + X_HB8) + (size_t)m * D))[lane]; r1[q] = r0[q]; }
                            else { const u32x4* src = (const u32x4*)(HB + (size_t)m * D); r0[q] = src[lane]; r1[q] = src[lane + 64]; } }
#pragma unroll
                        for (int q = 0; q < 4; ++q) { const int m = m0 + q * NGW; if (m < T) { const int row = rowq[q];
                            if (MOE_F8_GU) { u32x4* dst = (u32x4*)((unsigned char*)XG + ((size_t)s * MOE_ROWS + row) * D); dst[lane] = r0[q]; }
                            else { u32x4* dst = (u32x4*)(XG + ((size_t)s * MOE_ROWS + row) * D); dst[lane] = r0[q]; dst[lane + 64] = r1[q]; }
                            if (lane == 0) { ROWL[s * MOE_ROWS + row] = m; WROW[s * MOE_ROWS + row] = twq[q]; RSG[s * MOE_ROWS + row] = rsq[q]; } } } }
#pragma unroll
                    for (int e = 0; e < 8; ++e) { const int c = (int)__builtin_amdgcn_readlane(cntv, s * 8 + e); const int lo = off[e] + c, hi = off[e + 1];
                        for (int row = lo + gw; row < hi; row += NGW) { unsigned z0 = 0u; asm volatile("" : "+v"(z0)); const u32x4 zz = {z0, z0, z0, z0};
                            if (MOE_F8_GU) { u32x4* dst = (u32x4*)((unsigned char*)XG + ((size_t)s * MOE_ROWS + row) * D); dst[lane] = zz; }
                            else { u32x4* dst = (u32x4*)(XG + ((size_t)s * MOE_ROWS + row) * D); dst[lane] = zz; dst[lane + 64] = zz; }
                            if (lane == 0) { ROWL[s * MOE_ROWS + row] = -1; WROW[s * MOE_ROWS + row] = 0.f; RSG[s * MOE_ROWS + row] = 0.f; } } }
                }
                GRID_BAR();
            }
            if (PH(16)) for (int rep = 0; rep < NREP(16); ++rep) {
                PHASE_ENTER();
                const int npan = (int)__builtin_amdgcn_readfirstlane(ld_u32_agent(WSP(unsigned, WS_MOE + MO_NPAN)));
                LAS unsigned* PXL = (LAS unsigned*)(lds + 131072 + 8192); pg8::moe_pexp_to_lds(WSP(unsigned, WS_MOE + MO_PEXP), PXL, tid);
                pg8::Gemm g{WSP(bf16_t, WS_X + X_XG), WSP(bf16_t, WS_WMOE + WM_GU), D, D, D}; pg8::MoeOrder S; S.init(npan, 2 * DFF / 256, G, bid, PXL);
                pg8::EpiSwigluT<(bool)MOE_F8_DN> E{WSP(bf16_t, WS_X + X_ACT), WSP(float, WS_MOE + MO_RSG), 0, MOE_F8_GU ? 1.f / F8_WGU : 1.f};
                pg8::gemm_phase<pg8::EpiSwigluT<(bool)MOE_F8_DN>, pg8::MoeOrder, true, true, (bool)MOE_F8_GU>(lds, g, S, E, wave0);
                {
                  const int n0 = npan * (2 * DFF / 256), f0 = n0 % G;
                  const int npan1 = (int)__builtin_amdgcn_readfirstlane(ld_u32_agent(WSP(unsigned, WS_MOE + MO_NPAN) + 1));
                  pg8::Gemm g1{(const bf16_t*)(ws + WS_X + X_XG + (size_t)MOE_ROWS * D * (MOE_F8_GU ? 1 : 2)), WSP(bf16_t, WS_WMOE + WM_GU), D, D, D};
                  pg8::MoeOrder S1; S1.init(npan1, 2 * DFF / 256, 1 << 28, (f0 > 0 && bid >= f0) ? bid - f0 : (1 << 28), PXL + 256);
                  pg8::EpiSwigluT<(bool)MOE_F8_DN> E1{WSP(bf16_t, WS_X + X_ACT2), WSP(float, WS_MOE + MO_RSG) + MOE_ROWS, 0, MOE_F8_GU ? 1.f / F8_WGU : 1.f};
                  pg8::gemm_phase<pg8::EpiSwigluT<(bool)MOE_F8_DN>, pg8::MoeOrder, true, true, (bool)MOE_F8_GU>(lds, g1, S1, E1, wave0); }
                GRID_BAR();
            }
            if (PH(17)) {
                PHASE_ENTER();
                LAS unsigned* PXL = (LAS unsigned*)(lds + 131072 + 8192); pg8::moe_pexp_to_lds(WSP(unsigned, WS_MOE + MO_PEXP), PXL, tid);
                { const int npan = (int)__builtin_amdgcn_readfirstlane(ld_u32_agent(WSP(unsigned, WS_MOE + MO_NPAN)));
                  pg8::Gemm g{WSP(bf16_t, WS_X + X_ACT), WSP(bf16_t, WS_WMOE + WM_DN), DFF, DFF, DFF}; pg8::MoeOrder S; S.init(npan, D / 256, G, bid, PXL);
                  pg8::EpiMoeDown E{WSP(bf16_t, WS_HB), WSP(int, WS_MOE + MO_ROWL), WSP(float, WS_MOE + MO_WROW), WSP(bf16_t, WS_HB), nullptr, (LAS float*)(lds + 131072), MOE_F8_DN ? 1.f / F8_WDN : 1.f};
                  pg8::gemm_phase<pg8::EpiMoeDown, pg8::MoeOrder, true, true, (bool)MOE_F8_DN>(lds, g, S, E, wave0); }
                { const int npan = (int)__builtin_amdgcn_readfirstlane(ld_u32_agent(WSP(unsigned, WS_MOE + MO_NPAN) + 1));
                  pg8::Gemm g{(const bf16_t*)(ws + WS_X + X_XG + (size_t)MOE_ROWS * D * (MOE_F8_GU ? 1 : 2)), WSP(bf16_t, WS_WMOE + WM_GU), D, D, D}; pg8::MoeOrder S; S.init(npan, 2 * DFF / 256, G, bid, PXL + 256);
                  {
                    const int npan0 = (int)__builtin_amdgcn_readfirstlane(ld_u32_agent(WSP(unsigned, WS_MOE + MO_NPAN)));
                    const int n0 = npan0 * (2 * DFF / 256), f0 = n0 % G, n1 = npan * (2 * DFF / 256); int F = f0 > 0 ? G - f0 : 0; F = F < n1 ? F : n1;
                    const int h9 = (npan0 * (D / 256)) % G, heavy = bid < h9;
                    S.ne = heavy ? 0 : 2; S.stride0 = G - h9; S.c0 = bid - h9; S.base0 = F; S.base1 = (long)F + 2 * (G - h9); S.c = heavy ? G - h9 + bid : bid - h9; }
                  pg8::EpiSwigluT<(bool)MOE_F8_DN> E{WSP(bf16_t, WS_X + X_ACT2), WSP(float, WS_MOE + MO_RSG) + MOE_ROWS, 0, MOE_F8_GU ? 1.f / F8_WGU : 1.f};
                  pg8::gemm_phase<pg8::EpiSwigluT<(bool)MOE_F8_DN>, pg8::MoeOrder, true, true, (bool)MOE_F8_GU>(lds, g, S, E, wave0); }
                GRID_BAR();
            }
            if (PH(19)) for (int rep = 0; rep < NREP(19); ++rep) {
                PHASE_ENTER();
                LAS unsigned* PXL = (LAS unsigned*)(lds + 131072 + 8192); pg8::moe_pexp_to_lds(WSP(unsigned, WS_MOE + MO_PEXP), PXL, tid);
                const int npan = (int)__builtin_amdgcn_readfirstlane(ld_u32_agent(WSP(unsigned, WS_MOE + MO_NPAN) + 1));
                pg8::Gemm g{WSP(bf16_t, WS_X + X_ACT2), WSP(bf16_t, WS_WMOE + WM_DN), DFF, DFF, DFF}; pg8::MoeOrder S; S.init(npan, D / 256, G, bid, PXL + 256);
                pg8::EpiMoeDown E{WSP(bf16_t, WS_HB), WSP(int, WS_MOE + MO_ROWL) + MOE_ROWS, WSP(float, WS_MOE + MO_WROW) + MOE_ROWS, (rep + 1 < NREP(19)) ? WSP(bf16_t, WS_X + X_GS) : WSP(bf16_t, WS_HB),
                                  WSP(float, WS_SSQ + (size_t)((rep + 1 < NREP(19)) ? 13 : 3 * l + 2) * SSQ_BYTES), (LAS float*)(lds + 131072), MOE_F8_DN ? 1.f / F8_WDN : 1.f, WSP(unsigned char, WS_X + X_HB8)};
                pg8::gemm_phase<pg8::EpiMoeDown, pg8::MoeOrder, true, true, (bool)MOE_F8_DN>(lds, g, S, E, wave0);
                if (l + 2 < DEPTH && rep + 1 == NREP(19)) {
                    const int nx = npan * (D / 256) - 2 * G > 0 ? npan * (D / 256) - 2 * G : 0;
                    if (bid >= nx) moe_convert(p, ws, l + 2, jf + 1, 3, (bid - nx) * 8 + wave, (G - nx) * 8, (LAS float*)(lds + wave * 16384), lane);
                }
                GRID_BAR();
            }
        }
    }
    if (p.l_hi == DEPTH && PH(20)) {
        PHASE_ENTER();
        const float* gf = p.in[I_FINAL]; float* O = p.out; const bf16_t* HB = WSP(bf16_t, WS_HB); const float* SSQ = WSP(float, WS_SSQ + (size_t)(3 * DEPTH - 1) * SSQ_BYTES);
        for (int m = gw; m < T; m += NGW) { const float rstd = rstd4(SSQ + (size_t)m * 4); const u32x2* xr = (const u32x2*)(HB + (size_t)m * D) + lane; f32x4* orow = (f32x4*)(O + (size_t)m * D) + lane;
#pragma unroll
            for (int j = 0; j < 4; ++j) { const u32x2 w = xr[64 * j]; const f32x4 g4 = *((const f32x4*)gf + lane + 64 * j); orow[64 * j] = (f32x4){bflo(w.x), bfhi(w.x), bflo(w.y), bfhi(w.y)} * rstd * g4; } }
        PHASE_DELAY();
    }
#undef PH
#undef GRID_BAR
}

extern "C" void kernel_launch(void* const* d_in, const int* in_sizes, int n_in, void* d_out, int out_size, void* d_ws, size_t ws_size, hipStream_t stream) {
    static int grid = 0;
    if (grid == 0) {
        if (n_in != 28 || out_size != T * D || ws_size < WS_END) { fprintf(stderr, "kernel_launch: unexpected problem (n_in %d, out %d, ws %zu < %zu)\n", n_in, out_size, ws_size, (size_t)WS_END); grid = -1; return; }
        int dev = 0, cus = 0;
        if (hipGetDevice(&dev) != hipSuccess || hipDeviceGetAttribute(&cus, hipDeviceAttributeMultiprocessorCount, dev) != hipSuccess) { grid = -1; return; }
        if (hipFuncSetAttribute((const void*)mk_fwd, hipFuncAttributeMaxDynamicSharedMemorySize, LDS_BYTES) != hipSuccess) { fprintf(stderr, "kernel_launch: hipFuncSetAttribute failed\n"); grid = -1; return; }
        int per_cu = 0;
        if (hipOccupancyMaxActiveBlocksPerMultiprocessor(&per_cu, (const void*)mk_fwd, 512, LDS_BYTES) != hipSuccess || per_cu < 1) { fprintf(stderr, "kernel_launch: occupancy query says %d\n", per_cu); (void)hipGetLastError(); }
        grid = cus;
    }
    if (grid < 0) return;
    (void)hipMemsetAsync((char*)d_ws + WS_CTL, 0, 1 * MiB, stream);
    Params p{};
    for (int i = 0; i < 28; ++i) p.in[i] = (const float*)d_in[i];
    p.out = (float*)d_out; p.ws = (unsigned char*)d_ws;
#if MK_ONE_LAUNCH
    p.l_lo = 0; p.l_hi = DEPTH; p.ph_lo = 0; p.ph_hi = 21;
    hipLaunchKernelGGL(mk_fwd, dim3(grid), dim3(512), LDS_BYTES, stream, p);
#else
    auto launch = [&](int l, int ph) { p.l_lo = l; p.l_hi = l + 1; p.ph_lo = ph; p.ph_hi = ph + 1; hipLaunchKernelGGL(mk_fwd, dim3(grid), dim3(512), LDS_BYTES, stream, p); };
    launch(0, 0); launch(0, 1);
    for (int l = 0; l < DEPTH; ++l) { const int last = (l & 1) ? 19 : 16; for (int ph = 2; ph <= last; ++ph) launch(l, ph); }
    launch(DEPTH - 1, 20);
#endif
}
```

```cpp
#include <hip/hip_runtime.h>
#include <cstdio>
#include <cstdint>

#define LAS __attribute__((address_space(3)))
#define GAS __attribute__((address_space(1)))
typedef unsigned short bf16_t;
typedef short bf16x8 __attribute__((ext_vector_type(8)));
typedef float f32x4 __attribute__((ext_vector_type(4)));
typedef float f32x2 __attribute__((ext_vector_type(2)));
typedef unsigned u32x4 __attribute__((ext_vector_type(4)));
typedef unsigned u32x2 __attribute__((ext_vector_type(2)));

#ifndef PROBE_MASK
#define PROBE_MASK 0u
#endif
#define NREP(k) ((int)((PROBE_MASK >> (k)) & 1u) + 1)
#ifndef DELAY_MASK
#define DELAY_MASK 0u
#endif
#ifndef PROBE_VAR
#define PROBE_VAR 0
#endif
#ifndef MK_ONE_LAUNCH
#define MK_ONE_LAUNCH 1
#define DENSE_GU8_MASK 2
#define DENSE_DN8_MASK 2
#define INPROJ8_MASK 12
#define MIX8_MASK 0
static_assert((MIX8_MASK & ~INPROJ8_MASK) == 0, "fp8 v rows live in the fp8 layout of W_IN");
#define MOE_F8_GU 1
#define MOE_F8_DN 1
#endif

constexpr int T = 32768, D = 1024, SEQ = 2048, NBATCH = 16, DEPTH = 4, MEMLEN = 256, TM = NBATCH * MEMLEN;
constexpr int INW = 5904, NPROJ = 6144, NMAIN = 5632, DFF = 2816, NEXP = 8;
constexpr int MOE_ROWS = T + NEXP * 256;
constexpr int MOE_PAN = MOE_ROWS / 256;
constexpr float EPS = 1e-6f;

constexpr size_t MiB = 1u << 20;
constexpr size_t WS_CTL = 0;
constexpr size_t WS_RS = 1 * MiB;
constexpr size_t WS_RSMEM = WS_RS + 256 * 1024;
constexpr size_t WS_DT = 2 * MiB;
constexpr size_t WS_MOE = 4 * MiB;
constexpr size_t WS_SSQ_OLD_UNUSED = 6 * MiB;
constexpr size_t SSQ_BYTES = (size_t)T * 16;
constexpr size_t WS_KM = 8 * MiB;
constexpr size_t WS_VTM = 24 * MiB;
constexpr size_t WS_MEMB = 40 * MiB;
constexpr size_t WS_HB = 48 * MiB;
constexpr size_t WS_W = 112 * MiB;
constexpr size_t W_IN = 0, W_SSDO = W_IN + (size_t)NPROJ * 1024 * 2, W_SBO = W_SSDO + 2 * MiB, W_OUT = W_SBO + 1 * MiB, W_Q = W_OUT + 2 * MiB, W_O = W_Q + 1 * MiB, W_LAYER = W_O + 1 * MiB;
constexpr size_t WS_WKV = WS_W + 4 * W_LAYER;
constexpr size_t WS_WFF = WS_WKV + 8 * MiB;
constexpr size_t W_GU = 0, W_DN = (size_t)2 * DFF * 1024 * 2, W_FF = W_DN + (size_t)1024 * DFF * 2;
constexpr size_t WS_WMOE = WS_WFF + 2 * W_FF;
constexpr size_t WM_GU = 0, WM_DN = (size_t)NEXP * 2 * DFF * 1024 * 2;
constexpr size_t WS_X = WS_WMOE + NEXP * W_FF;
constexpr size_t X_Z = 0, X_XBC = X_Z + 64 * MiB, X_XT = X_XBC + 80 * MiB, X_BR = X_XT + 64 * MiB, X_BT = X_BR + 8 * MiB, X_CR = X_BT + 8 * MiB, X_Q = X_CR + 8 * MiB, X_K = X_Q + 32 * MiB, X_V = X_K + 32 * MiB,
                 X_GS = X_V + 32 * MiB, X_PREV = X_GS + 128 * MiB, X_END = 512 * MiB;
constexpr size_t X_HB8 = 456 * MiB;
static_assert(X_HB8 == X_PREV, "HB8 overlays PREV");
constexpr float F8_WGU = 32.f, F8_WDN = 64.f;
constexpr size_t X_ACT = 0;
constexpr size_t X_ACT2 = 188 * MiB;
constexpr size_t X_XG = 376 * MiB;
constexpr size_t WS_SSQ = WS_X + X_END;
constexpr size_t WS_END = WS_SSQ + 8 * MiB;
static_assert(X_XG + (size_t)2 * MOE_ROWS * 1024 * 2 <= X_END, "moe region");
static_assert((size_t)MOE_ROWS * DFF * 2 <= X_ACT2 && X_ACT2 + (size_t)MOE_ROWS * DFF * 2 <= X_XG && X_PREV + 32 * MiB <= X_END, "act regions");
constexpr size_t MO_TE = 0, MO_TW = MO_TE + 2 * T * 4, MO_TP = MO_TW + 2 * T * 4, MO_ROWL = MO_TP + 2 * T * 4, MO_WROW = MO_ROWL + 2 * MOE_ROWS * 4, MO_RSG = MO_WROW + 2 * MOE_ROWS * 4,
                 MO_PEXP = MO_RSG + 2 * MOE_ROWS * 4, MO_NPAN = MO_PEXP + 2 * 256 * 4, MO_END = MO_NPAN + 256;
static_assert(MO_END <= 2 * MiB, "moe tables");
constexpr int CW_BAR = 4096;
constexpr int CW_LBAR = 24576;
constexpr int CW_PLC = 28672;
constexpr int CW_CNT = 16384;

constexpr int RING_BYTES = 155648;
constexpr int LDSCTL_OFF = RING_BYTES;
constexpr int LDS_BYTES = 160 * 1024;

__device__ __forceinline__ float bf2f(unsigned b) { return __builtin_bit_cast(float, b << 16); }
__device__ __forceinline__ float bflo(unsigned w) { return __builtin_bit_cast(float, w << 16); }
__device__ __forceinline__ float bfhi(unsigned w) { return __builtin_bit_cast(float, w & 0xffff0000u); }
__device__ __forceinline__ unsigned cvt_pk_bf16(float lo, float hi) { unsigned r; asm volatile("v_cvt_pk_bf16_f32 %0, %1, %2" : "=v"(r) : "v"(lo), "v"(hi)); return r; }
__device__ __forceinline__ unsigned short f2bf(float f) { return (unsigned short)(cvt_pk_bf16(f, 0.f) & 0xffffu); }
__device__ __forceinline__ unsigned cvt_pk_fp8(float a, float b, float c, float d) { int w = __builtin_amdgcn_cvt_pk_fp8_f32(a, b, 0, false); w = __builtin_amdgcn_cvt_pk_fp8_f32(c, d, w, true); return (unsigned)w; }
__device__ __forceinline__ float wave_sum(float v) {
#pragma unroll
    for (int o = 1; o < 64; o <<= 1) v += __shfl_xor(v, o);
    return v;
}
__device__ __forceinline__ float wave_max(float v) {
#pragma unroll
    for (int o = 1; o < 64; o <<= 1) v = fmaxf(v, __shfl_xor(v, o));
    return v;
}
__device__ __forceinline__ float fexp(float x) { return __builtin_amdgcn_exp2f(1.4426950408889634f * x); }
__device__ __forceinline__ float softplusf_(float x) { return fmaxf(x, 0.f) + 0.6931471805599453f * __builtin_amdgcn_logf(1.f + __builtin_amdgcn_exp2f(-1.4426950408889634f * fabsf(x))); }
__device__ __forceinline__ float sigmoidf_(float x) { return __builtin_amdgcn_rcpf(1.f + __builtin_amdgcn_exp2f(-1.4426950408889634f * x)); }
__device__ __forceinline__ unsigned ld_u32_agent(const unsigned* p) { return __hip_atomic_load(p, __ATOMIC_RELAXED, __HIP_MEMORY_SCOPE_AGENT); }
__device__ __forceinline__ float ld_f32_agent(const float* p) { return __builtin_bit_cast(float, __hip_atomic_load((const unsigned*)p, __ATOMIC_RELAXED, __HIP_MEMORY_SCOPE_AGENT)); }
__device__ __forceinline__ float rstd_of(float sumsq) { return __builtin_amdgcn_rsqf(sumsq * (1.f / 1024.f) + 1e-6f); }
__device__ __forceinline__ void rstd4x8(const float* base, int stride_rows  , float (&rr)[8], float mul) {
    f32x4 q[8];
#pragma unroll
    for (int gI = 0; gI < 8; ++gI) q[gI] = *(const f32x4*)(base + (size_t)((gI >> 2) * stride_rows + (gI & 3) * 16) * 4);
    asm volatile("" ::: "memory");
#pragma unroll
    for (int gI = 0; gI < 8; ++gI) rr[gI] = __builtin_amdgcn_rsqf(((q[gI].x + q[gI].y) + (q[gI].z + q[gI].w)) * (1.f / 1024.f) + 1e-6f) * mul;
}
__device__ __forceinline__ float rstd4(const float* q4) { const f32x4 q = *(const f32x4*)q4; return rstd_of((q.x + q.y) + (q.z + q.w)); }
#define LDS_WAIT() asm volatile("s_waitcnt lgkmcnt(0)" ::: "memory")
__device__ __forceinline__ int lane_id_opaque() { int l; asm volatile("v_mbcnt_lo_u32_b32 %0, -1, 0\n\tv_mbcnt_hi_u32_b32 %0, -1, %0" : "=v"(l)); return l; }

namespace pg8 {
constexpr int BM = 256, BK = 64, HALF = 128, HTB = HALF * BK * 2, STAGE_BYTES = 8 * HTB, NXCD = 8, WGM = 8;
__host__ __device__ __forceinline__ int lds_byte(int r, int c) { const int st = (r >> 4) * 2 + (c >> 5), rr = r & 15, cc = c & 31, ob = rr * 64 + cc * 2; return st * 1024 + (ob ^ (((ob >> 9) & 1) << 5)); }
__host__ __device__ __forceinline__ void stage_rc(int b, int& R, int& C) { const unsigned ub = (unsigned)b, st = ub >> 10, sb = ub & 1023u, swz = sb ^ (((sb >> 9) & 1u) << 5); R = (int)((st >> 1) * 16u + (swz >> 6)); C = (int)((st & 1u) * 32u + ((swz & 63u) >> 1)); }
__host__ __device__ __forceinline__ int perm32(int rho) { const int n = rho >> 4, i = rho & 15; return 8 * (i >> 2) + 4 * n + (i & 3); }

struct Unit { int pm, pn, pb; };
struct Gemm { const bf16_t* A; const bf16_t* Bt; int lda, ldb, K; };

struct StaticOrder {
    int nM, nN, nwg, G, c; int pm0 = 0, pn0 = 0;
    __device__ void init(int M, int N, int G_, int c_) { nM = M / BM; nN = N / BM; nwg = nM * nN; G = G_; c = c_; }
    __device__ bool next(int i, Unit& u) const {
        const long L = (long)i * G + c; if (L >= nwg) return false;
        int wgid = (int)L; { const int q = nwg / NXCD, r = nwg % NXCD, xcd = wgid % NXCD, off = wgid / NXCD; wgid = (xcd < r ? xcd * (q + 1) : r * (q + 1) + (xcd - r) * q) + off; }
        const int nig = WGM * nN, gid = wgid / nig, fm = gid * WGM, gsz = (nM - fm) < WGM ? (nM - fm) : WGM;
        u.pm = fm + ((wgid % nig) % gsz) + pm0; u.pn = (wgid % nig) / gsz + pn0; u.pb = u.pn; return true;
    }
};
struct MoeOrder {
    int nM, nN, nwg, G, c; const LAS unsigned* pexp; int ne = 0, stride0 = 0, c0 = 0; long base0 = 0, base1 = 0;
    __device__ void init(int nM_, int nN_, int G_, int c_, const LAS unsigned* pexp_) { nM = nM_; nN = nN_; nwg = nM * nN; G = G_; c = c_; pexp = pexp_; }
    __device__ bool next(int i, Unit& u) const {
        const long L = i < ne ? base0 + (long)i * stride0 + c0 : base1 + (long)(i - ne) * G + c; if (L >= nwg) return false;
        int wgid = (int)L; { const int q = nwg / NXCD, r = nwg % NXCD, xcd = wgid % NXCD, off = wgid / NXCD; wgid = (xcd < r ? xcd * (q + 1) : r * (q + 1) + (xcd - r) * q) + off; }
        const int nig = WGM * nN, gid = wgid / nig, fm = gid * WGM, gsz = (nM - fm) < WGM ? (nM - fm) : WGM;
        u.pm = fm + ((wgid % nig) % gsz); u.pn = (wgid % nig) / gsz;
        const int e = (int)__builtin_amdgcn_readfirstlane(pexp[u.pm]); u.pb = e * nN + u.pn; return true;
    }
};

__device__ __forceinline__ void moe_pexp_to_lds(const unsigned* pexp_g, LAS unsigned* dst, int tid) {
    dst[tid] = ld_u32_agent(pexp_g + tid);
    __syncthreads();
}
typedef int i32x8 __attribute__((ext_vector_type(8)));
typedef int i32x4 __attribute__((ext_vector_type(4)));
template <class Epi, class Sched, bool ALIGN_EPI = false, bool SP2 = false, bool FP8 = false>
__device__ __forceinline__ void gemm_phase(LAS unsigned char* lds, const Gemm g, const Sched& S, const Epi& E, const int wave0) {
    int tid_ = wave0 * 64 + lane_id_opaque();
    const int tid = tid_, wid = __builtin_amdgcn_readfirstlane(tid >> 6), lane = tid & 63, wr = wid >> 2, wc = wid & 3, fr = lane & 15, fq = lane >> 4;
    constexpr int ESZ = FP8 ? 1 : 2;
    const int K = g.K, nt = K / (FP8 ? 2 * BK : BK);
    unsigned voffA[2], voffB[2];
    { int R, C; stage_rc(tid * 16, R, C); const int Rb = Epi::PERM ? ((R & ~31) + perm32(R & 31)) : R;
      voffA[0] = (unsigned)(R * g.lda) * ESZ + (unsigned)C * 2u; voffB[0] = (unsigned)(Rb * g.ldb) * ESZ + (unsigned)C * 2u; voffA[1] = voffA[0] + (unsigned)(64 * g.lda) * ESZ; voffB[1] = voffB[0] + (unsigned)(64 * g.ldb) * ESZ; }
    const size_t kstep = (size_t)(BK * 2);
    const size_t hsA = (size_t)HALF * g.lda * ESZ, hsB = (size_t)HALF * g.ldb * ESZ;
    const size_t tsA = 2 * hsA, tsB = 2 * hsB;
    const unsigned ldsw = (unsigned)wid * 1024u;
    const int swz_ = (fr * 64 + fq * 16) ^ ((fr & 8) << 2);
    const int aoff = wr * 8192 + swz_, boff = wc * 4096 + swz_;
    int sc1 = 0x7F7F7F7F; asm volatile("" : "+v"(sc1)); (void)sc1;
    constexpr int KD = 1024;
#define PG8_SA(b, h) (((b) * 2 + (h)) * HTB)
#define PG8_SB(b, h) ((4 + (b) * 2 + (h)) * HTB)
#define PG8_STAGE(bufoff, gbase, voff) do { _Pragma("unroll") for (int _i = 0; _i < 2; ++_i) \
        __builtin_amdgcn_global_load_lds((const unsigned*)((const char*)(gbase) + (voff)[_i]), (LAS unsigned*)(lds + (bufoff) + ldsw + _i * 8192), 16, 0, 0); } while (0)
#define PG8_LDA(dst, b, h) do { _Pragma("unroll") for (int m = 0; m < 4; ++m) _Pragma("unroll") for (int k = 0; k < 2; ++k) dst[m][k] = *(const LAS bf16x8*)(lds + PG8_SA(b, h) + aoff + m * 2048 + k * KD); } while (0)
#define PG8_LDB(dst, b, h) do { _Pragma("unroll") for (int n = 0; n < 2; ++n) _Pragma("unroll") for (int k = 0; k < 2; ++k) dst[n][k] = *(const LAS bf16x8*)(lds + PG8_SB(b, h) + boff + n * 2048 + k * KD); } while (0)
#define PG8_CAT8(x) __builtin_shufflevector(__builtin_bit_cast(i32x4, (x)[0]), __builtin_bit_cast(i32x4, (x)[1]), 0, 1, 2, 3, 4, 5, 6, 7)
#define PG8_MMA(ai, bj, At, Bt) do { __builtin_amdgcn_s_setprio(1); _Pragma("unroll") for (int m = 0; m < 4; ++m) _Pragma("unroll") for (int n = 0; n < 2; ++n) { \
        if constexpr (FP8) asm volatile("v_mfma_scale_f32_16x16x128_f8f6f4 %0, %1, %2, %0, %3, %3 op_sel_hi:[0,0,0]" : "+v"(acc[ai][bj][m][n]) : "v"(PG8_CAT8(Bt[n])), "v"(PG8_CAT8(At[m])), "v"(sc1)); \
        else { _Pragma("unroll") for (int k = 0; k < 2; ++k) acc[ai][bj][m][n] = __builtin_amdgcn_mfma_f32_16x16x32_bf16(Bt[n][k], At[m][k], acc[ai][bj][m][n], 0, 0, 0); } } __builtin_amdgcn_s_setprio(0); } while (0)
#define PG8_WAIT_V(n) asm volatile("s_waitcnt vmcnt(" #n ")" ::: "memory")
#define PG8_WAIT_L(n) asm volatile("s_waitcnt lgkmcnt(" #n ")" ::: "memory")
#define PG8_BAR __builtin_amdgcn_s_barrier()
#define PG8_SCHED __builtin_amdgcn_sched_barrier(0)
    Unit cur, nxt; int ui = 0;
    if (!S.next(0, cur)) return;
    f32x4 acc[2][2][4][2];
#pragma unroll
    for (int a = 0; a < 2; ++a)
#pragma unroll
        for (int b = 0; b < 2; ++b)
#pragma unroll
            for (int m = 0; m < 4; ++m)
#pragma unroll
                for (int n = 0; n < 2; ++n) acc[a][b][m][n] = (f32x4){0.f, 0.f, 0.f, 0.f};
    bf16x8 At[4][2], B0[2][2], B1[2][2];
    const char* cA = (const char*)g.A + (size_t)cur.pm * tsA; const char* cB = (const char*)g.Bt + (size_t)cur.pb * tsB;
    if constexpr (SP2) {
        PG8_STAGE(PG8_SB(0, 0), cB, voffB); PG8_STAGE(PG8_SB(0, 1), cB + hsB, voffB); PG8_STAGE(PG8_SA(0, 0), cA, voffA); PG8_STAGE(PG8_SA(0, 1), cA + hsA, voffA);
        if (wr == 1) PG8_BAR;
        PG8_WAIT_V(2); PG8_BAR;
        PG8_STAGE(PG8_SB(1, 0), cB + kstep, voffB); PG8_STAGE(PG8_SA(1, 0), cA + kstep, voffA); PG8_STAGE(PG8_SB(1, 1), cB + hsB + kstep, voffB);
        PG8_WAIT_V(6); PG8_BAR;
    } else {
        PG8_STAGE(PG8_SB(0, 0), cB, voffB); PG8_STAGE(PG8_SA(0, 0), cA, voffA); PG8_STAGE(PG8_SB(0, 1), cB + hsB, voffB); PG8_STAGE(PG8_SA(0, 1), cA + hsA, voffA);
        if (wr == 1) PG8_BAR;
        PG8_WAIT_V(4); PG8_BAR;
        PG8_STAGE(PG8_SB(1, 0), cB + kstep, voffB); PG8_STAGE(PG8_SA(1, 0), cA + kstep, voffA); PG8_STAGE(PG8_SB(1, 1), cB + hsB + kstep, voffB);
        PG8_WAIT_V(6); PG8_BAR;
    }
    for (;;) {
        const bool has_next = S.next(ui + 1, nxt);
        const char* nA = has_next ? (const char*)g.A + (size_t)nxt.pm * tsA : cA; const char* nB = has_next ? (const char*)g.Bt + (size_t)nxt.pb * tsB : cB;
#pragma nounroll
        for (int t = 0; t < nt; t += 2) {
            const bool last = (t == nt - 2);
            const char* a1 = cA + (size_t)(t + 1) * kstep;
            const char* a2 = last ? nA : cA + (size_t)(t + 2) * kstep; const char* b2 = last ? nB : cB + (size_t)(t + 2) * kstep;
            const char* a3 = a2 + kstep; const char* b3 = b2 + kstep;
            if constexpr (SP2) {
            PG8_LDB(B0, 0, 0); PG8_LDB(B1, 0, 1); PG8_SCHED; PG8_LDA(At, 0, 0); PG8_STAGE(PG8_SA(1, 1), a1 + hsA, voffA);
            PG8_WAIT_V(8); PG8_WAIT_L(0); PG8_BAR; PG8_MMA(0, 0, At, B0); PG8_MMA(0, 1, At, B1); PG8_BAR; PG8_SCHED;
            PG8_LDA(At, 0, 1); PG8_STAGE(PG8_SB(0, 0), b2, voffB); PG8_STAGE(PG8_SB(0, 1), b2 + hsB, voffB); PG8_STAGE(PG8_SA(0, 0), a2, voffA);
            PG8_WAIT_V(8); PG8_WAIT_L(0); PG8_BAR; PG8_MMA(1, 0, At, B0); PG8_MMA(1, 1, At, B1); PG8_BAR; PG8_SCHED;
            PG8_LDB(B0, 1, 0); PG8_LDB(B1, 1, 1); PG8_SCHED; PG8_LDA(At, 1, 0); PG8_STAGE(PG8_SA(0, 1), a2 + hsA, voffA);
            PG8_WAIT_V(8); PG8_WAIT_L(0); PG8_BAR; PG8_MMA(0, 0, At, B0); PG8_MMA(0, 1, At, B1); PG8_BAR; PG8_SCHED;
            PG8_LDA(At, 1, 1); PG8_STAGE(PG8_SB(1, 0), b3, voffB); PG8_STAGE(PG8_SB(1, 1), b3 + hsB, voffB); PG8_STAGE(PG8_SA(1, 0), a3, voffA);
            PG8_WAIT_V(8); PG8_WAIT_L(0); PG8_BAR; PG8_MMA(1, 0, At, B0); PG8_MMA(1, 1, At, B1); PG8_BAR; PG8_SCHED;
            } else {
            PG8_LDB(B0, 0, 0); PG8_SCHED; PG8_LDA(At, 0, 0); PG8_STAGE(PG8_SA(1, 1), a1 + hsA, voffA);
            PG8_WAIT_L(8); PG8_BAR; PG8_WAIT_L(0); PG8_MMA(0, 0, At, B0); PG8_BAR; PG8_SCHED;
            PG8_LDB(B1, 0, 1); PG8_STAGE(PG8_SB(0, 0), b2, voffB);
            PG8_BAR; PG8_WAIT_L(0); PG8_MMA(0, 1, At, B1); PG8_BAR;
            PG8_LDA(At, 0, 1); PG8_STAGE(PG8_SA(0, 0), a2, voffA);
            PG8_BAR; PG8_WAIT_L(0); PG8_MMA(1, 0, At, B0); PG8_BAR; PG8_SCHED;
            PG8_STAGE(PG8_SB(0, 1), b2 + hsB, voffB);
            PG8_WAIT_V(6); PG8_BAR; PG8_MMA(1, 1, At, B1); PG8_BAR;
            PG8_LDB(B0, 1, 0); PG8_SCHED; PG8_LDA(At, 1, 0); PG8_STAGE(PG8_SA(0, 1), a2 + hsA, voffA);
            PG8_WAIT_L(8); PG8_BAR; PG8_WAIT_L(0); PG8_MMA(0, 0, At, B0); PG8_BAR; PG8_SCHED;
            PG8_LDB(B1, 1, 1); PG8_STAGE(PG8_SB(1, 0), b3, voffB);
            PG8_BAR; PG8_WAIT_L(0); PG8_MMA(0, 1, At, B1); PG8_BAR;
            PG8_LDA(At, 1, 1); PG8_STAGE(PG8_SA(1, 0), a3, voffA);
            PG8_BAR; PG8_WAIT_L(0); PG8_MMA(1, 0, At, B0); PG8_BAR; PG8_SCHED;
            PG8_STAGE(PG8_SB(1, 1), b3 + hsB, voffB);
            PG8_WAIT_V(6); PG8_BAR; PG8_MMA(1, 1, At, B1); PG8_BAR;
            }
        }
        if constexpr (ALIGN_EPI) { if (wr == 0) PG8_BAR; }
        if constexpr (FP8) asm volatile("s_nop 15\n\ts_nop 15\n\ts_nop 15\n\ts_nop 15\n\ts_nop 15\n\ts_nop 15" ::: "memory");
        E(acc, cur, wr, wc, fr, fq);
        if (!has_next) break;
#pragma unroll
        for (int a = 0; a < 2; ++a)
#pragma unroll
            for (int b = 0; b < 2; ++b)
#pragma unroll
                for (int m = 0; m < 4; ++m)
#pragma unroll
                    for (int n = 0; n < 2; ++n) acc[a][b][m][n] = (f32x4){0.f, 0.f, 0.f, 0.f};
        cur = nxt; cA = nA; cB = nB; ++ui;
        if constexpr (ALIGN_EPI) { if (wr == 1) PG8_BAR; }
    }
    PG8_WAIT_V(0);
    if constexpr (!ALIGN_EPI) { if (wr == 0) PG8_BAR; }
    PG8_BAR;
#undef PG8_SA
#undef PG8_SB
#undef PG8_STAGE
#undef PG8_LDA
#undef PG8_LDB
#undef PG8_MMA
#undef PG8_WAIT_V
#undef PG8_WAIT_L
#undef PG8_BAR
#undef PG8_SCHED
}

typedef const f32x4 (&AccT)[2][2][4][2];
#define EPI_FENCE() asm volatile("" ::: "memory")

struct EpiInProj {
    static constexpr bool PERM = true;
    unsigned char* xbase; const float* ssq; float* rs_out; float* dtt; const float* dt_bias; float asc = 1.f;
    __device__ __forceinline__ void operator()(AccT acc, const Unit& u, int wr, int wc, int fr_, int fq_) const {
        int fr = fr_, fq = fq_; asm volatile("" : "+v"(fr), "+v"(fq));
        const int pn = u.pn; int bmib = (int)(X_Z >> 20), ld = 1024, ct = pn; bool sig = false;
        float sc = 1.f;
        if (pn < 4) { }
        else if (pn < 9) { bmib = (int)(X_XBC >> 20); ld = 1280; ct = pn - 4; }
        else if (pn < 11) { bmib = (int)(X_Q >> 20); ld = 512; ct = pn - 9; sc = 0.18033688011112042f; }
        else if (pn < 13) { bmib = (int)(X_K >> 20); ld = 512; ct = pn - 11; }
        else { bmib = (int)(X_GS >> 20); ld = 2048; ct = pn - 13; sig = true; }
        const unsigned lo = (unsigned)(fr * ld + 8 * fq) * 2u;
        unsigned char* tb = xbase + ((size_t)(unsigned)bmib << 20) + ((size_t)(u.pm * BM + wr * 64) * ld + ct * BM + wc * 32) * 2;
        const int rowb = u.pm * BM + wr * 64 + fr;
        float rr[8];
        rstd4x8(ssq + (size_t)rowb * 4, HALF, rr, 1.f);
        if (pn == 21) {
            if (wc == 0 && fq < 2) {
                int fqo = fq; asm volatile("" : "+v"(fqo));
                float* dbase = dtt + (size_t)(8 * fqo) * T;
                const f32x4 b0 = *(const f32x4*)(dt_bias + 8 * fqo), b1 = *(const f32x4*)(dt_bias + 8 * fqo + 4);
#pragma unroll
                for (int ai = 0; ai < 2; ++ai)
#pragma unroll
                    for (int m = 0; m < 4; ++m) { const int row = rowb + ai * HALF + m * 16; const float r = rr[ai * 4 + m] * asc; const f32x4 v0 = acc[ai][0][m][0] * r + b0, v1 = acc[ai][0][m][1] * r + b1;
#pragma unroll
                        for (int j = 0; j < 4; ++j) { dbase[(size_t)j * T + row] = softplusf_(v0[j]); dbase[(size_t)(4 + j) * T + row] = softplusf_(v1[j]); } }
            }
            return;
        }
#pragma unroll
        for (int ai = 0; ai < 2; ++ai)
#pragma unroll
            for (int m = 0; m < 4; ++m) { const int row = rowb + ai * HALF + m * 16; const float r0 = rr[ai * 4 + m]; const float r = r0 * (sc * asc); unsigned char* rowp = tb + (size_t)(ai * HALF + m * 16) * ld * 2;
                if (pn == 0 && wc == 0 && fq == 0) rs_out[row] = r0;
#pragma unroll
                for (int bj = 0; bj < 2; ++bj) { f32x4 v0 = acc[ai][bj][m][0] * r, v1 = acc[ai][bj][m][1] * r;
                    if (sig) {
#pragma unroll
                        for (int j = 0; j < 4; ++j) { v0[j] = sigmoidf_(v0[j]); v1[j] = sigmoidf_(v1[j]); } }
                    u32x4 w; w.x = cvt_pk_bf16(v0[0], v0[1]); w.y = cvt_pk_bf16(v0[2], v0[3]); w.z = cvt_pk_bf16(v1[0], v1[1]); w.w = cvt_pk_bf16(v1[2], v1[3]);
                    *(u32x4*)(rowp + lo + bj * HALF * 2) = w; }
                EPI_FENCE(); }
    }
};
struct EpiBf16Rs {
    static constexpr bool PERM = true;
    bf16_t* O; int ldc; const float* rs; float sc; int ssq16;
    __device__ __forceinline__ void operator()(AccT acc, const Unit& u, int wr, int wc, int fr_, int fq_) const {
        int fr = fr_, fq = fq_; asm volatile("" : "+v"(fr), "+v"(fq));
        const unsigned lo = (unsigned)(fr * ldc + 8 * fq) * 2u;
        unsigned char* tb = (unsigned char*)O + ((size_t)(u.pm * BM + wr * 64) * ldc + u.pn * BM + wc * 32) * 2;
        const float* rsb = rs + (size_t)(u.pm * BM + wr * 64 + fr) * (ssq16 ? 4 : 1);
        float rr[8];
#pragma unroll
        for (int gI = 0; gI < 8; ++gI) { const int ro = (gI >> 2) * HALF + (gI & 3) * 16; rr[gI] = ssq16 ? 0.f : rsb[ro] * sc; }
        if (ssq16) rstd4x8(rsb, HALF, rr, sc);
#pragma unroll
        for (int ai = 0; ai < 2; ++ai)
#pragma unroll
            for (int m = 0; m < 4; ++m) { const float r = rr[ai * 4 + m]; unsigned char* rowp = tb + (size_t)(ai * HALF + m * 16) * ldc * 2;
#pragma unroll
                for (int bj = 0; bj < 2; ++bj) { const f32x4 v0 = acc[ai][bj][m][0] * r, v1 = acc[ai][bj][m][1] * r;
                    u32x4 w; w.x = cvt_pk_bf16(v0[0], v0[1]); w.y = cvt_pk_bf16(v0[2], v0[3]); w.z = cvt_pk_bf16(v1[0], v1[1]); w.w = cvt_pk_bf16(v1[2], v1[3]);
                    *(u32x4*)(rowp + lo + bj * HALF * 2) = w; }
                EPI_FENCE(); }
    }
};
struct EpiBf16Cs {
    static constexpr bool PERM = true;
    bf16_t* O; int ldc; const float* cs; float sc; int chunk_rows;
    __device__ __forceinline__ void operator()(AccT acc, const Unit& u, int wr, int wc, int fr_, int fq_) const {
        int fr = fr_, fq = fq_; asm volatile("" : "+v"(fr), "+v"(fq));
        const int rstride = chunk_rows ? 128 : ldc;
        const size_t bjstride = chunk_rows ? (size_t)chunk_rows * 128 : (size_t)HALF;
        const unsigned lo = (unsigned)(fr * rstride + 8 * fq) * 2u;
        unsigned char* tb = (unsigned char*)O + (chunk_rows ? ((size_t)(u.pn * 2) * chunk_rows * 128 + (size_t)(u.pm * BM + wr * 64) * 128 + wc * 32) : ((size_t)(u.pm * BM + wr * 64) * ldc + u.pn * BM + wc * 32)) * 2;
        const float* csb = cs + u.pn * BM + wc * 32 + 8 * fq;
        f32x4 c0[2], c1[2];
#pragma unroll
        for (int bj = 0; bj < 2; ++bj) { c0[bj] = *(const f32x4*)(csb + bj * HALF) * sc; c1[bj] = *(const f32x4*)(csb + bj * HALF + 4) * sc; }
#pragma unroll
        for (int ai = 0; ai < 2; ++ai)
#pragma unroll
            for (int m = 0; m < 4; ++m) { unsigned char* rowp = tb + (size_t)(ai * HALF + m * 16) * rstride * 2;
#pragma unroll
                for (int bj = 0; bj < 2; ++bj) { const f32x4 v0 = acc[ai][bj][m][0] * c0[bj], v1 = acc[ai][bj][m][1] * c1[bj];
                    u32x4 w; w.x = cvt_pk_bf16(v0[0], v0[1]); w.y = cvt_pk_bf16(v0[2], v0[3]); w.z = cvt_pk_bf16(v1[0], v1[1]); w.w = cvt_pk_bf16(v1[2], v1[3]);
                    *(u32x4*)(rowp + lo + bj * bjstride * 2) = w; }
                EPI_FENCE(); }
    }
};
template <bool ADD, bool W8 = false> struct EpiGate {
    static constexpr bool PERM = true;
    bf16_t* O; const bf16_t* GS; int gcol0; const bf16_t* Oin;
    unsigned char* o8 = nullptr;
    __device__ __forceinline__ void operator()(AccT acc, const Unit& u, int wr, int wc, int fr_, int fq_) const {
        int fr = fr_, fq = fq_; asm volatile("" : "+v"(fr), "+v"(fq));
        const unsigned lo = (unsigned)(fr * 1024 + 8 * fq) * 2u, lg = (unsigned)(fr * 2048 + 8 * fq) * 2u;
        unsigned char* tb = (unsigned char*)O + ((size_t)(u.pm * BM + wr * 64) * 1024 + u.pn * BM + wc * 32) * 2;
        const unsigned char* ib = (const unsigned char*)Oin + ((size_t)(u.pm * BM + wr * 64) * 1024 + u.pn * BM + wc * 32) * 2;
        const unsigned char* gb = (const unsigned char*)GS + ((size_t)(u.pm * BM + wr * 64) * 2048 + gcol0 + u.pn * BM + wc * 32) * 2;
        u32x4 gq[2][2], pq[2][2];
#pragma unroll
        for (int bj = 0; bj < 2; ++bj) { gq[0][bj] = *(const u32x4*)(gb + lg + bj * HALF * 2); if (ADD) pq[0][bj] = *(const u32x4*)(ib + lo + bj * HALF * 2); }
#pragma unroll
        for (int gI = 0; gI < 8; ++gI) { const int ai = gI >> 2, m = gI & 3, cur = gI & 1, nx = cur ^ 1;
            if (gI < 7) { const size_t ro = (size_t)(((gI + 1) >> 2) * HALF + ((gI + 1) & 3) * 16);
#pragma unroll
                for (int bj = 0; bj < 2; ++bj) { gq[nx][bj] = *(const u32x4*)(gb + ro * 2048 * 2 + lg + bj * HALF * 2); if (ADD) pq[nx][bj] = *(const u32x4*)(ib + ro * 1024 * 2 + lo + bj * HALF * 2); } }
            unsigned char* rowp = tb + (size_t)(ai * HALF + m * 16) * 1024 * 2;
#pragma unroll
            for (int bj = 0; bj < 2; ++bj) { const u32x4 gw = gq[cur][bj]; f32x4 v0 = acc[ai][bj][m][0], v1 = acc[ai][bj][m][1];
                v0[0] *= bflo(gw.x); v0[1] *= bfhi(gw.x); v0[2] *= bflo(gw.y); v0[3] *= bfhi(gw.y); v1[0] *= bflo(gw.z); v1[1] *= bfhi(gw.z); v1[2] *= bflo(gw.w); v1[3] *= bfhi(gw.w);
                if (ADD) { const u32x4 pw = pq[cur][bj];
                    v0[0] += bflo(pw.x); v0[1] += bfhi(pw.x); v0[2] += bflo(pw.y); v0[3] += bfhi(pw.y); v1[0] += bflo(pw.z); v1[1] += bfhi(pw.z); v1[2] += bflo(pw.w); v1[3] += bfhi(pw.w); }
                if constexpr (W8) { u32x2 q8; q8.x = cvt_pk_fp8(v0[0], v0[1], v0[2], v0[3]); q8.y = cvt_pk_fp8(v1[0], v1[1], v1[2], v1[3]);
                    *(u32x2*)(o8 + (size_t)(u.pm * BM + wr * 64 + ai * HALF + m * 16 + fr) * 2048 + u.pn * BM + wc * 32 + 8 * fq + bj * HALF) = q8; }
                else { u32x4 w; w.x = cvt_pk_bf16(v0[0], v0[1]); w.y = cvt_pk_bf16(v0[2], v0[3]); w.z = cvt_pk_bf16(v1[0], v1[1]); w.w = cvt_pk_bf16(v1[2], v1[3]);
                       *(u32x4*)(rowp + lo + bj * HALF * 2) = w; } }
        }
    }
};
template <bool W8 = false, bool SC = false>
struct EpiResidBfT {
    static constexpr bool PERM = true;
    const bf16_t* Hin; bf16_t* Hout; float* ssq; LAS float* sl;
    unsigned char* h8 = nullptr; float asc = 1.f;
    __device__ __forceinline__ void operator()(AccT acc, const Unit& u, int wr, int wc, int fr_, int fq_) const {
        int fr = fr_, fq = fq_; asm volatile("" : "+v"(fr), "+v"(fq));
        const unsigned lo = (unsigned)(fr * 1024 + 8 * fq) * 2u;
        const size_t ub = ((size_t)(u.pm * BM + wr * 64) * 1024 + u.pn * BM + wc * 32) * 2;
        const unsigned char* hi0 = (const unsigned char*)Hin + ub + lo; unsigned char* ho0 = (unsigned char*)Hout + ub + lo;
        unsigned char* h80 = W8 ? h8 + (ub >> 1) + (lo >> 1) : nullptr; (void)h80;
        u32x4 hq[2][2];
#pragma unroll
        for (int bj = 0; bj < 2; ++bj) hq[0][bj] = *(const u32x4*)(hi0 + bj * HALF * 2);
#pragma unroll
        for (int gI = 0; gI < 8; ++gI) { const int ai = gI >> 2, m = gI & 3, cur = gI & 1, nx = cur ^ 1;
            if (gI < 7) { const size_t ro = (size_t)(((gI + 1) >> 2) * HALF + ((gI + 1) & 3) * 16) * 1024 * 2;
#pragma unroll
                for (int bj = 0; bj < 2; ++bj) hq[nx][bj] = *(const u32x4*)(hi0 + ro + bj * HALF * 2); }
            unsigned char* ho = ho0 + (size_t)(ai * HALF + m * 16) * 1024 * 2;
            float ss = 0.f;
#pragma unroll
            for (int bj = 0; bj < 2; ++bj) { f32x4 a0 = acc[ai][bj][m][0], a1 = acc[ai][bj][m][1]; const u32x4 hv = hq[cur][bj]; u32x4 w;
                if constexpr (SC) { a0 *= asc; a1 *= asc; }
                a0[0] += bflo(hv.x); a0[1] += bfhi(hv.x); a0[2] += bflo(hv.y); a0[3] += bfhi(hv.y); a1[0] += bflo(hv.z); a1[1] += bfhi(hv.z); a1[2] += bflo(hv.w); a1[3] += bfhi(hv.w);
                w.x = cvt_pk_bf16(a0[0], a0[1]); w.y = cvt_pk_bf16(a0[2], a0[3]); w.z = cvt_pk_bf16(a1[0], a1[1]); w.w = cvt_pk_bf16(a1[2], a1[3]);
                *(u32x4*)(ho + bj * HALF * 2) = w;
                if constexpr (W8) { u32x2 q8; q8.x = cvt_pk_fp8(a0[0], a0[1], a0[2], a0[3]); q8.y = cvt_pk_fp8(a1[0], a1[1], a1[2], a1[3]); *(u32x2*)(h80 + (size_t)(ai * HALF + m * 16) * 1024 + bj * HALF) = q8; }
                ss += (bflo(w.x) * bflo(w.x) + bfhi(w.x) * bfhi(w.x)) + (bflo(w.y) * bflo(w.y) + bfhi(w.y) * bfhi(w.y)) + (bflo(w.z) * bflo(w.z) + bfhi(w.z) * bfhi(w.z)) + (bflo(w.w) * bflo(w.w) + bfhi(w.w) * bfhi(w.w)); }
            ss += __shfl_xor(ss, 16); ss += __shfl_xor(ss, 32);
            if (fq == 0) sl[wc * 256 + ai * HALF + wr * 64 + m * 16 + fr] = ss;
        }
        asm volatile("s_waitcnt lgkmcnt(0)" ::: "memory"); __builtin_amdgcn_s_barrier(); asm volatile("" ::: "memory");
        const int t = (wr * 4 + wc) * 64 + fq * 16 + fr;
        if (t < 256) ssq[(size_t)(u.pm * BM + t) * 4 + u.pn] = (sl[t] + sl[256 + t]) + (sl[512 + t] + sl[768 + t]);
    }
};
typedef EpiResidBfT<false, false> EpiResidBf;
template <bool F8 = false>
struct EpiSwigluT {
    static constexpr bool PERM = true;
    bf16_t* ACT; const float* rs; int ssq16; float asc = 1.f;
    __device__ __forceinline__ void operator()(AccT acc, const Unit& u, int wr, int wc, int fr_, int fq_) const {
        int fr = fr_, fq = fq_; asm volatile("" : "+v"(fr), "+v"(fq));
        constexpr unsigned ES = F8 ? 1u : 2u;
        const unsigned lo = (unsigned)(fr * DFF + 8 * fq) * ES;
        unsigned char* tb = (unsigned char*)ACT + ((size_t)(u.pm * BM + wr * 64) * DFF + u.pn * HALF + wc * 32) * ES;
        const float* rsb = rs + (size_t)(u.pm * BM + wr * 64 + fr) * (ssq16 ? 4 : 1);
        float rr[8];
#pragma unroll
        for (int gI = 0; gI < 8; ++gI) { const int ro = (gI >> 2) * HALF + (gI & 3) * 16; rr[gI] = ssq16 ? 0.f : rsb[ro] * asc; }
        if (ssq16) rstd4x8(rsb, HALF, rr, asc);
#pragma unroll
        for (int ai = 0; ai < 2; ++ai)
#pragma unroll
            for (int m = 0; m < 4; ++m) { const float r = rr[ai * 4 + m];
                float o[8];
#pragma unroll
                for (int n = 0; n < 2; ++n)
#pragma unroll
                    for (int j = 0; j < 4; ++j) { const float gt = acc[ai][0][m][n][j] * r, up = acc[ai][1][m][n][j] * r; o[n * 4 + j] = gt * sigmoidf_(gt) * up; }
                if constexpr (F8) { u32x2 w; w.x = cvt_pk_fp8(o[0], o[1], o[2], o[3]); w.y = cvt_pk_fp8(o[4], o[5], o[6], o[7]); *(u32x2*)(tb + (size_t)(ai * HALF + m * 16) * DFF + lo) = w; }
                else { u32x4 w; w.x = cvt_pk_bf16(o[0], o[1]); w.y = cvt_pk_bf16(o[2], o[3]); w.z = cvt_pk_bf16(o[4], o[5]); w.w = cvt_pk_bf16(o[6], o[7]);
                       *(u32x4*)(tb + (size_t)(ai * HALF + m * 16) * DFF * 2 + lo) = w; }
                EPI_FENCE(); }
    }
};
typedef EpiSwigluT<false> EpiSwiglu;
struct EpiMoeDown {
    static constexpr bool PERM = true;
    const bf16_t* H; const int* rowl; const float* wrow; bf16_t* Hout; float* ssq; LAS float* sl;
    float asc = 1.f; unsigned char* h8 = nullptr;
    __device__ __forceinline__ void operator()(AccT acc, const Unit& u, int wr, int wc, int fr_, int fq_) const {
        int fr = fr_, fq = fq_; asm volatile("" : "+v"(fr), "+v"(fq));
        const int rb = u.pm * BM + wr * 64 + fr; const unsigned cb = (unsigned)(u.pn * BM + wc * 32 + 8 * fq) * 2u;
        int tk[8]; float wt[8];
#pragma unroll
        for (int gI = 0; gI < 8; ++gI) { const int row = rb + (gI >> 2) * HALF + (gI & 3) * 16; tk[gI] = rowl[row]; wt[gI] = wrow[row] * asc; }
        u32x4 hq[2][2];
        { const size_t to = (size_t)(tk[0] < 0 ? 0 : tk[0]);
#pragma unroll
          for (int bj = 0; bj < 2; ++bj) hq[0][bj] = *(const u32x4*)((const unsigned char*)H + to * 2048 + cb + bj * HALF * 2); }
#pragma unroll
        for (int gI = 0; gI < 8; ++gI) { const int ai = gI >> 2, m = gI & 3, cur = gI & 1, nx = cur ^ 1;
            if (gI < 7) { const size_t tn = (size_t)(tk[gI + 1] < 0 ? 0 : tk[gI + 1]);
#pragma unroll
                for (int bj = 0; bj < 2; ++bj) hq[nx][bj] = *(const u32x4*)((const unsigned char*)H + tn * 2048 + cb + bj * HALF * 2); }
            const int tok = tk[gI]; const size_t to = (size_t)(tok < 0 ? 0 : tok);
            unsigned char* op = (unsigned char*)Hout + to * 2048 + cb;
            float ss = 0.f;
            if (tok >= 0) {
#pragma unroll
                for (int bj = 0; bj < 2; ++bj) { f32x4 a0 = acc[ai][bj][m][0] * wt[gI], a1 = acc[ai][bj][m][1] * wt[gI]; const u32x4 hv = hq[cur][bj]; u32x4 w;
                    a0[0] += bflo(hv.x); a0[1] += bfhi(hv.x); a0[2] += bflo(hv.y); a0[3] += bfhi(hv.y); a1[0] += bflo(hv.z); a1[1] += bfhi(hv.z); a1[2] += bflo(hv.w); a1[3] += bfhi(hv.w);
                    w.x = cvt_pk_bf16(a0[0], a0[1]); w.y = cvt_pk_bf16(a0[2], a0[3]); w.z = cvt_pk_bf16(a1[0], a1[1]); w.w = cvt_pk_bf16(a1[2], a1[3]);
                    *(u32x4*)(op + bj * HALF * 2) = w;
                    if (h8 != nullptr) { u32x2 q8; q8.x = cvt_pk_fp8(a0[0], a0[1], a0[2], a0[3]); q8.y = cvt_pk_fp8(a1[0], a1[1], a1[2], a1[3]); *(u32x2*)(h8 + to * 1024 + (cb >> 1) + bj * HALF) = q8; }
                    ss += (bflo(w.x) * bflo(w.x) + bfhi(w.x) * bfhi(w.x)) + (bflo(w.y) * bflo(w.y) + bfhi(w.y) * bfhi(w.y)) + (bflo(w.z) * bflo(w.z) + bfhi(w.z) * bfhi(w.z)) + (bflo(w.w) * bflo(w.w) + bfhi(w.w) * bfhi(w.w)); } }
            ss += __shfl_xor(ss, 16); ss += __shfl_xor(ss, 32);
            if (ssq != nullptr && fq == 0) sl[wc * 256 + ai * HALF + wr * 64 + m * 16 + fr] = ss;
        }
        if (ssq != nullptr) {
            asm volatile("s_waitcnt lgkmcnt(0)" ::: "memory"); __builtin_amdgcn_s_barrier(); asm volatile("" ::: "memory");
            const int t = (wr * 4 + wc) * 64 + fq * 16 + fr;
            if (t < 256) { const int tok = rowl[u.pm * BM + t]; if (tok >= 0) ssq[(size_t)tok * 4 + u.pn] = (sl[t] + sl[256 + t]) + (sl[512 + t] + sl[768 + t]); }
        }
    }
};
}

#define XB_TMO      128
#define XB_XCNT(j)  (256  + 64 * (j))
#define XB_XSUB(j)  (1280 + 64 * (j))
#define XB_XGEN(j)  (2304 + 64 * (j))
#define XB_TOP      3328
#define XB_TOPGEN   3392
#define XCD_BAR_WORDS 3456
#define XB_SPIN_CAP (1u << 22)
__device__ __forceinline__ unsigned xb_ld(unsigned* p)              { return __hip_atomic_load(p, __ATOMIC_RELAXED, __HIP_MEMORY_SCOPE_AGENT); }
__device__ __forceinline__ unsigned xb_add(unsigned* p, unsigned v) { return __hip_atomic_fetch_add(p, v, __ATOMIC_RELAXED, __HIP_MEMORY_SCOPE_AGENT); }
__device__ __forceinline__ unsigned xb_xcc_id() { return (unsigned)__builtin_amdgcn_s_getreg((3 << 11) | 20) & 0xFu; }
#define XB_SPIN(cond, bar) do { unsigned _sp = 0; while (cond) { __builtin_amdgcn_s_sleep(1); \
    if ((++_sp & 255u) == 0u) { if (xb_ld(&(bar)[XB_TMO])) break; if (_sp > XB_SPIN_CAP) { atomicAdd(&(bar)[XB_TMO], 1u); break; } } } } while (0)
struct XcdBarrier { unsigned* bar; unsigned x; volatile LAS unsigned* st; };
__device__ __forceinline__ XcdBarrier xcd_barrier_post(unsigned* bar, volatile LAS unsigned* st) {
    XcdBarrier b; b.bar = bar; b.x = xb_xcc_id(); b.st = st;
    if (threadIdx.x == 0) (void)xb_add(&bar[XB_XCNT(b.x)], 1u);
    return b;
}
__device__ __forceinline__ void xcd_barrier_complete(unsigned* bar, unsigned x, unsigned& nloc, unsigned& nx) {
    const unsigned G = gridDim.x * gridDim.y * gridDim.z;
    unsigned sum, cnt, mine, sp = 0u;
    for (;;) {
        sum = 0u; cnt = 0u; mine = 0u;
#pragma unroll
        for (unsigned j = 0; j < 16; ++j) { const unsigned c = xb_ld(&bar[XB_XCNT(j)]); sum += c; cnt += (c > 0u) ? 1u : 0u; mine = (j == x) ? c : mine; }
        if (sum == G) break;
        __builtin_amdgcn_s_sleep(1);
        if ((++sp & 255u) == 0u) { if (xb_ld(&bar[XB_TMO])) break; if (sp > XB_SPIN_CAP) { atomicAdd(&bar[XB_TMO], 1u); break; } }
    }
    nloc = mine > 0u ? mine : 1u; nx = cnt > 0u ? cnt : 1u;
}
__device__ __forceinline__ void xcd_barrier(const XcdBarrier& b, const bool leader_thread) {
    asm volatile("s_waitcnt vmcnt(0)" ::: "memory");
    __syncthreads();
    if (leader_thread) {
        unsigned* bar = b.bar;
        __builtin_amdgcn_s_waitcnt(0);
        unsigned nloc = b.st[0], nx = b.st[1];
        if (nloc == 0u) { xcd_barrier_complete(bar, b.x, nloc, nx); b.st[0] = nloc; b.st[1] = nx; }
        const unsigned old = xb_add(&bar[XB_XSUB(b.x)], 1u);
        const unsigned gen = old / nloc;
        if (old + 1u == (gen + 1u) * nloc) {
            __builtin_amdgcn_fence(__ATOMIC_RELEASE, "agent");
            asm volatile("s_waitcnt vmcnt(0)" ::: "memory");
            const unsigned og = xb_add(&bar[XB_TOP], 1u);
            const unsigned tg = og / nx;
            if (og + 1u == (tg + 1u) * nx) xb_add(&bar[XB_TOPGEN], 1u);
            else XB_SPIN(xb_ld(&bar[XB_TOPGEN]) == tg, bar);
            __builtin_amdgcn_fence(__ATOMIC_ACQUIRE, "agent");
            xb_add(&bar[XB_XGEN(b.x)], 1u);
            asm volatile("s_waitcnt vmcnt(0)" ::: "memory");
        } else {
            XB_SPIN(xb_ld(&bar[XB_XGEN(b.x)]) == gen, bar);
            __builtin_amdgcn_fence(__ATOMIC_ACQUIRE, "agent");
            asm volatile("s_waitcnt vmcnt(0)" ::: "memory");
        }
    }
    __syncthreads();
}

__device__ __forceinline__ void grp_barrier(unsigned* lb, unsigned RG, unsigned* tmo_bar, const bool leader_thread) {
    asm volatile("s_waitcnt vmcnt(0)" ::: "memory");
    __syncthreads();
    if (leader_thread) {
        __builtin_amdgcn_s_waitcnt(0);
        const unsigned old = xb_add(lb, 1u);
        const unsigned gen = old / RG;
        if (old + 1u == (gen + 1u) * RG) xb_add(lb + 64, 1u);
        else XB_SPIN(xb_ld(lb + 64) == gen, tmo_bar);
        __builtin_amdgcn_fence(__ATOMIC_ACQUIRE, "agent");
        asm volatile("s_waitcnt vmcnt(0)" ::: "memory");
    }
    __syncthreads();
}

struct Params {
    const float* in[28];
    float* out;
    unsigned char* ws;
    int l_lo, l_hi, ph_lo, ph_hi;
};
enum { I_X = 0, I_MEM, I_NORM_MIX, I_W_IN, I_CONV_W, I_CONV_B, I_DT_BIAS, I_A_LOG, I_D_SKIP, I_SSD_NORM, I_W_SSD_O, I_W_SB_O, I_W_OUT, I_NORM_XA, I_NORM_MEM,
       I_XA_WQ, I_XA_WK, I_XA_WV, I_XA_WO, I_NORM_FFN, I_FFN_G, I_FFN_U, I_FFN_D, I_MOE_R, I_MOE_G, I_MOE_U, I_MOE_D, I_FINAL };

struct TrStream { float v[32]; f32x4 g0, g1; bool pending; unsigned char* dst; int ldt, k0, drow0; float f8; };
__device__ __forceinline__ void tr_scatter(const TrStream& S, LAS float* scr, int lane) {
    const int hl = lane >> 5, nl = lane & 31;
#pragma unroll
    for (int i = 0; i < 32; ++i) scr[(2 * i + hl) * 33 + nl] = S.v[i];
}
__device__ __forceinline__ void tr_store(unsigned char* dst, int ldt, int k0, int drow0, float f8, f32x4 g0, f32x4 g1, LAS float* scr, int lane) {
    const int c = lane & 7;
    if (f8 != 0.f) {
        g0 *= f8; g1 *= f8;
#pragma unroll
        for (int j = 0; j < 4; ++j) { const int n = (lane >> 3) + 8 * j; const LAS float* s = scr + (8 * c) * 33 + n;
            u32x2 o; o.x = cvt_pk_fp8(s[0 * 33] * g0.x, s[1 * 33] * g0.y, s[2 * 33] * g0.z, s[3 * 33] * g0.w); o.y = cvt_pk_fp8(s[4 * 33] * g1.x, s[5 * 33] * g1.y, s[6 * 33] * g1.z, s[7 * 33] * g1.w);
            *(u32x2*)(dst + (size_t)(drow0 + n) * ldt + k0 + 8 * c) = o; }
    } else {
#pragma unroll
        for (int j = 0; j < 4; ++j) { const int n = (lane >> 3) + 8 * j; const LAS float* s = scr + (8 * c) * 33 + n;
            u32x4 o; o.x = cvt_pk_bf16(s[0 * 33] * g0.x, s[1 * 33] * g0.y); o.y = cvt_pk_bf16(s[2 * 33] * g0.z, s[3 * 33] * g0.w); o.z = cvt_pk_bf16(s[4 * 33] * g1.x, s[5 * 33] * g1.y); o.w = cvt_pk_bf16(s[6 * 33] * g1.z, s[7 * 33] * g1.w);
            *(u32x4*)((bf16_t*)dst + (size_t)(drow0 + n) * ldt + k0 + 8 * c) = o; }
    }
}
__device__ __forceinline__ void tr_finish(TrStream& S, LAS float* scr, int lane) {
    if (S.pending) { tr_scatter(S, scr, lane); LDS_WAIT(); tr_store(S.dst, S.ldt, S.k0, S.drow0, S.f8, S.g0, S.g1, scr, lane); LDS_WAIT(); S.pending = false; }
}
__device__ __forceinline__ void tr_push(TrStream& S, const float* W, int ldw, int k0, int n0, const float* gain, bf16_t* WT, int ldt, int drow0, float f8, LAS float* scr, int lane) {
    const bool had = S.pending; unsigned char* odst = S.dst; const int oldt = S.ldt, ok0 = S.k0, odrow0 = S.drow0; const float of8 = S.f8; const f32x4 og0 = S.g0, og1 = S.g1;
    if (had) tr_scatter(S, scr, lane);
    { const int hl = lane >> 5, nl = lane & 31, c = lane & 7;
      const float* src = W + (size_t)(k0 + hl) * ldw + n0 + nl;
#pragma unroll
      for (int i = 0; i < 32; ++i) S.v[i] = src[(size_t)(2 * i) * ldw];
      S.g0 = (f32x4){1.f, 1.f, 1.f, 1.f}; S.g1 = S.g0;
      if (gain) { S.g0 = *(const f32x4*)(gain + k0 + 8 * c); S.g1 = *(const f32x4*)(gain + k0 + 8 * c + 4); }
      S.dst = (unsigned char*)WT; S.ldt = ldt; S.k0 = k0; S.drow0 = drow0; S.f8 = f8; S.pending = true; }
    if (had) { LDS_WAIT(); tr_store(odst, oldt, ok0, odrow0, of8, og0, og1, scr, lane); LDS_WAIT(); }
}
struct TrJob { const float* W; int ldw, K, col0, ncols; const float* gain; bf16_t* WT; int dbase, dgroup; float f8 = 0.f; };
__device__ __forceinline__ void run_job(TrStream& S, const TrJob& j, int& base, int gw, int NGW, LAS float* scr, int lane) {
    const int nblk = j.ncols / 32, nitems = (j.K / 64) * nblk;
    int start = (gw - base) % NGW; if (start < 0) start += NGW;
    for (int it = start; it < nitems; it += NGW) { const int kb = it / nblk, nb = it % nblk, c0 = nb * 32;
        tr_push(S, j.W, j.ldw, kb * 64, j.col0 + c0, j.gain, j.WT, j.K, j.dbase + (c0 / 128) * j.dgroup + (c0 % 128), j.f8, scr, lane); }
    base = (base + nitems) % NGW;
}

__device__ __forceinline__ float row_to_bf16(const float* xrow, bf16_t* brow, int lane) {
    const f32x4* xr = (const f32x4*)xrow + lane; u32x2* o8 = (u32x2*)brow + lane; float s = 0.f;
    f32x4 vin[4];
#pragma unroll
    for (int j = 0; j < 4; ++j) vin[j] = xr[64 * j];
#pragma unroll
    for (int j = 0; j < 4; ++j) { const f32x4 v = vin[j]; u32x2 w; w.x = cvt_pk_bf16(v.x, v.y); w.y = cvt_pk_bf16(v.z, v.w); o8[64 * j] = w;
        s += (bflo(w.x) * bflo(w.x) + bfhi(w.x) * bfhi(w.x)) + (bflo(w.y) * bflo(w.y) + bfhi(w.y) * bfhi(w.y)); }
    return wave_sum(s);
}
template <int NE>
__device__ __forceinline__ void row_dots_raw(const u32x2 (&xw)[4], int lane, const LAS float* wsm, float rstd, float (&ex)[NE]) {
    f32x4 v[4];
#pragma unroll
    for (int j = 0; j < 4; ++j) { const u32x2 w = xw[j]; v[j] = (f32x4){bflo(w.x), bfhi(w.x), bflo(w.y), bfhi(w.y)}; }
#pragma unroll
    for (int e = 0; e < NE; ++e) { float pp = 0.f;
#pragma unroll
        for (int j = 0; j < 4; ++j) { const f32x4 w4 = *(const LAS f32x4*)(wsm + e * 1024 + 256 * j + 4 * lane); pp += (v[j].x * w4.x + v[j].y * w4.y) + (v[j].z * w4.z + v[j].w * w4.w); }
        ex[e] = wave_sum(pp) * rstd; }
}
template <int NE>
__device__ __forceinline__ void row_dots_bf16(const bf16_t* brow, int lane, const LAS float* wsm, float rstd, float (&ex)[NE]) {
    const u32x2* xr = (const u32x2*)brow + lane; f32x4 v[4];
#pragma unroll
    for (int j = 0; j < 4; ++j) { const u32x2 w = xr[64 * j]; v[j] = (f32x4){bflo(w.x), bfhi(w.x), bflo(w.y), bfhi(w.y)}; }
#pragma unroll
    for (int e = 0; e < NE; ++e) { float pp = 0.f;
#pragma unroll
        for (int j = 0; j < 4; ++j) { const f32x4 w4 = *(const LAS f32x4*)(wsm + e * 1024 + 256 * j + 4 * lane); pp += (v[j].x * w4.x + v[j].y * w4.y) + (v[j].z * w4.z + v[j].w * w4.w); }
        ex[e] = wave_sum(pp) * rstd; }
}

typedef float f32x16 __attribute__((ext_vector_type(16)));
#define MFMA32(a, b, c) __builtin_amdgcn_mfma_f32_32x32x16_bf16((a), (b), (c), 0, 0, 0)
__device__ __forceinline__ bf16x8 ldg8(const bf16_t* p) { return *(const bf16x8*)p; }
__device__ __forceinline__ bf16x8 pack8(const float* v) { u32x4 w; w.x = cvt_pk_bf16(v[0], v[1]); w.y = cvt_pk_bf16(v[2], v[3]); w.z = cvt_pk_bf16(v[4], v[5]); w.w = cvt_pk_bf16(v[6], v[7]); return __builtin_bit_cast(bf16x8, w); }
__device__ __forceinline__ int pi32(int r) { return 16 * ((r >> 2) & 1) + 4 * (r >> 3) + (r & 3); }

__device__ __forceinline__ void sb_attn_mfma(const bf16_t* Q, const bf16_t* Kb, const bf16_t* Vt, bf16_t* Yo, int vg, int rg, int RG, int wave, int lane) {
    const int c = lane & 31, hh = lane >> 5, pr = pi32(c);
    bf16x8 U[2];
#pragma unroll
    for (int kk = 0; kk < 2; ++kk) { u32x4 uw;
#pragma unroll
        for (int q = 0; q < 4; ++q) uw[q] = ((16 * hh + 8 * kk + 2 * q > pr) ? 0x3F80u : 0u) | ((16 * hh + 8 * kk + 2 * q + 1 > pr) ? 0x3F800000u : 0u);
        U[kk] = __builtin_bit_cast(bf16x8, uw); }
    for (int vb = rg; vb < 32; vb += RG)
    for (int iu = 0; iu < 4; ++iu) {
        const int k4 = iu, a = vb >> 1, bh = (2 * vg + (vb & 1)) * 8 + wave;
        const int qblk = k4 == 0 ? a : k4 == 1 ? 31 - a : k4 == 2 ? 32 + a : 63 - a;
        const int b = bh >> 3, h = bh & 7, t0 = qblk * 32;
        const bf16_t* qp = Q + (size_t)(b * SEQ + t0 + c) * 512 + h * 64; bf16_t* yp = Yo + (size_t)(b * SEQ + t0 + c) * 512 + h * 64;
        bf16x8 qf[4];
#pragma unroll
        for (int jj = 0; jj < 4; ++jj) qf[jj] = ldg8(qp + 16 * jj + 8 * hh);
        const bf16_t* kbase = Kb + (size_t)(b * SEQ + pr) * 512 + h * 64 + 8 * hh;
        const bf16_t* vbase = Vt + (size_t)(b * 16) * 512 * 128 + (size_t)(h * 64 + c) * 128 + 16 * hh;
        f32x16 o0, o1;
#pragma unroll
        for (int i = 0; i < 16; ++i) { o0[i] = 0.f; o1[i] = 0.f; }
        float R = 0.f;
        bf16x8 kf[4], vf[4], kn[4], vn[4];
#pragma unroll
        for (int jj = 0; jj < 4; ++jj) { kf[jj] = ldg8(kbase + (size_t)t0 * 512 + 16 * jj); vf[jj] = ldg8(vbase + (size_t)(t0 >> 7) * 512 * 128 + (t0 & 127) + (jj >> 1) * 32 * 128 + 8 * (jj & 1)); }
        for (int kb = qblk; kb >= 0; --kb) {
            const int s0 = kb * 32;
            if (kb > 0) {
#pragma unroll
                for (int jj = 0; jj < 4; ++jj) { kn[jj] = ldg8(kbase + (size_t)(s0 - 32) * 512 + 16 * jj); vn[jj] = ldg8(vbase + (size_t)((s0 - 32) >> 7) * 512 * 128 + ((s0 - 32) & 127) + (jj >> 1) * 32 * 128 + 8 * (jj & 1)); }
            }
            f32x16 s;
#pragma unroll
            for (int i = 0; i < 16; ++i) s[i] = 0.f;
#pragma unroll
            for (int jj = 0; jj < 4; ++jj) s = MFMA32(kf[jj], qf[jj], s);
            const bool diag = (kb == qblk);
            float sp[16]; float rsum = 0.f;
#pragma unroll
            for (int i = 0; i < 16; ++i) { const float x = s[i]; float v = fmaxf(x, 0.f) + __builtin_amdgcn_logf(1.f + __builtin_amdgcn_exp2f(-fabsf(x)));
                if (diag && !(16 * hh + i < c)) v = 0.f;
                sp[i] = v; rsum += v; }
            f32x16 E;
#pragma unroll
            for (int i = 0; i < 16; ++i) E[i] = 0.f;
            E = MFMA32(U[0], pack8(sp), E); E = MFMA32(U[1], pack8(sp + 8), E);
            float at[16];
#pragma unroll
            for (int i = 0; i < 16; ++i) { float av = __builtin_amdgcn_exp2f(s[i] - sp[i] - E[i] - R); if (diag && !(16 * hh + i < c)) av = 0.f; at[i] = av; }
            const bf16x8 a0 = pack8(at), a1 = pack8(at + 8);
            o0 = MFMA32(vf[0], a0, o0); o0 = MFMA32(vf[1], a1, o0);
            o1 = MFMA32(vf[2], a0, o1); o1 = MFMA32(vf[3], a1, o1);
            rsum += __shfl_xor(rsum, 32); R += rsum;
            if (__all(R > 48.f)) break;
#pragma unroll
            for (int jj = 0; jj < 4; ++jj) { kf[jj] = kn[jj]; vf[jj] = vn[jj]; }
        }
#pragma unroll
        for (int g = 0; g < 4; ++g) { u32x2 w0, w1; w0.x = cvt_pk_bf16(o0[4 * g], o0[4 * g + 1]); w0.y = cvt_pk_bf16(o0[4 * g + 2], o0[4 * g + 3]); w1.x = cvt_pk_bf16(o1[4 * g], o1[4 * g + 1]); w1.y = cvt_pk_bf16(o1[4 * g + 2], o1[4 * g + 3]);
            *(u32x2*)(yp + 8 * g + 4 * hh) = w0; *(u32x2*)(yp + 32 + 8 * g + 4 * hh) = w1; }
    }
}

__device__ __forceinline__ void xattn_lds(const bf16_t* XQ, const bf16_t* KMl, const bf16_t* VtMl, bf16_t* XO, int vg, int rg, int RG, int tid, int wave, int lane, LAS unsigned char* lds) {
    constexpr int KP = 272, VP = 528;
    LAS unsigned char* Ks = lds; LAS unsigned char* Vs = lds + 256 * KP;
    const int c = lane & 31, hh = lane >> 5, pr = pi32(c);
    for (int u = rg; u < 32; u += RG) { const int b = 2 * vg + (u >> 4), hd = (u >> 2) & 3, qz = u & 3;
        __syncthreads();
        { u32x4 kr[8], vr[8];
#pragma unroll
          for (int i = 0; i < 8; ++i) { const int idx = tid + 512 * i; kr[i] = *(const u32x4*)(KMl + (size_t)(b * MEMLEN + (idx >> 4)) * 2048 + hd * 128 + (idx & 15) * 8);
              vr[i] = *(const u32x4*)(VtMl + (size_t)(hd * 128 + (idx >> 5)) * TM + b * MEMLEN + (idx & 31) * 8); }
#pragma unroll
          for (int i = 0; i < 8; ++i) { const int idx = tid + 512 * i; *(LAS u32x4*)(Ks + (idx >> 4) * KP + (idx & 15) * 16) = kr[i]; *(LAS u32x4*)(Vs + (idx >> 5) * VP + (idx & 31) * 16) = vr[i]; } }
        __syncthreads();
        const LAS unsigned char* kl = Ks + pr * KP + 16 * hh;
        const LAS unsigned char* vl = Vs + c * VP + 32 * hh;
        for (int qi = 0; qi < 2; ++qi) { const int t0 = (qz * 16 + wave * 2 + qi) * 32;
            const bf16_t* qp = XQ + (size_t)(b * SEQ + t0 + c) * 512 + hd * 128 + 8 * hh;
            bf16x8 qf[8];
#pragma unroll
            for (int jj = 0; jj < 8; ++jj) qf[jj] = ldg8(qp + 16 * jj);
            float mx = -3.0e38f;
            for (int kb = 0; kb < 8; ++kb) { f32x16 sc;
#pragma unroll
                for (int i = 0; i < 16; ++i) sc[i] = 0.f;
#pragma unroll
                for (int jj = 0; jj < 8; ++jj) sc = MFMA32(*(const LAS bf16x8*)(kl + kb * 32 * KP + 32 * jj), qf[jj], sc);
#pragma unroll
                for (int i = 0; i < 16; ++i) mx = fmaxf(mx, sc[i]); }
            mx = fmaxf(mx, __shfl_xor(mx, 32));
            f32x16 o[4];
#pragma unroll
            for (int db = 0; db < 4; ++db)
#pragma unroll
                for (int i = 0; i < 16; ++i) o[db][i] = 0.f;
            float sum = 0.f;
            for (int kb = 0; kb < 8; ++kb) { f32x16 sc;
#pragma unroll
                for (int i = 0; i < 16; ++i) sc[i] = 0.f;
#pragma unroll
                for (int jj = 0; jj < 8; ++jj) sc = MFMA32(*(const LAS bf16x8*)(kl + kb * 32 * KP + 32 * jj), qf[jj], sc);
                float pv[16];
#pragma unroll
                for (int i = 0; i < 16; ++i) { pv[i] = __builtin_amdgcn_exp2f(sc[i] - mx); sum += pv[i]; }
                const bf16x8 p0 = pack8(pv), p1 = pack8(pv + 8);
#pragma unroll
                for (int db = 0; db < 4; ++db) { const LAS unsigned char* vp = vl + db * 32 * VP + kb * 64; o[db] = MFMA32(*(const LAS bf16x8*)vp, p0, o[db]); o[db] = MFMA32(*(const LAS bf16x8*)(vp + 16), p1, o[db]); } }
            sum += __shfl_xor(sum, 32);
            const float inv = 1.f / sum;
            bf16_t* op = XO + (size_t)(b * SEQ + t0 + c) * 512 + hd * 128 + 4 * hh;
#pragma unroll
            for (int db = 0; db < 4; ++db)
#pragma unroll
                for (int g = 0; g < 4; ++g) { u32x2 w0; w0.x = cvt_pk_bf16(o[db][4 * g] * inv, o[db][4 * g + 1] * inv); w0.y = cvt_pk_bf16(o[db][4 * g + 2] * inv, o[db][4 * g + 3] * inv);
                    *(u32x2*)(op + 32 * db + 8 * g) = w0; }
        }
    }
}

template <int CTRL, int ROWMASK> __device__ __forceinline__ float dpp_mov0(float v) { return __builtin_bit_cast(float, __builtin_amdgcn_update_dpp(0, __builtin_bit_cast(int, v), CTRL, ROWMASK, 0xF, false)); }
__device__ __forceinline__ float wave_incl_scan(float v, int) {
    v += dpp_mov0<0x111, 0xF>(v); v += dpp_mov0<0x112, 0xF>(v); v += dpp_mov0<0x114, 0xF>(v); v += dpp_mov0<0x118, 0xF>(v);
    v += dpp_mov0<0x142, 0xA>(v); v += dpp_mov0<0x143, 0xC>(v);
    return v;
}
__device__ __forceinline__ float lane63(float v) { return __builtin_bit_cast(float, __builtin_amdgcn_readlane(__builtin_bit_cast(int, v), 63)); }
__device__ __forceinline__ void conv_unit(const bf16_t* XBC, const float* cw, const float* cb, bf16_t* XT, bf16_t* BR, bf16_t* BT, bf16_t* CR, int u, int lane) {
    const int tb = u / 10, cbk = u - tb * 10, tok0 = tb * 64, ch0 = cbk * 128 + 2 * lane;
    float w[4][2], bs[2];
#pragma unroll
    for (int k = 0; k < 4; ++k) { w[k][0] = cw[k * 1280 + ch0]; w[k][1] = cw[k * 1280 + ch0 + 1]; }
    bs[0] = cb[ch0]; bs[1] = cb[ch0 + 1];
    const bf16_t* src = XBC + (size_t)tok0 * 1280 + ch0;
    float h0[2] = {0.f, 0.f}, h1[2] = {0.f, 0.f}, h2[2] = {0.f, 0.f};
    if ((tok0 & (SEQ - 1)) != 0) { const unsigned a = *(const unsigned*)(src - 3 * 1280), b = *(const unsigned*)(src - 2 * 1280), c = *(const unsigned*)(src - 1280);
        h0[0] = bflo(a); h0[1] = bfhi(a); h1[0] = bflo(b); h1[1] = bfhi(b); h2[0] = bflo(c); h2[1] = bfhi(c); }
    unsigned ylo[32], yhi[32]; float pe0 = 0.f, pe1 = 0.f;
    bf16_t* rdst = (cbk == 8) ? BR : CR;
    unsigned xin[64];
#pragma unroll
    for (int tt = 0; tt < 64; ++tt) xin[tt] = *(const unsigned*)(src + (size_t)tt * 1280);
#pragma unroll
    for (int tt = 0; tt < 64; ++tt) { const unsigned xw = xin[tt]; const float x0 = bflo(xw), x1 = bfhi(xw);
        float v0 = bs[0] + w[0][0] * h0[0] + w[1][0] * h1[0] + w[2][0] * h2[0] + w[3][0] * x0, v1 = bs[1] + w[0][1] * h0[1] + w[1][1] * h1[1] + w[2][1] * h2[1] + w[3][1] * x1;
        v0 *= sigmoidf_(v0); v1 *= sigmoidf_(v1);
        h0[0] = h1[0]; h0[1] = h1[1]; h1[0] = h2[0]; h1[1] = h2[1]; h2[0] = x0; h2[1] = x1;
        xin[tt] = cvt_pk_bf16(v0, v1);
        if (tt & 1) { ylo[tt >> 1] = cvt_pk_bf16(pe0, v0); yhi[tt >> 1] = cvt_pk_bf16(pe1, v1); } else { pe0 = v0; pe1 = v1; } }
    if (cbk >= 8) {
#pragma unroll
        for (int tt = 0; tt < 64; ++tt) *(unsigned*)(rdst + (size_t)(tok0 + tt) * 128 + 2 * lane) = xin[tt]; }
    if (cbk <= 8) { bf16_t* tbase = (cbk < 8) ? XT + ((size_t)(tok0 >> 7) * 1024 + ch0) * 128 + (tok0 & 127) : BT + ((size_t)(tok0 >> 7) * 128 + 2 * lane) * 128 + (tok0 & 127);
#pragma unroll
        for (int q = 0; q < 8; ++q) { u32x4 a, b; a.x = ylo[4 * q]; a.y = ylo[4 * q + 1]; a.z = ylo[4 * q + 2]; a.w = ylo[4 * q + 3]; b.x = yhi[4 * q]; b.y = yhi[4 * q + 1]; b.z = yhi[4 * q + 2]; b.w = yhi[4 * q + 3];
            *(u32x4*)(tbase + 8 * q) = a; *(u32x4*)(tbase + 128 + 8 * q) = b; } }
}
__device__ __forceinline__ void ssd_scan_block(const bf16_t* XT, const bf16_t* BT, const float* DTT, bf16_t* PREV, float negA, int b, int h, int wave, int lane, LAS float* wl  , LAS float* xch  ) {
    const int c32 = lane & 31, hh = lane >> 5, g = h >> 3, q = wave & 3, pblk = q >> 1, nblk = q & 1, c0 = (wave >> 2) * 8;
    const bf16_t* xrow = XT + ((size_t)(b * 16) * 1024 + h * 64 + pblk * 32 + c32) * 128 + 8 * hh;
    const bf16_t* brow = BT + ((size_t)(b * 16) * 128 + g * 64 + nblk * 32 + c32) * 128 + 8 * hh;
    const float* dtp = DTT + (size_t)h * T + b * SEQ + lane;
    f32x16 S[8]; float dec[8];
#pragma unroll
    for (int ci = 0; ci < 8; ++ci) { const int c = c0 + ci;
        const float d0 = dtp[c * 128], d1 = dtp[c * 128 + 64];
        u32x4 xa[8]; bf16x8 ba[8];
#pragma unroll
        for (int ks = 0; ks < 8; ++ks) { xa[ks] = *(const u32x4*)(xrow + (size_t)c * 1024 * 128 + 16 * ks); ba[ks] = ldg8(brow + (size_t)c * 128 * 128 + 16 * ks); }
        const float s0 = wave_incl_scan(d0 * negA, lane); const float tot0 = lane63(s0);
        const float s1 = wave_incl_scan(d1 * negA, lane) + tot0; const float last = lane63(s1);
        wl[lane] = d0 * fexp(last - s0); wl[64 + lane] = d1 * fexp(last - s1);
        dec[ci] = fexp(last);
        f32x16 st;
#pragma unroll
        for (int i = 0; i < 16; ++i) st[i] = 0.f;
#pragma unroll
        for (int ks = 0; ks < 8; ++ks) { const u32x4 xw = xa[ks];
            const f32x4 wa = *(const LAS f32x4*)(wl + 16 * ks + 8 * hh), wb = *(const LAS f32x4*)(wl + 16 * ks + 8 * hh + 4);
            float xs[8]; xs[0] = bflo(xw.x) * wa.x; xs[1] = bfhi(xw.x) * wa.y; xs[2] = bflo(xw.y) * wa.z; xs[3] = bfhi(xw.y) * wa.w; xs[4] = bflo(xw.z) * wb.x; xs[5] = bfhi(xw.z) * wb.y; xs[6] = bflo(xw.w) * wb.z; xs[7] = bfhi(xw.w) * wb.w;
            st = MFMA32(pack8(xs), ba[ks], st); }
        S[ci] = st;
        asm volatile("" ::: "memory");
    }
    f32x16 carry;
#pragma unroll
    for (int i = 0; i < 16; ++i) carry[i] = 0.f;
    LAS float* xq = xch + q * 1024 + lane;
    bf16_t* pv = PREV + ((size_t)((b * 16) * 16 + h) * 64 + pblk * 32) * 64 + nblk * 32 + c32;
#pragma unroll
    for (int half = 0; half < 2; ++half) {
        if ((wave >> 2) == half) {
            if (half == 1) {
#pragma unroll
                for (int i = 0; i < 16; ++i) carry[i] = xq[i * 64]; }
#pragma unroll
            for (int ci = 0; ci < 8; ++ci) { bf16_t* pc = pv + (size_t)(c0 + ci) * 16 * 4096;
#pragma unroll
                for (int i = 0; i < 16; ++i) pc[(8 * (i >> 2) + 4 * hh + (i & 3)) * 64] = f2bf(carry[i]);
#pragma unroll
                for (int i = 0; i < 16; ++i) carry[i] = carry[i] * dec[ci] + S[ci][i]; }
            if (half == 0) {
#pragma unroll
                for (int i = 0; i < 16; ++i) xq[i * 64] = carry[i]; }
        }
        if (half == 0) { asm volatile("s_waitcnt lgkmcnt(0)" ::: "memory"); __builtin_amdgcn_s_barrier(); asm volatile("" ::: "memory"); }
    }
}
__device__ __forceinline__ void ssd_out_unit(const bf16_t* XT, const bf16_t* BR, const bf16_t* CR, const float* DTT, const bf16_t* PREV, const bf16_t* Zb, bf16_t* Y, float negA, float dsk,
                                             int b, int c, int g, int wave, int lane, LAS float* tab  , LAS float* red  , LAS float* cbl  , const int var) {
    const int c32 = lane & 31, hh = lane >> 5, pr = pi32(c32), h = g * 8 + wave;
    const int tokc = b * SEQ + c * 128;
    const float* dtp = DTT + (size_t)h * T + tokc + lane;
    { bf16x8 bb[2][4], cc[2][4];
#pragma unroll
      for (int r = 0; r < 2; ++r) { const int kk = wave + 8 * r; if (kk < 10) { const int tqk = kk < 1 ? 0 : kk < 3 ? 1 : kk < 6 ? 2 : 3, jk = kk - tqk * (tqk + 1) / 2;
#pragma unroll
          for (int ks = 0; ks < 4; ++ks) { bb[r][ks] = ldg8(BR + (size_t)(tokc + 32 * jk + pr) * 128 + g * 64 + 8 * hh + 16 * ks); cc[r][ks] = ldg8(CR + (size_t)(tokc + 32 * tqk + c32) * 128 + g * 64 + 16 * ks + 8 * hh); } } }
#pragma unroll
      for (int r = 0; r < 2; ++r) { const int kk = wave + 8 * r; if (kk < 10) { f32x16 t;
#pragma unroll
          for (int i = 0; i < 16; ++i) t[i] = 0.f;
#pragma unroll
          for (int ks = 0; ks < 4; ++ks) t = MFMA32(bb[r][ks], cc[r][ks], t);
#pragma unroll
          for (int q = 0; q < 4; ++q) *(LAS f32x4*)(cbl + ((kk * 4 + q) * 64 + lane) * 4) = (f32x4){t[4 * q], t[4 * q + 1], t[4 * q + 2], t[4 * q + 3]}; } } }
    const float d0 = dtp[0], d1 = dtp[64];
    const bf16_t* pv = PREV + ((size_t)((b * 16 + c) * 16 + h) * 64 + c32) * 64 + 8 * hh;
    const bf16_t* xrow = XT + ((size_t)(b * 16 + c) * 1024 + h * 64 + c32) * 128 + 16 * hh;
    const float s0 = wave_incl_scan(d0 * negA, lane); const float tot0 = lane63(s0);
    const float s1 = wave_incl_scan(d1 * negA, lane) + tot0;
    tab[lane] = s0; tab[64 + lane] = s1; tab[128 + lane] = d0; tab[192 + lane] = d1;
    tab[256 + lane] = d0 * fexp(tab[lane | 31] - s0); tab[320 + lane] = d1 * fexp(tab[64 + (lane | 31)] - s1);
    asm volatile("s_waitcnt lgkmcnt(0)" ::: "memory"); __builtin_amdgcn_s_barrier(); asm volatile("" ::: "memory");
    bf16x8 pf[8];
#pragma unroll
    for (int ks = 0; ks < 4; ++ks) { pf[ks] = ldg8(pv + 16 * ks); pf[4 + ks] = ldg8(pv + 32 * 64 + 16 * ks); }
    bf16x8 cf[4], xfr[4], xnx[4]; u32x2 zr[8];
#define SSD_LOAD_TQ(tqq) do { const size_t tg_ = (size_t)(tokc + (tqq) * 32 + c32); \
        _Pragma("unroll") for (int ks = 0; ks < 4; ++ks) cf[ks] = ldg8(CR + tg_ * 128 + g * 64 + 16 * ks + 8 * hh); \
        xfr[0] = ldg8(xrow); xfr[1] = ldg8(xrow + 8); xfr[2] = ldg8(xrow + 32 * 128); xfr[3] = ldg8(xrow + 32 * 128 + 8); \
        const bf16_t* zp_ = Zb + tg_ * 1024 + h * 64 + 4 * hh; \
        _Pragma("unroll") for (int gq = 0; gq < 4; ++gq) { zr[gq] = *(const u32x2*)(zp_ + 8 * gq); zr[4 + gq] = *(const u32x2*)(zp_ + 32 + 8 * gq); } } while (0)
    SSD_LOAD_TQ(0);
    for (int tq = 0; tq < ((var & 8) ? 0 : 4); ++tq) {
        const size_t tokg = (size_t)(tokc + tq * 32 + c32);
        const float acum_t = tab[tq * 32 + c32];
        f32x16 y0, y1;
#pragma unroll
        for (int i = 0; i < 16; ++i) { y0[i] = 0.f; y1[i] = 0.f; }
        if (!(var & 2))
#pragma unroll
        for (int ks = 0; ks < 4; ++ks) { y0 = MFMA32(pf[ks], cf[ks], y0); y1 = MFMA32(pf[4 + ks], cf[ks], y1); }
        { const float ea = fexp(acum_t);
#pragma unroll
          for (int i = 0; i < 16; ++i) { y0[i] *= ea; y1[i] *= ea; } }
        for (int j = 0; j <= ((var & 1) ? -1 : tq); ++j) {
            if (j < tq) {
                xnx[0] = ldg8(xrow + 32 * (j + 1)); xnx[1] = ldg8(xrow + 32 * (j + 1) + 8); xnx[2] = ldg8(xrow + 32 * 128 + 32 * (j + 1)); xnx[3] = ldg8(xrow + 32 * 128 + 32 * (j + 1) + 8); }
            f32x16 cbt;
            { const LAS float* cb = cbl + (((tq * (tq + 1) / 2 + j) * 4) * 64 + lane) * 4;
#pragma unroll
              for (int q = 0; q < 4; ++q) { const f32x4 t4 = *(const LAS f32x4*)(cb + q * 256); cbt[4 * q] = t4.x; cbt[4 * q + 1] = t4.y; cbt[4 * q + 2] = t4.z; cbt[4 * q + 3] = t4.w; } }
            float m[16];
            if (j < tq) { const float et = fexp(acum_t - tab[32 * j + 31]);
#pragma unroll
                for (int q = 0; q < 4; ++q) { const f32x4 ks = *(const LAS f32x4*)(tab + 256 + 32 * j + 16 * hh + 4 * q);
#pragma unroll
                    for (int e = 0; e < 4; ++e) m[4 * q + e] = cbt[4 * q + e] * ks[e] * et; }
            } else {
#pragma unroll
                for (int q = 0; q < 4; ++q) { const f32x4 as = *(const LAS f32x4*)(tab + 32 * j + 16 * hh + 4 * q), ds = *(const LAS f32x4*)(tab + 128 + 32 * j + 16 * hh + 4 * q);
#pragma unroll
                    for (int e = 0; e < 4; ++e) { const int i = 4 * q + e; float v = cbt[i] * ds[e] * fexp(acum_t - as[e]);
                        if (16 * hh + i > c32) v = 0.f; if (16 * hh + i == c32) v += dsk;
                        m[i] = v; } }
            }
            const bf16x8 m0 = pack8(m), m1 = pack8(m + 8);
            y0 = MFMA32(xfr[0], m0, y0); y0 = MFMA32(xfr[1], m1, y0);
            y1 = MFMA32(xfr[2], m0, y1); y1 = MFMA32(xfr[3], m1, y1);
#pragma unroll
            for (int ks = 0; ks < 4; ++ks) xfr[ks] = xnx[ks];
        }
        float ss = 0.f;
#pragma unroll
        for (int gq = 0; gq < 4; ++gq) { const u32x2 za = zr[gq], zb2 = zr[4 + gq];
            const float z0[4] = {bflo(za.x), bfhi(za.x), bflo(za.y), bfhi(za.y)}, z1[4] = {bflo(zb2.x), bfhi(zb2.x), bflo(zb2.y), bfhi(zb2.y)};
#pragma unroll
            for (int e = 0; e < 4; ++e) { const int i = 4 * gq + e; y0[i] *= z0[e] * sigmoidf_(z0[e]); y1[i] *= z1[e] * sigmoidf_(z1[e]); ss += y0[i] * y0[i] + y1[i] * y1[i]; } }
        if (tq + 1 < 4) SSD_LOAD_TQ(tq + 1);
        ss += __shfl_xor(ss, 32);
        LAS float* rd = red + (tq & 1) * 256;
        if (hh == 0) rd[wave * 32 + c32] = ss;
        asm volatile("s_waitcnt lgkmcnt(0)" ::: "memory"); __builtin_amdgcn_s_barrier(); asm volatile("" ::: "memory");
        float tot = 0.f;
#pragma unroll
        for (int w8 = 0; w8 < 8; ++w8) tot += rd[w8 * 32 + c32];
        const float rstd = __builtin_amdgcn_rsqf(tot * (1.f / 512.f) + EPS);
        bf16_t* yp = Y + tokg * 1280 + h * 64 + 4 * hh;
#pragma unroll
        for (int gq = 0; gq < 4; ++gq) { u32x2 o0, o1; o0.x = cvt_pk_bf16(y0[4 * gq] * rstd, y0[4 * gq + 1] * rstd); o0.y = cvt_pk_bf16(y0[4 * gq + 2] * rstd, y0[4 * gq + 3] * rstd);
            o1.x = cvt_pk_bf16(y1[4 * gq] * rstd, y1[4 * gq + 1] * rstd); o1.y = cvt_pk_bf16(y1[4 * gq + 2] * rstd, y1[4 * gq + 3] * rstd);
            if (!(var & 4)) { *(u32x2*)(yp + 8 * gq) = o0; *(u32x2*)(yp + 32 + 8 * gq) = o1; } }
    }
#undef SSD_LOAD_TQ
}

__device__ __forceinline__ void moe_convert(const Params& p, unsigned char* ws, int lm, int jfm, int kinds, int gwc, int NGWc, LAS float* scr, int lane) {
    int base = 0; const float* gn = p.in[I_NORM_FFN] + lm * D; TrStream S{};
    for (int jb = 0; jb < NEXP * 3; ++jb) { const int e = jb / 3, k = jb % 3; if (!((kinds >> k) & 1)) continue;
        TrJob j; const size_t eo = ((size_t)jfm * NEXP + e) * D * DFF;
        if (k == 0) j = TrJob{p.in[I_MOE_G] + eo, DFF, D, 0, DFF, gn, (bf16_t*)(ws + WS_WMOE + WM_GU + (size_t)e * 2 * DFF * 1024 * (MOE_F8_GU ? 1 : 2)), 0, 256, MOE_F8_GU ? F8_WGU : 0.f};
        else if (k == 1) j = TrJob{p.in[I_MOE_U] + eo, DFF, D, 0, DFF, gn, (bf16_t*)(ws + WS_WMOE + WM_GU + (size_t)e * 2 * DFF * 1024 * (MOE_F8_GU ? 1 : 2)), 128, 256, MOE_F8_GU ? F8_WGU : 0.f};
        else j = TrJob{p.in[I_MOE_D] + eo, D, DFF, 0, D, nullptr, (bf16_t*)(ws + WS_WMOE + WM_DN + (size_t)e * 1024 * DFF * (MOE_F8_DN ? 1 : 2)), 0, 128, MOE_F8_DN ? F8_WDN : 0.f};
        run_job(S, j, base, gwc, NGWc, scr, lane); }
    tr_finish(S, scr, lane);
}

#define PHASE_DELAY() do { if ((DELAY_MASK >> site_) & 1u) { const unsigned long long t1_ = __builtin_amdgcn_s_memrealtime(); while (__builtin_amdgcn_s_memrealtime() - t1_ < t1_ - t0_) __builtin_amdgcn_s_sleep(8); } } while (0)
#define PHASE_ENTER() constexpr int site_ = __COUNTER__; const unsigned long long t0_ = (DELAY_MASK >> site_) & 1u ? __builtin_amdgcn_s_memrealtime() : 0ull; (void)t0_; GAS unsigned char* ws_ = (GAS unsigned char*)p.ws; asm volatile("" : "+s"(ws_)); unsigned char* const ws = (unsigned char*)ws_;     \
    GAS float* out_ = (GAS float*)p.out; asm volatile("" : "+s"(out_)); float* const OUTP = (float*)out_; (void)OUTP; int tid_ = wave0 * 64 + lane_id_opaque(); int bid_ = blockIdx.x; asm volatile("" : "+s"(bid_)); \
    const int tid = tid_, lane = tid & 63, wave = __builtin_amdgcn_readfirstlane(tid >> 6); \
    const int G = gridDim.x, bid = bid_, gw = bid * 8 + wave, NGW = G * 8, vg = bid & 7, rg = bid >> 3, RG = G >> 3; (void)lane; (void)gw; (void)NGW; (void)wave; (void)bid; (void)G; (void)vg; (void)rg; (void)RG
#define WSP(type, off) ((type*)(ws + (off)))
__global__ void __launch_bounds__(512, 2) mk_fwd(Params p) {
    extern __shared__ __attribute__((aligned(16))) unsigned char lds_raw[];
    LAS unsigned char* lds = (LAS unsigned char*)lds_raw;
    volatile LAS unsigned* ldsctl = (volatile LAS unsigned*)(lds + LDSCTL_OFF);
    if (threadIdx.x < 64) ldsctl[threadIdx.x] = 0u;
    int wave0 = __builtin_amdgcn_readfirstlane((int)threadIdx.x >> 6); asm volatile("" : "+s"(wave0));
    __syncthreads();
    const int ph_lo = p.ph_lo, ph_hi = p.ph_hi;
    const bool use_bar = (ph_hi - ph_lo) > 1 || (p.l_hi - p.l_lo) > 1;
    XcdBarrier bar; bar.bar = (unsigned*)(p.ws + WS_CTL) + CW_BAR; bar.x = 0; bar.st = nullptr;
    if (use_bar) bar = xcd_barrier_post((unsigned*)(p.ws + WS_CTL) + CW_BAR, ldsctl + 8);
    int local_ok = 0;
    if (use_bar && threadIdx.x == 0) { const unsigned xcc = xb_xcc_id(); unsigned* plc = (unsigned*)(p.ws + WS_CTL) + CW_PLC + 64 * (blockIdx.x & 7);
        (void)__hip_atomic_fetch_max(plc, xcc + 1u, __ATOMIC_RELAXED, __HIP_MEMORY_SCOPE_AGENT); (void)__hip_atomic_fetch_max(plc + 1, 16u - xcc, __ATOMIC_RELAXED, __HIP_MEMORY_SCOPE_AGENT); }
#define LOCAL_BAR() do { PHASE_DELAY(); if (use_bar) { if (local_ok) grp_barrier((unsigned*)(p.ws + WS_CTL) + CW_LBAR + 128 * (blockIdx.x & 7), gridDim.x >> 3, bar.bar, wave0 == 0 && lane_id_opaque() == 0); \
                                                       else xcd_barrier(bar, wave0 == 0 && lane_id_opaque() == 0); } } while (0)
#define PH(k) (ph_lo <= (k) && (k) < ph_hi)
#define GRID_BAR() do { PHASE_DELAY(); if (use_bar) xcd_barrier(bar, wave0 == 0 && lane_id_opaque() == 0); } while (0)

    if (p.l_lo == 0 && PH(0)) for (int rep = 0; rep < NREP(0); ++rep) {
        PHASE_ENTER();
        LAS float* scr = (LAS float*)(lds + wave * 16384);
        int base = 0; TrStream S{};
        for (int jb = 0; jb < 4 * 12 + 2 * 3; ++jb) {
            TrJob j;
            if (jb < 48) { const int l = jb / 12, k = jb % 12; unsigned char* wl = ws + WS_W + (size_t)l * W_LAYER;
                switch (k) {
                case 0: j = TrJob{p.in[I_W_IN] + (size_t)l * D * INW, INW, D, 0, 2304, p.in[I_NORM_MIX] + l * D, (bf16_t*)(wl + W_IN), 0, 128, ((INPROJ8_MASK >> l) & 1) ? F8_WGU : 0.f}; break;
                case 1: j = TrJob{p.in[I_W_IN] + (size_t)l * D * INW, INW, D, 2320, 1024, p.in[I_NORM_MIX] + l * D, (bf16_t*)(wl + W_IN), 2304, 128, ((INPROJ8_MASK >> l) & 1) ? F8_WGU : 0.f}; break;
                case 9: j = TrJob{p.in[I_W_IN] + (size_t)l * D * INW, INW, D, 3344, 512, p.in[I_NORM_MIX] + l * D, (bf16_t*)(wl + W_IN), NMAIN, 128, ((MIX8_MASK >> l) & 1) ? F8_WGU : 0.f}; break;
                case 11: j = TrJob{p.in[I_W_IN] + (size_t)l * D * INW, INW, D, 2304, 32, p.in[I_NORM_MIX] + l * D, (bf16_t*)(wl + W_IN), 5376, 128, ((INPROJ8_MASK >> l) & 1) ? F8_WGU : 0.f}; break;
                case 10: j = TrJob{p.in[I_W_IN] + (size_t)l * D * INW, INW, D, 3856, 2048, p.in[I_NORM_MIX] + l * D, (bf16_t*)(wl + W_IN), 3328, 128, ((INPROJ8_MASK >> l) & 1) ? F8_WGU : 0.f}; break;
                case 2: j = TrJob{p.in[I_W_SSD_O] + (size_t)l * D * D, D, D, 0, D, p.in[I_SSD_NORM] + l * D, (bf16_t*)(wl + W_SSDO), 0, 128}; break;
                case 3: j = TrJob{p.in[I_W_SB_O] + (size_t)l * 512 * D, D, 512, 0, D, nullptr, (bf16_t*)(wl + W_SBO), 0, 128}; break;
                case 4: j = TrJob{p.in[I_W_OUT] + (size_t)l * D * D, D, D, 0, D, nullptr, (bf16_t*)(wl + W_OUT), 0, 128, ((MIX8_MASK >> l) & 1) ? F8_WGU : 0.f}; break;
                case 5: j = TrJob{p.in[I_XA_WQ] + (size_t)l * D * 512, 512, D, 0, 512, p.in[I_NORM_XA] + l * D, (bf16_t*)(wl + W_Q), 0, 128, ((MIX8_MASK >> l) & 1) ? F8_WGU : 0.f}; break;
                case 6: j = TrJob{p.in[I_XA_WK] + (size_t)l * D * 512, 512, D, 0, 512, p.in[I_NORM_MEM] + l * D, (bf16_t*)(ws + WS_WKV), l * 512, 128}; break;
                case 7: j = TrJob{p.in[I_XA_WV] + (size_t)l * D * 512, 512, D, 0, 512, p.in[I_NORM_MEM] + l * D, (bf16_t*)(ws + WS_WKV), 2048 + l * 512, 128}; break;
                case 8: j = TrJob{p.in[I_XA_WO] + (size_t)l * 512 * D, D, 512, 0, D, nullptr, (bf16_t*)(wl + W_O), 0, 128}; break;
                }
            } else { const int jj = (jb - 48) / 3, k = (jb - 48) % 3; unsigned char* wf = ws + WS_WFF + (size_t)jj * W_FF; const float* gn = p.in[I_NORM_FFN] + (2 * jj) * D;
                if (k == 0) j = TrJob{p.in[I_FFN_G] + (size_t)jj * D * DFF, DFF, D, 0, DFF, gn, (bf16_t*)(wf + W_GU), 0, 256, ((DENSE_GU8_MASK >> jj) & 1) ? F8_WGU : 0.f};
                else if (k == 1) j = TrJob{p.in[I_FFN_U] + (size_t)jj * D * DFF, DFF, D, 0, DFF, gn, (bf16_t*)(wf + W_GU), 128, 256, ((DENSE_GU8_MASK >> jj) & 1) ? F8_WGU : 0.f};
                else j = TrJob{p.in[I_FFN_D] + (size_t)jj * DFF * D, D, DFF, 0, D, nullptr, (bf16_t*)(wf + W_DN), 0, 128, ((DENSE_DN8_MASK >> jj) & 1) ? F8_WDN : 0.f};
            }
            run_job(S, j, base, gw, NGW, scr, lane);
        }
        tr_finish(S, scr, lane);
        bf16_t* MEMB = WSP(bf16_t, WS_MEMB); float* RSMEM = WSP(float, WS_RSMEM);
        for (int m = gw; m < TM; m += NGW) { const float q = row_to_bf16(p.in[I_MEM] + (size_t)m * D, MEMB + (size_t)m * D, lane); if (lane == 0) RSMEM[m] = __builtin_amdgcn_rsqf(q * (1.f / D) + EPS); }
        { bf16_t* HB = WSP(bf16_t, WS_HB); float* SSQ = WSP(float, WS_SSQ + (size_t)(12) * SSQ_BYTES);
          for (int m = gw; m < T; m += NGW) { const float q = row_to_bf16(p.in[I_X] + (size_t)m * D, HB + (size_t)m * D, lane); if (lane < 4) SSQ[(size_t)m * 4 + lane] = lane == 0 ? q : 0.f; } }
        for (int it = gw; it < 4 * 224; it += NGW) { const int l = it / 224, r = 5408 + it % 224;
            const u32x4 zz = {0u, 0u, 0u, 0u};
            if ((INPROJ8_MASK >> l) & 1) { u32x4* dst = (u32x4*)(WSP(unsigned char, WS_W + (size_t)l * W_LAYER + W_IN) + (size_t)r * 1024); dst[lane] = zz; }
            else { u32x4* dst = (u32x4*)(WSP(bf16_t, WS_W + (size_t)l * W_LAYER + W_IN) + (size_t)r * 1024); dst[lane] = zz; dst[lane + 64] = zz; } }
        GRID_BAR();
        if (use_bar && (G & 7) == 0) {
            if (tid == 0) { unsigned okv = 1u; const unsigned* plc = WSP(unsigned, WS_CTL) + CW_PLC;
                for (int v = 0; v < 8; ++v) okv &= (ld_u32_agent(plc + 64 * v) + ld_u32_agent(plc + 64 * v + 1) == 17u) ? 1u : 0u;
                ldsctl[12] = okv; }
            __syncthreads();
            local_ok = (int)__builtin_amdgcn_readfirstlane(ldsctl[12]);
        }
    }
    if (p.l_lo == 0 && PH(1)) for (int rep = 0; rep < NREP(1); ++rep) {
        PHASE_ENTER();
        { pg8::Gemm g{WSP(bf16_t, WS_MEMB), WSP(bf16_t, WS_WKV), D, D, D}; pg8::StaticOrder S; S.init(TM, 2048, G, bid);
          pg8::EpiBf16Rs E{WSP(bf16_t, WS_KM), 2048, WSP(float, WS_RSMEM), 1.f, 0};
          pg8::gemm_phase<pg8::EpiBf16Rs, pg8::StaticOrder, true, true>(lds, g, S, E, wave0); }
        { pg8::Gemm g{WSP(bf16_t, WS_WKV) + (size_t)2048 * 1024, WSP(bf16_t, WS_MEMB), D, D, D}; pg8::StaticOrder S; S.init(2048, TM, G, (bid + G / 2) % G);
          pg8::EpiBf16Cs E{WSP(bf16_t, WS_VTM), TM, WSP(float, WS_RSMEM), 1.f, 0};
          pg8::gemm_phase<pg8::EpiBf16Cs, pg8::StaticOrder, true, true>(lds, g, S, E, wave0); }
        GRID_BAR();
    }

    for (int l = p.l_lo; l < p.l_hi; ++l) {
        const bool moe = (l & 1) != 0; const int jf = l >> 1;

        if (PH(3)) for (int rep = 0; rep < NREP(3); ++rep) {
            PHASE_ENTER();
            const bool in8 = (INPROJ8_MASK >> l) & 1;
            pg8::Gemm g{in8 ? WSP(bf16_t, WS_X + X_HB8) : WSP(bf16_t, WS_HB), (const bf16_t*)(ws + WS_W + (size_t)l * W_LAYER + W_IN), D, D, D}; pg8::StaticOrder S; S.init(T / 8, NMAIN, RG, rg); S.pm0 = 16 * vg;
            pg8::EpiInProj E{ws + WS_X, WSP(float, WS_SSQ + (size_t)(l == 0 ? 12 : 3 * l - 1) * SSQ_BYTES), WSP(float, WS_RS), WSP(float, WS_DT), p.in[I_DT_BIAS] + l * 16, in8 ? 1.f / F8_WGU : 1.f};
            if (in8) pg8::gemm_phase<pg8::EpiInProj, pg8::StaticOrder, true, true, true>(lds, g, S, E, wave0);
            else pg8::gemm_phase<pg8::EpiInProj, pg8::StaticOrder, true, true, false>(lds, g, S, E, wave0);
            LOCAL_BAR();
        }
        if (PH(4)) for (int rep = 0; rep < NREP(4); ++rep) {
            PHASE_ENTER();
            const float* cw = p.in[I_CONV_W] + (size_t)l * 4 * 1280; const float* cb = p.in[I_CONV_B] + (size_t)l * 1280;
            for (int u = rg * 8 + wave; u < (T / 8 / 64) * 10; u += RG * 8) conv_unit(WSP(bf16_t, WS_X + X_XBC), cw, cb, WSP(bf16_t, WS_X + X_XT), WSP(bf16_t, WS_X + X_BR), WSP(bf16_t, WS_X + X_BT), WSP(bf16_t, WS_X + X_CR), vg * ((T / 8 / 64) * 10) + u, lane);
            { const bool v8 = (MIX8_MASK >> l) & 1;
              pg8::Gemm g{(const bf16_t*)(ws + WS_W + (size_t)l * W_LAYER + W_IN + (size_t)NMAIN * 1024 * (v8 ? 1 : 2)), v8 ? WSP(bf16_t, WS_X + X_HB8) : WSP(bf16_t, WS_HB), D, D, D}; pg8::StaticOrder S; S.init(512, T / 8, RG, rg); S.pn0 = 16 * vg;
              pg8::EpiBf16Cs E{WSP(bf16_t, WS_X + X_V), T, WSP(float, WS_RS), v8 ? 1.f / F8_WGU : 1.f, 512};
              if (v8) pg8::gemm_phase<pg8::EpiBf16Cs, pg8::StaticOrder, true, true, true>(lds, g, S, E, wave0);
              else pg8::gemm_phase<pg8::EpiBf16Cs, pg8::StaticOrder, true, true, false>(lds, g, S, E, wave0); }
            if (moe)
                moe_convert(p, ws, l, jf, l == 1 ? 7 : 4, gw, NGW, (LAS float*)(lds + wave * 16384), lane);
            LOCAL_BAR();
        }
        if (PH(5)) for (int rep = 0; rep < NREP(5); ++rep) {
            PHASE_ENTER();
            const int pvar = (rep + 1 < NREP(5)) ? PROBE_VAR : 0;
            if (!(pvar & 1)) for (int u = rg; u < 32; u += RG) { const int b = 2 * vg + (u >> 4), h = u & 15;
                __syncthreads();
                ssd_scan_block(WSP(bf16_t, WS_X + X_XT), WSP(bf16_t, WS_X + X_BT), WSP(float, WS_DT), WSP(bf16_t, WS_X + X_PREV), -fexp(p.in[I_A_LOG][l * 16 + h]), b, h, wave, lane, (LAS float*)(lds + wave * 1024), (LAS float*)(lds + 8192)); }
            if (!(pvar & 2)) sb_attn_mfma(WSP(bf16_t, WS_X + X_Q), WSP(bf16_t, WS_X + X_K), WSP(bf16_t, WS_X + X_V), (rep + 1 < NREP(5)) ? WSP(bf16_t, WS_X + X_XBC) : WSP(bf16_t, WS_X + X_Q), vg, rg, RG, wave, lane);
            LOCAL_BAR();
        }
        if (PH(6)) for (int rep = 0; rep < NREP(6); ++rep) {
            PHASE_ENTER();
            for (int u = rg; u < 64; u += RG) { const int b = 2 * vg + (u >> 5), c = (u >> 1) & 15, g = u & 1; const int h = g * 8 + wave;
                ssd_out_unit(WSP(bf16_t, WS_X + X_XT), WSP(bf16_t, WS_X + X_BR), WSP(bf16_t, WS_X + X_CR), WSP(float, WS_DT), WSP(bf16_t, WS_X + X_PREV), WSP(bf16_t, WS_X + X_Z), WSP(bf16_t, WS_X + X_XBC),
                             -fexp(p.in[I_A_LOG][l * 16 + h]), p.in[I_D_SKIP][l * 16 + h], b, c, g, wave, lane, (LAS float*)(lds + wave * 2048), (LAS float*)(lds + 16384), (LAS float*)(lds + 32768), (rep + 1 < NREP(6)) ? PROBE_VAR : 0); }
            LOCAL_BAR();
        }
        if (PH(7)) for (int rep = 0; rep < NREP(7); ++rep) {
            PHASE_ENTER();
            pg8::Gemm g{WSP(bf16_t, WS_X + X_XBC), (const bf16_t*)(ws + WS_W + (size_t)l * W_LAYER + W_SSDO), 1280, D, D};   pg8::StaticOrder S; S.init(T / 8, D, RG, rg); S.pm0 = 16 * vg;
            pg8::EpiGate<false> E{WSP(bf16_t, WS_X + X_Z), WSP(bf16_t, WS_X + X_GS), 0, WSP(bf16_t, WS_X + X_Z)};
            pg8::gemm_phase<pg8::EpiGate<false>, pg8::StaticOrder, true, true>(lds, g, S, E, wave0);
            PHASE_DELAY();
        }
        if (PH(8)) for (int rep = 0; rep < NREP(8); ++rep) {
            PHASE_ENTER();
            pg8::Gemm g{WSP(bf16_t, WS_X + X_Q), (const bf16_t*)(ws + WS_W + (size_t)l * W_LAYER + W_SBO), 512, 512, 512}; pg8::StaticOrder S; S.init(T / 8, D, RG, rg); S.pm0 = 16 * vg;
            if ((MIX8_MASK >> l) & 1) {
                pg8::EpiGate<true, true> E{WSP(bf16_t, WS_X + X_Z), WSP(bf16_t, WS_X + X_GS), 1024, WSP(bf16_t, WS_X + X_Z), WSP(unsigned char, WS_X + X_XT)};
                pg8::gemm_phase<pg8::EpiGate<true, true>, pg8::StaticOrder, true, true>(lds, g, S, E, wave0);
            } else {
            pg8::EpiGate<true> E{(rep + 1 < NREP(8)) ? WSP(bf16_t, WS_X + X_XT) : WSP(bf16_t, WS_X + X_Z), WSP(bf16_t, WS_X + X_GS), 1024, WSP(bf16_t, WS_X + X_Z)};
            pg8::gemm_phase<pg8::EpiGate<true>, pg8::StaticOrder, true, true>(lds, g, S, E, wave0); }
            LOCAL_BAR();
        }
        if (PH(9)) for (int rep = 0; rep < NREP(9); ++rep) {
            PHASE_ENTER();
            if ((MIX8_MASK >> l) & 1) {
                pg8::Gemm g{WSP(bf16_t, WS_X + X_XT), (const bf16_t*)(ws + WS_W + (size_t)l * W_LAYER + W_OUT), 2048, D, D}; pg8::StaticOrder S; S.init(T / 8, D, RG, rg); S.pm0 = 16 * vg;
                pg8::EpiResidBfT<true, true> E{WSP(bf16_t, WS_HB), WSP(bf16_t, WS_HB), WSP(float, WS_SSQ + (size_t)(3 * l) * SSQ_BYTES), (LAS float*)(lds + 131072), WSP(unsigned char, WS_X + X_HB8), 1.f / F8_WGU};
                pg8::gemm_phase<pg8::EpiResidBfT<true, true>, pg8::StaticOrder, true, true, true>(lds, g, S, E, wave0);
            } else {
            pg8::Gemm g{WSP(bf16_t, WS_X + X_Z), (const bf16_t*)(ws + WS_W + (size_t)l * W_LAYER + W_OUT), D, D, D}; pg8::StaticOrder S; S.init(T / 8, D, RG, rg); S.pm0 = 16 * vg;
            pg8::EpiResidBf E{WSP(bf16_t, WS_HB), (rep + 1 < NREP(9)) ? WSP(bf16_t, WS_X + X_XT) : WSP(bf16_t, WS_HB), WSP(float, WS_SSQ + (size_t)((rep + 1 < NREP(9)) ? 13 : 3 * l) * SSQ_BYTES), (LAS float*)(lds + 131072)};
            pg8::gemm_phase<pg8::EpiResidBf, pg8::StaticOrder, true, true>(lds, g, S, E, wave0); }
            LOCAL_BAR();
        }
        if (PH(11)) for (int rep = 0; rep < NREP(11); ++rep) {
            PHASE_ENTER();
            const bool q8 = (MIX8_MASK >> l) & 1;
            pg8::Gemm g{q8 ? WSP(bf16_t, WS_X + X_HB8) : WSP(bf16_t, WS_HB), (const bf16_t*)(ws + WS_W + (size_t)l * W_LAYER + W_Q), D, D, D}; pg8::StaticOrder S; S.init(T / 8, 512, RG, rg); S.pm0 = 16 * vg;
            pg8::EpiBf16Rs E{WSP(bf16_t, WS_X + X_K), 512, WSP(float, WS_SSQ + (size_t)(3 * l) * SSQ_BYTES), 0.12751743082459868f * (q8 ? 1.f / F8_WGU : 1.f), 1};
            if (q8) pg8::gemm_phase<pg8::EpiBf16Rs, pg8::StaticOrder, true, true, true>(lds, g, S, E, wave0);
            else pg8::gemm_phase<pg8::EpiBf16Rs, pg8::StaticOrder, true, true, false>(lds, g, S, E, wave0);
            LOCAL_BAR();
        }
        if (PH(12)) for (int rep = 0; rep < NREP(12); ++rep) {
            PHASE_ENTER();
            xattn_lds(WSP(bf16_t, WS_X + X_K), WSP(bf16_t, WS_KM) + l * 512, WSP(bf16_t, WS_VTM) + (size_t)l * 512 * TM, WSP(bf16_t, WS_X + X_V), vg, rg, RG, tid, wave, lane, lds);
            LOCAL_BAR();
        }
        if (PH(13)) for (int rep = 0; rep < NREP(13); ++rep) {
            PHASE_ENTER();
            pg8::Gemm g{WSP(bf16_t, WS_X + X_V), (const bf16_t*)(ws + WS_W + (size_t)l * W_LAYER + W_O), 512, 512, 512}; pg8::StaticOrder S; S.init(T / 8, D, RG, rg); S.pm0 = 16 * vg;
            pg8::EpiResidBfT<true, false> E{WSP(bf16_t, WS_HB), (rep + 1 < NREP(13)) ? WSP(bf16_t, WS_X + X_XT) : WSP(bf16_t, WS_HB), WSP(float, WS_SSQ + (size_t)((rep + 1 < NREP(13)) ? 13 : 3 * l + 1) * SSQ_BYTES), (LAS float*)(lds + 131072),
                                            WSP(unsigned char, WS_X + X_HB8), 1.f};
            pg8::gemm_phase<pg8::EpiResidBfT<true, false>, pg8::StaticOrder, true, true>(lds, g, S, E, wave0);
            if (moe) LOCAL_BAR(); else GRID_BAR();
        }
        if (moe && PH(14)) for (int rep = 0; rep < NREP(14); ++rep) {
            PHASE_ENTER();
            const bf16_t* HB = WSP(bf16_t, WS_HB); float* RS = WSP(float, WS_RS); const float* SSQ = WSP(float, WS_SSQ + (size_t)(3 * l + 1) * SSQ_BYTES);
            int* TE = WSP(int, WS_MOE + MO_TE); float* TW = WSP(float, WS_MOE + MO_TW); int* TP = WSP(int, WS_MOE + MO_TP); unsigned* CNT = WSP(unsigned, WS_CTL) + CW_CNT + jf * 1024;
            LAS float* wsm = (LAS float*)lds;
            LAS unsigned* lcnt = (LAS unsigned*)(lds + 32768); LAS unsigned* lbase = lcnt + 16;
            LAS int* le = (LAS int*)(lds + 32768 + 128); LAS int* lp = le + 256;
#pragma unroll
            for (int q = 0; q < 16; ++q) { const int i = tid + 512 * q; const int e = i >> 10, k = i & 1023; wsm[i] = p.in[I_MOE_R][(size_t)jf * D * NEXP + (size_t)k * NEXP + e] * p.in[I_NORM_FFN][l * D + k]; }
            const int gwl = rg * 8 + wave, NGL = RG * 8, tok0 = vg * (T / 8);
            for (int k0 = 0; gwl + k0 * NGL < T / 8; k0 += 16) {
                __syncthreads();
                if (tid < 16) lcnt[tid] = 0u;
                __syncthreads();
                u32x2 xn[4]; f32x4 qn = {0.f, 0.f, 0.f, 0.f};
                { const int ml0 = gwl + k0 * NGL; const int m0 = tok0 + (ml0 < T / 8 ? ml0 : 0);
#pragma unroll
                  for (int j = 0; j < 4; ++j) xn[j] = ((const u32x2*)(HB + (size_t)m0 * D) + lane)[64 * j];
                  qn = *(const f32x4*)(SSQ + (size_t)m0 * 4); }
                for (int k = 0; k < 16; ++k) { const int ml = gwl + (k0 + k) * NGL; if (ml >= T / 8) break; const int m = tok0 + ml;
                    u32x2 xc[4];
#pragma unroll
                    for (int j = 0; j < 4; ++j) xc[j] = xn[j];
                    float lg[8]; const float r = rstd_of((qn.x + qn.y) + (qn.z + qn.w));
                    { const int mln = gwl + (k0 + k + 1) * NGL; const int mn = tok0 + ((k + 1 < 16 && mln < T / 8) ? mln : ml);
#pragma unroll
                      for (int j = 0; j < 4; ++j) xn[j] = ((const u32x2*)(HB + (size_t)mn * D) + lane)[64 * j];
                      qn = *(const f32x4*)(SSQ + (size_t)mn * 4); }
                    row_dots_raw<8>(xc, lane, wsm, r, lg);
                    if (lane == 0) { RS[m] = r;
                        int i0 = 0; float v0 = lg[0];
#pragma unroll
                        for (int e = 1; e < 8; ++e) if (lg[e] > v0) { v0 = lg[e]; i0 = e; }
                        int i1 = -1; float v1 = -3.0e38f;
#pragma unroll
                        for (int e = 0; e < 8; ++e) if (e != i0 && lg[e] > v1) { v1 = lg[e]; i1 = e; }
                        const float w0 = __builtin_amdgcn_rcpf(1.f + fexp(v1 - v0));
                        const int li = k * 8 + wave;
                        le[li] = i0; le[128 + li] = i1;
                        lp[li] = (int)__hip_atomic_fetch_add(lcnt + i0, 1u, __ATOMIC_RELAXED, __HIP_MEMORY_SCOPE_WORKGROUP);
                        lp[128 + li] = (int)__hip_atomic_fetch_add(lcnt + 8 + i1, 1u, __ATOMIC_RELAXED, __HIP_MEMORY_SCOPE_WORKGROUP);
                        TE[m] = i0; TE[T + m] = i1; TW[m] = w0; TW[T + m] = 1.f - w0; }
                }
                __syncthreads();
                if (tid < 16 && rep + 1 == NREP(14)) lbase[tid] = atomicAdd(CNT + tid * 64, lcnt[tid]);
                __syncthreads();
                if (rep + 1 == NREP(14))
                for (int li = tid; li < 256; li += 512) { const int sl = li >> 7, idx = li & 127, ml = (rg * 8 + (idx & 7)) + (k0 + (idx >> 3)) * NGL;
                    if (ml < T / 8) TP[sl * T + tok0 + ml] = (int)lbase[sl * 8 + le[li]] + lp[li]; }
            }
            GRID_BAR();
        }
        if (!moe) {
            if (PH(15)) for (int rep = 0; rep < NREP(15); ++rep) {
                PHASE_ENTER();
#define DENSE_GU(GU8, DN8) do { pg8::Gemm g{GU8 ? WSP(bf16_t, WS_X + X_HB8) : WSP(bf16_t, WS_HB), (const bf16_t*)(ws + WS_WFF + (size_t)jf * W_FF + W_GU), D, D, D}; pg8::StaticOrder S; S.init(T / 8, 2 * DFF, RG, rg); S.pm0 = 16 * vg; \
                pg8::EpiSwigluT<DN8> E{WSP(bf16_t, WS_X + X_ACT), WSP(float, WS_SSQ + (size_t)(3 * l + 1) * SSQ_BYTES), 1, GU8 ? 1.f / F8_WGU : 1.f}; \
                pg8::gemm_phase<pg8::EpiSwigluT<DN8>, pg8::StaticOrder, true, true, GU8>(lds, g, S, E, wave0); } while (0)
                const bool gu8 = (DENSE_GU8_MASK >> jf) & 1, dn8 = (DENSE_DN8_MASK >> jf) & 1;
                if (gu8 && dn8) DENSE_GU(true, true); else if (gu8) DENSE_GU(true, false); else if (dn8) DENSE_GU(false, true); else DENSE_GU(false, false);
                LOCAL_BAR();
            }
            if (PH(16)) for (int rep = 0; rep < NREP(16); ++rep) {
                PHASE_ENTER();
                pg8::Gemm g{WSP(bf16_t, WS_X + X_ACT), (const bf16_t*)(ws + WS_WFF + (size_t)jf * W_FF + W_DN), DFF, DFF, DFF}; pg8::StaticOrder S; S.init(T / 8, D, RG, rg); S.pm0 = 16 * vg;
                pg8::EpiResidBfT<true, true> E{WSP(bf16_t, WS_HB), (rep + 1 < NREP(16)) ? WSP(bf16_t, WS_X + X_GS) : WSP(bf16_t, WS_HB), WSP(float, WS_SSQ + (size_t)((rep + 1 < NREP(16)) ? 13 : 3 * l + 2) * SSQ_BYTES), (LAS float*)(lds + 131072),
                                               WSP(unsigned char, WS_X + X_HB8), ((DENSE_DN8_MASK >> jf) & 1) ? 1.f / F8_WDN : 1.f};
                if ((DENSE_DN8_MASK >> jf) & 1) pg8::gemm_phase<pg8::EpiResidBfT<true, true>, pg8::StaticOrder, true, true, true>(lds, g, S, E, wave0);
                else pg8::gemm_phase<pg8::EpiResidBfT<true, true>, pg8::StaticOrder, true, true, false>(lds, g, S, E, wave0);
                GRID_BAR();
            }
        } else {
            if (PH(15)) for (int rep = 0; rep < NREP(15); ++rep) {
                PHASE_ENTER();
                const bf16_t* HB = WSP(bf16_t, WS_HB); const float* RS = WSP(float, WS_RS); bf16_t* XG = WSP(bf16_t, WS_X + X_XG);
                const int* TE = WSP(int, WS_MOE + MO_TE); const float* TW = WSP(float, WS_MOE + MO_TW); const int* TP = WSP(int, WS_MOE + MO_TP); unsigned* CNT = WSP(unsigned, WS_CTL) + CW_CNT + jf * 1024;
                int* ROWL = WSP(int, WS_MOE + MO_ROWL); float* WROW = WSP(float, WS_MOE + MO_WROW); float* RSG = WSP(float, WS_MOE + MO_RSG);
                unsigned* PEXP = WSP(unsigned, WS_MOE + MO_PEXP); unsigned* NPAN = WSP(unsigned, WS_MOE + MO_NPAN);
                const unsigned cntv = ld_u32_agent(CNT + (lane & 15) * 64);
#pragma unroll
                for (int s = 0; s < 2; ++s) {
                    int off[9]; { int a = 0;
#pragma unroll
                        for (int e = 0; e < 8; ++e) { off[e] = a; a += ((int)__builtin_amdgcn_readlane(cntv, s * 8 + e) + 255) & ~255; }
                        off[8] = a; }
                    if (bid == 0 && tid == 0) { NPAN[s] = (unsigned)(off[8] >> 8);
#pragma unroll
                        for (int e = 0; e < 8; ++e) for (int pnl = off[e] >> 8; pnl < (off[e + 1] >> 8); ++pnl) PEXP[s * 256 + pnl] = (unsigned)e; }
                    for (int m0 = gw; m0 < T; m0 += 4 * NGW) {
                        int rowq[4]; float twq[4], rsq[4];
#pragma unroll
                        for (int q = 0; q < 4; ++q) { const int m = m0 + q * NGW < T ? m0 + q * NGW : m0; const int e = TE[s * T + m]; int o = 0;
#pragma unroll
                            for (int k = 0; k < 8; ++k) o = (e == k) ? off[k] : o;
                            rowq[q] = o + TP[s * T + m]; twq[q] = TW[s * T + m]; rsq[q] = RS[m]; }
                        u32x4 r0[4], r1[4];
#pragma unroll
                        for (int q = 0; q < 4; ++q) { const int m = m0 + q * NGW < T ? m0 + q * NGW : m0;
                            if (MOE_F8_GU) { r0[q] = ((const u32x4*)(WSP(unsigned char, WS_X + X_HB8) + (size_t)m * D))[lane]; r1[q] = r0[q]; }
                            else { const u32x4* src = (const u32x4*)(HB + (size_t)m * D); r0[q] = src[lane]; r1[q] = src[lane + 64]; } }
#pragma unroll
                        for (int q = 0; q < 4; ++q) { const int m = m0 + q * NGW; if (m < T) { const int row = rowq[q];
                            if (MOE_F8_GU) { u32x4* dst = (u32x4*)((unsigned char*)XG + ((size_t)s * MOE_ROWS + row) * D); dst[lane] = r0[q]; }
                            else { u32x4* dst = (u32x4*)(XG + ((size_t)s * MOE_ROWS + row) * D); dst[lane] = r0[q]; dst[lane + 64] = r1[q]; }
                            if (lane == 0) { ROWL[s * MOE_ROWS + row] = m; WROW[s * MOE_ROWS + row] = twq[q]; RSG[s * MOE_ROWS + row] = rsq[q]; } } } }
#pragma unroll
                    for (int e = 0; e < 8; ++e) { const int c = (int)__builtin_amdgcn_readlane(cntv, s * 8 + e); const int lo = off[e] + c, hi = off[e + 1];
                        for (int row = lo + gw; row < hi; row += NGW) { unsigned z0 = 0u; asm volatile("" : "+v"(z0)); const u32x4 zz = {z0, z0, z0, z0};
                            if (MOE_F8_GU) { u32x4* dst = (u32x4*)((unsigned char*)XG + ((size_t)s * MOE_ROWS + row) * D); dst[lane] = zz; }
                            else { u32x4* dst = (u32x4*)(XG + ((size_t)s * MOE_ROWS + row) * D); dst[lane] = zz; dst[lane + 64] = zz; }
                            if (lane == 0) { ROWL[s * MOE_ROWS + row] = -1; WROW[s * MOE_ROWS + row] = 0.f; RSG[s * MOE_ROWS + row] = 0.f; } } }
                }
                GRID_BAR();
            }
            if (PH(16)) for (int rep = 0; rep < NREP(16); ++rep) {
                PHASE_ENTER();
                const int npan = (int)__builtin_amdgcn_readfirstlane(ld_u32_agent(WSP(unsigned, WS_MOE + MO_NPAN)));
                LAS unsigned* PXL = (LAS unsigned*)(lds + 131072 + 8192); pg8::moe_pexp_to_lds(WSP(unsigned, WS_MOE + MO_PEXP), PXL, tid);
                pg8::Gemm g{WSP(bf16_t, WS_X + X_XG), WSP(bf16_t, WS_WMOE + WM_GU), D, D, D}; pg8::MoeOrder S; S.init(npan, 2 * DFF / 256, G, bid, PXL);
                pg8::EpiSwigluT<(bool)MOE_F8_DN> E{WSP(bf16_t, WS_X + X_ACT), WSP(float, WS_MOE + MO_RSG), 0, MOE_F8_GU ? 1.f / F8_WGU : 1.f};
                pg8::gemm_phase<pg8::EpiSwigluT<(bool)MOE_F8_DN>, pg8::MoeOrder, true, true, (bool)MOE_F8_GU>(lds, g, S, E, wave0);
                {
                  const int n0 = npan * (2 * DFF / 256), f0 = n0 % G;
                  const int npan1 = (int)__builtin_amdgcn_readfirstlane(ld_u32_agent(WSP(unsigned, WS_MOE + MO_NPAN) + 1));
                  pg8::Gemm g1{(const bf16_t*)(ws + WS_X + X_XG + (size_t)MOE_ROWS * D * (MOE_F8_GU ? 1 : 2)), WSP(bf16_t, WS_WMOE + WM_GU), D, D, D};
                  pg8::MoeOrder S1; S1.init(npan1, 2 * DFF / 256, 1 << 28, (f0 > 0 && bid >= f0) ? bid - f0 : (1 << 28), PXL + 256);
                  pg8::EpiSwigluT<(bool)MOE_F8_DN> E1{WSP(bf16_t, WS_X + X_ACT2), WSP(float, WS_MOE + MO_RSG) + MOE_ROWS, 0, MOE_F8_GU ? 1.f / F8_WGU : 1.f};
                  pg8::gemm_phase<pg8::EpiSwigluT<(bool)MOE_F8_DN>, pg8::MoeOrder, true, true, (bool)MOE_F8_GU>(lds, g1, S1, E1, wave0); }
                GRID_BAR();
            }
            if (PH(17)) {
                PHASE_ENTER();
                LAS unsigned* PXL = (LAS unsigned*)(lds + 131072 + 8192); pg8::moe_pexp_to_lds(WSP(unsigned, WS_MOE + MO_PEXP), PXL, tid);
                { const int npan = (int)__builtin_amdgcn_readfirstlane(ld_u32_agent(WSP(unsigned, WS_MOE + MO_NPAN)));
                  pg8::Gemm g{WSP(bf16_t, WS_X + X_ACT), WSP(bf16_t, WS_WMOE + WM_DN), DFF, DFF, DFF}; pg8::MoeOrder S; S.init(npan, D / 256, G, bid, PXL);
                  pg8::EpiMoeDown E{WSP(bf16_t, WS_HB), WSP(int, WS_MOE + MO_ROWL), WSP(float, WS_MOE + MO_WROW), WSP(bf16_t, WS_HB), nullptr, (LAS float*)(lds + 131072), MOE_F8_DN ? 1.f / F8_WDN : 1.f};
                  pg8::gemm_phase<pg8::EpiMoeDown, pg8::MoeOrder, true, true, (bool)MOE_F8_DN>(lds, g, S, E, wave0); }
                { const int npan = (int)__builtin_amdgcn_readfirstlane(ld_u32_agent(WSP(unsigned, WS_MOE + MO_NPAN) + 1));
                  pg8::Gemm g{(const bf16_t*)(ws + WS_X + X_XG + (size_t)MOE_ROWS * D * (MOE_F8_GU ? 1 : 2)), WSP(bf16_t, WS_WMOE + WM_GU), D, D, D}; pg8::MoeOrder S; S.init(npan, 2 * DFF / 256, G, bid, PXL + 256);
                  {
                    const int npan0 = (int)__builtin_amdgcn_readfirstlane(ld_u32_agent(WSP(unsigned, WS_MOE + MO_NPAN)));
                    const int n0 = npan0 * (2 * DFF / 256), f0 = n0 % G, n1 = npan * (2 * DFF / 256); int F = f0 > 0 ? G - f0 : 0; F = F < n1 ? F : n1;
                    const int h9 = (npan0 * (D / 256)) % G, heavy = bid < h9;
                    S.ne = heavy ? 0 : 2; S.stride0 = G - h9; S.c0 = bid - h9; S.base0 = F; S.base1 = (long)F + 2 * (G - h9); S.c = heavy ? G - h9 + bid : bid - h9; }
                  pg8::EpiSwigluT<(bool)MOE_F8_DN> E{WSP(bf16_t, WS_X + X_ACT2), WSP(float, WS_MOE + MO_RSG) + MOE_ROWS, 0, MOE_F8_GU ? 1.f / F8_WGU : 1.f};
                  pg8::gemm_phase<pg8::EpiSwigluT<(bool)MOE_F8_DN>, pg8::MoeOrder, true, true, (bool)MOE_F8_GU>(lds, g, S, E, wave0); }
                GRID_BAR();
            }
            if (PH(19)) for (int rep = 0; rep < NREP(19); ++rep) {
                PHASE_ENTER();
                LAS unsigned* PXL = (LAS unsigned*)(lds + 131072 + 8192); pg8::moe_pexp_to_lds(WSP(unsigned, WS_MOE + MO_PEXP), PXL, tid);
                const int npan = (int)__builtin_amdgcn_readfirstlane(ld_u32_agent(WSP(unsigned, WS_MOE + MO_NPAN) + 1));
                pg8::Gemm g{WSP(bf16_t, WS_X + X_ACT2), WSP(bf16_t, WS_WMOE + WM_DN), DFF, DFF, DFF}; pg8::MoeOrder S; S.init(npan, D / 256, G, bid, PXL + 256);
                pg8::EpiMoeDown E{WSP(bf16_t, WS_HB), WSP(int, WS_MOE + MO_ROWL) + MOE_ROWS, WSP(float, WS_MOE + MO_WROW) + MOE_ROWS, (rep + 1 < NREP(19)) ? WSP(bf16_t, WS_X + X_GS) : WSP(bf16_t, WS_HB),
                                  WSP(float, WS_SSQ + (size_t)((rep + 1 < NREP(19)) ? 13 : 3 * l + 2) * SSQ_BYTES), (LAS float*)(lds + 131072), MOE_F8_DN ? 1.f / F8_WDN : 1.f, WSP(unsigned char, WS_X + X_HB8)};
                pg8::gemm_phase<pg8::EpiMoeDown, pg8::MoeOrder, true, true, (bool)MOE_F8_DN>(lds, g, S, E, wave0);
                if (l + 2 < DEPTH && rep + 1 == NREP(19)) {
                    const int nx = npan * (D / 256) - 2 * G > 0 ? npan * (D / 256) - 2 * G : 0;
                    if (bid >= nx) moe_convert(p, ws, l + 2, jf + 1, 3, (bid - nx) * 8 + wave, (G - nx) * 8, (LAS float*)(lds + wave * 16384), lane);
                }
                GRID_BAR();
            }
        }
    }
    if (p.l_hi == DEPTH && PH(20)) {
        PHASE_ENTER();
        const float* gf = p.in[I_FINAL]; float* O = p.out; const bf16_t* HB = WSP(bf16_t, WS_HB); const float* SSQ = WSP(float, WS_SSQ + (size_t)(3 * DEPTH - 1) * SSQ_BYTES);
        for (int m = gw; m < T; m += NGW) { const float rstd = rstd4(SSQ + (size_t)m * 4); const u32x2* xr = (const u32x2*)(HB + (size_t)m * D) + lane; f32x4* orow = (f32x4*)(O + (size_t)m * D) + lane;
#pragma unroll
            for (int j = 0; j < 4; ++j) { const u32x2 w = xr[64 * j]; const f32x4 g4 = *((const f32x4*)gf + lane + 64 * j); orow[64 * j] = (f32x4){bflo(w.x), bfhi(w.x), bflo(w.y), bfhi(w.y)} * rstd * g4; } }
        PHASE_DELAY();
    }
#undef PH
#undef GRID_BAR
}

extern "C" void kernel_launch(void* const* d_in, const int* in_sizes, int n_in, void* d_out, int out_size, void* d_ws, size_t ws_size, hipStream_t stream) {
    static int grid = 0;
    if (grid == 0) {
        if (n_in != 28 || out_size != T * D || ws_size < WS_END) { fprintf(stderr, "kernel_launch: unexpected problem (n_in %d, out %d, ws %zu < %zu)\n", n_in, out_size, ws_size, (size_t)WS_END); grid = -1; return; }
        int dev = 0, cus = 0;
        if (hipGetDevice(&dev) != hipSuccess || hipDeviceGetAttribute(&cus, hipDeviceAttributeMultiprocessorCount, dev) != hipSuccess) { grid = -1; return; }
        if (hipFuncSetAttribute((const void*)mk_fwd, hipFuncAttributeMaxDynamicSharedMemorySize, LDS_BYTES) != hipSuccess) { fprintf(stderr, "kernel_launch: hipFuncSetAttribute failed\n"); grid = -1; return; }
        int per_cu = 0;
        if (hipOccupancyMaxActiveBlocksPerMultiprocessor(&per_cu, (const void*)mk_fwd, 512, LDS_BYTES) != hipSuccess || per_cu < 1) { fprintf(stderr, "kernel_launch: occupancy query says %d\n", per_cu); (void)hipGetLastError(); }
        grid = cus;
    }
    if (grid < 0) return;
    (void)hipMemsetAsync((char*)d_ws + WS_CTL, 0, 1 * MiB, stream);
    Params p{};
    for (int i = 0; i < 28; ++i) p.in[i] = (const float*)d_in[i];
    p.out = (float*)d_out; p.ws = (unsigned char*)d_ws;
#if MK_ONE_LAUNCH
    p.l_lo = 0; p.l_hi = DEPTH; p.ph_lo = 0; p.ph_hi = 21;
    hipLaunchKernelGGL(mk_fwd, dim3(grid), dim3(512), LDS_BYTES, stream, p);
#else
    auto launch = [&](int l, int ph) { p.l_lo = l; p.l_hi = l + 1; p.ph_lo = ph; p.ph_hi = ph + 1; hipLaunchKernelGGL(mk_fwd, dim3(grid), dim3(512), LDS_BYTES, stream, p); };
    launch(0, 0); launch(0, 1);
    for (int l = 0; l < DEPTH; ++l) { const int last = (l & 1) ? 19 : 16; for (int ph = 2; ph <= last; ++ph) launch(l, ph); }
    launch(DEPTH - 1, 20);
#endif
}
```
